# Optimizing an MI355X kernel written in HIP

```python
import math
import jax, jax.numpy as jnp
from jax import lax
import numpy as np

D_MODEL = 2048
BATCH = 1
SEQ = 16384
DEPTH = 2

GLA_HEADS = 4
GLA_DK = 128
GLA_DV = 256
GLA_GATE_RANK = 16
GLA_GATE_NORMALIZER = 16.0
GLA_CHUNK = 64
MOBA_HEADS = 8
MOBA_HD = 128
MOBA_BLOCK = 256
MOBA_TOPK = 3
MOBA_QCHUNK = 64
ROPE_THETA = 10000.0
GLA_QK_W = GLA_HEADS * GLA_DK
GLA_V_W = GLA_HEADS * GLA_DV
MOBA_W = MOBA_HEADS * MOBA_HD
MIX_W = GLA_V_W + MOBA_W
IN_SIZES = [GLA_QK_W, GLA_QK_W, GLA_V_W, GLA_V_W, GLA_GATE_RANK, MOBA_W, MOBA_W, MOBA_W]
D_IN = sum(IN_SIZES)
IN_SPLITS = [int(s) for s in np.cumsum(IN_SIZES)[:-1]]
N_EXPERTS = 16
N_GROUPS = 4
EXPERTS_PER_GROUP = N_EXPERTS // N_GROUPS
TOP_K = 2
D_EXPERT = 1024
DN_ALPHA = (2.0 * DEPTH) ** 0.25
DN_BETA = (8.0 * DEPTH) ** -0.25
LN_EPS = 1e-5
RMS_EPS = 1e-6
NEG = -1e30

kernel_name = "hybrid_gla_moba_shared_router_moe_deepnorm"


def layer_norm(x, g, b):
    xf = x.astype(jnp.float32)
    mu = jnp.mean(xf, axis=-1, keepdims=True)
    var = jnp.mean(jnp.square(xf - mu), axis=-1, keepdims=True)
    y = (xf - mu) * lax.rsqrt(var + LN_EPS) * g.astype(jnp.float32) + b.astype(jnp.float32)
    return y.astype(x.dtype)


def rope_tables(positions):
    inv = 1.0 / (ROPE_THETA ** (jnp.arange(0, MOBA_HD, 2, dtype=jnp.float32) / MOBA_HD))
    ang = positions.astype(jnp.float32)[..., None] * inv
    return jnp.cos(ang), jnp.sin(ang)


def apply_rope(x, cos, sin):
    xf = x.astype(jnp.float32)
    x1, x2 = jnp.split(xf, 2, axis=-1)
    c, s = cos[:, :, None, :], sin[:, :, None, :]
    return jnp.concatenate([x1 * c - x2 * s, x2 * c + x1 * s], axis=-1).astype(x.dtype)


def gla_chunked(q, k, v, log_decay):
    B, S, H, DK = q.shape
    DV = v.shape[-1]
    C = GLA_CHUNK
    nc = S // C

    def to_chunks(t):
        return t.astype(jnp.float32).reshape(B, nc, C, H, t.shape[-1]).transpose(1, 0, 3, 2, 4)

    qc = to_chunks(q) * (DK ** -0.5)
    kc, vc, gc = to_chunks(k), to_chunks(v), to_chunks(log_decay)
    causal = jnp.tril(jnp.ones((C, C), dtype=bool))

    def step(state, inp):
        qi, ki, vi, gi = inp
        b = jnp.cumsum(gi, axis=2)
        inter = jnp.einsum('bhcd,bhde->bhce', qi * jnp.exp(b), state)
        diff = b[:, :, :, None, :] - b[:, :, None, :, :]
        decay = jnp.exp(jnp.where(causal[None, None, :, :, None], diff, -jnp.inf))
        attn = jnp.einsum('bhid,bhjd,bhijd->bhij', qi, ki, decay)
        intra = jnp.einsum('bhij,bhje->bhie', attn, vi)
        b_last = b[:, :, -1:, :]
        new_state = jnp.exp(b_last[:, :, 0, :])[..., None] * state + jnp.einsum(
            'bhcd,bhce->bhde', ki * jnp.exp(b_last - b), vi)
        return new_state, inter + intra

    state0 = jnp.zeros((B, H, DK, DV), jnp.float32)
    _, o = lax.scan(step, state0, (qc, kc, vc, gc))
    return o.transpose(1, 0, 3, 2, 4).reshape(B, S, H, DV)


def moba_attention(q, k, v):
    B, S, H, D = q.shape
    nb = -(-S // MOBA_BLOCK)
    Sp = nb * MOBA_BLOCK
    pad = Sp - S

    def prep(t):
        t = jnp.pad(t, ((0, 0), (0, pad), (0, 0), (0, 0)))
        return t.transpose(0, 2, 1, 3).reshape(B * H, Sp, D)

    q, k, v = prep(q), prep(k), prep(v)
    BH = B * H
    kb = k.reshape(BH, nb, MOBA_BLOCK, D)
    vb = v.reshape(BH, nb, MOBA_BLOCK, D)
    k_mean = jnp.mean(kb.astype(jnp.float32), axis=2)
    gate = jnp.einsum('nsd,nbd->nsb', q.astype(jnp.float32), k_mean)
    q_blk = jnp.arange(Sp) // MOBA_BLOCK
    fully_past = jnp.arange(nb)[None, :] < q_blk[:, None]
    gate = jnp.where(fully_past[None], gate, NEG)
    kk = min(MOBA_TOPK, nb)
    _, sel = lax.top_k(gate, kk)
    sel_valid = jnp.arange(kk)[None, :] < q_blk[:, None]
    scale = D ** -0.5
    QC = MOBA_QCHUNK

    def chunk(c):
        start = c * QC
        qc = lax.dynamic_slice_in_dim(q, start, QC, axis=1)
        selc = lax.dynamic_slice_in_dim(sel, start, QC, axis=1)
        validc = lax.dynamic_slice_in_dim(sel_valid, start, QC, axis=0)
        own = start // MOBA_BLOCK
        k_own = lax.dynamic_index_in_dim(kb, own, axis=1, keepdims=False)
        v_own = lax.dynamic_index_in_dim(vb, own, axis=1, keepdims=False)
        k_sel = jax.vmap(lambda blocks, idx: blocks[idx])(kb, selc)
        v_sel = jax.vmap(lambda blocks, idx: blocks[idx])(vb, selc)
        s_sel = jnp.einsum('nqd,nqjkd->nqjk', qc, k_sel).astype(jnp.float32) * scale
        s_sel = jnp.where(validc[None, :, :, None], s_sel, NEG).reshape(BH, QC, kk * MOBA_BLOCK)
        s_own = jnp.einsum('nqd,nkd->nqk', qc, k_own).astype(jnp.float32) * scale
        q_pos = start + jnp.arange(QC)
        k_pos = own * MOBA_BLOCK + jnp.arange(MOBA_BLOCK)
        s_own = jnp.where((k_pos[None, :] <= q_pos[:, None])[None], s_own, NEG)
        p = jax.nn.softmax(jnp.concatenate([s_sel, s_own], axis=-1), axis=-1).astype(v.dtype)
        p_sel, p_own = p[..., :kk * MOBA_BLOCK], p[..., kk * MOBA_BLOCK:]
        o = jnp.einsum('nqk,nqkd->nqd', p_sel, v_sel.reshape(BH, QC, kk * MOBA_BLOCK, D))
        return o + jnp.einsum('nqk,nkd->nqd', p_own, v_own)

    out = lax.map(chunk, jnp.arange(Sp // QC))
    out = out.transpose(1, 0, 2, 3).reshape(B, H, Sp, D)[:, :, :S]
    return out.transpose(0, 2, 1, 3)


def mixer(h, w_in, w_gk, b_gk, gla_norm, w_o, cos, sin):
    B, S, _ = h.shape
    proj = h @ w_in
    gq, gk, gv, gg, glow, mq, mk, mv = jnp.split(proj, IN_SPLITS, axis=-1)
    log_decay = jax.nn.log_sigmoid((glow @ w_gk + b_gk).astype(jnp.float32)) / GLA_GATE_NORMALIZER
    o_gla = gla_chunked(gq.reshape(B, S, GLA_HEADS, GLA_DK), gk.reshape(B, S, GLA_HEADS, GLA_DK),
                        gv.reshape(B, S, GLA_HEADS, GLA_DV), log_decay.reshape(B, S, GLA_HEADS, GLA_DK))
    o_gla = o_gla * lax.rsqrt(jnp.mean(jnp.square(o_gla), axis=-1, keepdims=True) + RMS_EPS)
    o_gla = o_gla * gla_norm.astype(jnp.float32) * jax.nn.silu(
        gg.astype(jnp.float32).reshape(B, S, GLA_HEADS, GLA_DV))
    o_gla = o_gla.reshape(B, S, GLA_V_W).astype(h.dtype)
    mq = apply_rope(mq.reshape(B, S, MOBA_HEADS, MOBA_HD), cos, sin)
    mk = apply_rope(mk.reshape(B, S, MOBA_HEADS, MOBA_HD), cos, sin)
    o_moba = moba_attention(mq, mk, mv.reshape(B, S, MOBA_HEADS, MOBA_HD)).reshape(B, S, MOBA_W)
    return jnp.concatenate([o_gla, o_moba.astype(h.dtype)], axis=-1) @ w_o


def moe(h, w_router, b_router, w_gate, w_up, w_down):
    B, S, D = h.shape
    t = h.reshape(-1, D)
    aff = jax.nn.softmax((t @ w_router).astype(jnp.float32), axis=-1)
    biased = aff + b_router.astype(jnp.float32)
    T = t.shape[0]
    group_score = jnp.sum(lax.top_k(biased.reshape(T, N_GROUPS, EXPERTS_PER_GROUP), TOP_K)[0], axis=-1)
    best_group = jnp.argmax(group_score, axis=-1)
    in_group = (jnp.arange(N_EXPERTS) // EXPERTS_PER_GROUP)[None, :] == best_group[:, None]
    _, idx = lax.top_k(jnp.where(in_group, biased, -jnp.inf), TOP_K)
    w = jnp.take_along_axis(aff, idx, axis=-1)
    w = w / jnp.sum(w, axis=-1, keepdims=True)
    combine = jnp.sum(jax.nn.one_hot(idx, N_EXPERTS, dtype=jnp.float32) * w[..., None], axis=1)
    y = jnp.zeros((T, D), jnp.float32)
    for e in range(N_EXPERTS):
        he = jax.nn.silu(t @ w_gate[e]) * (t @ w_up[e])
        y = y + combine[:, e:e + 1] * (he @ w_down[e]).astype(jnp.float32)
    return y.astype(h.dtype).reshape(B, S, D)


def setup_inputs(seed: int = 0) -> dict:
    key = jax.random.key(seed)
    ks = jax.random.split(key, 16)
    nrm = jax.random.normal
    x = nrm(ks[0], (BATCH, SEQ, D_MODEL), jnp.float32)
    positions = jnp.broadcast_to(jnp.arange(SEQ, dtype=jnp.int32)[None, :], (BATCH, SEQ))
    w_in = nrm(ks[1], (DEPTH, D_MODEL, D_IN), jnp.float32) * D_MODEL ** -0.5
    w_gk = nrm(ks[2], (DEPTH, GLA_GATE_RANK, GLA_QK_W), jnp.float32) * GLA_GATE_RANK ** -0.5
    b_gk = nrm(ks[3], (DEPTH, GLA_QK_W), jnp.float32) * 0.02
    gla_norm = 1.0 + 0.02 * nrm(ks[4], (DEPTH, GLA_DV), jnp.float32)
    w_o = nrm(ks[5], (DEPTH, MIX_W, D_MODEL), jnp.float32) * (MIX_W ** -0.5) * DN_BETA
    ln1_g = 1.0 + 0.02 * nrm(ks[6], (DEPTH, D_MODEL), jnp.float32)
    ln1_b = 0.02 * nrm(ks[7], (DEPTH, D_MODEL), jnp.float32)
    w_router = nrm(ks[8], (D_MODEL, N_EXPERTS), jnp.float32) * D_MODEL ** -0.5
    b_router = 0.01 * nrm(ks[9], (N_EXPERTS,), jnp.float32)
    w_gate = nrm(ks[10], (DEPTH, N_EXPERTS, D_MODEL, D_EXPERT), jnp.float32) * D_MODEL ** -0.5
    w_up = nrm(ks[11], (DEPTH, N_EXPERTS, D_MODEL, D_EXPERT), jnp.float32) * D_MODEL ** -0.5
    w_down = nrm(ks[12], (DEPTH, N_EXPERTS, D_EXPERT, D_MODEL), jnp.float32) * (D_EXPERT ** -0.5) * DN_BETA
    ln2_g = 1.0 + 0.02 * nrm(ks[13], (DEPTH, D_MODEL), jnp.float32)
    ln2_b = 0.02 * nrm(ks[14], (DEPTH, D_MODEL), jnp.float32)
    return {"x": x, "positions": positions, "w_in": w_in, "w_gk": w_gk, "b_gk": b_gk,
            "gla_norm": gla_norm, "w_o": w_o, "ln1_g": ln1_g, "ln1_b": ln1_b,
            "w_router": w_router, "b_router": b_router, "w_gate": w_gate, "w_up": w_up,
            "w_down": w_down, "ln2_g": ln2_g, "ln2_b": ln2_b}


def reference(x, positions, w_in, w_gk, b_gk, gla_norm, w_o, ln1_g, ln1_b,
              w_router, b_router, w_gate, w_up, w_down, ln2_g, ln2_b):
    cos, sin = rope_tables(positions)
    h = x
    for l in range(DEPTH):
        h = layer_norm(DN_ALPHA * h + mixer(h, w_in[l], w_gk[l], b_gk[l], gla_norm[l], w_o[l], cos, sin),
                       ln1_g[l], ln1_b[l])
        h = layer_norm(DN_ALPHA * h + moe(h, w_router, b_router, w_gate[l], w_up[l], w_down[l]),
                       ln2_g[l], ln2_b[l])
    return h
```

```cpp
#define MK_DEBUG 0
#define MK_ONE_LAUNCH 1

#include <hip/hip_runtime.h>
#include <cstdio>
#include <cstdint>
__device__ __forceinline__ int opq_tid() { int t = (int)threadIdx.x; asm volatile("" : "+v"(t)); return t; }
namespace pg8 {
#define PG8_LAS __attribute__((address_space(3)))
typedef unsigned short bf16_t;
typedef short bf16x8 __attribute__((ext_vector_type(8)));
typedef float f32x4 __attribute__((ext_vector_type(4)));
typedef unsigned u32x4 __attribute__((ext_vector_type(4)));
constexpr int BM = 256, BK = 64, HALF = 128, HTB = HALF * BK * 2  , STAGE_BYTES = 8 * HTB, NXCD = 8, WGM = 8;

__host__ __device__ __forceinline__ int lds_byte(int r, int c) { const int st = (r >> 4) * 2 + (c >> 5), rr = r & 15, cc = c & 31, ob = rr * 64 + cc * 2; return st * 1024 + (ob ^ (((ob >> 9) & 1) << 5)); }
__host__ __device__ __forceinline__ void stage_rc(int b, int& R, int& C) { const int st = b / 1024, sb = b % 1024, swz = sb ^ (((sb >> 9) & 1) << 5); R = (st >> 1) * 16 + swz / 64; C = (st & 1) * 32 + (swz % 64) / 2; }
__host__ __device__ __forceinline__ int perm32(int rho) { const int n = rho >> 4, i = rho & 15; return 8 * (i >> 2) + 4 * n + (i & 3); }

struct Unit { int pm, pn; };
struct Gemm { const bf16_t* A; const bf16_t* Bt; int M, N, K; };

struct StaticOrder {
    int nM, nN, nwg, G, c;
    __host__ __device__ void init(int M, int N, int G_, int c_) { nM = M / BM; nN = N / BM; nwg = nM * nN; G = G_; c = c_; }
    __host__ __device__ bool next(int i, Unit& u) const {
        const long L = (long)i * G + c; if (L >= nwg) return false;
        int wgid = (int)L; { const int q = nwg / NXCD, r = nwg % NXCD, xcd = wgid % NXCD, off = wgid / NXCD; wgid = (xcd < r ? xcd * (q + 1) : r * (q + 1) + (xcd - r) * q) + off; }
        const int nig = WGM * nN, gid = wgid / nig, fm = gid * WGM, gsz = (nM - fm) < WGM ? (nM - fm) : WGM;
        u.pm = fm + ((wgid % nig) % gsz); u.pn = (wgid % nig) / gsz; return true;
    }
    __device__ __forceinline__ void a_ready(const Unit&) const {}
    __device__ __forceinline__ void done(const Unit&) const {}
};
__device__ __forceinline__ unsigned cvt_pk_bf16(float lo, float hi) { unsigned r; asm volatile("v_cvt_pk_bf16_f32 %0, %1, %2" : "=v"(r) : "v"(lo), "v"(hi)); return r; }

template <class Epi, class Sched, bool ALIGN_EPI = false, bool SP2 = false>
__device__ __forceinline__ void gemm_phase(PG8_LAS unsigned char* lds, const Gemm g, const Sched& S, const Epi& E) {
    const int tid = opq_tid(), wid = __builtin_amdgcn_readfirstlane(tid >> 6), lane = tid & 63, wr = wid >> 2, wc = wid & 3, fr = lane & 15, fq = lane >> 4;
    const int K = g.K, nt = K / BK;
    unsigned voffA[2], voffB[2];
#pragma unroll
    for (int i = 0; i < 2; ++i) { int R, C; stage_rc(tid * 16 + i * 8192, R, C); const int Rb = Epi::PERM ? ((R & ~31) + perm32(R & 31)) : R;
        voffA[i] = (unsigned)(R * K + C) * 2u; voffB[i] = (unsigned)(Rb * K + C) * 2u; }
    const size_t kstep = (size_t)(BK * 2);
    const size_t hstep = (size_t)HALF * K * 2;
    const size_t tstep = 2 * hstep;
    const unsigned ldsw = (unsigned)wid * 1024u;
    const int aoff = lds_byte(wr * 64 + fr, fq * 8), boff = lds_byte(wc * 32 + fr, fq * 8);
#define PG8_SA(b, h) (((b) * 2 + (h)) * HTB)
#define PG8_SB(b, h) ((4 + (b) * 2 + (h)) * HTB)
#define PG8_STAGE(bufoff, gbase, voff) do { _Pragma("unroll") for (int _i = 0; _i < 2; ++_i) \
        __builtin_amdgcn_global_load_lds((const unsigned*)((const char*)(gbase) + (voff)[_i]), (PG8_LAS unsigned*)(lds + (bufoff) + ldsw + _i * 8192), 16, 0, 0); } while (0)
#define PG8_LDA(dst, b, h) do { _Pragma("unroll") for (int m = 0; m < 4; ++m) _Pragma("unroll") for (int k = 0; k < 2; ++k) dst[m][k] = *(const PG8_LAS bf16x8*)(lds + PG8_SA(b, h) + aoff + m * 2048 + k * 1024); } while (0)
#define PG8_LDB(dst, b, h) do { _Pragma("unroll") for (int n = 0; n < 2; ++n) _Pragma("unroll") for (int k = 0; k < 2; ++k) dst[n][k] = *(const PG8_LAS bf16x8*)(lds + PG8_SB(b, h) + boff + n * 2048 + k * 1024); } while (0)
#define PG8_MMA(ai, bj, At, Bt) do { __builtin_amdgcn_s_setprio(1); _Pragma("unroll") for (int m = 0; m < 4; ++m) _Pragma("unroll") for (int n = 0; n < 2; ++n) _Pragma("unroll") for (int k = 0; k < 2; ++k) \
        acc[ai][bj][m][n] = __builtin_amdgcn_mfma_f32_16x16x32_bf16(Bt[n][k], At[m][k], acc[ai][bj][m][n], 0, 0, 0); __builtin_amdgcn_s_setprio(0); } while (0)
#define PG8_WAIT_V(n) asm volatile("s_waitcnt vmcnt(" #n ")" ::: "memory")
#define PG8_WAIT_L(n) asm volatile("s_waitcnt lgkmcnt(" #n ")" ::: "memory")
#define PG8_BAR __builtin_amdgcn_s_barrier()
#define PG8_SCHED __builtin_amdgcn_sched_barrier(0)
    Unit cur, nxt; int ui = 0;
    if (!S.next(0, cur)) return;
    f32x4 acc[2][2][4][2];
#pragma unroll
    for (int a = 0; a < 2; ++a)
#pragma unroll
        for (int b = 0; b < 2; ++b)
#pragma unroll
            for (int m = 0; m < 4; ++m)
#pragma unroll
                for (int n = 0; n < 2; ++n) acc[a][b][m][n] = (f32x4){0.f, 0.f, 0.f, 0.f};
    bf16x8 At[4][2], B0[2][2], B1[2][2];
    const char* cA = (const char*)g.A + (size_t)cur.pm * tstep; const char* cB = (const char*)g.Bt + (size_t)cur.pn * tstep;
    S.a_ready(cur);
    if constexpr (SP2) {
        PG8_STAGE(PG8_SB(0, 0), cB, voffB); PG8_STAGE(PG8_SB(0, 1), cB + hstep, voffB); PG8_STAGE(PG8_SA(0, 0), cA, voffA); PG8_STAGE(PG8_SA(0, 1), cA + hstep, voffA);
        if (wr == 1) PG8_BAR;
        PG8_WAIT_V(2); PG8_BAR;
        PG8_STAGE(PG8_SB(1, 0), cB + kstep, voffB); PG8_STAGE(PG8_SA(1, 0), cA + kstep, voffA); PG8_STAGE(PG8_SB(1, 1), cB + hstep + kstep, voffB);
        PG8_WAIT_V(6); PG8_BAR;
    } else {
        PG8_STAGE(PG8_SB(0, 0), cB, voffB); PG8_STAGE(PG8_SA(0, 0), cA, voffA); PG8_STAGE(PG8_SB(0, 1), cB + hstep, voffB); PG8_STAGE(PG8_SA(0, 1), cA + hstep, voffA);
        if (wr == 1) PG8_BAR;
        PG8_WAIT_V(4); PG8_BAR;
        PG8_STAGE(PG8_SB(1, 0), cB + kstep, voffB); PG8_STAGE(PG8_SA(1, 0), cA + kstep, voffA); PG8_STAGE(PG8_SB(1, 1), cB + hstep + kstep, voffB);
        PG8_WAIT_V(6); PG8_BAR;
    }
    for (;;) {
        const bool has_next = S.next(ui + 1, nxt);
        const char* nA = has_next ? (const char*)g.A + (size_t)nxt.pm * tstep : cA; const char* nB = has_next ? (const char*)g.Bt + (size_t)nxt.pn * tstep : cB;
        for (int t = 0; t < nt; t += 2) {
            const bool last = (t == nt - 2);
            const char* a1 = cA + (size_t)(t + 1) * kstep;
            const char* a2 = last ? nA : cA + (size_t)(t + 2) * kstep; const char* b2 = last ? nB : cB + (size_t)(t + 2) * kstep;
            const char* a3 = a2 + kstep; const char* b3 = b2 + kstep;
            if (last && has_next) S.a_ready(nxt);
            if constexpr (SP2) {
            PG8_LDB(B0, 0, 0); PG8_LDB(B1, 0, 1); PG8_SCHED; PG8_LDA(At, 0, 0); PG8_STAGE(PG8_SA(1, 1), a1 + hstep, voffA);
            PG8_WAIT_V(8); PG8_WAIT_L(0); PG8_BAR; PG8_MMA(0, 0, At, B0); PG8_MMA(0, 1, At, B1); PG8_BAR; PG8_SCHED;
            PG8_LDA(At, 0, 1); PG8_STAGE(PG8_SB(0, 0), b2, voffB); PG8_STAGE(PG8_SB(0, 1), b2 + hstep, voffB); PG8_STAGE(PG8_SA(0, 0), a2, voffA);
            PG8_WAIT_V(8); PG8_WAIT_L(0); PG8_BAR; PG8_MMA(1, 0, At, B0); PG8_MMA(1, 1, At, B1); PG8_BAR; PG8_SCHED;
            PG8_LDB(B0, 1, 0); PG8_LDB(B1, 1, 1); PG8_SCHED; PG8_LDA(At, 1, 0); PG8_STAGE(PG8_SA(0, 1), a2 + hstep, voffA);
            PG8_WAIT_V(8); PG8_WAIT_L(0); PG8_BAR; PG8_MMA(0, 0, At, B0); PG8_MMA(0, 1, At, B1); PG8_BAR; PG8_SCHED;
            PG8_LDA(At, 1, 1); PG8_STAGE(PG8_SB(1, 0), b3, voffB); PG8_STAGE(PG8_SB(1, 1), b3 + hstep, voffB); PG8_STAGE(PG8_SA(1, 0), a3, voffA);
            PG8_WAIT_V(8); PG8_WAIT_L(0); PG8_BAR; PG8_MMA(1, 0, At, B0); PG8_MMA(1, 1, At, B1); PG8_BAR; PG8_SCHED;
            } else {
            PG8_LDB(B0, 0, 0); PG8_SCHED; PG8_LDA(At, 0, 0); PG8_STAGE(PG8_SA(1, 1), a1 + hstep, voffA);
            PG8_WAIT_L(8); PG8_BAR; PG8_WAIT_L(0); PG8_MMA(0, 0, At, B0); PG8_BAR; PG8_SCHED;
            PG8_LDB(B1, 0, 1); PG8_STAGE(PG8_SB(0, 0), b2, voffB);
            PG8_BAR; PG8_WAIT_L(0); PG8_MMA(0, 1, At, B1); PG8_BAR;
            PG8_LDA(At, 0, 1); PG8_STAGE(PG8_SA(0, 0), a2, voffA);
            PG8_BAR; PG8_WAIT_L(0); PG8_MMA(1, 0, At, B0); PG8_BAR; PG8_SCHED;
            PG8_STAGE(PG8_SB(0, 1), b2 + hstep, voffB);
            PG8_WAIT_V(6); PG8_BAR; PG8_MMA(1, 1, At, B1); PG8_BAR;
            PG8_LDB(B0, 1, 0); PG8_SCHED; PG8_LDA(At, 1, 0); PG8_STAGE(PG8_SA(0, 1), a2 + hstep, voffA);
            PG8_WAIT_L(8); PG8_BAR; PG8_WAIT_L(0); PG8_MMA(0, 0, At, B0); PG8_BAR; PG8_SCHED;
            PG8_LDB(B1, 1, 1); PG8_STAGE(PG8_SB(1, 0), b3, voffB);
            PG8_BAR; PG8_WAIT_L(0); PG8_MMA(0, 1, At, B1); PG8_BAR;
            PG8_LDA(At, 1, 1); PG8_STAGE(PG8_SA(1, 0), a3, voffA);
            PG8_BAR; PG8_WAIT_L(0); PG8_MMA(1, 0, At, B0); PG8_BAR; PG8_SCHED;
            PG8_STAGE(PG8_SB(1, 1), b3 + hstep, voffB);
            PG8_WAIT_V(6); PG8_BAR; PG8_MMA(1, 1, At, B1); PG8_BAR;
            }
        }
        if constexpr (ALIGN_EPI) { if (wr == 0) PG8_BAR; }
        if constexpr (!Epi::AFTER_DRAIN) { E(acc, cur, wr, wc, fr, fq); S.done(cur); }
        if (!has_next) break;
#pragma unroll
        for (int a = 0; a < 2; ++a)
#pragma unroll
            for (int b = 0; b < 2; ++b)
#pragma unroll
                for (int m = 0; m < 4; ++m)
#pragma unroll
                    for (int n = 0; n < 2; ++n) acc[a][b][m][n] = (f32x4){0.f, 0.f, 0.f, 0.f};
        cur = nxt; cA = nA; cB = nB; ++ui;
        if constexpr (ALIGN_EPI) { if (wr == 1) PG8_BAR; }
    }
    PG8_WAIT_V(0);
    if constexpr (!ALIGN_EPI) { if (wr == 0) PG8_BAR; }
    PG8_BAR;
    if constexpr (Epi::AFTER_DRAIN) { E.fused(acc, cur, wr, wc, fr, fq, lds, wid, lane); S.done(cur); }
#undef PG8_SA
#undef PG8_SB
#undef PG8_STAGE
#undef PG8_LDA
#undef PG8_LDB
#undef PG8_MMA
#undef PG8_WAIT_V
#undef PG8_WAIT_L
#undef PG8_BAR
#undef PG8_SCHED
}
}
#define LAS __attribute__((address_space(3)))
#define XB_TMO      128
#define XB_XCNT(j)  (256  + 64 * (j))
#define XB_XSUB(j)  (1280 + 64 * (j))
#define XB_XGEN(j)  (2304 + 64 * (j))
#define XB_TOP      3328
#define XB_TOPGEN   3392
#define XCD_BAR_WORDS 3456
#define XB_SPIN_CAP (1u << 18)

__device__ __forceinline__ unsigned xb_ld(unsigned* p)              { return __hip_atomic_load(p, __ATOMIC_RELAXED, __HIP_MEMORY_SCOPE_AGENT); }
__device__ __forceinline__ unsigned xb_add(unsigned* p, unsigned v) { return __hip_atomic_fetch_add(p, v, __ATOMIC_RELAXED, __HIP_MEMORY_SCOPE_AGENT); }
__device__ __forceinline__ unsigned xb_xcc_id() { return (unsigned)__builtin_amdgcn_s_getreg((3 << 11) | 20) & 0xFu; }
#define XB_SPIN(cond, bar) do { unsigned _sp = 0; while (cond) { __builtin_amdgcn_s_sleep(1); \
    if ((++_sp & 255u) == 0u) { if (xb_ld(&(bar)[XB_TMO])) break; if (_sp > XB_SPIN_CAP) { atomicAdd(&(bar)[XB_TMO], 1u); break; } } } } while (0)

struct XcdBarrier {
    unsigned* bar; unsigned x;
    volatile LAS unsigned* st;
};

__device__ __forceinline__ XcdBarrier xcd_barrier_post(unsigned* bar, volatile LAS unsigned* st) {
    XcdBarrier b; b.bar = bar; b.x = xb_xcc_id(); b.st = st;
    if (threadIdx.x == 0) (void)xb_add(&bar[XB_XCNT(b.x)], 1u);
    return b;
}
__device__ __forceinline__ void xcd_barrier_complete(unsigned* bar, unsigned x, unsigned& nloc, unsigned& nx) {
    const unsigned G = gridDim.x * gridDim.y * gridDim.z;
    unsigned sum, cnt, mine, sp = 0u;
    for (;;) {
        sum = 0u; cnt = 0u; mine = 0u;
#pragma unroll
        for (unsigned j = 0; j < 16; ++j) { const unsigned c = xb_ld(&bar[XB_XCNT(j)]); sum += c; cnt += (c > 0u) ? 1u : 0u; mine = (j == x) ? c : mine; }
        if (sum == G) break;
        __builtin_amdgcn_s_sleep(1);
        if ((++sp & 255u) == 0u) { if (xb_ld(&bar[XB_TMO])) break; if (sp > XB_SPIN_CAP) { atomicAdd(&bar[XB_TMO], 1u); break; } }
    }
    nloc = mine > 0u ? mine : 1u; nx = cnt > 0u ? cnt : 1u;
}

__device__ __forceinline__ void xcd_barrier(const XcdBarrier& b) {
    asm volatile("s_waitcnt vmcnt(0)" ::: "memory");
    __syncthreads();
    if (threadIdx.x == 0) {
        unsigned* bar = b.bar;
        __builtin_amdgcn_s_waitcnt(0);
        unsigned nloc = b.st[0], nx = b.st[1];
        if (nloc == 0u) { xcd_barrier_complete(bar, b.x, nloc, nx); b.st[0] = nloc; b.st[1] = nx; }
        const unsigned old = xb_add(&bar[XB_XSUB(b.x)], 1u);
        const unsigned gen = old / nloc;
        if (old + 1u == (gen + 1u) * nloc) {
            __builtin_amdgcn_fence(__ATOMIC_RELEASE, "agent");
            asm volatile("s_waitcnt vmcnt(0)" ::: "memory");
            const unsigned og = xb_add(&bar[XB_TOP], 1u);
            const unsigned tg = og / nx;
            if (og + 1u == (tg + 1u) * nx) xb_add(&bar[XB_TOPGEN], 1u);
            else XB_SPIN(xb_ld(&bar[XB_TOPGEN]) == tg, bar);
            __builtin_amdgcn_fence(__ATOMIC_ACQUIRE, "agent");
            xb_add(&bar[XB_XGEN(b.x)], 1u);
            asm volatile("s_waitcnt vmcnt(0)" ::: "memory");
        } else {
            XB_SPIN(xb_ld(&bar[XB_XGEN(b.x)]) == gen, bar);
            __builtin_amdgcn_fence(__ATOMIC_ACQUIRE, "agent");
            asm volatile("s_waitcnt vmcnt(0)" ::: "memory");
        }
    }
    __syncthreads();
}

#define GAS __attribute__((address_space(1)))
typedef unsigned short bf16_t;
typedef short bf16x8 __attribute__((ext_vector_type(8)));
typedef short s16x4 __attribute__((ext_vector_type(4)));
typedef float f32x4 __attribute__((ext_vector_type(4)));
typedef float f32x16 __attribute__((ext_vector_type(16)));
typedef unsigned u32x4 __attribute__((ext_vector_type(4)));
typedef unsigned u32x2 __attribute__((ext_vector_type(2)));

constexpr int T = 16384, DM = 2048, DIN = 6160, NPROJ = 6144, NLAYER = 2, NE = 16, DEXP = 1024;
constexpr int PQ = 0, PK = 512, PV = 1024, PG = 2048, PMQ = 3072, PMK = 4096, PMV = 5120;
constexpr float DN_ALPHA = 1.4142135623730951f;
constexpr int MAXROWS = 36864;
constexpr int LISTH = 516096;
constexpr int NTHR = 512;

constexpr size_t MiB = 1u << 20;
constexpr size_t WS_CTL = 0, CTL_BYTES = 1 * MiB;
constexpr size_t WS_MISC = 1 * MiB;
constexpr size_t WS_ITEMS = 1 * MiB + 65536;
constexpr size_t WS_TOK = 2 * MiB, WS_SEL = 3 * MiB, WS_KMEAN = 4 * MiB, WS_GDEC = 5 * MiB, WS_GLOW = 6 * MiB, WS_PML = 8 * MiB;
constexpr size_t WS_ROPE = 12 * MiB, WS_LIST = 20 * MiB;
constexpr size_t WS_WIN = 36 * MiB, WS_WO = 60 * MiB, WS_WGU = 68 * MiB, WS_WD = 196 * MiB;
constexpr size_t WS_HB = 260 * MiB, WS_MIX = 324 * MiB;
constexpr size_t WS_PROJ = 388 * MiB, WS_U = 580 * MiB, WS_S = 644 * MiB, WS_PO = 708 * MiB;
constexpr size_t WS_XS = 388 * MiB, WS_HS = 532 * MiB, WS_YS = 604 * MiB;
constexpr size_t WS_END = 836 * MiB;
constexpr int CW_BAR = 4096, CW_CNT = 8192, CW_NIT = 8448, CW_DBG = 8704;
constexpr int LDS_SCR = 131072, LDS_BYTES = 151552;

struct Params { const float* in[16]; float* out; unsigned char* ws; int g_lo, g_hi; };

__device__ __forceinline__ unsigned cvt_pk(float lo, float hi) { return pg8::cvt_pk_bf16(lo, hi); }
__device__ __forceinline__ float bflo(unsigned u) { return __uint_as_float(u << 16); }
__device__ __forceinline__ float bfhi(unsigned u) { return __uint_as_float(u & 0xffff0000u); }
__device__ __forceinline__ float bf2f(bf16_t u) { return __uint_as_float(((unsigned)u) << 16); }
__device__ __forceinline__ unsigned ldu(const unsigned* p) { return __hip_atomic_load(p, __ATOMIC_RELAXED, __HIP_MEMORY_SCOPE_AGENT); }
__device__ __forceinline__ float ldf(const float* p) { return __uint_as_float(__hip_atomic_load((const unsigned*)p, __ATOMIC_RELAXED, __HIP_MEMORY_SCOPE_AGENT)); }
__device__ __forceinline__ float wave_sum(float v) {
#pragma unroll
    for (int o = 32; o >= 1; o >>= 1) v += __shfl_xor(v, o);
    return v;
}
__device__ __forceinline__ float silu_f(float x) { return x / (1.0f + __expf(-x)); }
__device__ __forceinline__ s16x4 tr_rd(int addr) { s16x4 r; asm volatile("ds_read_b64_tr_b16 %0, %1" : "=&v"(r) : "v"(addr) : "memory"); return r; }
#define LGKM0() do { asm volatile("s_waitcnt lgkmcnt(0)" ::: "memory"); __builtin_amdgcn_sched_barrier(0); } while (0)
#define PK8(L, H) ((bf16x8){L[0], L[1], L[2], L[3], H[0], H[1], H[2], H[3]})
#define MFMA16(a, b, c) __builtin_amdgcn_mfma_f32_16x16x32_bf16((a), (b), (c), 0, 0, 0)

namespace pg8 {
struct EpiProj {
    static constexpr bool PERM = true, AFTER_DRAIN = false;
    bf16_t* O; const float* cs; const float* sn;
    __device__ __forceinline__ void operator()(const f32x4 (&acc)[2][2][4][2], const Unit& u, int wr, int wc, int fr, int fq) const {
        const int row0 = u.pm * BM + wr * 64 + fr, col0 = u.pn * BM + wc * 32 + 8 * fq;
        const bool rope = (u.pn >= 12 && u.pn < 20);
#pragma unroll
        for (int ai = 0; ai < 2; ++ai)
#pragma unroll
            for (int m = 0; m < 4; ++m) {
                const int row = row0 + ai * HALF + m * 16;
                bf16_t* rowp = O + (size_t)row * 6144 + col0;
                f32x4 c = {1.f, 1.f, 1.f, 1.f}, s = {0.f, 0.f, 0.f, 0.f};
                if (rope) { c = *(const f32x4*)(cs + (size_t)row * 64 + 16 * wc + 4 * fq); s = *(const f32x4*)(sn + (size_t)row * 64 + 16 * wc + 4 * fq); }
#pragma unroll
                for (int bj = 0; bj < 2; ++bj) {
                    const f32x4 a0 = acc[ai][bj][m][0], a1 = acc[ai][bj][m][1];
                    const f32x4 v0 = a0 * c - a1 * s, v1 = a1 * c + a0 * s;
                    u32x4 w; w.x = cvt_pk_bf16(v0[0], v0[1]); w.y = cvt_pk_bf16(v0[2], v0[3]); w.z = cvt_pk_bf16(v1[0], v1[1]); w.w = cvt_pk_bf16(v1[2], v1[3]);
                    *(u32x4*)(rowp + bj * HALF) = w; }
            }
    }
};
struct EpiOut {
    static constexpr bool PERM = false, AFTER_DRAIN = false;
    const float* res; float* out; float alpha;
    __device__ __forceinline__ void operator()(const f32x4 (&acc)[2][2][4][2], const Unit& u, int wr, int wc, int fr, int fq) const {
        const int row0 = u.pm * BM + wr * 64 + fr, col0 = u.pn * BM + wc * 32 + 4 * fq;
#pragma unroll
        for (int ai = 0; ai < 2; ++ai)
#pragma unroll
            for (int m = 0; m < 4; ++m) { const size_t off = (size_t)(row0 + ai * HALF + m * 16) * 2048 + col0;
#pragma unroll
                for (int bj = 0; bj < 2; ++bj)
#pragma unroll
                    for (int n = 0; n < 2; ++n) { const f32x4 r = *(const f32x4*)(res + off + bj * HALF + n * 16); *(f32x4*)(out + off + bj * HALF + n * 16) = r * alpha + acc[ai][bj][m][n]; } }
    }
};
struct EpiGU {
    static constexpr bool PERM = true, AFTER_DRAIN = false;
    bf16_t* H;
    __device__ __forceinline__ void operator()(const f32x4 (&acc)[2][2][4][2], const Unit& u, int wr, int wc, int fr, int fq) const {
        const int row0 = u.pm * BM + wr * 64 + fr, col0 = ((u.pn & 7) * BM + wc * 32 + 8 * fq) >> 1;
#pragma unroll
        for (int ai = 0; ai < 2; ++ai)
#pragma unroll
            for (int m = 0; m < 4; ++m) { bf16_t* rowp = H + (size_t)(row0 + ai * HALF + m * 16) * 1024 + col0;
#pragma unroll
                for (int bj = 0; bj < 2; ++bj) { const f32x4 g = acc[ai][bj][m][0], up = acc[ai][bj][m][1]; f32x4 h;
#pragma unroll
                    for (int j = 0; j < 4; ++j) h[j] = g[j] / (1.0f + __expf(-g[j])) * up[j];
                    u32x2 w; w.x = cvt_pk_bf16(h[0], h[1]); w.y = cvt_pk_bf16(h[2], h[3]); *(u32x2*)(rowp + bj * (HALF / 2)) = w; } }
    }
};
struct EpiY {
    static constexpr bool PERM = true, AFTER_DRAIN = false;
    bf16_t* Y;
    __device__ __forceinline__ void operator()(const f32x4 (&acc)[2][2][4][2], const Unit& u, int wr, int wc, int fr, int fq) const {
        const int row0 = u.pm * BM + wr * 64 + fr, col0 = (u.pn & 7) * BM + wc * 32 + 8 * fq;
#pragma unroll
        for (int ai = 0; ai < 2; ++ai)
#pragma unroll
            for (int m = 0; m < 4; ++m) { bf16_t* rowp = Y + (size_t)(row0 + ai * HALF + m * 16) * 2048 + col0;
#pragma unroll
                for (int bj = 0; bj < 2; ++bj) { const f32x4 v0 = acc[ai][bj][m][0], v1 = acc[ai][bj][m][1];
                    u32x4 w; w.x = cvt_pk_bf16(v0[0], v0[1]); w.y = cvt_pk_bf16(v0[2], v0[3]); w.z = cvt_pk_bf16(v1[0], v1[1]); w.w = cvt_pk_bf16(v1[2], v1[3]);
                    *(u32x4*)(rowp + bj * HALF) = w; } }
    }
};
struct MoeOrder : StaticOrder {
    const unsigned* pe;
    __device__ __forceinline__ bool next(int i, Unit& u) const {
        if (!StaticOrder::next(i, u)) return false;
        u.pn += 8 * (int)__builtin_amdgcn_readfirstlane(__hip_atomic_load(pe + u.pm, __ATOMIC_RELAXED, __HIP_MEMORY_SCOPE_AGENT));
        return true; }
};
}
__device__ __forceinline__ int rope_src_col(int n) {
    const int seg = (n - PMQ) >> 7, pp = (n - PMQ) & 127, g = pp >> 3, e = pp & 7;
    return 3088 + seg * 128 + (e < 4 ? 4 * g + e : 64 + 4 * g + (e - 4));
}
__device__ void phase_cvt(const Params& p, int layer, unsigned char* lds) {
    const int tid = opq_tid();
    constexpr int TSB = 136;
    const float* w_in = p.in[2] + (size_t)layer * DM * DIN;
    const float* w_o = p.in[6] + (size_t)layer * DM * DM;
    const float* w_gate = p.in[11] + (size_t)layer * NE * DM * DEXP;
    const float* w_up = p.in[12] + (size_t)layer * NE * DM * DEXP;
    const float* w_down = p.in[13] + (size_t)layer * NE * DEXP * DM;
    bf16_t* w_inT = (bf16_t*)(p.ws + WS_WIN); bf16_t* w_oT = (bf16_t*)(p.ws + WS_WO); bf16_t* w_guT = (bf16_t*)(p.ws + WS_WGU); bf16_t* w_dT = (bf16_t*)(p.ws + WS_WD);
    for (int tile = blockIdx.x; tile < 14336; tile += gridDim.x) {
        int job, e = 0, nt, kt, t = tile;
        if (t < 1536) { job = 0; nt = t >> 4; kt = t & 15; }
        else if (t < 2048) { t -= 1536; job = 1; nt = t >> 4; kt = t & 15; }
        else if (t < 10240) { t -= 2048; job = 2; e = t >> 9; t &= 511; nt = t >> 4; kt = t & 15; }
        else { t -= 10240; job = 3; e = t >> 8; t &= 255; nt = t >> 3; kt = t & 7; }
        const int n0 = nt * 64, k0 = kt * 128;
#pragma unroll
        for (int it = 0; it < 4; ++it) {
            const int kk = it * 32 + (tid >> 4), c4 = tid & 15, n = n0 + 4 * c4, k = k0 + kk;
            const float* s;
            if (job == 0) { const int col = (n < PMQ) ? n : (n < PMV ? rope_src_col(n) : n + 16); s = w_in + (size_t)k * DIN + col; }
            else if (job == 1) s = w_o + (size_t)k * DM + n;
            else if (job == 2) s = ((n & 4) ? w_up : w_gate) + ((size_t)e * DM + k) * DEXP + 4 * (n >> 3);
            else s = w_down + ((size_t)e * DEXP + k) * DM + n;
            const f32x4 v = *(const f32x4*)s;
            u32x2 pk; pk.x = cvt_pk(v[0], v[1]); pk.y = cvt_pk(v[2], v[3]);
            *(u32x2*)(lds + kk * TSB + 8 * c4) = pk;
        }
        __syncthreads();
#pragma unroll
        for (int it = 0; it < 2; ++it) {
            const int n = tid & 63, kc = (tid >> 6) + 8 * it;
            unsigned w[4];
#pragma unroll
            for (int i = 0; i < 4; ++i) { const unsigned lo = *(const unsigned short*)(lds + (8 * kc + 2 * i) * TSB + 2 * n), hi = *(const unsigned short*)(lds + (8 * kc + 2 * i + 1) * TSB + 2 * n); w[i] = lo | (hi << 16); }
            bf16_t* d;
            if (job == 0) d = w_inT + (size_t)(n0 + n) * DM + k0 + 8 * kc;
            else if (job == 1) d = w_oT + (size_t)(n0 + n) * DM + k0 + 8 * kc;
            else if (job == 2) d = w_guT + ((size_t)e * 2048 + n0 + n) * DM + k0 + 8 * kc;
            else d = w_dT + ((size_t)e * 2048 + n0 + n) * DEXP + k0 + 8 * kc;
            *(u32x4*)d = (u32x4){w[0], w[1], w[2], w[3]};
        }
        __syncthreads();
    }
}

__device__ void phase_rope(const Params& p) {
    float* cs = (float*)(p.ws + WS_ROPE); float* sn = cs + (size_t)T * 64;
    const int* pos = (const int*)p.in[1];
    for (int idx = blockIdx.x * NTHR + opq_tid(); idx < T * 64; idx += gridDim.x * NTHR) {
        const int t = idx >> 6, i = idx & 63;
        double pw = 1.0; for (int k = 0; k < i; ++k) pw *= 1.1547819846894583;
        const float inv = 1.0f / (float)pw;
        const float ang = (float)pos[t] * inv;
        const double rev = (double)ang * 0.15915494309189535; const float fr = (float)(rev - floor(rev));
        cs[idx] = __builtin_amdgcn_cosf(fr); sn[idx] = __builtin_amdgcn_sinf(fr);
    }
}

template <int MODE> __device__ void phase_rows(const Params& p, int layer, unsigned char* lds) {
    const int tid = opq_tid(), lane = tid & 63, wave = tid >> 6;
    float* wT = (float*)lds;
    int* lcnt = (int*)(lds + LDS_SCR + 512); int* gbase = lcnt + 16; float* rinfo = (float*)(lds + LDS_SCR + 1024);
    const bool last = (layer == NLAYER - 1);
    const bool do_skinny = !(MODE == 2 && last);
    const float* W; int ld, c0;
    if (MODE == 0) { W = p.in[2]; ld = DIN; c0 = 3072; }
    else if (MODE == 1) { W = p.in[9]; ld = 16; c0 = 0; }
    else { W = p.in[2] + (size_t)(last ? layer : layer + 1) * DM * DIN; ld = DIN; c0 = 3072; }
    if (do_skinny) for (int idx = tid; idx < DM * 16; idx += NTHR) { const int k = idx >> 4, e = idx & 15; wT[e * DM + k] = W[(size_t)k * ld + c0 + e]; }
    if (MODE == 1 && tid < 16) lcnt[tid] = 0;
    __syncthreads();
    float* gl = (float*)(lds + LDS_SCR + 4096); float* bl2 = gl + DM;
    if (MODE != 0) {
        const float* gp = p.in[MODE == 1 ? 7 : 14] + (size_t)layer * DM; const float* bp = p.in[MODE == 1 ? 8 : 15] + (size_t)layer * DM;
        for (int idx = tid; idx < DM; idx += NTHR) { gl[idx] = gp[idx]; bl2[idx] = bp[idx]; }
    }
    __syncthreads();
    float br[16];
    if (MODE == 1) {
#pragma unroll
        for (int e = 0; e < 16; ++e) br[e] = p.in[10][e];
    }
    bf16_t* hb = (bf16_t*)(p.ws + WS_HB);
    float* glow = (float*)(p.ws + WS_GLOW);
    unsigned* tok = (unsigned*)(p.ws + WS_TOK);
    const bf16_t* Ys = (const bf16_t*)(p.ws + WS_YS);
    const int nit = T / (8 * (int)gridDim.x);
    for (int it = 0; it < nit; ++it) {
        const int row = (it * (int)gridDim.x + (int)blockIdx.x) * 8 + wave;
        float v[32];
        const float* src = (MODE == 0 ? p.in[0] : (const float*)p.out) + (size_t)row * DM;
#pragma unroll
        for (int i = 0; i < 8; ++i) { const f32x4 x = *(const f32x4*)(src + 256 * i + 4 * lane);
#pragma unroll
            for (int j = 0; j < 4; ++j) v[4 * i + j] = x[j]; }
        if (MODE == 2) {
            const float w0 = __uint_as_float(ldu(tok + row * 8 + 2)), w1 = __uint_as_float(ldu(tok + row * 8 + 3));
            const unsigned r0 = ldu(tok + row * 8 + 6), r1 = ldu(tok + row * 8 + 7);
            const bf16_t* y0 = Ys + (size_t)r0 * DM; const bf16_t* y1 = Ys + (size_t)r1 * DM;
#pragma unroll
            for (int i = 0; i < 8; ++i) { const u32x2 a = *(const u32x2*)(y0 + 256 * i + 4 * lane), c = *(const u32x2*)(y1 + 256 * i + 4 * lane);
                v[4 * i + 0] = DN_ALPHA * v[4 * i + 0] + w0 * bflo(a.x) + w1 * bflo(c.x); v[4 * i + 1] = DN_ALPHA * v[4 * i + 1] + w0 * bfhi(a.x) + w1 * bfhi(c.x);
                v[4 * i + 2] = DN_ALPHA * v[4 * i + 2] + w0 * bflo(a.y) + w1 * bflo(c.y); v[4 * i + 3] = DN_ALPHA * v[4 * i + 3] + w0 * bfhi(a.y) + w1 * bfhi(c.y); }
        }
        if (MODE != 0) {
            float s = 0.f;
#pragma unroll
            for (int i = 0; i < 32; ++i) s += v[i];
            const float mean = wave_sum(s) * (1.0f / DM);
            float q = 0.f;
#pragma unroll
            for (int i = 0; i < 32; ++i) { const float d = v[i] - mean; q += d * d; }
            const float rstd = rsqrtf(wave_sum(q) * (1.0f / DM) + 1e-5f);
#pragma unroll
            for (int i = 0; i < 8; ++i) { const f32x4 gv = *(const f32x4*)(gl + 256 * i + 4 * lane), bv = *(const f32x4*)(bl2 + 256 * i + 4 * lane);
#pragma unroll
                for (int j = 0; j < 4; ++j) v[4 * i + j] = (v[4 * i + j] - mean) * rstd * gv[j] + bv[j]; }
            float* dst = p.out + (size_t)row * DM;
#pragma unroll
            for (int i = 0; i < 8; ++i) *(f32x4*)(dst + 256 * i + 4 * lane) = (f32x4){v[4 * i], v[4 * i + 1], v[4 * i + 2], v[4 * i + 3]};
        }
        if (!(MODE == 2 && last)) {
#pragma unroll
            for (int i = 0; i < 8; ++i) { u32x2 w; w.x = cvt_pk(v[4 * i], v[4 * i + 1]); w.y = cvt_pk(v[4 * i + 2], v[4 * i + 3]); *(u32x2*)(hb + (size_t)row * DM + 256 * i + 4 * lane) = w; }
        }
        if (do_skinny) {
            float acc[16];
#pragma unroll
            for (int e = 0; e < 16; ++e) acc[e] = 0.f;
#pragma unroll
            for (int i = 0; i < 8; ++i)
#pragma unroll
                for (int e = 0; e < 16; ++e) { const f32x4 w4 = *(const f32x4*)(wT + e * DM + 256 * i + 4 * lane);
                    acc[e] += v[4 * i] * w4[0] + v[4 * i + 1] * w4[1] + v[4 * i + 2] * w4[2] + v[4 * i + 3] * w4[3]; }
#pragma unroll
            for (int e = 0; e < 16; ++e) acc[e] = wave_sum(acc[e]);
            if (MODE != 1) {
                float val = acc[0];
#pragma unroll
                for (int e = 1; e < 16; ++e) val = (lane == e) ? acc[e] : val;
                if (lane < 16) glow[(size_t)row * 16 + lane] = val;
            } else {
                float mx = acc[0];
#pragma unroll
                for (int e = 1; e < 16; ++e) mx = fmaxf(mx, acc[e]);
                float aff[16], bi[16], sum = 0.f;
#pragma unroll
                for (int e = 0; e < 16; ++e) { aff[e] = __expf(acc[e] - mx); sum += aff[e]; }
                const float rs = 1.0f / sum;
#pragma unroll
                for (int e = 0; e < 16; ++e) { aff[e] *= rs; bi[e] = aff[e] + br[e]; }
                float gs[4];
#pragma unroll
                for (int gi = 0; gi < 4; ++gi) { const float a0 = bi[4 * gi], a1 = bi[4 * gi + 1], a2 = bi[4 * gi + 2], a3 = bi[4 * gi + 3];
                    gs[gi] = fmaxf(fmaxf(fmaxf(a0 + a1, a0 + a2), fmaxf(a0 + a3, a1 + a2)), fmaxf(a1 + a3, a2 + a3)); }
                int best = 0; float bv = gs[0];
#pragma unroll
                for (int gi = 1; gi < 4; ++gi) if (gs[gi] > bv) { bv = gs[gi]; best = gi; }
                float ab[4], aa[4];
#pragma unroll
                for (int k = 0; k < 4; ++k) { ab[k] = best == 0 ? bi[k] : best == 1 ? bi[4 + k] : best == 2 ? bi[8 + k] : bi[12 + k];
                                              aa[k] = best == 0 ? aff[k] : best == 1 ? aff[4 + k] : best == 2 ? aff[8 + k] : aff[12 + k]; }
                int i1 = 0; float v1 = ab[0];
#pragma unroll
                for (int k = 1; k < 4; ++k) if (ab[k] > v1) { v1 = ab[k]; i1 = k; }
                int i2 = -1; float v2 = -3.0e38f;
#pragma unroll
                for (int k = 0; k < 4; ++k) if (k != i1 && ab[k] > v2) { v2 = ab[k]; i2 = k; }
                const float a1 = i1 == 0 ? aa[0] : i1 == 1 ? aa[1] : i1 == 2 ? aa[2] : aa[3];
                const float a2 = i2 == 0 ? aa[0] : i2 == 1 ? aa[1] : i2 == 2 ? aa[2] : aa[3];
                const float ws = 1.0f / (a1 + a2);
                const int e0 = 4 * best + i1, e1 = 4 * best + i2;
                if (lane == 0) {
                    const int ls0 = atomicAdd(&lcnt[e0], 1), ls1 = atomicAdd(&lcnt[e1], 1);
                    float* ri = rinfo + (it * 8 + wave) * 8;
                    ri[0] = __int_as_float(e0); ri[1] = __int_as_float(e1); ri[2] = a1 * ws; ri[3] = a2 * ws; ri[4] = __int_as_float(ls0); ri[5] = __int_as_float(ls1);
                }
            }
        }
    }
    if (MODE == 1) {
        unsigned* cnt = (unsigned*)(p.ws + WS_CTL) + CW_CNT + layer * 64;
        __syncthreads();
        if (tid < 16) gbase[tid] = (int)atomicAdd(&cnt[tid], (unsigned)lcnt[tid]);
        __syncthreads();
        if (tid < 8 * nit) {
            const int it = tid >> 3, wv = tid & 7, row = (it * (int)gridDim.x + (int)blockIdx.x) * 8 + wv;
            const float* ri = rinfo + tid * 8;
            const int e0 = __float_as_int(ri[0]), e1 = __float_as_int(ri[1]);
            u32x4 a; a.x = (unsigned)e0; a.y = (unsigned)e1; a.z = __float_as_uint(ri[2]); a.w = __float_as_uint(ri[3]);
            u32x4 c; c.x = (unsigned)(gbase[e0] + __float_as_int(ri[4])); c.y = (unsigned)(gbase[e1] + __float_as_int(ri[5])); c.z = 0u; c.w = 0u;
            *(u32x4*)(tok + row * 8) = a; *(u32x4*)(tok + row * 8 + 4) = c;
        }
        __syncthreads();
    }
    __syncthreads();
}

__device__ void phase_perm(const Params& p, int layer, unsigned char* lds) {
    const int tid = opq_tid(), lane = tid & 63, wave = tid >> 6;
    int* sb = (int*)lds;
    const unsigned* cnt = (const unsigned*)(p.ws + WS_CTL) + CW_CNT + layer * 64;
    unsigned* misc = (unsigned*)(p.ws + WS_MISC) + layer * 256;
    if (tid < 64) {
        const int c = (lane < NE) ? (int)ldu(cnt + lane) : 0;
        const int nP = (c + 255) >> 8;
        int incl = nP;
#pragma unroll
        for (int o = 1; o < 16; o <<= 1) { const int t = __shfl_up(incl, o); if (lane >= o) incl += t; }
        const int excl = incl - nP;
        if (lane < NE) {
            sb[lane] = excl * 256;
            if (blockIdx.x == 0) { misc[16 + lane] = (unsigned)(excl * 256); for (int q = 0; q < nP; ++q) misc[64 + excl + q] = (unsigned)lane; if (lane == NE - 1) misc[0] = (unsigned)incl; }
        }
    }
    __syncthreads();
    unsigned* tok = (unsigned*)(p.ws + WS_TOK);
    const bf16_t* hb = (const bf16_t*)(p.ws + WS_HB); bf16_t* Xs = (bf16_t*)(p.ws + WS_XS);
    const int nit = T / (8 * (int)gridDim.x);
    for (int it = 0; it < nit; ++it) {
        const int row = (it * (int)gridDim.x + (int)blockIdx.x) * 8 + wave;
        const int e0 = (int)ldu(tok + row * 8), e1 = (int)ldu(tok + row * 8 + 1);
        const int r0 = sb[e0] + (int)ldu(tok + row * 8 + 4), r1 = sb[e1] + (int)ldu(tok + row * 8 + 5);
        const u32x4* s = (const u32x4*)(hb + (size_t)row * DM); u32x4* d0 = (u32x4*)(Xs + (size_t)r0 * DM); u32x4* d1 = (u32x4*)(Xs + (size_t)r1 * DM);
#pragma unroll
        for (int i = 0; i < 4; ++i) { const u32x4 x = s[lane + 64 * i]; d0[lane + 64 * i] = x; d1[lane + 64 * i] = x; }
        if (lane == 0) { tok[row * 8 + 6] = (unsigned)r0; tok[row * 8 + 7] = (unsigned)r1; }
    }
    __syncthreads();
}
constexpr int GL_V = 0, GL_K = 33792, GL_Q = 51200, GL_B = 68608, GL_GLW = 101376, GL_TOT = 105472, GL_AT = 107520, GL_RED = 116736;
#ifndef GLA_NOTR
#define GLA_NOTR 0
#endif
constexpr int KSB = 272, VSB = 528, ASB = 144;

__device__ __forceinline__ float gla_decay(const Params& p, int layer, int c, int h, unsigned char* lds) {
    const int tid = opq_tid();
    float* bl = (float*)(lds + GL_B); float* glw = (float*)(lds + GL_GLW); float* tot = (float*)(lds + GL_TOT);
    const float* glow = (const float*)(p.ws + WS_GLOW) + (size_t)c * 64 * 16;
    if (tid < 256) ((f32x4*)glw)[tid] = ((const f32x4*)glow)[tid];
    const int dk = tid & 127, grp = tid >> 7;
    float w[16];
    const float* wg = p.in[3] + (size_t)layer * 16 * 512 + h * 128 + dk;
#pragma unroll
    for (int r = 0; r < 16; ++r) w[r] = wg[r * 512];
    const float bg = p.in[4][layer * 512 + h * 128 + dk];
    __syncthreads();
    float run = 0.f;
#pragma unroll 4
    for (int tt = 0; tt < 16; ++tt) {
        const int tk = grp * 16 + tt; const f32x4* gr = (const f32x4*)(glw + tk * 16);
        float x = bg;
#pragma unroll
        for (int q = 0; q < 4; ++q) { const f32x4 gq = gr[q]; x += gq[0] * w[4 * q] + gq[1] * w[4 * q + 1] + gq[2] * w[4 * q + 2] + gq[3] * w[4 * q + 3]; }
        const float ls = fminf(x, 0.f) - __logf(1.0f + __expf(-fabsf(x)));
        run += ls * 0.0625f; bl[tk * 128 + dk] = run;
    }
    tot[grp * 128 + dk] = run;
    __syncthreads();
    float pre = 0.f, all = 0.f;
#pragma unroll
    for (int g2 = 0; g2 < 4; ++g2) { const float tv = tot[g2 * 128 + dk]; pre += (g2 < grp) ? tv : 0.f; all += tv; }
#pragma unroll 4
    for (int tt = 0; tt < 16; ++tt) bl[(grp * 16 + tt) * 128 + dk] += pre;
    __syncthreads();
    return all;
}
__device__ __forceinline__ void unpack8(const u32x4 x, float (&f)[8]) { f[0] = bflo(x.x); f[1] = bfhi(x.x); f[2] = bflo(x.y); f[3] = bfhi(x.y); f[4] = bflo(x.z); f[5] = bfhi(x.z); f[6] = bflo(x.w); f[7] = bfhi(x.w); }
__device__ __forceinline__ u32x4 pack8(const float (&f)[8]) { u32x4 w; w.x = cvt_pk(f[0], f[1]); w.y = cvt_pk(f[2], f[3]); w.z = cvt_pk(f[4], f[5]); w.w = cvt_pk(f[6], f[7]); return w; }

__device__ __forceinline__ void gla_stage_v(const bf16_t* proj, int c, int h, unsigned char* lds) {
    const int tid = opq_tid(), tk = tid >> 3, dv0 = (tid & 7) * 32;
    const u32x4* s = (const u32x4*)(proj + (size_t)(c * 64 + tk) * NPROJ + PV + h * 256 + dv0);
    u32x4* d = (u32x4*)(lds + GL_V + tk * VSB + dv0 * 2);
#pragma unroll
    for (int i = 0; i < 4; ++i) d[i] = s[i];
}

__device__ void gla_u_unit(const Params& p, int layer, int c, int h, unsigned char* lds) {
    const int tid = opq_tid(), lane = tid & 63, wave = tid >> 6, g = lane >> 4;
    const bf16_t* proj = (const bf16_t*)(p.ws + WS_PROJ);
    const float blast = gla_decay(p, layer, c, h, lds);
    const float* bl = (const float*)(lds + GL_B); float* tot = (float*)(lds + GL_TOT);
    if (tid < 128) { tot[tid] = blast; ((float*)(p.ws + WS_GDEC))[((size_t)c * 4 + h) * 128 + tid] = __expf(blast); }
    __syncthreads();
    { const int tk = tid >> 3, dk0 = (tid & 7) * 16;
      const u32x4* s = (const u32x4*)(proj + (size_t)(c * 64 + tk) * NPROJ + PK + h * 128 + dk0);
#pragma unroll
      for (int hlf = 0; hlf < 2; ++hlf) { float f[8]; unpack8(s[hlf], f);
#pragma unroll
          for (int j = 0; j < 8; ++j) f[j] *= __expf(tot[dk0 + hlf * 8 + j] - bl[tk * 128 + dk0 + hlf * 8 + j]);
          *(u32x4*)(lds + GL_K + tk * KSB + (dk0 + hlf * 8) * 2) = pack8(f); } }
    gla_stage_v(proj, c, h, lds);
    __syncthreads();
    const int lbase = (int)(uintptr_t)lds, trow = (lane & 15) >> 2, tcol = 4 * (lane & 3);
    f32x4 acc[8][2];
#pragma unroll
    for (int m = 0; m < 8; ++m) { acc[m][0] = (f32x4){0.f, 0.f, 0.f, 0.f}; acc[m][1] = (f32x4){0.f, 0.f, 0.f, 0.f}; }
#pragma unroll
    for (int ks = 0; ks < 2; ++ks) {
        const int kb = 32 * ks + 8 * g + trow;
#if GLA_NOTR
        bf16x8 af[8], bfv[2];
#pragma unroll
        for (int m = 0; m < 8; ++m) {
#pragma unroll
            for (int j = 0; j < 8; ++j) af[m][j] = *(const short*)(lds + GL_K + (32 * ks + 8 * g + j) * KSB + (16 * m + (lane & 15)) * 2); }
#pragma unroll
        for (int nn = 0; nn < 2; ++nn) {
#pragma unroll
            for (int j = 0; j < 8; ++j) bfv[nn][j] = *(const short*)(lds + GL_V + (32 * ks + 8 * g + j) * VSB + (32 * wave + 16 * nn + (lane & 15)) * 2); }
#pragma unroll
        for (int m = 0; m < 8; ++m)
#pragma unroll
            for (int nn = 0; nn < 2; ++nn) acc[m][nn] = MFMA16(af[m], bfv[nn], acc[m][nn]);
#else
        s16x4 al[4], ah[4], vl[2], vh[2];
#pragma unroll
        for (int nn = 0; nn < 2; ++nn) { const int a = lbase + GL_V + kb * VSB + (32 * wave + 16 * nn + tcol) * 2; vl[nn] = tr_rd(a); vh[nn] = tr_rd(a + 4 * VSB); }
#pragma unroll
        for (int mh = 0; mh < 2; ++mh) {
#pragma unroll
            for (int m = 0; m < 4; ++m) { const int a = lbase + GL_K + kb * KSB + (16 * (4 * mh + m) + tcol) * 2; al[m] = tr_rd(a); ah[m] = tr_rd(a + 4 * KSB); }
            LGKM0();
#pragma unroll
            for (int m = 0; m < 4; ++m)
#pragma unroll
                for (int nn = 0; nn < 2; ++nn) acc[4 * mh + m][nn] = MFMA16(PK8(al[m], ah[m]), PK8(vl[nn], vh[nn]), acc[4 * mh + m][nn]);
            __builtin_amdgcn_sched_barrier(0);
        }
#endif
    }
    bf16_t* U = (bf16_t*)(p.ws + WS_U);
#pragma unroll
    for (int m = 0; m < 8; ++m)
#pragma unroll
        for (int nn = 0; nn < 2; ++nn) { const int dv = 32 * wave + 16 * nn + (lane & 15), dk = 16 * m + 4 * g;
            u32x2 w; w.x = cvt_pk(acc[m][nn][0], acc[m][nn][1]); w.y = cvt_pk(acc[m][nn][2], acc[m][nn][3]);
            *(u32x2*)(U + (((size_t)c * 4 + h) * 256 + dv) * 128 + dk) = w; }
    __syncthreads();
}

__device__ void gla_scan(const Params& p, int bi, int nblk) {
    const unsigned* U32 = (const unsigned*)(p.ws + WS_U); unsigned* S32 = (unsigned*)(p.ws + WS_S); const float* gdec = (const float*)(p.ws + WS_GDEC);
    for (int idx = bi * NTHR + opq_tid(); idx < 65536; idx += nblk * NTHR) {
        const int e2 = idx * 2, h = e2 >> 15, dk = e2 & 127;
        float s0 = 0.f, s1 = 0.f;
        for (int c0 = 0; c0 < 256; c0 += 16) {
            unsigned u[16]; float a0[16], a1[16];
#pragma unroll
            for (int i = 0; i < 16; ++i) { u[i] = U32[(size_t)(c0 + i) * 65536 + idx]; const float* ap = gdec + ((size_t)(c0 + i) * 4 + h) * 128 + dk; a0[i] = ap[0]; a1[i] = ap[1]; }
#pragma unroll
            for (int i = 0; i < 16; ++i) { S32[(size_t)(c0 + i) * 65536 + idx] = cvt_pk(s0, s1); s0 = a0[i] * s0 + bflo(u[i]); s1 = a1[i] * s1 + bfhi(u[i]); }
        }
    }
}

__device__ void gla_out_unit(const Params& p, int layer, int c, int h, unsigned char* lds) {
    const int tid = opq_tid(), lane = tid & 63, wave = tid >> 6, g = lane >> 4, l15 = lane & 15;
    const bf16_t* proj = (const bf16_t*)(p.ws + WS_PROJ);
    (void)gla_decay(p, layer, c, h, lds);
    const float* bl = (const float*)(lds + GL_B);
    { const int tk = tid >> 3, dk0 = (tid & 7) * 16;
      const u32x4* sq = (const u32x4*)(proj + (size_t)(c * 64 + tk) * NPROJ + PQ + h * 128 + dk0);
      const u32x4* sk = (const u32x4*)(proj + (size_t)(c * 64 + tk) * NPROJ + PK + h * 128 + dk0);
#pragma unroll
      for (int hlf = 0; hlf < 2; ++hlf) { float fq[8], fk[8]; unpack8(sq[hlf], fq); unpack8(sk[hlf], fk);
#pragma unroll
          for (int j = 0; j < 8; ++j) { const float bb = bl[tk * 128 + dk0 + hlf * 8 + j]; fq[j] *= __expf(bb) * 0.08838834764831845f; fk[j] *= __expf(-bb); }
          *(u32x4*)(lds + GL_Q + tk * KSB + (dk0 + hlf * 8) * 2) = pack8(fq); *(u32x4*)(lds + GL_K + tk * KSB + (dk0 + hlf * 8) * 2) = pack8(fk); } }
    gla_stage_v(proj, c, h, lds);
    __syncthreads();
    { const int mj = wave >> 1;
      f32x4 at[2] = {(f32x4){0.f, 0.f, 0.f, 0.f}, (f32x4){0.f, 0.f, 0.f, 0.f}};
#pragma unroll
      for (int ks = 0; ks < 4; ++ks) {
          const bf16x8 A = *(const bf16x8*)(lds + GL_K + (16 * mj + l15) * KSB + (32 * ks + 8 * g) * 2);
#pragma unroll
          for (int t2 = 0; t2 < 2; ++t2) { const int ni = 2 * (wave & 1) + t2; const bf16x8 B = *(const bf16x8*)(lds + GL_Q + (16 * ni + l15) * KSB + (32 * ks + 8 * g) * 2); at[t2] = MFMA16(A, B, at[t2]); }
      }
#pragma unroll
      for (int t2 = 0; t2 < 2; ++t2) { const int ni = 2 * (wave & 1) + t2, i = 16 * ni + l15, j0 = 16 * mj + 4 * g;
          float v[4];
#pragma unroll
          for (int r = 0; r < 4; ++r) v[r] = (i >= j0 + r) ? at[t2][r] : 0.f;
          u32x2 w; w.x = cvt_pk(v[0], v[1]); w.y = cvt_pk(v[2], v[3]); *(u32x2*)(lds + GL_AT + i * ASB + j0 * 2) = w; }
    }
    __syncthreads();
    const int lbase = (int)(uintptr_t)lds, trow = l15 >> 2, tcol = 4 * (lane & 3);
    f32x4 acc[2][4];
#pragma unroll
    for (int mm = 0; mm < 2; ++mm)
#pragma unroll
        for (int n = 0; n < 4; ++n) acc[mm][n] = (f32x4){0.f, 0.f, 0.f, 0.f};
#pragma unroll
    for (int ks = 0; ks < 2; ++ks) {
        const int kb = 32 * ks + 8 * g + trow;
        s16x4 vl[2], vh[2]; bf16x8 B[4];
#pragma unroll
        for (int mm = 0; mm < 2; ++mm) { const int a = lbase + GL_V + kb * VSB + (32 * wave + 16 * mm + tcol) * 2; vl[mm] = tr_rd(a); vh[mm] = tr_rd(a + 4 * VSB); }
#pragma unroll
        for (int n = 0; n < 4; ++n) B[n] = *(const bf16x8*)(lds + GL_AT + (16 * n + l15) * ASB + (32 * ks + 8 * g) * 2);
        LGKM0();
#pragma unroll
        for (int mm = 0; mm < 2; ++mm)
#pragma unroll
            for (int n = 0; n < 4; ++n) acc[mm][n] = MFMA16(PK8(vl[mm], vh[mm]), B[n], acc[mm][n]);
    }
    if (c > 0) {
        const bf16_t* S = (const bf16_t*)(p.ws + WS_S) + ((size_t)c * 4 + h) * 256 * 128;
#pragma unroll
        for (int ks = 0; ks < 4; ++ks) {
            bf16x8 A[2], B[4];
#pragma unroll
            for (int mm = 0; mm < 2; ++mm) A[mm] = *(const bf16x8*)(S + (size_t)(32 * wave + 16 * mm + l15) * 128 + 32 * ks + 8 * g);
#pragma unroll
            for (int n = 0; n < 4; ++n) B[n] = *(const bf16x8*)(lds + GL_Q + (16 * n + l15) * KSB + (32 * ks + 8 * g) * 2);
#pragma unroll
            for (int mm = 0; mm < 2; ++mm)
#pragma unroll
                for (int n = 0; n < 4; ++n) acc[mm][n] = MFMA16(A[mm], B[n], acc[mm][n]);
        }
    }
    float* red = (float*)(lds + GL_RED);
    float ss[4];
#pragma unroll
    for (int n = 0; n < 4; ++n) { float s = 0.f;
#pragma unroll
        for (int mm = 0; mm < 2; ++mm)
#pragma unroll
            for (int r = 0; r < 4; ++r) s += acc[mm][n][r] * acc[mm][n][r];
        s += __shfl_xor(s, 16); s += __shfl_xor(s, 32); ss[n] = s; }
    if (g == 0) {
#pragma unroll
        for (int n = 0; n < 4; ++n) red[(16 * n + l15) * 8 + wave] = ss[n]; }
    __syncthreads();
    bf16_t* mix = (bf16_t*)(p.ws + WS_MIX);
    const float* gnorm = p.in[5] + layer * 256;
#pragma unroll
    for (int n = 0; n < 4; ++n) {
        const int tk = 16 * n + l15; const f32x4 r0 = *(const f32x4*)(red + tk * 8), r1 = *(const f32x4*)(red + tk * 8 + 4);
        const float rstd = rsqrtf(((r0[0] + r0[1]) + (r0[2] + r0[3]) + (r1[0] + r1[1]) + (r1[2] + r1[3])) * (1.0f / 256.0f) + 1e-6f);
        const size_t tg = (size_t)c * 64 + tk;
#pragma unroll
        for (int mm = 0; mm < 2; ++mm) { const int dv = 32 * wave + 16 * mm + 4 * g;
            const u32x2 gg = *(const u32x2*)(proj + tg * NPROJ + PG + h * 256 + dv); const f32x4 nr = *(const f32x4*)(gnorm + dv);
            const float o0 = acc[mm][n][0] * rstd * nr[0] * silu_f(bflo(gg.x)), o1 = acc[mm][n][1] * rstd * nr[1] * silu_f(bfhi(gg.x));
            const float o2 = acc[mm][n][2] * rstd * nr[2] * silu_f(bflo(gg.y)), o3 = acc[mm][n][3] * rstd * nr[3] * silu_f(bfhi(gg.y));
            u32x2 w; w.x = cvt_pk(o0, o1); w.y = cvt_pk(o2, o3); *(u32x2*)(mix + tg * DM + h * 256 + dv) = w; }
    }
    __syncthreads();
}

__device__ void moba_kmean_unit(const Params& p, int h, int j, unsigned char* lds) {
    const int tid = opq_tid(), d0 = (tid & 15) * 8, kg = tid >> 4;
    const bf16_t* proj = (const bf16_t*)(p.ws + WS_PROJ);
    float acc[8];
#pragma unroll
    for (int i = 0; i < 8; ++i) acc[i] = 0.f;
#pragma unroll
    for (int kk = 0; kk < 8; ++kk) { float f[8]; unpack8(*(const u32x4*)(proj + (size_t)(j * 256 + kg * 8 + kk) * NPROJ + PMK + h * 128 + d0), f);
#pragma unroll
        for (int i = 0; i < 8; ++i) acc[i] += f[i]; }
    float* red = (float*)lds;
#pragma unroll
    for (int i = 0; i < 8; ++i) red[kg * 128 + d0 + i] = acc[i];
    __syncthreads();
    if (tid < 128) { float s = 0.f;
#pragma unroll 8
        for (int q = 0; q < 32; ++q) s += red[q * 128 + tid];
        ((float*)(p.ws + WS_KMEAN))[((size_t)h * 64 + j) * 128 + tid] = s * (1.0f / 256.0f); }
    __syncthreads();
}

#define TOP3_INS(s, j) do { const float _s = (s); const int _j = (j); \
    if (_s > v0 || (_s == v0 && _j < i0)) { v2 = v1; i2 = i1; v1 = v0; i1 = i0; v0 = _s; i0 = _j; } \
    else if (_s > v1 || (_s == v1 && _j < i1)) { v2 = v1; i2 = i1; v1 = _s; i1 = _j; } \
    else if (_s > v2 || (_s == v2 && _j < i2)) { v2 = _s; i2 = _j; } } while (0)

__device__ void moba_gate_unit(const Params& p, int h, int qb, unsigned char* lds) {
    const int tid = opq_tid(), par = tid >> 8;
    const bf16_t* proj = (const bf16_t*)(p.ws + WS_PROJ);
    float* km = (float*)lds; float* cand = (float*)(lds + 32768);
    for (int idx = tid; idx < 64 * 128 / 4; idx += NTHR) ((f32x4*)km)[idx] = ((const f32x4*)((const float*)(p.ws + WS_KMEAN) + (size_t)h * 64 * 128))[idx];
    const int q = qb * 256 + (tid & 255);
    float qv[128];
#pragma unroll
    for (int i = 0; i < 16; ++i) { float f[8]; unpack8(*(const u32x4*)(proj + (size_t)q * NPROJ + PMQ + h * 128 + 8 * i), f);
#pragma unroll
        for (int j = 0; j < 8; ++j) qv[8 * i + j] = f[j]; }
    __syncthreads();
    float v0 = -3.0e38f, v1 = -3.0e38f, v2 = -3.0e38f; int i0 = 255, i1 = 255, i2 = 255;
    for (int j = par; j < qb; j += 2) {
        const f32x4* kr = (const f32x4*)(km + j * 128);
        float s0 = 0.f, s1 = 0.f, s2 = 0.f, s3 = 0.f;
#pragma unroll
        for (int i = 0; i < 32; ++i) { const f32x4 kk = kr[i]; s0 += qv[4 * i] * kk[0]; s1 += qv[4 * i + 1] * kk[1]; s2 += qv[4 * i + 2] * kk[2]; s3 += qv[4 * i + 3] * kk[3]; }
        TOP3_INS((s0 + s1) + (s2 + s3), j);
    }
    if (par == 1) { float* cd = cand + (tid & 255) * 6; cd[0] = v0; cd[1] = v1; cd[2] = v2; cd[3] = __int_as_float(i0); cd[4] = __int_as_float(i1); cd[5] = __int_as_float(i2); }
    __syncthreads();
    if (par == 0) {
        const float* cd = cand + tid * 6;
        const float c0 = cd[0], c1 = cd[1], c2 = cd[2]; const int j0 = __float_as_int(cd[3]), j1 = __float_as_int(cd[4]), j2 = __float_as_int(cd[5]);
        if (j0 != 255) TOP3_INS(c0, j0);
        if (j1 != 255) TOP3_INS(c1, j1);
        if (j2 != 255) TOP3_INS(c2, j2);
        ((unsigned*)(p.ws + WS_SEL))[(size_t)h * T + q] = (unsigned)i0 | ((unsigned)i1 << 8) | ((unsigned)i2 << 16) | 0xFF000000u;
    }
    __syncthreads();
}

__device__ __forceinline__ int list_off(int j) { return 256 * (63 * j - (j * (j - 1)) / 2); }

__device__ void moba_list_unit(const Params& p, int layer, int h, int j, unsigned char* lds) {
    const int tid = opq_tid(), lane = tid & 63, wave = tid >> 6;
    const unsigned* sel = (const unsigned*)(p.ws + WS_SEL) + (size_t)h * T;
    unsigned* list = (unsigned*)(p.ws + WS_LIST) + (size_t)h * LISTH + list_off(j);
    int* wcnt = (int*)lds;
    int total = 0;
    for (int q0 = (j + 1) * 256; q0 < T; q0 += NTHR) {
        const int q = q0 + tid;
        const unsigned w = (q < T) ? sel[q] : 0xFFFFFFFFu;
        const int slot = ((w & 0xFF) == (unsigned)j) ? 0 : (((w >> 8) & 0xFF) == (unsigned)j) ? 1 : (((w >> 16) & 0xFF) == (unsigned)j) ? 2 : -1;
        const unsigned long long bal = __ballot(slot >= 0);
        const int pre = __builtin_popcountll(bal & ((1ull << lane) - 1ull)), wc = __builtin_popcountll(bal);
        if (lane == 0) wcnt[wave] = wc;
        __syncthreads();
        int off = total, tot = 0;
#pragma unroll
        for (int w2 = 0; w2 < 8; ++w2) { const int cw = wcnt[w2]; off += (w2 < wave) ? cw : 0; tot += cw; }
        if (slot >= 0) list[off + pre] = (unsigned)q | ((unsigned)slot << 16);
        total += tot;
        __syncthreads();
    }
    if (tid == 0) {
        unsigned* ctl = (unsigned*)(p.ws + WS_CTL);
        const int nit = (total + 255) >> 8;
        const unsigned base = atomicAdd(&ctl[CW_NIT + layer * 64], (unsigned)(nit + 1));
        u32x4* items = (u32x4*)(p.ws + WS_ITEMS) + layer * 4096;
        items[base] = (u32x4){(unsigned)h, (unsigned)j, 0xFFFFu, 256u};
        for (int c = 0; c < nit; ++c) items[base + 1 + c] = (u32x4){(unsigned)h, (unsigned)j, (unsigned)c, (unsigned)total};
    }
}
namespace att {
constexpr int D = 128, NW = 8, QBLK = 32, KVBLK = 64, LDK = NPROJ;
constexpr float SCALE = 0.088388347648318440f, THR = 8.f;
constexpr float CEXP = SCALE * 1.4426950408889634f;
constexpr size_t SHM_V = KVBLK * D * 2, SHM_K = KVBLK * D * 2;
#define KSWZ(row, colB) ((row) * 256 + ((colB) ^ (((row) & 7) << 4)))
#define SBAR() __builtin_amdgcn_sched_barrier(0)
__device__ __forceinline__ int crow(int r, int hi) { return (r & 3) + 8 * (r >> 2) + 4 * hi; }
__device__ __forceinline__ unsigned cvtpk(float lo, float hi) { return cvt_pk(lo, hi); }

__device__ __forceinline__ void partialSM(f32x16& p0, f32x16& p1, float& m_reg, float& mn, float& alpha) {
  constexpr float C = CEXP;
  float pmax = p0[0];
#pragma unroll
  for (int r = 1; r < 16; ++r) pmax = fmaxf(pmax, p0[r]);
#pragma unroll
  for (int r = 0; r < 16; ++r) pmax = fmaxf(pmax, p1[r]);
  { auto rr = __builtin_amdgcn_permlane32_swap(__float_as_uint(pmax), __float_as_uint(pmax), false, false);
    pmax = fmaxf(__uint_as_float(rr[0]), __uint_as_float(rr[1])); }
  if (__builtin_expect(__all(pmax - m_reg <= THR / SCALE), 1)) { mn = m_reg; alpha = 1.f; }
  else { mn = fmaxf(m_reg, pmax); alpha = __builtin_amdgcn_exp2f((m_reg - mn) * C); m_reg = mn; }
  const float mnC = -mn * C;
#pragma unroll
  for (int r = 0; r < 16; ++r) p0[r] = fmaf(p0[r], C, mnC);
#pragma unroll
  for (int r = 0; r < 16; ++r) p1[r] = fmaf(p1[r], C, mnC);
#pragma unroll
  for (int r = 0; r < 16; ++r) p0[r] = __builtin_amdgcn_exp2f(p0[r]);
}
__device__ __forceinline__ void finishSM(f32x16& p0, f32x16& p1, float alpha, float& l_reg, bf16x8& pa0, bf16x8& pa1, bf16x8& pa2, bf16x8& pa3) {
#pragma unroll
  for (int r = 0; r < 16; ++r) p1[r] = __builtin_amdgcn_exp2f(p1[r]);
  float ps = 0;
#pragma unroll
  for (int r = 0; r < 16; ++r) ps += p0[r];
#pragma unroll
  for (int r = 0; r < 16; ++r) ps += p1[r];
  { auto rr = __builtin_amdgcn_permlane32_swap(__float_as_uint(ps), __float_as_uint(ps), false, false);
    ps = __uint_as_float(rr[0]) + __uint_as_float(rr[1]); }
  l_reg = l_reg * alpha + ps;
#define PK4(P, BASE, OUT) do { unsigned a0 = cvtpk(P[BASE + 0], P[BASE + 1]), a1 = cvtpk(P[BASE + 2], P[BASE + 3]);   \
    unsigned b0 = cvtpk(P[BASE + 4], P[BASE + 5]), b1 = cvtpk(P[BASE + 6], P[BASE + 7]);                              \
    auto r0 = __builtin_amdgcn_permlane32_swap(a0, b0, false, false); auto r1 = __builtin_amdgcn_permlane32_swap(a1, b1, false, false); \
    u32x4 w = {r0[0], r1[0], r0[1], r1[1]}; OUT = *reinterpret_cast<bf16x8*>(&w); } while (0)
  PK4(p0, 0, pa0); PK4(p0, 8, pa1); PK4(p1, 0, pa2); PK4(p1, 8, pa3);
#undef PK4
}
__device__ __forceinline__ void qkt(f32x16& p0, f32x16& p1, const char* Ks, const bf16x8* qr, int r32, int hi) {
  p0 = f32x16{}; p1 = f32x16{};
#pragma unroll
  for (int d0 = 0; d0 < 8; ++d0) { const int cb = (d0 * 16 + hi * 8) * 2;
    const bf16x8 b0 = *reinterpret_cast<const bf16x8*>(Ks + KSWZ(r32, cb));
    const bf16x8 b1 = *reinterpret_cast<const bf16x8*>(Ks + KSWZ(32 + r32, cb));
    p0 = __builtin_amdgcn_mfma_f32_32x32x16_bf16(b0, qr[d0], p0, 0, 0, 0);
    p1 = __builtin_amdgcn_mfma_f32_32x32x16_bf16(b1, qr[d0], p1, 0, 0, 0); }
}
__device__ __forceinline__ void mask_tile(f32x16& p0, f32x16& p1, int tile, int qrow, int hi) {
#pragma unroll
  for (int r = 0; r < 16; ++r) { const int key = tile * 64 + crow(r, hi); if (key > qrow) p0[r] = -1.0e30f; if (key + 32 > qrow) p1[r] = -1.0e30f; }
}
__device__ __forceinline__ int v_st(int k, int c) { const int kk = (k & ~0xC) | ((k & 4) << 1) | ((k & 8) >> 1); return ((kk >> 3) * 4 + (c >> 5)) * 512 + ((kk & 7) * 32 + (c & 31)) * 2; }
__device__ __forceinline__ int v_rd_base(int lane) { return ((lane & 3) << 3) | (((lane >> 2) & 3) << 6) | (((lane >> 4) & 1) << 5) | (((lane >> 5) & 1) << 8); }
constexpr int v_rd_off(int d0, int ks, int half) { return d0 * 512 + ks * 4096 + half * 2048; }
template <int OFF> __device__ __forceinline__ s16x4 tr_read(int vb) {
  s16x4 r; asm volatile("ds_read_b64_tr_b16 %0, %1 offset:%2" : "=&v"(r) : "v"(vb), "i"(OFF) : "memory"); return r;
}
template <int D0> __device__ __forceinline__ void pv_one(f32x16& od, int vb, bf16x8 pa0, bf16x8 pa1, bf16x8 pa2, bf16x8 pa3) {
  const s16x4 l0 = tr_read<v_rd_off(D0, 0, 0)>(vb), h0 = tr_read<v_rd_off(D0, 0, 1)>(vb), l1 = tr_read<v_rd_off(D0, 1, 0)>(vb), h1 = tr_read<v_rd_off(D0, 1, 1)>(vb);
  const s16x4 l2 = tr_read<v_rd_off(D0, 2, 0)>(vb), h2 = tr_read<v_rd_off(D0, 2, 1)>(vb), l3 = tr_read<v_rd_off(D0, 3, 0)>(vb), h3 = tr_read<v_rd_off(D0, 3, 1)>(vb);
  asm volatile("s_waitcnt lgkmcnt(0)" ::: "memory"); SBAR();
  od = __builtin_amdgcn_mfma_f32_32x32x16_bf16(pa0, PK8(l0, h0), od, 0, 0, 0);
  od = __builtin_amdgcn_mfma_f32_32x32x16_bf16(pa1, PK8(l1, h1), od, 0, 0, 0);
  od = __builtin_amdgcn_mfma_f32_32x32x16_bf16(pa2, PK8(l2, h2), od, 0, 0, 0);
  od = __builtin_amdgcn_mfma_f32_32x32x16_bf16(pa3, PK8(l3, h3), od, 0, 0, 0);
}
__device__ __forceinline__ void pv_d0(f32x16* o, int vb, bf16x8 pa0, bf16x8 pa1, bf16x8 pa2, bf16x8 pa3) {
  pv_one<0>(o[0], vb, pa0, pa1, pa2, pa3); pv_one<1>(o[1], vb, pa0, pa1, pa2, pa3); pv_one<2>(o[2], vb, pa0, pa1, pa2, pa3); pv_one<3>(o[3], vb, pa0, pa1, pa2, pa3);
}

__device__ __forceinline__ void moba_item(const bf16_t* __restrict__ proj, int h, int jblk, const unsigned* list, int nvalid, bf16_t* PO, float* PML, char* lds) {
  const int tid = opq_tid(), wid = tid >> 6, lane = tid & 63, r32 = lane & 31, hi = lane >> 5;
  const bool own = (list == nullptr);
  char* V_lds = lds; char* K_lds = lds + 2 * SHM_V;
  float* ws = (float*)(lds + 2 * SHM_V + 2 * SHM_K) + wid * 64; float* al_l = ws + 32;
  float m_reg = -1e30f, l_reg = 0; f32x16 o[4] = {}; bf16x8 qr[8];
  const int myrow = wid * QBLK + r32;
  int q, slot; bool valid;
  if (own) { q = jblk * 256 + myrow; slot = 3; valid = true; }
  else { const int rr = myrow < nvalid ? myrow : nvalid - 1; const unsigned e = list[rr]; q = (int)(e & 0xFFFFu); slot = (int)(e >> 16); valid = myrow < nvalid; }
  const bf16_t* Qw = proj + (size_t)q * NPROJ + PMQ + h * D + hi * 8;
#pragma unroll
  for (int d0 = 0; d0 < 8; ++d0) qr[d0] = *reinterpret_cast<const bf16x8*>(Qw + d0 * 16);
  const bf16_t* Kh = proj + (size_t)jblk * 256 * NPROJ + PMK + h * D;
  const bf16_t* Vh = proj + (size_t)jblk * 256 * NPROJ + PMV + h * D;
  const int sr = tid >> 4, sc = (tid & 15) * 8, vst0 = v_st(sr, sc), vst1 = v_st(32 + sr, sc);
  const int vb0 = (int)(uintptr_t)V_lds + v_rd_base(lane);
  struct { bf16x8 vs0, vs1, ks0, ks1; } sr_[2];
#define SLOAD(i, k0) do { sr_[i].vs0 = *(const bf16x8*)(&Vh[(size_t)((k0) + sr) * LDK + sc]); sr_[i].vs1 = *(const bf16x8*)(&Vh[(size_t)((k0) + 32 + sr) * LDK + sc]); \
    sr_[i].ks0 = *(const bf16x8*)(&Kh[(size_t)((k0) + sr) * LDK + sc]); sr_[i].ks1 = *(const bf16x8*)(&Kh[(size_t)((k0) + 32 + sr) * LDK + sc]); } while (0)
#define SWRITE(b, i) do { *(bf16x8*)(V_lds + (b) * SHM_V + vst0) = sr_[i].vs0;          \
    *(bf16x8*)(V_lds + (b) * SHM_V + vst1) = sr_[i].vs1; const int kc = sc * 2;               \
    *(bf16x8*)(K_lds + (b) * SHM_K + KSWZ(sr, kc)) = sr_[i].ks0;                       \
    *(bf16x8*)(K_lds + (b) * SHM_K + KSWZ(32 + sr, kc)) = sr_[i].ks1; } while (0)
#define SWAIT() asm volatile("s_waitcnt vmcnt(4)" ::: "memory")
#define RESC(a) do { if (__any((a) < 1.f)) { if (hi == 0) al_l[r32] = (a); asm volatile("s_waitcnt lgkmcnt(0)" ::: "memory"); \
    _Pragma("unroll") for (int d = 0; d < 4; ++d) _Pragma("unroll") for (int r = 0; r < 16; ++r) o[d][r] *= al_l[crow(r, hi)]; } } while (0)
  f32x16 pA0, pA1, pB0, pB1; float mnA, mnB, alA, alB; bf16x8 pa0, pa1, pa2, pa3;
  constexpr int NT = 4, SE = 0, SO = 1;
  SLOAD(SE, 0); asm volatile("s_waitcnt vmcnt(0)" ::: "memory"); SWRITE(0, SE); __syncthreads();
  qkt(pA0, pA1, K_lds, qr, r32, hi); if (own) mask_tile(pA0, pA1, 0, myrow, hi); partialSM(pA0, pA1, m_reg, mnA, alA);
  SLOAD(SO, KVBLK); SLOAD(SE, 2 * KVBLK);
  SWAIT(); SWRITE(1, SO); __syncthreads();
  {
    SBAR(); qkt(pB0, pB1, K_lds + SHM_K, qr, r32, hi); if (own) mask_tile(pB0, pB1, 1, myrow, hi);
    finishSM(pA0, pA1, alA, l_reg, pa0, pa1, pa2, pa3); SBAR();
    SLOAD(SO, 3 * KVBLK); SBAR();
    pv_d0(o, vb0, pa0, pa1, pa2, pa3); partialSM(pB0, pB1, m_reg, mnB, alB);
    __syncthreads(); SWAIT(); SWRITE(0, SE);
    RESC(alB); __syncthreads();
    SBAR(); qkt(pA0, pA1, K_lds, qr, r32, hi); if (own) mask_tile(pA0, pA1, 2, myrow, hi);
    finishSM(pB0, pB1, alB, l_reg, pa0, pa1, pa2, pa3); SBAR();
    pv_d0(o, vb0 + (int)SHM_V, pa0, pa1, pa2, pa3); partialSM(pA0, pA1, m_reg, mnA, alA);
    __syncthreads(); asm volatile("s_waitcnt vmcnt(0)" ::: "memory"); SWRITE(1, SO);
    RESC(alA); __syncthreads();
  }
  SBAR(); qkt(pB0, pB1, K_lds + SHM_K, qr, r32, hi); if (own) mask_tile(pB0, pB1, 3, myrow, hi);
  finishSM(pA0, pA1, alA, l_reg, pa0, pa1, pa2, pa3); SBAR();
  pv_d0(o, vb0, pa0, pa1, pa2, pa3); partialSM(pB0, pB1, m_reg, mnB, alB);
  __syncthreads(); RESC(alB);
  finishSM(pB0, pB1, alB, l_reg, pa0, pa1, pa2, pa3); SBAR();
  pv_d0(o, vb0 + (int)SHM_V, pa0, pa1, pa2, pa3);
  __syncthreads();
  unsigned short* st = (unsigned short*)(lds + wid * 8192);
#pragma unroll
  for (int d0 = 0; d0 < 4; ++d0)
#pragma unroll
    for (int r = 0; r < 16; ++r) st[crow(r, hi) * 128 + 32 * d0 + r32] = (unsigned short)(cvtpk(o[d0][r], o[d0][r]) & 0xFFFFu);
  const int porow = valid ? ((q * 8 + h) * 4 + slot) : -1;
  if (hi == 0 && valid) { PML[(size_t)porow * 2] = m_reg * CEXP; PML[(size_t)porow * 2 + 1] = l_reg; }
  asm volatile("s_waitcnt lgkmcnt(0)" ::: "memory");
#pragma unroll
  for (int it = 0; it < 8; ++it) {
    const int row = it * 4 + (lane >> 4), ch = lane & 15;
    const int pr = __shfl(porow, row);
    const u32x4 vv = *(const u32x4*)(st + row * 128 + ch * 8);
    if (pr >= 0) *(u32x4*)(PO + (size_t)pr * 128 + ch * 8) = vv;
  }
  __syncthreads();
#undef SLOAD
#undef SWRITE
#undef SWAIT
#undef RESC
}
#undef KSWZ
#undef SBAR
}

__device__ void moba_combine(const Params& p) {
    const bf16_t* PO = (const bf16_t*)(p.ws + WS_PO); const float* PML = (const float*)(p.ws + WS_PML); bf16_t* mix = (bf16_t*)(p.ws + WS_MIX);
    for (int idx = blockIdx.x * NTHR + opq_tid(); idx < T * 8 * 16; idx += gridDim.x * NTHR) {
        const int ch = idx & 15, qh = idx >> 4, q = qh >> 3, h = qh & 7, qb = q >> 8, nv = qb < 3 ? qb : 3;
        float m[4], l[4], M = -3.0e38f;
#pragma unroll
        for (int k = 0; k < 4; ++k) { const bool ok = (k == 3) || (k < nv); m[k] = ok ? PML[((size_t)qh * 4 + k) * 2] : -3.0e38f; l[k] = ok ? PML[((size_t)qh * 4 + k) * 2 + 1] : 0.f; M = fmaxf(M, m[k]); }
        float o[8], L = 0.f;
#pragma unroll
        for (int i = 0; i < 8; ++i) o[i] = 0.f;
#pragma unroll
        for (int k = 0; k < 4; ++k) { const bool ok = (k == 3) || (k < nv);
            if (ok) { const float w = __builtin_amdgcn_exp2f(m[k] - M); L += w * l[k]; float f[8]; unpack8(*(const u32x4*)(PO + ((size_t)qh * 4 + k) * 128 + ch * 8), f);
#pragma unroll
                for (int i = 0; i < 8; ++i) o[i] += w * f[i]; } }
        const float rl = 1.0f / L;
#pragma unroll
        for (int i = 0; i < 8; ++i) o[i] *= rl;
        *(u32x4*)(mix + (size_t)q * DM + 1024 + h * 128 + ch * 8) = pack8(o);
    }
}
#ifndef PHMASK
#define PHMASK 0xFFFF
#endif
enum { PH_CVT = 0, PH_INPROJ, PH_MIXA, PH_MIXB, PH_MIXC, PH_ATT, PH_COMB, PH_OUTPROJ, PH_LN1, PH_PERM, PH_MOE1, PH_MOE2, PH_LN2, NPH };
constexpr int NSLOT = 2 * NPH;
#ifndef MK_DEBUG
#define MK_DEBUG 0
#endif
#if MK_DEBUG
#include "part_chk.inc"
#endif

__global__ void __launch_bounds__(NTHR, 2) mk_fwd(Params p) {
    extern __shared__ __attribute__((aligned(16))) unsigned char lds[];
    const int tid = threadIdx.x;
    for (int u = tid; u < (LDS_BYTES - LDS_SCR) / 4; u += NTHR) ((unsigned*)(lds + LDS_SCR))[u] = 0u;
    __syncthreads();
    unsigned* ctl = (unsigned*)(p.ws + WS_CTL);
    XcdBarrier bar; bar.bar = ctl + CW_BAR; bar.x = 0; bar.st = (volatile LAS unsigned*)(lds + LDS_SCR + 32);
    constexpr int STEP = 2;
    if (p.g_hi - p.g_lo > STEP) bar = xcd_barrier_post(ctl + CW_BAR, (volatile LAS unsigned*)(lds + LDS_SCR + 32));
    const int G = (int)gridDim.x, bx = (int)blockIdx.x;
    PG8_LAS unsigned char* lds3 = (PG8_LAS unsigned char*)lds;
    bf16_t* proj = (bf16_t*)(p.ws + WS_PROJ);

    for (int layer = 0; layer < NLAYER; ++layer) {
        const int s0 = layer * NSLOT;
#define IN(k) (((PHMASK >> (k)) & 1) && p.g_lo <= s0 + 2 * (k) && s0 + 2 * (k) < p.g_hi)
#define SEAM(k) do { if (s0 + 2 * (k) + STEP < p.g_hi) xcd_barrier(bar); } while (0)
        if (IN(PH_CVT)) {
            phase_cvt(p, layer, lds);
            if (layer == 0) { phase_rope(p); phase_rows<0>(p, 0, lds); }
            SEAM(PH_CVT); }
        if (IN(PH_INPROJ)) {
            pg8::Gemm g{(const bf16_t*)(p.ws + WS_HB), (const bf16_t*)(p.ws + WS_WIN), T, NPROJ, DM}; pg8::StaticOrder S; S.init(T, NPROJ, G, bx);
            pg8::EpiProj E{proj, (const float*)(p.ws + WS_ROPE), (const float*)(p.ws + WS_ROPE) + (size_t)T * 64};
            pg8::gemm_phase<pg8::EpiProj, pg8::StaticOrder, true, true>(lds3, g, S, E);
            SEAM(PH_INPROJ); }
        if (IN(PH_MIXA)) {
            for (int u = bx; u < 1536; u += G) { if (u < 1024) gla_u_unit(p, layer, u >> 2, u & 3, lds); else moba_kmean_unit(p, (u - 1024) >> 6, (u - 1024) & 63, lds); }
            SEAM(PH_MIXA); }
        if (IN(PH_MIXB)) {
            const int half = G >> 1;
            if (bx < half) gla_scan(p, bx, half);
            else for (int u = bx - half; u < 512; u += G - half) moba_gate_unit(p, u >> 6, u & 63, lds);
            SEAM(PH_MIXB); }
        if (IN(PH_MIXC)) {
            for (int u = bx; u < 1536; u += G) { if (u < 1024) gla_out_unit(p, layer, u >> 2, u & 3, lds); else moba_list_unit(p, layer, (u - 1024) >> 6, (u - 1024) & 63, lds); }
            SEAM(PH_MIXC); }
        if (IN(PH_ATT)) {
            const int nit = (int)ldu(ctl + CW_NIT + layer * 64);
            const unsigned* items = (const unsigned*)(p.ws + WS_ITEMS) + layer * 4096 * 4;
            for (int it = bx; it < nit; it += G) {
                const int h = (int)ldu(items + it * 4), j = (int)ldu(items + it * 4 + 1), c = (int)ldu(items + it * 4 + 2), n = (int)ldu(items + it * 4 + 3);
                const bool own = (c == 0xFFFF);
                const unsigned* list = own ? nullptr : (const unsigned*)(p.ws + WS_LIST) + (size_t)h * LISTH + list_off(j) + c * 256;
                const int nvalid = own ? 256 : (n - c * 256 < 256 ? n - c * 256 : 256);
                att::moba_item(proj, h, j, list, nvalid, (bf16_t*)(p.ws + WS_PO), (float*)(p.ws + WS_PML), (char*)lds);
            }
            SEAM(PH_ATT); }
        if (IN(PH_COMB)) { moba_combine(p); SEAM(PH_COMB); }
        if (IN(PH_OUTPROJ)) {
            pg8::Gemm g{(const bf16_t*)(p.ws + WS_MIX), (const bf16_t*)(p.ws + WS_WO), T, DM, DM}; pg8::StaticOrder S; S.init(T, DM, G, bx);
            pg8::EpiOut E{layer == 0 ? p.in[0] : (const float*)p.out, p.out, DN_ALPHA};
            pg8::gemm_phase<pg8::EpiOut, pg8::StaticOrder, true, true>(lds3, g, S, E);
            SEAM(PH_OUTPROJ); }
        if (IN(PH_LN1)) { phase_rows<1>(p, layer, lds); SEAM(PH_LN1); }
        if (IN(PH_PERM)) { phase_perm(p, layer, lds); SEAM(PH_PERM); }
        if (IN(PH_MOE1)) {
            const unsigned* misc = (const unsigned*)(p.ws + WS_MISC) + layer * 256;
            const int np = (int)__builtin_amdgcn_readfirstlane(ldu(misc));
            pg8::Gemm g{(const bf16_t*)(p.ws + WS_XS), (const bf16_t*)(p.ws + WS_WGU), np * 256, 2048, DM}; pg8::MoeOrder S; S.init(np * 256, 2048, G, bx); S.pe = misc + 64;
            pg8::EpiGU E{(bf16_t*)(p.ws + WS_HS)};
            pg8::gemm_phase<pg8::EpiGU, pg8::MoeOrder, true, true>(lds3, g, S, E);
            SEAM(PH_MOE1); }
        if (IN(PH_MOE2)) {
            const unsigned* misc = (const unsigned*)(p.ws + WS_MISC) + layer * 256;
            const int np = (int)__builtin_amdgcn_readfirstlane(ldu(misc));
            pg8::Gemm g{(const bf16_t*)(p.ws + WS_HS), (const bf16_t*)(p.ws + WS_WD), np * 256, 2048, DEXP}; pg8::MoeOrder S; S.init(np * 256, 2048, G, bx); S.pe = misc + 64;
            pg8::EpiY E{(bf16_t*)(p.ws + WS_YS)};
            pg8::gemm_phase<pg8::EpiY, pg8::MoeOrder, true, true>(lds3, g, S, E);
            SEAM(PH_MOE2); }
        if (IN(PH_LN2)) { phase_rows<2>(p, layer, lds); SEAM(PH_LN2); }
#undef IN
#undef SEAM
    }
}

#if MK_DEBUG
__global__ void __launch_bounds__(NTHR, 2) mk_chk(Params p, int layer, int k) { if (k >= 0) chk_phase(p, layer, k); else chk_final(p); }
#endif
#ifndef MK_ONE_LAUNCH
#define MK_ONE_LAUNCH 1
#endif
extern "C" void kernel_launch(void* const* d_in, const int* in_sizes, int n_in, void* d_out, int out_size, void* d_ws, size_t ws_size, hipStream_t stream) {
    static int grid = 0;
    if (grid == 0) {
        if (n_in != 16 || in_sizes[0] != T * DM || out_size != T * DM || ws_size < WS_END) {
            fprintf(stderr, "kernel_launch: unexpected problem: n_in %d in0 %d out %d ws %zu (need >= %zu); nothing launched\n", n_in, n_in > 0 ? in_sizes[0] : -1, out_size, ws_size, (size_t)WS_END); grid = -1; return; }
        int dev = 0, cus = 0, per_cu = 0;
        if (hipGetDevice(&dev) != hipSuccess || hipDeviceGetAttribute(&cus, hipDeviceAttributeMultiprocessorCount, dev) != hipSuccess) { grid = -1; return; }
        if (hipFuncSetAttribute((const void*)mk_fwd, hipFuncAttributeMaxDynamicSharedMemorySize, LDS_BYTES) != hipSuccess) { fprintf(stderr, "kernel_launch: hipFuncSetAttribute failed\n"); grid = -1; return; }
        if (hipOccupancyMaxActiveBlocksPerMultiprocessor(&per_cu, (const void*)mk_fwd, NTHR, LDS_BYTES) != hipSuccess || per_cu < 1)
            fprintf(stderr, "kernel_launch: note: occupancy query reports %d blocks per CU\n", per_cu);
        (void)hipGetLastError();
        grid = cus;
        if (grid != 256) fprintf(stderr, "kernel_launch: note: %d CUs (row phases assume the grid divides 2048 row groups)\n", grid);
        if (2048 % grid != 0) grid = 256;
    }
    if (grid < 0) return;
    if (hipMemsetAsync((char*)d_ws + WS_CTL, 0, CTL_BYTES, stream) != hipSuccess) return;
    Params p{};
    for (int i = 0; i < 16; ++i) p.in[i] = (const float*)d_in[i];
    p.out = (float*)d_out; p.ws = (unsigned char*)d_ws;
#if MK_ONE_LAUNCH
    p.g_lo = 0; p.g_hi = NLAYER * NSLOT;
    hipLaunchKernelGGL(mk_fwd, dim3(grid), dim3(NTHR), LDS_BYTES, stream, p);
#else
    for (int s = 0; s < NLAYER * NSLOT; s += 2) { p.g_lo = s; p.g_hi = s + 1; hipLaunchKernelGGL(mk_fwd, dim3(grid), dim3(NTHR), LDS_BYTES, stream, p);
#if MK_DEBUG
        hipLaunchKernelGGL(mk_chk, dim3(8), dim3(NTHR), 0, stream, p, s / NSLOT, (s % NSLOT) / 2);
#endif
    }
#if MK_DEBUG
    hipLaunchKernelGGL(mk_chk, dim3(grid), dim3(NTHR), 0, stream, p, 0, -1);
#endif
#endif
    const hipError_t le = hipPeekAtLastError();
    if (le != hipSuccess) fprintf(stderr, "kernel_launch: launch failed: %s\n", hipGetErrorName(le));
}
```

```cpp
#define MK_DEBUG 0
#define MK_ONE_LAUNCH 1
#define RECOMP 0
#include <hip/hip_runtime.h>
#include <cstdio>
#include <cstdint>
__device__ __forceinline__ int opq_tid() { int t = (int)threadIdx.x; asm volatile("" : "+v"(t)); return t; }
#ifndef EPI_PROBE
#define EPI_PROBE 0
#endif
namespace pg8 {
#define PG8_LAS __attribute__((address_space(3)))
typedef unsigned short bf16_t;
typedef short bf16x8 __attribute__((ext_vector_type(8)));
typedef float f32x4 __attribute__((ext_vector_type(4)));
typedef unsigned u32x4 __attribute__((ext_vector_type(4)));
constexpr int BM = 256, BK = 64, HALF = 128, HTB = HALF * BK * 2  , STAGE_BYTES = 8 * HTB, NXCD = 8, WGM = 4;

__host__ __device__ __forceinline__ int lds_byte(int r, int c) { const int st = (r >> 4) * 2 + (c >> 5), rr = r & 15, cc = c & 31, ob = rr * 64 + cc * 2; return st * 1024 + (ob ^ (((ob >> 9) & 1) << 5)); }
__host__ __device__ __forceinline__ void stage_rc(int b, int& R, int& C) { const int st = b / 1024, sb = b % 1024, swz = sb ^ (((sb >> 9) & 1) << 5); R = (st >> 1) * 16 + swz / 64; C = (st & 1) * 32 + (swz % 64) / 2; }
__host__ __device__ __forceinline__ int perm32(int rho) { const int n = rho >> 4, i = rho & 15; return 8 * (i >> 2) + 4 * n + (i & 3); }

struct Unit { int pm, pn; };
struct Gemm { const bf16_t* A; const bf16_t* Bt; int M, N, K; int sa, sb; };

struct StaticOrder {
    int nM, nN, nwg, G, c;
    __host__ __device__ void init(int M, int N, int G_, int c_) { nM = M / BM; nN = N / BM; nwg = nM * nN; G = G_; c = c_; }
    __host__ __device__ bool next(int i, Unit& u) const {
        const long L = (long)i * G + c; if (L >= nwg) return false;
        int wgid = (int)L; { const int q = nwg / NXCD, r = nwg % NXCD, xcd = wgid % NXCD, off = wgid / NXCD; wgid = (xcd < r ? xcd * (q + 1) : r * (q + 1) + (xcd - r) * q) + off; }
        const int nig = WGM * nN, gid = wgid / nig, fm = gid * WGM, gsz = (nM - fm) < WGM ? (nM - fm) : WGM;
        u.pm = fm + ((wgid % nig) % gsz); u.pn = (wgid % nig) / gsz; return true;
    }
    __device__ __forceinline__ void a_ready(const Unit&) const {}
    __device__ __forceinline__ void done(const Unit&) const {}
    __device__ __forceinline__ unsigned arow(const Unit&, int) const { return 0u; }
};
__device__ __forceinline__ unsigned cvt_pk_bf16(float lo, float hi) { unsigned r; asm volatile("v_cvt_pk_bf16_f32 %0, %1, %2" : "=v"(r) : "v"(lo), "v"(hi)); return r; }

typedef int v8i32 __attribute__((ext_vector_type(8)));
typedef int v4i32 __attribute__((ext_vector_type(4)));
__device__ __forceinline__ v8i32 cat8(bf16x8 lo, bf16x8 hi) { const v4i32 a = __builtin_bit_cast(v4i32, lo), b = __builtin_bit_cast(v4i32, hi); return __builtin_shufflevector(a, b, 0, 1, 2, 3, 4, 5, 6, 7); }
template <class Epi, class Sched, bool ALIGN_EPI = false, bool SP2 = false, bool FP8 = false, bool GATHER = false>
__device__ __forceinline__ void gemm_phase(PG8_LAS unsigned char* lds, const Gemm g, const Sched& S, const Epi& E) {
    const int tid = opq_tid(), wid = __builtin_amdgcn_readfirstlane(tid >> 6), lane = tid & 63, wr = wid >> 2, wc = wid & 3, fr = lane & 15, fq = lane >> 4;
    int Kq = g.K; asm volatile("" : "+s"(Kq));
    const int K = Kq, nt = K / BK;
    unsigned voffA[2], voffB[2];
#pragma unroll
    for (int i = 0; i < 2; ++i) { int R, C; stage_rc(tid * 16 + i * 8192, R, C); const int Rb = Epi::PERM ? ((R & ~31) + perm32(R & 31)) : R;
        voffA[i] = (unsigned)(R * K + C) * 2u; voffB[i] = (unsigned)(Rb * K + C) * 2u; }
    unsigned va[2][2] = {{0u, 0u}, {0u, 0u}};
    PG8_LAS unsigned* vnl = (PG8_LAS unsigned*)(lds + STAGE_BYTES + 8192) + tid * 4;
#define PG8_GCALC(v, u) do { _Pragma("unroll") for (int _h = 0; _h < 2; ++_h) _Pragma("unroll") for (int _i = 0; _i < 2; ++_i) { int _R, _C; stage_rc(tid * 16 + _i * 8192, _R, _C); (v)[_h][_i] = S.arow((u), _h * HALF + _R) + (unsigned)_C * 2u; } } while (0)
#define PG8_STAGE_A(bufoff, gbase, h, v) do { if constexpr (GATHER) { _Pragma("unroll") for (int _i = 0; _i < 2; ++_i) \
        __builtin_amdgcn_global_load_lds((const unsigned*)((const char*)(gbase) + (v)[h][_i]), (PG8_LAS unsigned*)(lds + (bufoff) + ldsw + _i * 8192), 16, 0, 0); } \
        else { PG8_STAGE(bufoff, (gbase) + (h) * hstep, voffA); } } while (0)
    const size_t kstep = (size_t)(BK * 2);
    const size_t hstep = (size_t)HALF * K * 2;
    const size_t tstep = 2 * hstep;
    const unsigned ldsw = (unsigned)wid * 1024u;
    const int aoff = lds_byte(wr * 64 + fr, fq * 8), boff = lds_byte(wc * 32 + fr, fq * 8);
#define PG8_SA(b, h) (((b) * 2 + (h)) * HTB)
#define PG8_SB(b, h) ((4 + (b) * 2 + (h)) * HTB)
#define PG8_STAGE(bufoff, gbase, voff) do { _Pragma("unroll") for (int _i = 0; _i < 2; ++_i) \
        __builtin_amdgcn_global_load_lds((const unsigned*)((const char*)(gbase) + (voff)[_i]), (PG8_LAS unsigned*)(lds + (bufoff) + ldsw + _i * 8192), 16, 0, 0); } while (0)
#define PG8_LDA(dst, b, h) do { _Pragma("unroll") for (int m = 0; m < 4; ++m) _Pragma("unroll") for (int k = 0; k < 2; ++k) dst[m][k] = *(const PG8_LAS bf16x8*)(lds + PG8_SA(b, h) + aoff + m * 2048 + k * 1024); } while (0)
#define PG8_LDB(dst, b, h) do { _Pragma("unroll") for (int n = 0; n < 2; ++n) _Pragma("unroll") for (int k = 0; k < 2; ++k) dst[n][k] = *(const PG8_LAS bf16x8*)(lds + PG8_SB(b, h) + boff + n * 2048 + k * 1024); } while (0)
#define PG8_MMA(ai, bj, At, Bt) do { __builtin_amdgcn_s_setprio(1); _Pragma("unroll") for (int m = 0; m < 4; ++m) _Pragma("unroll") for (int n = 0; n < 2; ++n) { \
        if constexpr (FP8) { const v8i32 wq = cat8(Bt[n][0], Bt[n][1]), aq = cat8(At[m][0], At[m][1]); \
            asm volatile("s_nop 1\n\tv_mfma_scale_f32_16x16x128_f8f6f4 %0, %1, %2, %0, %3, %4 op_sel_hi:[0,0,0]" : "+v"(acc[ai][bj][m][n]) : "v"(wq), "v"(aq), "v"(g.sa), "v"(g.sb)); } \
        else { _Pragma("unroll") for (int k = 0; k < 2; ++k) acc[ai][bj][m][n] = __builtin_amdgcn_mfma_f32_16x16x32_bf16(Bt[n][k], At[m][k], acc[ai][bj][m][n], 0, 0, 0); } } \
        __builtin_amdgcn_s_setprio(0); } while (0)
#define PG8_WAIT_V(n) asm volatile("s_waitcnt vmcnt(" #n ")" ::: "memory")
#define PG8_WAIT_L(n) asm volatile("s_waitcnt lgkmcnt(" #n ")" ::: "memory")
#define PG8_BAR __builtin_amdgcn_s_barrier()
#define PG8_SCHED __builtin_amdgcn_sched_barrier(0)
    Unit cur, nxt; int ui = 0;
    if (!S.next(0, cur)) return;
    f32x4 acc[2][2][4][2];
#pragma unroll
    for (int a = 0; a < 2; ++a)
#pragma unroll
        for (int b = 0; b < 2; ++b)
#pragma unroll
            for (int m = 0; m < 4; ++m)
#pragma unroll
                for (int n = 0; n < 2; ++n) acc[a][b][m][n] = (f32x4){0.f, 0.f, 0.f, 0.f};
    bf16x8 At[4][2], B0[2][2], B1[2][2];
    const char* cA = (const char*)g.A + (GATHER ? (size_t)0 : (size_t)cur.pm * tstep); const char* cB = (const char*)g.Bt + (size_t)cur.pn * tstep;
    if constexpr (GATHER) PG8_GCALC(va, cur);
    S.a_ready(cur);
    if constexpr (SP2) {
        PG8_STAGE(PG8_SB(0, 0), cB, voffB); PG8_STAGE(PG8_SB(0, 1), cB + hstep, voffB); PG8_STAGE_A(PG8_SA(0, 0), cA, 0, va); PG8_STAGE_A(PG8_SA(0, 1), cA, 1, va);
        if (wr == 1) PG8_BAR;
        PG8_WAIT_V(2); PG8_BAR;
        PG8_STAGE(PG8_SB(1, 0), cB + kstep, voffB); PG8_STAGE_A(PG8_SA(1, 0), cA + kstep, 0, va); PG8_STAGE(PG8_SB(1, 1), cB + hstep + kstep, voffB);
        PG8_WAIT_V(6); PG8_BAR;
    } else {
        PG8_STAGE(PG8_SB(0, 0), cB, voffB); PG8_STAGE(PG8_SA(0, 0), cA, voffA); PG8_STAGE(PG8_SB(0, 1), cB + hstep, voffB); PG8_STAGE(PG8_SA(0, 1), cA + hstep, voffA);
        if (wr == 1) PG8_BAR;
        PG8_WAIT_V(4); PG8_BAR;
        PG8_STAGE(PG8_SB(1, 0), cB + kstep, voffB); PG8_STAGE(PG8_SA(1, 0), cA + kstep, voffA); PG8_STAGE(PG8_SB(1, 1), cB + hstep + kstep, voffB);
        PG8_WAIT_V(6); PG8_BAR;
    }
    for (;;) {
        const bool has_next = S.next(ui + 1, nxt);
        const char* nA = (has_next && !GATHER) ? (const char*)g.A + (size_t)nxt.pm * tstep : cA; const char* nB = has_next ? (const char*)g.Bt + (size_t)nxt.pn * tstep : cB;
        if constexpr (GATHER) { unsigned vn[2][2]; if (has_next) PG8_GCALC(vn, nxt); else { _Pragma("unroll") for (int _h = 0; _h < 2; ++_h) _Pragma("unroll") for (int _i = 0; _i < 2; ++_i) vn[_h][_i] = va[_h][_i]; }
            vnl[0] = vn[0][0]; vnl[1] = vn[0][1]; vnl[2] = vn[1][0]; vnl[3] = vn[1][1]; }
        for (int t = 0; t < nt; t += 2) {
            const bool last = (t == nt - 2);
            const char* a1 = cA + (size_t)(t + 1) * kstep;
            const char* a2 = last ? nA : cA + (size_t)(t + 2) * kstep; const char* b2 = last ? nB : cB + (size_t)(t + 2) * kstep;
            const char* a3 = a2 + kstep; const char* b3 = b2 + kstep;
            if (last && has_next) S.a_ready(nxt);
            unsigned v2[2][2];
            if constexpr (GATHER) { _Pragma("unroll") for (int _h = 0; _h < 2; ++_h) _Pragma("unroll") for (int _i = 0; _i < 2; ++_i) v2[_h][_i] = va[_h][_i];
                if (last) { v2[0][0] = vnl[0]; v2[0][1] = vnl[1]; v2[1][0] = vnl[2]; v2[1][1] = vnl[3]; } }
            if constexpr (SP2) {
            PG8_LDB(B0, 0, 0); PG8_LDB(B1, 0, 1); PG8_SCHED; PG8_LDA(At, 0, 0); PG8_STAGE_A(PG8_SA(1, 1), a1, 1, va);
            PG8_WAIT_V(8); PG8_WAIT_L(0); PG8_BAR; PG8_MMA(0, 0, At, B0); PG8_MMA(0, 1, At, B1); PG8_BAR; PG8_SCHED;
            PG8_LDA(At, 0, 1); PG8_STAGE(PG8_SB(0, 0), b2, voffB); PG8_STAGE(PG8_SB(0, 1), b2 + hstep, voffB); PG8_STAGE_A(PG8_SA(0, 0), a2, 0, v2);
            PG8_WAIT_V(8); PG8_WAIT_L(0); PG8_BAR; PG8_MMA(1, 0, At, B0); PG8_MMA(1, 1, At, B1); PG8_BAR; PG8_SCHED;
            PG8_LDB(B0, 1, 0); PG8_LDB(B1, 1, 1); PG8_SCHED; PG8_LDA(At, 1, 0); PG8_STAGE_A(PG8_SA(0, 1), a2, 1, v2);
            PG8_WAIT_V(8); PG8_WAIT_L(0); PG8_BAR; PG8_MMA(0, 0, At, B0); PG8_MMA(0, 1, At, B1); PG8_BAR; PG8_SCHED;
            PG8_LDA(At, 1, 1); PG8_STAGE(PG8_SB(1, 0), b3, voffB); PG8_STAGE(PG8_SB(1, 1), b3 + hstep, voffB); PG8_STAGE_A(PG8_SA(1, 0), a3, 0, v2);
            PG8_WAIT_V(8); PG8_WAIT_L(0); PG8_BAR; PG8_MMA(1, 0, At, B0); PG8_MMA(1, 1, At, B1); PG8_BAR; PG8_SCHED;
            } else {
            PG8_LDB(B0, 0, 0); PG8_SCHED; PG8_LDA(At, 0, 0); PG8_STAGE(PG8_SA(1, 1), a1 + hstep, voffA);
            PG8_WAIT_L(8); PG8_BAR; PG8_WAIT_L(0); PG8_MMA(0, 0, At, B0); PG8_BAR; PG8_SCHED;
            PG8_LDB(B1, 0, 1); PG8_STAGE(PG8_SB(0, 0), b2, voffB);
            PG8_BAR; PG8_WAIT_L(0); PG8_MMA(0, 1, At, B1); PG8_BAR;
            PG8_LDA(At, 0, 1); PG8_STAGE(PG8_SA(0, 0), a2, voffA);
            PG8_BAR; PG8_WAIT_L(0); PG8_MMA(1, 0, At, B0); PG8_BAR; PG8_SCHED;
            PG8_STAGE(PG8_SB(0, 1), b2 + hstep, voffB);
            PG8_WAIT_V(6); PG8_BAR; PG8_MMA(1, 1, At, B1); PG8_BAR;
            PG8_LDB(B0, 1, 0); PG8_SCHED; PG8_LDA(At, 1, 0); PG8_STAGE(PG8_SA(0, 1), a2 + hstep, voffA);
            PG8_WAIT_L(8); PG8_BAR; PG8_WAIT_L(0); PG8_MMA(0, 0, At, B0); PG8_BAR; PG8_SCHED;
            PG8_LDB(B1, 1, 1); PG8_STAGE(PG8_SB(1, 0), b3, voffB);
            PG8_BAR; PG8_WAIT_L(0); PG8_MMA(0, 1, At, B1); PG8_BAR;
            PG8_LDA(At, 1, 1); PG8_STAGE(PG8_SA(1, 0), a3, voffA);
            PG8_BAR; PG8_WAIT_L(0); PG8_MMA(1, 0, At, B0); PG8_BAR; PG8_SCHED;
            PG8_STAGE(PG8_SB(1, 1), b3 + hstep, voffB);
            PG8_WAIT_V(6); PG8_BAR; PG8_MMA(1, 1, At, B1); PG8_BAR;
            }
        }
        if constexpr (FP8) { asm volatile("s_nop 15\n\ts_nop 15" ::: "memory"); }
        if constexpr (ALIGN_EPI) { if (wr == 0) PG8_BAR; }
        if constexpr (!Epi::AFTER_DRAIN) { E(acc, cur, wr, wc, fr, fq);
#if EPI_PROBE
            _Pragma("unroll 1") for (int pr_ = 0; pr_ < 2; ++pr_) { asm volatile("" ::: "memory"); E(acc, cur, wr, wc, fr, fq); }
#endif
            S.done(cur); }
        if (!has_next) break;
#pragma unroll
        for (int a = 0; a < 2; ++a)
#pragma unroll
            for (int b = 0; b < 2; ++b)
#pragma unroll
                for (int m = 0; m < 4; ++m)
#pragma unroll
                    for (int n = 0; n < 2; ++n) acc[a][b][m][n] = (f32x4){0.f, 0.f, 0.f, 0.f};
        cur = nxt; cA = nA; cB = nB; ++ui;
        if constexpr (GATHER) { va[0][0] = vnl[0]; va[0][1] = vnl[1]; va[1][0] = vnl[2]; va[1][1] = vnl[3]; }
        if constexpr (ALIGN_EPI) { if (wr == 1) PG8_BAR; }
    }
    PG8_WAIT_V(0);
    if constexpr (!ALIGN_EPI) { if (wr == 0) PG8_BAR; }
    PG8_BAR;
    if constexpr (Epi::AFTER_DRAIN) { E.fused(acc, cur, wr, wc, fr, fq, lds, wid, lane); S.done(cur); }
#undef PG8_SA
#undef PG8_SB
#undef PG8_STAGE
#undef PG8_STAGE_A
#undef PG8_GCALC
#undef PG8_LDA
#undef PG8_LDB
#undef PG8_MMA
#undef PG8_WAIT_V
#undef PG8_WAIT_L
#undef PG8_BAR
#undef PG8_SCHED
}
}
#define LAS __attribute__((address_space(3)))
#define XB_TMO      128
#define XB_XCNT(j)  (256  + 64 * (j))
#define XB_XSUB(j)  (1280 + 64 * (j))
#define XB_XGEN(j)  (2304 + 64 * (j))
#define XB_TOP      3328
#define XB_TOPGEN   3392
#define XCD_BAR_WORDS 3456
#define XB_SPIN_CAP (1u << 18)

__device__ __forceinline__ unsigned xb_ld(unsigned* p)              { return __hip_atomic_load(p, __ATOMIC_RELAXED, __HIP_MEMORY_SCOPE_AGENT); }
__device__ __forceinline__ unsigned xb_add(unsigned* p, unsigned v) { return __hip_atomic_fetch_add(p, v, __ATOMIC_RELAXED, __HIP_MEMORY_SCOPE_AGENT); }
__device__ __forceinline__ unsigned xb_xcc_id() { return (unsigned)__builtin_amdgcn_s_getreg((3 << 11) | 20) & 0xFu; }
#define XB_SPIN(cond, bar) do { unsigned _sp = 0; while (cond) { __builtin_amdgcn_s_sleep(1); \
    if ((++_sp & 255u) == 0u) { if (xb_ld(&(bar)[XB_TMO])) break; if (_sp > XB_SPIN_CAP) { atomicAdd(&(bar)[XB_TMO], 1u); break; } } } } while (0)

struct XcdBarrier {
    unsigned* bar; unsigned x;
    volatile LAS unsigned* st;
};

__device__ __forceinline__ XcdBarrier xcd_barrier_post(unsigned* bar, volatile LAS unsigned* st) {
    XcdBarrier b; b.bar = bar; b.x = xb_xcc_id(); b.st = st;
    if (threadIdx.x == 0) (void)xb_add(&bar[XB_XCNT(b.x)], 1u);
    return b;
}
__device__ __forceinline__ void xcd_barrier_complete(unsigned* bar, unsigned x, unsigned& nloc, unsigned& nx) {
    const unsigned G = gridDim.x * gridDim.y * gridDim.z;
    unsigned sum, cnt, mine, sp = 0u;
    for (;;) {
        sum = 0u; cnt = 0u; mine = 0u;
#pragma unroll 1
        for (unsigned j = 0; j < 16; ++j) { const unsigned c = xb_ld(&bar[XB_XCNT(j)]); sum += c; cnt += (c > 0u) ? 1u : 0u; mine = (j == x) ? c : mine; }
        if (sum == G) break;
        __builtin_amdgcn_s_sleep(1);
        if ((++sp & 255u) == 0u) { if (xb_ld(&bar[XB_TMO])) break; if (sp > XB_SPIN_CAP) { atomicAdd(&bar[XB_TMO], 1u); break; } }
    }
    nloc = mine > 0u ? mine : 1u; nx = cnt > 0u ? cnt : 1u;
}

__device__ __forceinline__ void xcd_barrier_census(const XcdBarrier& b) {
    if (threadIdx.x == 0) { unsigned nloc, nx; xcd_barrier_complete(b.bar, b.x, nloc, nx); b.st[0] = nloc; b.st[1] = nx; }
    __syncthreads();
}
__device__ __forceinline__ void xcd_barrier(const XcdBarrier& b) {
    asm volatile("s_waitcnt vmcnt(0)" ::: "memory");
    __syncthreads();
    if (threadIdx.x == 0) {
        unsigned* bar = b.bar;
        __builtin_amdgcn_s_waitcnt(0);
        unsigned nloc = b.st[0], nx = b.st[1];
        const unsigned old = xb_add(&bar[XB_XSUB(b.x)], 1u);
        const unsigned gen = old / nloc;
        if (old + 1u == (gen + 1u) * nloc) {
            __builtin_amdgcn_fence(__ATOMIC_RELEASE, "agent");
            asm volatile("s_waitcnt vmcnt(0)" ::: "memory");
            const unsigned og = xb_add(&bar[XB_TOP], 1u);
            const unsigned tg = og / nx;
            if (og + 1u == (tg + 1u) * nx) xb_add(&bar[XB_TOPGEN], 1u);
            else XB_SPIN(xb_ld(&bar[XB_TOPGEN]) == tg, bar);
            __builtin_amdgcn_fence(__ATOMIC_ACQUIRE, "agent");
            xb_add(&bar[XB_XGEN(b.x)], 1u);
            asm volatile("s_waitcnt vmcnt(0)" ::: "memory");
        } else {
            XB_SPIN(xb_ld(&bar[XB_XGEN(b.x)]) == gen, bar);
            __builtin_amdgcn_fence(__ATOMIC_ACQUIRE, "agent");
            asm volatile("s_waitcnt vmcnt(0)" ::: "memory");
        }
    }
    __syncthreads();
}

#define GAS __attribute__((address_space(1)))
typedef unsigned short bf16_t;
typedef short bf16x8 __attribute__((ext_vector_type(8)));
typedef short s16x4 __attribute__((ext_vector_type(4)));
typedef float f32x4 __attribute__((ext_vector_type(4)));
typedef float f32x2 __attribute__((ext_vector_type(2)));
typedef float f32x16 __attribute__((ext_vector_type(16)));
typedef unsigned u32x4 __attribute__((ext_vector_type(4)));
typedef unsigned u32x2 __attribute__((ext_vector_type(2)));

constexpr int T = 16384, DM = 2048, DIN = 6160, NPROJ = 6144, NLAYER = 2, NE = 16, DEXP = 1024;
constexpr int PQ = 0, PK = 512, PV = 1024, PG = 2048, PMQ = 3072, PMK = 4096, PMV = 5120;
__host__ __device__ __forceinline__ size_t ix_gq(int h, int t) { return ((size_t)(0 + h) * T + t) * 128; }
__host__ __device__ __forceinline__ size_t ix_gk(int h, int t) { return ((size_t)(4 + h) * T + t) * 128; }
__host__ __device__ __forceinline__ size_t ix_gv(int h, int t) { return (size_t)(8 + 2 * h) * T * 128 + (size_t)t * 256; }
__host__ __device__ __forceinline__ size_t ix_gg(int h, int t) { return (size_t)(16 + 2 * h) * T * 128 + (size_t)t * 256; }
__host__ __device__ __forceinline__ size_t ix_mq(int h, int t) { return ((size_t)(24 + h) * T + t) * 128; }
__host__ __device__ __forceinline__ size_t ix_mk(int h, int t) { return ((size_t)(32 + h) * T + t) * 128; }
__host__ __device__ __forceinline__ size_t ix_mv(int h, int t) { return ((size_t)(40 + h) * T + t) * 128; }
constexpr float DN_ALPHA = 1.4142135623730951f;
constexpr int MAXROWS = 36864;
constexpr int LISTH = 516096;
constexpr int NTHR = 512;

constexpr size_t MiB = 1u << 20;
constexpr size_t WS_CTL = 0, CTL_BYTES = 1 * MiB;
constexpr size_t WS_MISC = 1 * MiB;
constexpr size_t WS_ITEMS = 1 * MiB + 65536;
constexpr size_t WS_TOK = 2 * MiB, WS_SEL = 3 * MiB, WS_KMEAN = 4 * MiB, WS_GDEC = 5 * MiB, WS_GLOW = 6 * MiB, WS_PML = 8 * MiB;
constexpr size_t WS_HBQ = 228 * MiB;
constexpr int WIN8_SH = 5;
constexpr size_t WS_IDX = 7 * MiB;
constexpr size_t WS_HB8 = 456 * MiB;
constexpr size_t WS_ROPE = 12 * MiB, WS_LIST = 20 * MiB;
constexpr size_t WS_WIN = 36 * MiB, WS_WO = 60 * MiB, WS_WGU = 68 * MiB, WS_WIN2 = 132 * MiB, WS_WD = 196 * MiB;
constexpr size_t WS_HB = 260 * MiB, WS_MIX = 324 * MiB;
constexpr size_t WS_PROJ = 388 * MiB, WS_U = 580 * MiB, WS_S = 644 * MiB, WS_PO = 708 * MiB;
constexpr size_t WS_BDEC = 708 * MiB;
constexpr size_t WS_PRE = 388 * MiB;
constexpr size_t WS_XS = 388 * MiB, WS_HS = 532 * MiB, WS_YS = 604 * MiB;
constexpr size_t WS_END = 836 * MiB;
constexpr int CW_BAR = 4096, CW_CNT = 8192, CW_NIT = 8448, CW_DBG = 8704, CW_CVQ = 9216;
constexpr int LDS_SCR = 131072, LDS_BYTES = 155648;

struct Params { const float* in[16]; float* out; unsigned char* ws; int g_lo, g_hi; };

__device__ __forceinline__ unsigned cvt_pk(float lo, float hi) { return pg8::cvt_pk_bf16(lo, hi); }
__device__ __forceinline__ float bflo(unsigned u) { return __uint_as_float(u << 16); }
__device__ __forceinline__ float bfhi(unsigned u) { return __uint_as_float(u & 0xffff0000u); }
__device__ __forceinline__ float bf2f(bf16_t u) { return __uint_as_float(((unsigned)u) << 16); }
__device__ __forceinline__ unsigned ldu(const unsigned* p) { return __hip_atomic_load(p, __ATOMIC_RELAXED, __HIP_MEMORY_SCOPE_AGENT); }
__device__ __forceinline__ float ldf(const float* p) { return __uint_as_float(__hip_atomic_load((const unsigned*)p, __ATOMIC_RELAXED, __HIP_MEMORY_SCOPE_AGENT)); }
#ifndef OUT8
#define OUT8 1
#endif
constexpr int MIX8_SH = 3, WO8_SH = 5;
#ifndef YS8
#define YS8 1
#endif
constexpr int Y8_SH = 4;
#ifndef RECOMP
#define RECOMP 1
#endif
#ifndef PO8
#define PO8 1
#endif
constexpr int PO8_SH = 4;
constexpr int X8_SH = 2, H8_SH = 2, WGU8_SH = 5, WD8_SH = 6;
__device__ __forceinline__ unsigned pk4_fp8(float a, float b, float c, float d) { int t = __builtin_amdgcn_cvt_pk_fp8_f32(a, b, 0, false); t = __builtin_amdgcn_cvt_pk_fp8_f32(c, d, t, true); return (unsigned)t; }
__device__ __forceinline__ float fp8_dec(unsigned b) { const unsigned s = b >> 7, e = (b >> 3) & 15u, m = b & 7u; const float v = e ? (1.0f + 0.125f * (float)m) * __builtin_ldexpf(1.0f, (int)e - 7) : 0.125f * (float)m * 0.015625f; return s ? -v : v; }
__device__ __forceinline__ void unpack8(const u32x4 x, float (&f)[8]) { f[0] = bflo(x.x); f[1] = bfhi(x.x); f[2] = bflo(x.y); f[3] = bfhi(x.y); f[4] = bflo(x.z); f[5] = bfhi(x.z); f[6] = bflo(x.w); f[7] = bfhi(x.w); }
__device__ __forceinline__ u32x4 pack8(const float (&f)[8]) { u32x4 w; w.x = cvt_pk(f[0], f[1]); w.y = cvt_pk(f[2], f[3]); w.z = cvt_pk(f[4], f[5]); w.w = cvt_pk(f[6], f[7]); return w; }

__device__ __forceinline__ void moe_bases(const unsigned* cnt, int* sb) {
    const int tid = opq_tid();
    if (tid < 64) { const int lane = tid;
        const int c = (lane < NE) ? (int)ldu(cnt + lane) : 0; const int nP = (c + 255) >> 8; int incl = nP;
#pragma unroll
        for (int o = 1; o < 16; o <<= 1) { const int t = __shfl_up(incl, o); if (lane >= o) incl += t; }
        if (lane < NE) { sb[lane] = (incl - nP) * 256; sb[32 + lane] = c; if (lane == NE - 1) sb[16] = incl * 256; } }
    __syncthreads();
}
__device__ __forceinline__ float wave_sum(float v) {
#define WS_DPP(ctrl) v += __int_as_float(__builtin_amdgcn_update_dpp(0, __float_as_int(v), (ctrl), 0xF, 0xF, true))
    WS_DPP(0xB1); WS_DPP(0x4E); WS_DPP(0x141); WS_DPP(0x140);
#undef WS_DPP
    const int vi = __float_as_int(v);
    return (__int_as_float(__builtin_amdgcn_readlane(vi, 0)) + __int_as_float(__builtin_amdgcn_readlane(vi, 16))) + (__int_as_float(__builtin_amdgcn_readlane(vi, 32)) + __int_as_float(__builtin_amdgcn_readlane(vi, 48)));
}
__device__ __forceinline__ float silu_f(float x) { return x * __builtin_amdgcn_rcpf(1.0f + __expf(-x)); }
__device__ __forceinline__ s16x4 tr_rd(int addr) { s16x4 r; asm volatile("ds_read_b64_tr_b16 %0, %1" : "=&v"(r) : "v"(addr) : "memory"); return r; }
#define LGKM0() do { asm volatile("s_waitcnt lgkmcnt(0)" ::: "memory"); __builtin_amdgcn_sched_barrier(0); } while (0)
#define PK8(L, H) ((bf16x8){L[0], L[1], L[2], L[3], H[0], H[1], H[2], H[3]})
#define MFMA16(a, b, c) __builtin_amdgcn_mfma_f32_16x16x32_bf16((a), (b), (c), 0, 0, 0)

namespace pg8 {
struct EpiProj {
    static constexpr bool PERM = true, AFTER_DRAIN = false;
    bf16_t* O; const float* cs; const float* sn;
    __device__ __forceinline__ void operator()(const f32x4 (&acc)[2][2][4][2], const Unit& u, int wr, int wc, int fr, int fq) const {
        const int row0 = u.pm * BM + wr * 64 + fr, cin = wc * 32 + 8 * fq;
        const bool rope = (u.pn >= 12 && u.pn < 20);
        size_t hb0[2]; int rs;
        if (u.pn < 4) { rs = 128; for (int bj = 0; bj < 2; ++bj) hb0[bj] = (size_t)((u.pn < 2 ? 0 : 4) + 2 * (u.pn & 1) + bj) * T * 128; }
        else if (u.pn < 12) { rs = 256; for (int bj = 0; bj < 2; ++bj) hb0[bj] = (size_t)((u.pn < 8 ? 8 : 16) + 2 * ((u.pn - 4) & 3)) * T * 128 + bj * 128; }
        else { rs = 128; for (int bj = 0; bj < 2; ++bj) hb0[bj] = (size_t)(24 + 8 * ((u.pn - 12) >> 2) + 2 * ((u.pn - 12) & 3) + bj) * T * 128; }
#pragma unroll
        for (int ai = 0; ai < 2; ++ai) {
            f32x4 c[4], s[4];
#pragma unroll
            for (int m = 0; m < 4; ++m) { c[m] = (f32x4){1.f, 1.f, 1.f, 1.f}; s[m] = (f32x4){0.f, 0.f, 0.f, 0.f}; }
            if (rope) {
#pragma unroll
                for (int m = 0; m < 4; ++m) { const int row = row0 + ai * HALF + m * 16; c[m] = *(const f32x4*)(cs + (size_t)row * 64 + 16 * wc + 4 * fq); s[m] = *(const f32x4*)(sn + (size_t)row * 64 + 16 * wc + 4 * fq); } }
#pragma unroll
            for (int m = 0; m < 4; ++m) {
                const int row = row0 + ai * HALF + m * 16;
#pragma unroll
                for (int bj = 0; bj < 2; ++bj) {
                    const f32x4 a0 = acc[ai][bj][m][0], a1 = acc[ai][bj][m][1];
                    const f32x4 v0 = a0 * c[m] - a1 * s[m], v1 = a1 * c[m] + a0 * s[m];
                    u32x4 w; w.x = cvt_pk_bf16(v0[0], v0[1]); w.y = cvt_pk_bf16(v0[2], v0[3]); w.z = cvt_pk_bf16(v1[0], v1[1]); w.w = cvt_pk_bf16(v1[2], v1[3]);
                    *(u32x4*)(O + hb0[bj] + (size_t)row * rs + cin) = w; }
            }
        }
    }
};
struct EpiOut {
    static constexpr bool PERM = true, AFTER_DRAIN = false;
    const float* res32; const bf16_t* res16; bf16_t* out; float alpha;
    __device__ __forceinline__ void operator()(const f32x4 (&acc)[2][2][4][2], const Unit& u, int wr, int wc, int fr, int fq) const {
        const int row0 = u.pm * BM + wr * 64 + fr, col0 = u.pn * BM + wc * 32 + 8 * fq;
        if (res32) {
#pragma unroll
            for (int ai = 0; ai < 2; ++ai)
#pragma unroll
                for (int mh = 0; mh < 2; ++mh) { f32x4 r[2][2][2];
#pragma unroll
                    for (int m2 = 0; m2 < 2; ++m2)
#pragma unroll
                        for (int bj = 0; bj < 2; ++bj) { const size_t off = (size_t)(row0 + ai * HALF + (2 * mh + m2) * 16) * 2048 + col0 + bj * HALF; r[m2][bj][0] = *(const f32x4*)(res32 + off); r[m2][bj][1] = *(const f32x4*)(res32 + off + 4); }
#pragma unroll
                    for (int m2 = 0; m2 < 2; ++m2)
#pragma unroll
                        for (int bj = 0; bj < 2; ++bj) { const int m = 2 * mh + m2; const size_t off = (size_t)(row0 + ai * HALF + m * 16) * 2048 + col0 + bj * HALF;
                            const f32x4 v0 = r[m2][bj][0] * alpha + acc[ai][bj][m][0], v1 = r[m2][bj][1] * alpha + acc[ai][bj][m][1];
                            u32x4 w; w.x = cvt_pk_bf16(v0[0], v0[1]); w.y = cvt_pk_bf16(v0[2], v0[3]); w.z = cvt_pk_bf16(v1[0], v1[1]); w.w = cvt_pk_bf16(v1[2], v1[3]);
                            *(u32x4*)(out + off) = w; } }
        } else {
#pragma unroll
            for (int ai = 0; ai < 2; ++ai) { u32x4 b[4][2];
#pragma unroll
                for (int m = 0; m < 4; ++m)
#pragma unroll
                    for (int bj = 0; bj < 2; ++bj) b[m][bj] = *(const u32x4*)(res16 + (size_t)(row0 + ai * HALF + m * 16) * 2048 + col0 + bj * HALF);
#pragma unroll
                for (int m = 0; m < 4; ++m)
#pragma unroll
                    for (int bj = 0; bj < 2; ++bj) { const size_t off = (size_t)(row0 + ai * HALF + m * 16) * 2048 + col0 + bj * HALF; const u32x4 bb = b[m][bj];
                        const f32x4 r0 = (f32x4){bflo(bb.x), bfhi(bb.x), bflo(bb.y), bfhi(bb.y)}, r1 = (f32x4){bflo(bb.z), bfhi(bb.z), bflo(bb.w), bfhi(bb.w)};
                        const f32x4 v0 = r0 * alpha + acc[ai][bj][m][0], v1 = r1 * alpha + acc[ai][bj][m][1];
                        u32x4 w; w.x = cvt_pk_bf16(v0[0], v0[1]); w.y = cvt_pk_bf16(v0[2], v0[3]); w.z = cvt_pk_bf16(v1[0], v1[1]); w.w = cvt_pk_bf16(v1[2], v1[3]);
                        *(u32x4*)(out + off) = w; } }
        }
    }
};
struct EpiGU {
    static constexpr bool PERM = true, AFTER_DRAIN = false;
    unsigned char* H;
    __device__ __forceinline__ void operator()(const f32x4 (&acc)[2][2][4][2], const Unit& u, int wr, int wc, int fr, int fq) const {
        const int row0 = u.pm * BM + wr * 64 + fr, col0 = ((u.pn & 7) * BM + wc * 32 + 8 * fq) >> 1;
#pragma unroll
        for (int ai = 0; ai < 2; ++ai)
#pragma unroll
            for (int m = 0; m < 4; ++m) { unsigned char* rowp = H + (size_t)(row0 + ai * HALF + m * 16) * 1024 + col0;
#pragma unroll
                for (int bj = 0; bj < 2; ++bj) { const f32x4 g = acc[ai][bj][m][0], up = acc[ai][bj][m][1]; f32x4 h;
#pragma unroll
                    for (int j = 0; j < 4; ++j) h[j] = g[j] * __builtin_amdgcn_rcpf(1.0f + __expf(-g[j])) * up[j] * (float)(1 << H8_SH);
                    *(unsigned*)(rowp + bj * (HALF / 2)) = pk4_fp8(h[0], h[1], h[2], h[3]); } }
    }
};
struct EpiY {
    static constexpr bool PERM = true, AFTER_DRAIN = false;
    bf16_t* Y;
    __device__ __forceinline__ void operator()(const f32x4 (&acc)[2][2][4][2], const Unit& u, int wr, int wc, int fr, int fq) const {
        const int row0 = u.pm * BM + wr * 64 + fr, col0 = (u.pn & 7) * BM + wc * 32 + 8 * fq;
#pragma unroll
        for (int ai = 0; ai < 2; ++ai)
#pragma unroll
            for (int m = 0; m < 4; ++m) { bf16_t* rowp = Y + (size_t)(row0 + ai * HALF + m * 16) * 2048 + col0;
#pragma unroll
                for (int bj = 0; bj < 2; ++bj) { const f32x4 v0 = acc[ai][bj][m][0], v1 = acc[ai][bj][m][1];
#if YS8
                    u32x2 w; w.x = pk4_fp8(v0[0] * (float)(1 << Y8_SH), v0[1] * (float)(1 << Y8_SH), v0[2] * (float)(1 << Y8_SH), v0[3] * (float)(1 << Y8_SH));
                    w.y = pk4_fp8(v1[0] * (float)(1 << Y8_SH), v1[1] * (float)(1 << Y8_SH), v1[2] * (float)(1 << Y8_SH), v1[3] * (float)(1 << Y8_SH));
                    *(u32x2*)((unsigned char*)Y + (size_t)(row0 + ai * HALF + m * 16) * 2048 + col0 + bj * HALF) = w; } }
#else
                    u32x4 w; w.x = cvt_pk_bf16(v0[0], v0[1]); w.y = cvt_pk_bf16(v0[2], v0[3]); w.z = cvt_pk_bf16(v1[0], v1[1]); w.w = cvt_pk_bf16(v1[2], v1[3]);
                    *(u32x4*)(rowp + bj * HALF) = w; } }
#endif
    }
};
struct MoeOrder : StaticOrder {
    const int* sb; const unsigned* idx; int rowbytes;
    __device__ __forceinline__ int expert_of(int pm) const { const int r = pm * BM; int e = 0;
#pragma unroll
        for (int k = 1; k < 16; ++k) e += (sb[k] <= r) ? 1 : 0;
        return e; }
    __device__ __forceinline__ bool next(int i, Unit& u) const {
        if (!StaticOrder::next(i, u)) return false;
        u.pn += 8 * __builtin_amdgcn_readfirstlane(expert_of(u.pm));
        return true; }
    __device__ __forceinline__ unsigned arow(const Unit& u, int r) const {
        const int e = u.pn >> 3, slot = u.pm * BM - sb[e] + r;
        const unsigned t = (slot < sb[32 + e]) ? __hip_atomic_load(idx + (size_t)e * 16384 + slot, __ATOMIC_RELAXED, __HIP_MEMORY_SCOPE_AGENT) : 0u;
        return t * (unsigned)rowbytes; }
};
}
__device__ __forceinline__ int rope_src_col(int n) {
    const int seg = (n - PMQ) >> 7, pp = (n - PMQ) & 127, g = pp >> 3, e = pp & 7;
    return 3088 + seg * 128 + (e < 4 ? 4 * g + e : 64 + 4 * g + (e - 4));
}
constexpr int CVT_NT = 1792, CVT_NT_IN = 192;
template <bool DYN, int JOBS>
static __device__ void phase_cvt(const Params& p, int tl, int t0, int ntot, int w, int nwk, unsigned char* lds, unsigned* qw = nullptr) {
    const int tid = opq_tid(), lane = tid & 63, wave = __builtin_amdgcn_readfirstlane(tid >> 6);
    volatile unsigned* qs = (volatile unsigned*)(lds + LDS_SCR + 96);
    int tt = w;
    if (DYN) { if (tid == 0) *qs = atomicAdd(qw, 1u); __syncthreads(); tt = (int)*qs; }
    while (tt < ntot) {
        unsigned qn = 0u; if (DYN && tid == 0) qn = atomicAdd(qw, 1u);
        int t = t0 + tt;
        int job, e = 0, kt, nt;
        if ((JOBS & 1) && (t < 192 || JOBS == 1)) { job = 0; kt = t / 12; nt = t % 12; }
        else if ((JOBS & 2) && (t < 256 || !(JOBS & 12))) { t -= 192; job = 1; kt = t >> 2; nt = t & 3; }
        else if ((JOBS & 4) && (t < 1280 || !(JOBS & 8))) { t -= 256; job = 2; e = t >> 6; t &= 63; kt = t >> 2; nt = t & 3; }
        else { t -= 1280; job = 3; e = t >> 5; t &= 31; kt = t >> 2; nt = t & 3; }
        const int n0 = nt * 512, k0 = kt * 128;
        const float* s0; const float* s1; size_t ld; int nl0, nl1;
        if (job == 0) { const float* wi = p.in[2] + (size_t)tl * DM * DIN + (size_t)k0 * DIN; ld = DIN;
            const int na = n0 + 4 * lane, nb = n0 + 256 + 4 * lane;
            s0 = wi + ((na < PMQ) ? na : (na < PMV ? rope_src_col(na) : na + 16)); s1 = wi + ((nb < PMQ) ? nb : (nb < PMV ? rope_src_col(nb) : nb + 16)); nl0 = 4 * lane; nl1 = 256 + 4 * lane; }
        else if (job == 1) { const float* wo = p.in[6] + (size_t)tl * DM * DM + (size_t)k0 * DM + n0; ld = DM; s0 = wo + 4 * lane; s1 = wo + 256 + 4 * lane; nl0 = 4 * lane; nl1 = 256 + 4 * lane; }
        else if (job == 2) { const size_t off = ((size_t)(tl * NE + e) * DM + k0) * DEXP + (n0 >> 1) + 4 * lane; ld = DEXP; s0 = p.in[11] + off; s1 = p.in[12] + off; nl0 = 8 * lane; nl1 = 8 * lane + 4; }
        else { const float* wd = p.in[13] + ((size_t)(tl * NE + e) * DEXP + k0) * DM + n0; ld = DM; s0 = wd + 4 * lane; s1 = wd + 256 + 4 * lane; nl0 = 4 * lane; nl1 = 256 + 4 * lane; }
        const bool f8 = OUT8 ? true : (job != 1); const float sc = (job == 0) ? (float)(1 << WIN8_SH) : (job == 1) ? (float)(1 << WO8_SH) : (job == 2) ? (float)(1 << WGU8_SH) : (float)(1 << WD8_SH);
        f32x4 v[3][8];
#pragma unroll
        for (int pb = 0; pb < 2; ++pb)
#pragma unroll
            for (int i = 0; i < 4; ++i) { const size_t ro = (size_t)(wave + 8 * (4 * pb + i)) * ld; v[pb][2 * i] = *(const f32x4*)(s0 + ro); v[pb][2 * i + 1] = *(const f32x4*)(s1 + ro); }
#pragma unroll
        for (int bt = 0; bt < 4; ++bt) {
            if (bt < 2) {
#pragma unroll
                for (int i = 0; i < 4; ++i) { const size_t ro = (size_t)(wave + 8 * (4 * (bt + 2) + i)) * ld; v[(bt + 2) % 3][2 * i] = *(const f32x4*)(s0 + ro); v[(bt + 2) % 3][2 * i + 1] = *(const f32x4*)(s1 + ro); } }
#pragma unroll
            for (int i = 0; i < 4; ++i) { const int r = wave + 8 * (4 * bt + i); const f32x4 x0 = v[bt % 3][2 * i], x1 = v[bt % 3][2 * i + 1];
                if (f8) { *(unsigned*)(lds + r * 512 + nl0) = pk4_fp8(x0[0] * sc, x0[1] * sc, x0[2] * sc, x0[3] * sc); *(unsigned*)(lds + r * 512 + nl1) = pk4_fp8(x1[0] * sc, x1[1] * sc, x1[2] * sc, x1[3] * sc); }
                else { u32x2 a; a.x = cvt_pk(x0[0], x0[1]); a.y = cvt_pk(x0[2], x0[3]); u32x2 c2; c2.x = cvt_pk(x1[0], x1[1]); c2.y = cvt_pk(x1[2], x1[3]);
                       *(u32x2*)(lds + r * 1024 + 2 * nl0) = a; *(u32x2*)(lds + r * 1024 + 2 * nl1) = c2; } }
        }
        __syncthreads();
        if (f8) {
            unsigned char* d = (job == 0) ? p.ws + ((tl & 1) ? WS_WIN2 : WS_WIN) + (size_t)(n0 + tid) * DM + k0
                             : (job == 1) ? p.ws + WS_WO + (size_t)(n0 + tid) * DM + k0
                             : (job == 2) ? p.ws + WS_WGU + ((size_t)e * 2048 + n0 + tid) * DM + k0 : p.ws + WS_WD + ((size_t)e * 2048 + n0 + tid) * DEXP + k0;
#pragma unroll
            for (int c = 0; c < 8; ++c) { unsigned wq[4];
#pragma unroll
                for (int j = 0; j < 4; ++j) { const unsigned char* s8 = lds + (16 * c + 4 * j) * 512 + tid; wq[j] = (unsigned)s8[0] | ((unsigned)s8[512] << 8) | ((unsigned)s8[1024] << 16) | ((unsigned)s8[1536] << 24); }
                *(u32x4*)(d + 16 * c) = (u32x4){wq[0], wq[1], wq[2], wq[3]}; }
        } else {
            unsigned char* d = p.ws + WS_WO + ((size_t)(n0 + tid) * DM + k0) * 2;
#pragma unroll
            for (int c = 0; c < 16; ++c) { unsigned wq[4];
#pragma unroll
                for (int j = 0; j < 4; ++j) { const unsigned lo = *(const unsigned short*)(lds + (8 * c + 2 * j) * 1024 + 2 * tid), hi = *(const unsigned short*)(lds + (8 * c + 2 * j + 1) * 1024 + 2 * tid); wq[j] = lo | (hi << 16); }
                *(u32x4*)(d + 16 * c) = (u32x4){wq[0], wq[1], wq[2], wq[3]}; }
        }
        if (DYN) { if (tid == 0) *qs = qn; }
        __syncthreads();
        if (DYN) tt = (int)*qs; else tt += nwk;
    }
}

static __device__ void phase_rope(const Params& p) {
    float* cs = (float*)(p.ws + WS_ROPE); float* sn = cs + (size_t)T * 64;
    const int* pos = (const int*)p.in[1];
    for (int idx = blockIdx.x * NTHR + opq_tid(); idx < T * 64; idx += gridDim.x * NTHR) {
        const int t = idx >> 6, i = idx & 63;
        double pw = 1.0; for (int k = 0; k < i; ++k) pw *= 1.1547819846894583;
        const float inv = 1.0f / (float)pw;
        const float ang = (float)pos[t] * inv;
        const double rev = (double)ang * 0.15915494309189535; const float fr = (float)(rev - floor(rev));
        cs[idx] = __builtin_amdgcn_cosf(fr); sn[idx] = __builtin_amdgcn_sinf(fr);
    }
}

__device__ __forceinline__ float reduce16(const float (&a)[16], int lane) {
    float b[8], c[4], d[2];
    const bool x = lane & 1, y = lane & 2, z = lane & 4, w = lane & 8;
#pragma unroll
    for (int m = 0; m < 8; ++m) { const float keep = x ? a[2 * m + 1] : a[2 * m], give = x ? a[2 * m] : a[2 * m + 1]; b[m] = keep + __shfl_xor(give, 1); }
#pragma unroll
    for (int m = 0; m < 4; ++m) { const float keep = y ? b[2 * m + 1] : b[2 * m], give = y ? b[2 * m] : b[2 * m + 1]; c[m] = keep + __shfl_xor(give, 2); }
#pragma unroll
    for (int m = 0; m < 2; ++m) { const float keep = z ? c[2 * m + 1] : c[2 * m], give = z ? c[2 * m] : c[2 * m + 1]; d[m] = keep + __shfl_xor(give, 4); }
    float e = (w ? d[1] : d[0]) + __shfl_xor(w ? d[0] : d[1], 8);
    e += __shfl_xor(e, 16); e += __shfl_xor(e, 32);
    return e;
}
#ifndef ROW_PROBE
#define ROW_PROBE 0
#endif
template <class Tp> __device__ __forceinline__ Tp* opq_uniform(Tp* ptr) { unsigned long long w = (unsigned long long)ptr; asm volatile("" : "+s"(w)); return (Tp*)w; }
template <int MODE, bool DUMMY = false> static __device__ void phase_rows(const Params& p, int layer, unsigned char* lds) {
    const int tid = opq_tid(), lane = tid & 63, wave = (MODE == 1) ? (tid >> 6) : __builtin_amdgcn_readfirstlane(tid >> 6);
    float* wT = (float*)lds;
    constexpr bool SK16 = false;
    int* lcnt = (int*)(lds + LDS_SCR + 512); int* gbase = lcnt + 16; float* rinfo = (float*)(lds + LDS_SCR + 1024);
    const bool last = (layer == NLAYER - 1);
    const bool do_skinny = !(MODE == 2 && last);
    const float* W; int ld, c0;
    if (MODE == 0) { W = p.in[2]; ld = DIN; c0 = 3072; }
    else if (MODE == 1) { W = p.in[9]; ld = 16; c0 = 0; }
    else { W = p.in[2] + (size_t)(last ? layer : layer + 1) * DM * DIN; ld = DIN; c0 = 3072; }
    bf16_t* hb = (bf16_t*)(p.ws + (DUMMY ? (MODE == 1 ? WS_U : WS_MIX) : WS_HB));
    float* glow = (float*)(p.ws + (DUMMY ? WS_PML + 2 * MiB : WS_GLOW));
    unsigned* tok = (unsigned*)(p.ws + (DUMMY && MODE == 1 ? WS_PML : WS_TOK));
    float* outw = DUMMY ? (float*)(p.ws + (MODE == 1 ? WS_PROJ : WS_WGU)) : p.out;
    const bf16_t* Ys = (const bf16_t*)(p.ws + WS_YS);
    int* sbm = (int*)(lds + LDS_SCR + 128);
#ifndef NR2_DEF
#define NR2_DEF 1
#endif
    constexpr int NR = (MODE == 2) ? NR2_DEF : 2;
    const int nit = T / (8 * (int)gridDim.x);
    constexpr bool PF = true;
#if YS8
    u32x2 nx[NR][8]; unsigned ny0[8], ny1[8]; f32x4 nf[NR][8];
#else
    u32x2 nx[NR][8], ny0[8], ny1[8]; f32x4 nf[NR][8];
#endif
    float nw0 = 0.f, nw1 = 0.f; unsigned nt[6];
    const bf16_t* srcb0 = (const bf16_t*)(p.ws + ((MODE == 2 && !RECOMP) ? WS_HB : WS_PRE));
    if (PF) {
#pragma unroll
        for (int rr = 0; rr < NR; ++rr) { const int r = (rr * (int)gridDim.x + (int)blockIdx.x) * 8 + wave;
#pragma unroll
            for (int i = 0; i < 8; ++i) { if (MODE == 1) nx[rr][i] = *(const u32x2*)(srcb0 + (size_t)r * DM + 256 * i + 4 * lane); else if (MODE == 2) nx[rr][i] = *(const u32x2*)(opq_uniform(srcb0 + (size_t)r * DM) + 256 * i + 4 * lane); else nf[rr][i] = *(const f32x4*)(opq_uniform(p.in[0] + (size_t)r * DM) + 256 * i + 4 * lane); } }
        if (MODE == 2) {
            const int r = (int)blockIdx.x * 8 + wave;
#pragma unroll
            for (int j = 0; j < 6; ++j) nt[j] = ldu(tok + r * 8 + j);
        }
    }
    if (MODE == 2) moe_bases((const unsigned*)(p.ws + WS_CTL) + CW_CNT + layer * 64, sbm);
    if (PF && MODE == 2) {
        nw0 = __uint_as_float(nt[2]); nw1 = __uint_as_float(nt[3]);
#if YS8
        const unsigned char* y0 = opq_uniform((const unsigned char*)Ys + (size_t)__builtin_amdgcn_readfirstlane((int)((unsigned)sbm[nt[0]] + nt[4])) * DM); const unsigned char* y1 = opq_uniform((const unsigned char*)Ys + (size_t)__builtin_amdgcn_readfirstlane((int)((unsigned)sbm[nt[1]] + nt[5])) * DM);
#pragma unroll
        for (int i = 0; i < 8; ++i) { ny0[i] = *(const unsigned*)(y0 + 256 * i + 4 * lane); ny1[i] = *(const unsigned*)(y1 + 256 * i + 4 * lane); }
#else
        const bf16_t* y0 = Ys + (size_t)((unsigned)sbm[nt[0]] + nt[4]) * DM; const bf16_t* y1 = Ys + (size_t)((unsigned)sbm[nt[1]] + nt[5]) * DM;
#pragma unroll
        for (int i = 0; i < 8; ++i) { ny0[i] = *(const u32x2*)(y0 + 256 * i + 4 * lane); ny1[i] = *(const u32x2*)(y1 + 256 * i + 4 * lane); }
#endif
        const int r2 = ((nit > 1 ? 1 : 0) * (int)gridDim.x + (int)blockIdx.x) * 8 + wave;
#pragma unroll
        for (int j = 0; j < 6; ++j) nt[j] = ldu(tok + r2 * 8 + j);
    }
    if (do_skinny) {
#pragma unroll
        for (int hb2 = 0; hb2 < 2; ++hb2) { f32x4 wv[8];
#pragma unroll
            for (int i = 0; i < 8; ++i) { const int i4 = tid + NTHR * (8 * hb2 + i), k = i4 >> 2, e4 = (i4 & 3) * 4; wv[i] = *(const f32x4*)(W + (size_t)k * ld + c0 + e4); }
#pragma unroll
            for (int i = 0; i < 8; ++i) { const int i4 = tid + NTHR * (8 * hb2 + i), k = i4 >> 2, e4 = (i4 & 3) * 4;
#pragma unroll
                for (int j = 0; j < 4; ++j) { if (SK16) ((unsigned short*)wT)[(e4 + j) * DM + k] = (unsigned short)(cvt_pk(wv[i][j], 0.f) & 0xFFFFu); else wT[(e4 + j) * DM + k] = wv[i][j]; } } }
    }
    if (MODE == 1 && tid < 16) lcnt[tid] = 0;
    float* gl = (float*)(lds + LDS_SCR + 4096); float* bl2 = gl + DM;
    unsigned short* tb2 = (unsigned short*)(lds + LDS_SCR + 12288); unsigned short* tg1 = tb2 + DM; unsigned short* tb1 = tg1 + DM;
    if (MODE != 0) {
        const float* gp = p.in[MODE == 1 ? 7 : 14] + (size_t)layer * DM; const float* bp = p.in[MODE == 1 ? 8 : 15] + (size_t)layer * DM;
        if (MODE == 2 && RECOMP) {
            const float* g1p = p.in[7] + (size_t)layer * DM; const float* b1p = p.in[8] + (size_t)layer * DM;
#pragma unroll
            for (int k = 0; k < DM / NTHR; ++k) { const int idx = tid + NTHR * k; gl[idx] = gp[idx];
                tb2[idx] = (unsigned short)(cvt_pk(bp[idx], 0.f) & 0xFFFFu); tg1[idx] = (unsigned short)(cvt_pk(g1p[idx], 0.f) & 0xFFFFu); tb1[idx] = (unsigned short)(cvt_pk(b1p[idx], 0.f) & 0xFFFFu); }
        } else {
#pragma unroll
            for (int k = 0; k < DM / NTHR; ++k) { const int idx = tid + NTHR * k; gl[idx] = gp[idx]; bl2[idx] = bp[idx]; }
        }
    }
    __syncthreads();
    for (int it = 0; it < nit; it += NR) {
        int row[NR]; float v[NR][32];
#pragma unroll
        for (int rr = 0; rr < NR; ++rr) { row[rr] = ((it + rr) * (int)gridDim.x + (int)blockIdx.x) * 8 + wave;
            if (MODE != 0) {
#pragma unroll
                for (int i = 0; i < 8; ++i) { const u32x2 x = nx[rr][i]; v[rr][4 * i] = bflo(x.x); v[rr][4 * i + 1] = bfhi(x.x); v[rr][4 * i + 2] = bflo(x.y); v[rr][4 * i + 3] = bfhi(x.y); }
            } else {
#pragma unroll
                for (int i = 0; i < 8; ++i) { const f32x4 x = nf[rr][i];
#pragma unroll
                    for (int j = 0; j < 4; ++j) v[rr][4 * i + j] = x[j]; } } }
        if (MODE == 2 && RECOMP) {
            __builtin_amdgcn_sched_barrier(0);
            float s = 0.f;
#pragma unroll
            for (int i = 0; i < 32; ++i) s += v[0][i];
            const float mean = wave_sum(s) * (1.0f / DM);
            float qq = 0.f;
#pragma unroll
            for (int i = 0; i < 32; ++i) { const float d = v[0][i] - mean; qq += d * d; }
            const float rstd = rsqrtf(wave_sum(qq) * (1.0f / DM) + 1e-5f);
#pragma unroll
            for (int i = 0; i < 8; ++i) { const u32x2 g4 = *(const u32x2*)(tg1 + 256 * i + 4 * lane), b4 = *(const u32x2*)(tb1 + 256 * i + 4 * lane);
                v[0][4 * i + 0] = (v[0][4 * i + 0] - mean) * rstd * bflo(g4.x) + bflo(b4.x); v[0][4 * i + 1] = (v[0][4 * i + 1] - mean) * rstd * bfhi(g4.x) + bfhi(b4.x);
                v[0][4 * i + 2] = (v[0][4 * i + 2] - mean) * rstd * bflo(g4.y) + bflo(b4.y); v[0][4 * i + 3] = (v[0][4 * i + 3] - mean) * rstd * bfhi(g4.y) + bfhi(b4.y);
                asm volatile("" ::: "memory"); }
            __builtin_amdgcn_sched_barrier(0);
        }
        if (MODE == 2) {
#if YS8
            const float w0 = nw0 * (1.0f / (float)(1 << Y8_SH)), w1 = nw1 * (1.0f / (float)(1 << Y8_SH));
#pragma unroll
            for (int i = 0; i < 8; ++i) { const unsigned a = ny0[i], c = ny1[i];
                const f32x2 a01 = __builtin_amdgcn_cvt_pk_f32_fp8((int)a, false), a23 = __builtin_amdgcn_cvt_pk_f32_fp8((int)a, true), c01 = __builtin_amdgcn_cvt_pk_f32_fp8((int)c, false), c23 = __builtin_amdgcn_cvt_pk_f32_fp8((int)c, true);
                v[0][4 * i + 0] = DN_ALPHA * v[0][4 * i + 0] + w0 * a01[0] + w1 * c01[0]; v[0][4 * i + 1] = DN_ALPHA * v[0][4 * i + 1] + w0 * a01[1] + w1 * c01[1];
                v[0][4 * i + 2] = DN_ALPHA * v[0][4 * i + 2] + w0 * a23[0] + w1 * c23[0]; v[0][4 * i + 3] = DN_ALPHA * v[0][4 * i + 3] + w0 * a23[1] + w1 * c23[1]; }
#else
            const float w0 = nw0, w1 = nw1;
#pragma unroll
            for (int i = 0; i < 8; ++i) { const u32x2 a = ny0[i], c = ny1[i];
                v[0][4 * i + 0] = DN_ALPHA * v[0][4 * i + 0] + w0 * bflo(a.x) + w1 * bflo(c.x); v[0][4 * i + 1] = DN_ALPHA * v[0][4 * i + 1] + w0 * bfhi(a.x) + w1 * bfhi(c.x);
                v[0][4 * i + 2] = DN_ALPHA * v[0][4 * i + 2] + w0 * bflo(a.y) + w1 * bflo(c.y); v[0][4 * i + 3] = DN_ALPHA * v[0][4 * i + 3] + w0 * bfhi(a.y) + w1 * bfhi(c.y); }
#endif
        }
        if (PF) {
            const int itn = (it + NR < nit) ? it + NR : it;
#pragma unroll
            for (int rr = 0; rr < NR; ++rr) { const int r = ((itn + rr) * (int)gridDim.x + (int)blockIdx.x) * 8 + wave;
#pragma unroll
                for (int i = 0; i < 8; ++i) { if (MODE == 1) nx[rr][i] = *(const u32x2*)(srcb0 + (size_t)r * DM + 256 * i + 4 * lane); else if (MODE == 2) nx[rr][i] = *(const u32x2*)(opq_uniform(srcb0 + (size_t)r * DM) + 256 * i + 4 * lane); else nf[rr][i] = *(const f32x4*)(opq_uniform(p.in[0] + (size_t)r * DM) + 256 * i + 4 * lane); } }
            if (MODE == 2) {
                nw0 = __uint_as_float(nt[2]); nw1 = __uint_as_float(nt[3]);
#if YS8
                        const unsigned char* y0 = opq_uniform((const unsigned char*)Ys + (size_t)__builtin_amdgcn_readfirstlane((int)((unsigned)sbm[nt[0]] + nt[4])) * DM); const unsigned char* y1 = opq_uniform((const unsigned char*)Ys + (size_t)__builtin_amdgcn_readfirstlane((int)((unsigned)sbm[nt[1]] + nt[5])) * DM);
#pragma unroll
                for (int i = 0; i < 8; ++i) { ny0[i] = *(const unsigned*)(y0 + 256 * i + 4 * lane); ny1[i] = *(const unsigned*)(y1 + 256 * i + 4 * lane); }
#else
                const bf16_t* y0 = Ys + (size_t)((unsigned)sbm[nt[0]] + nt[4]) * DM; const bf16_t* y1 = Ys + (size_t)((unsigned)sbm[nt[1]] + nt[5]) * DM;
#pragma unroll
                for (int i = 0; i < 8; ++i) { ny0[i] = *(const u32x2*)(y0 + 256 * i + 4 * lane); ny1[i] = *(const u32x2*)(y1 + 256 * i + 4 * lane); }
#endif
                const int it2 = (it + 2 < nit) ? it + 2 : nit - 1;
                const int r2 = (it2 * (int)gridDim.x + (int)blockIdx.x) * 8 + wave;
#pragma unroll
                for (int j = 0; j < 6; ++j) nt[j] = ldu(tok + r2 * 8 + j);
            }
        }
#pragma unroll
        for (int rr = 0; rr < NR; ++rr) {
            __builtin_amdgcn_sched_barrier(0);
            if (MODE != 0) {
                float s = 0.f;
#pragma unroll
                for (int i = 0; i < 32; ++i) s += v[rr][i];
                const float mean = wave_sum(s) * (1.0f / DM);
                float q = 0.f;
#pragma unroll
                for (int i = 0; i < 32; ++i) { const float d = v[rr][i] - mean; q += d * d; }
                const float rstd = rsqrtf(wave_sum(q) * (1.0f / DM) + 1e-5f);
#pragma unroll
                for (int i = 0; i < 8; ++i) { const f32x4 gv = *(const f32x4*)(gl + 256 * i + 4 * lane); f32x4 bv;
                    if (MODE == 2 && RECOMP) { const u32x2 b4 = *(const u32x2*)(tb2 + 256 * i + 4 * lane); bv = (f32x4){bflo(b4.x), bfhi(b4.x), bflo(b4.y), bfhi(b4.y)}; }
                    else bv = *(const f32x4*)(bl2 + 256 * i + 4 * lane);
#pragma unroll
                    for (int j = 0; j < 4; ++j) v[rr][4 * i + j] = (v[rr][4 * i + j] - mean) * rstd * gv[j] + bv[j]; }
                if (MODE == 2 && last) {
                    float* dst = (MODE == 1) ? outw + (size_t)row[rr] * DM : opq_uniform(outw + (size_t)row[rr] * DM);
#pragma unroll
                    for (int i = 0; i < 8; ++i) *(f32x4*)(dst + 256 * i + 4 * lane) = (f32x4){v[rr][4 * i], v[rr][4 * i + 1], v[rr][4 * i + 2], v[rr][4 * i + 3]}; }
            }
            if (MODE != 0 && !(MODE == 2 && last) && !(MODE == 1 && RECOMP)) {
#pragma unroll
                for (int i = 0; i < 8; ++i) { u32x2 w; w.x = cvt_pk(v[rr][4 * i], v[rr][4 * i + 1]); w.y = cvt_pk(v[rr][4 * i + 2], v[rr][4 * i + 3]); *(u32x2*)(((MODE == 1) ? hb + (size_t)row[rr] * DM : opq_uniform(hb + (size_t)row[rr] * DM)) + 256 * i + 4 * lane) = w; }
            }
            if (MODE == 1 || !(MODE == 2 && last)) {
                unsigned char* hb8 = p.ws + (DUMMY ? WS_S : (MODE == 1 ? WS_HB8 : WS_HBQ));
#pragma unroll
                for (int i = 0; i < 8; ++i) *(unsigned*)(((MODE == 1) ? hb8 + (size_t)row[rr] * DM : opq_uniform(hb8 + (size_t)row[rr] * DM)) + 256 * i + 4 * lane) = pk4_fp8(v[rr][4 * i] * (float)(1 << X8_SH), v[rr][4 * i + 1] * (float)(1 << X8_SH), v[rr][4 * i + 2] * (float)(1 << X8_SH), v[rr][4 * i + 3] * (float)(1 << X8_SH));
            }
            asm volatile("" ::: "memory"); __builtin_amdgcn_sched_barrier(0);
        }
        if (do_skinny) {
            float tots[NR];
#pragma unroll
            for (int rr = 0; rr < NR; ++rr) {
                asm volatile("" ::: "memory"); __builtin_amdgcn_sched_barrier(0);
                float acc1[16];
#if ROW_PROBE == 1
#pragma unroll 1
                for (int pr_ = 0; pr_ < 3; ++pr_) {
#endif
#pragma unroll
                for (int e = 0; e < 16; ++e) acc1[e] = 0.f;
#pragma unroll
                for (int i = 0; i < 8; ++i) {
                    constexpr int EG = (MODE == 2) ? 4 : 8;
                    typedef __bf16 bf2_t __attribute__((ext_vector_type(2)));
                    const bf2_t va = __builtin_bit_cast(bf2_t, cvt_pk(v[rr][4 * i], v[rr][4 * i + 1])), vb = __builtin_bit_cast(bf2_t, cvt_pk(v[rr][4 * i + 2], v[rr][4 * i + 3]));
#pragma unroll
                    for (int eh = 0; eh < 16 / EG; ++eh) {
#pragma unroll
                        for (int e = EG * eh; e < EG * eh + EG; ++e) {
                            if (SK16) { const u32x2 w2 = *(const u32x2*)((const unsigned short*)wT + e * DM + 256 * i + 4 * lane);
                                acc1[e] = __builtin_amdgcn_fdot2_f32_bf16(va, __builtin_bit_cast(bf2_t, w2.x), acc1[e], false); acc1[e] = __builtin_amdgcn_fdot2_f32_bf16(vb, __builtin_bit_cast(bf2_t, w2.y), acc1[e], false); }
                            else { const f32x4 w4 = *(const f32x4*)(wT + e * DM + 256 * i + 4 * lane);
                                acc1[e] += v[rr][4 * i] * w4[0] + v[rr][4 * i + 1] * w4[1] + v[rr][4 * i + 2] * w4[2] + v[rr][4 * i + 3] * w4[3]; } }
                        asm volatile("" ::: "memory"); } }
#if ROW_PROBE == 1
                asm volatile("" ::: "memory"); }
#endif
                tots[rr] = reduce16(acc1, lane);
                if (MODE != 1) { if (lane < 16) glow[(size_t)row[rr] * 16 + lane] = tots[rr]; }
            }
            if (MODE == 1) {
#pragma unroll
              for (int rr = 0; rr < NR; ++rr) {
                asm volatile("" ::: "memory"); __builtin_amdgcn_sched_barrier(0);
                const float tot = tots[rr];
                {
                    float lg[16];
#pragma unroll
                    for (int e = 0; e < 16; ++e) lg[e] = __int_as_float(__builtin_amdgcn_readlane(__float_as_int(tot), e));
                    float mx = lg[0];
#pragma unroll
                    for (int e = 1; e < 16; ++e) mx = fmaxf(mx, lg[e]);
                    float aff[16], bi[16], sum = 0.f;
#pragma unroll
                    for (int e = 0; e < 16; ++e) { aff[e] = __expf(lg[e] - mx); sum += aff[e]; }
                    const float rs = 1.0f / sum;
#pragma unroll
                    for (int e = 0; e < 16; ++e) { aff[e] *= rs; bi[e] = aff[e] + p.in[10][e]; }
                    float gs[4];
#pragma unroll
                    for (int gi = 0; gi < 4; ++gi) { const float a0 = bi[4 * gi], a1 = bi[4 * gi + 1], a2 = bi[4 * gi + 2], a3 = bi[4 * gi + 3];
                        gs[gi] = fmaxf(fmaxf(fmaxf(a0 + a1, a0 + a2), fmaxf(a0 + a3, a1 + a2)), fmaxf(a1 + a3, a2 + a3)); }
                    int best = 0; float bv = gs[0];
#pragma unroll
                    for (int gi = 1; gi < 4; ++gi) if (gs[gi] > bv) { bv = gs[gi]; best = gi; }
                    float ab[4], aa[4];
#pragma unroll
                    for (int k = 0; k < 4; ++k) { ab[k] = best == 0 ? bi[k] : best == 1 ? bi[4 + k] : best == 2 ? bi[8 + k] : bi[12 + k];
                                                  aa[k] = best == 0 ? aff[k] : best == 1 ? aff[4 + k] : best == 2 ? aff[8 + k] : aff[12 + k]; }
                    int i1 = 0; float v1 = ab[0];
#pragma unroll
                    for (int k = 1; k < 4; ++k) if (ab[k] > v1) { v1 = ab[k]; i1 = k; }
                    int i2 = -1; float v2 = -3.0e38f;
#pragma unroll
                    for (int k = 0; k < 4; ++k) if (k != i1 && ab[k] > v2) { v2 = ab[k]; i2 = k; }
                    const float a1 = i1 == 0 ? aa[0] : i1 == 1 ? aa[1] : i1 == 2 ? aa[2] : aa[3];
                    const float a2 = i2 == 0 ? aa[0] : i2 == 1 ? aa[1] : i2 == 2 ? aa[2] : aa[3];
                    const float ws = 1.0f / (a1 + a2);
                    const int e0 = 4 * best + i1, e1 = 4 * best + i2;
                    if (lane == 0) {
                        const int ls0 = atomicAdd(&lcnt[e0], 1), ls1 = atomicAdd(&lcnt[e1], 1);
                        float* ri = rinfo + ((it + rr) * 8 + wave) * 8;
                        ri[0] = __int_as_float(e0); ri[1] = __int_as_float(e1); ri[2] = a1 * ws; ri[3] = a2 * ws; ri[4] = __int_as_float(ls0); ri[5] = __int_as_float(ls1);
                    }
                }
              }
            }
        }
    }
    if (MODE == 1) {
        unsigned* cnt = (unsigned*)(p.ws + WS_CTL) + (DUMMY ? CW_DBG + 64 : CW_CNT + layer * 64);
        __syncthreads();
        if (tid < 16) gbase[tid] = (int)atomicAdd(&cnt[tid], (unsigned)lcnt[tid]);
        __syncthreads();
        if (tid < 8 * nit) {
            const int it = tid >> 3, wv = tid & 7, row = (it * (int)gridDim.x + (int)blockIdx.x) * 8 + wv;
            const float* ri = rinfo + tid * 8;
            const int e0 = __float_as_int(ri[0]), e1 = __float_as_int(ri[1]);
            u32x4 a; a.x = (unsigned)e0; a.y = (unsigned)e1; a.z = __float_as_uint(ri[2]); a.w = __float_as_uint(ri[3]);
            u32x4 c; c.x = (unsigned)(gbase[e0] + __float_as_int(ri[4])); c.y = (unsigned)(gbase[e1] + __float_as_int(ri[5])); c.z = 0u; c.w = 0u;
            *(u32x4*)(tok + row * 8) = a; *(u32x4*)(tok + row * 8 + 4) = c;
            if (!DUMMY) { unsigned* idx = (unsigned*)(p.ws + WS_IDX); idx[(size_t)e0 * 16384 + c.x] = (unsigned)row; idx[(size_t)e1 * 16384 + c.y] = (unsigned)row; }
        }
        __syncthreads();
    }
    __syncthreads();
}

__device__ void phase_perm(const Params& p, int layer, unsigned char* lds) {
    const int tid = opq_tid(), lane = tid & 63, wave = __builtin_amdgcn_readfirstlane(tid >> 6);
    int* sb = (int*)lds;
    const unsigned* cnt = (const unsigned*)(p.ws + WS_CTL) + CW_CNT + layer * 64;
    unsigned* misc = (unsigned*)(p.ws + WS_MISC) + layer * 256;
    if (tid < 64) {
        const int c = (lane < NE) ? (int)ldu(cnt + lane) : 0;
        const int nP = (c + 255) >> 8;
        int incl = nP;
#pragma unroll
        for (int o = 1; o < 16; o <<= 1) { const int t = __shfl_up(incl, o); if (lane >= o) incl += t; }
        const int excl = incl - nP;
        if (lane < NE) {
            sb[lane] = excl * 256;
            if (blockIdx.x == 0) { misc[16 + lane] = (unsigned)(excl * 256); for (int q = 0; q < nP; ++q) misc[64 + excl + q] = (unsigned)lane; if (lane == NE - 1) misc[0] = (unsigned)incl; }
        }
    }
    __syncthreads();
    unsigned* tok = (unsigned*)(p.ws + WS_TOK);
    const bf16_t* hb = (const bf16_t*)(p.ws + WS_HB); unsigned char* Xs = p.ws + WS_XS;
    const int nit = T / (8 * (int)gridDim.x);
    for (int it = 0; it < nit; ++it) {
        const int row = (it * (int)gridDim.x + (int)blockIdx.x) * 8 + wave;
        const int e0 = (int)ldu(tok + row * 8), e1 = (int)ldu(tok + row * 8 + 1);
        const int r0 = sb[e0] + (int)ldu(tok + row * 8 + 4), r1 = sb[e1] + (int)ldu(tok + row * 8 + 5);
        const u32x4* s = (const u32x4*)(hb + (size_t)row * DM);
#pragma unroll
        for (int hh = 0; hh < 2; ++hh) {
            float f[16]; { float fa[8], fb[8]; unpack8(s[2 * lane + 128 * hh], fa); unpack8(s[2 * lane + 1 + 128 * hh], fb);
#pragma unroll
                for (int i = 0; i < 8; ++i) { f[i] = fa[i] * (float)(1 << X8_SH); f[8 + i] = fb[i] * (float)(1 << X8_SH); } }
            const u32x4 x = {pk4_fp8(f[0], f[1], f[2], f[3]), pk4_fp8(f[4], f[5], f[6], f[7]), pk4_fp8(f[8], f[9], f[10], f[11]), pk4_fp8(f[12], f[13], f[14], f[15])};
            *(u32x4*)(Xs + (size_t)r0 * DM + 16 * lane + 1024 * hh) = x; *(u32x4*)(Xs + (size_t)r1 * DM + 16 * lane + 1024 * hh) = x; }
        if (lane == 0) { tok[row * 8 + 6] = (unsigned)r0; tok[row * 8 + 7] = (unsigned)r1; }
    }
    __syncthreads();
}
constexpr int GL_V = 0, GL_K = 33792, GL_Q = 51200, GL_B = 68608, GL_GLW = 101376, GL_TOT = 105472, GL_AT = 107520, GL_RED = 116736, GL_W = 118784;
#ifndef GLA_PROBE
#define GLA_PROBE 0
#endif
#ifndef GLA_NOTR
#define GLA_NOTR 0
#endif
#ifndef ATT_QMAX_DEF
#define ATT_QMAX_DEF 512
#endif
constexpr int ATT_QMAX = ATT_QMAX_DEF;
constexpr int KSB = 272, VSB = 528, ASB = 144;
__device__ __forceinline__ int blx(int row, int col) { return row * 128 + ((((col >> 2) ^ (row & 7))) << 2) + (col & 3); }

__device__ __forceinline__ f32x4 gla_decay(unsigned char* lds) {
    const int tid = opq_tid();
    float* bl = (float*)(lds + GL_B); const float* glw = (const float*)(lds + GL_GLW); float* tot = (float*)(lds + GL_TOT); float* gt = (float*)(lds + GL_AT);
    const int dq = tid & 31, tg = tid >> 5;
    asm volatile("s_waitcnt vmcnt(0)" ::: "memory");
    __syncthreads();
    f32x4 all = (f32x4){0.f, 0.f, 0.f, 0.f};
#pragma unroll 1
    for (int pr_ = 0; pr_ < (GLA_PROBE == 1 ? 5 : 1); ++pr_) {
    const f32x4 bg = *(const f32x4*)((const float*)(lds + GL_W) + 2048 + 4 * dq);
    f32x4 x[4] = {bg, bg, bg, bg};
#pragma unroll
    for (int hf = 0; hf < 2; ++hf) {
        f32x4 w[8];
#pragma unroll
        for (int r = 0; r < 8; ++r) w[r] = *(const f32x4*)((const float*)(lds + GL_W) + (8 * hf + r) * 128 + 4 * dq);
#pragma unroll
        for (int tt = 0; tt < 4; ++tt) { const f32x4* gr = (const f32x4*)(glw + (tg * 4 + tt) * 16 + 8 * hf); const f32x4 g0 = gr[0], g1 = gr[1];
            x[tt] += g0[0] * w[0] + g0[1] * w[1] + g0[2] * w[2] + g0[3] * w[3] + g1[0] * w[4] + g1[1] * w[5] + g1[2] * w[6] + g1[3] * w[7]; }
        __builtin_amdgcn_sched_barrier(0);
    }
    f32x4 run = (f32x4){0.f, 0.f, 0.f, 0.f};
#pragma unroll
    for (int tt = 0; tt < 4; ++tt) {
        const int tk = tg * 4 + tt;
#pragma unroll
        for (int j = 0; j < 4; ++j) run[j] += (fminf(x[tt][j], 0.f) - __logf(1.0f + __expf(-fabsf(x[tt][j])))) * 0.0625f;
        *(f32x4*)(bl + tk * 128 + 4 * dq) = run;
    }
    *(f32x4*)(gt + tg * 128 + 4 * dq) = run;
    __syncthreads();
    f32x4 pre = (f32x4){0.f, 0.f, 0.f, 0.f}; all = pre;
#pragma unroll
    for (int g2 = 0; g2 < 16; ++g2) { const f32x4 tv = *(const f32x4*)(gt + g2 * 128 + 4 * dq); if (g2 < tg) pre += tv; all += tv; }
#pragma unroll
    for (int tt = 0; tt < 4; ++tt) { f32x4* bp = (f32x4*)(bl + (tg * 4 + tt) * 128 + 4 * dq); *bp = *bp + pre; }
    if (tg == 0) { *(f32x4*)(tot + 4 * dq) = all; *(f32x4*)(tot + 128 + 4 * dq) = (f32x4){__expf(all[0]), __expf(all[1]), __expf(all[2]), __expf(all[3])}; }
    __syncthreads();
    }
    return all;
}
__device__ __forceinline__ void gla_stage_v(const bf16_t* proj, int c, int h, unsigned char* lds) {
    const int tid = opq_tid(), tk = tid >> 3, dv0 = (tid & 7) * 32;
    const u32x4* s = (const u32x4*)(proj + ix_gv(h, c * 64 + tk) + dv0);
    u32x4* d = (u32x4*)(lds + GL_V + tk * VSB + dv0 * 2);
#pragma unroll
    for (int i = 0; i < 4; ++i) d[i] = s[i];
}

template <bool OUT>
static __device__ void gla_super_unit(const Params& p, int layer, int sc, int h, unsigned char* lds) {
    const int tid = opq_tid(), lane = tid & 63, wave = tid >> 6, g = lane >> 4, l15 = lane & 15;
    const bf16_t* proj = (const bf16_t*)(p.ws + WS_PROJ);
    const int tk0 = tid >> 3, dk0 = (tid & 7) * 16, dv0 = (tid & 7) * 32;
    const int lbase = (int)(uintptr_t)lds, trow = l15 >> 2, tcol = 4 * (lane & 3);
    const float* bl = (const float*)(lds + GL_B); float* tot = (float*)(lds + GL_TOT);
    f32x4 S[8][2];
    if (OUT && sc > 0) {
        const bf16_t* Sst = (const bf16_t*)(p.ws + WS_S) + ((size_t)sc * 4 + h) * 256 * 128;
#pragma unroll
        for (int m = 0; m < 8; ++m)
#pragma unroll
            for (int nn = 0; nn < 2; ++nn) { const u32x2 w = *(const u32x2*)(Sst + (size_t)(32 * wave + 16 * nn + l15) * 128 + 16 * m + 4 * g);
                S[m][nn] = (f32x4){bflo(w.x), bfhi(w.x), bflo(w.y), bfhi(w.y)}; }
    } else {
#pragma unroll
        for (int m = 0; m < 8; ++m) { S[m][0] = (f32x4){0.f, 0.f, 0.f, 0.f}; S[m][1] = (f32x4){0.f, 0.f, 0.f, 0.f}; }
    }
    f32x4 bsum = (f32x4){0.f, 0.f, 0.f, 0.f};
    if (!OUT) { float* wl = (float*)(lds + GL_W);
#pragma unroll
      for (int j = 0; j < 4; ++j) { const int idx = tid + 512 * j; wl[idx] = p.in[3][(size_t)layer * 16 * 512 + (idx >> 7) * 512 + h * 128 + (idx & 127)]; }
      if (tid < 128) wl[2048 + tid] = p.in[4][layer * 512 + h * 128 + tid]; }
    float* gB = (float*)(p.ws + WS_BDEC);
    u32x4 qreg[2], kreg[2], vreg[4];
    const int wu = __builtin_amdgcn_readfirstlane(wave);
#define GLA_REQ(cq) { const int c_ = (cq); \
        const u32x4* sk = (const u32x4*)(proj + ix_gk(h, c_ * 64 + tk0) + dk0); const u32x4* sv = (const u32x4*)(proj + ix_gv(h, c_ * 64 + tk0) + dv0); \
        kreg[0] = sk[0]; kreg[1] = sk[1]; \
        if (OUT) { const u32x4* sq = (const u32x4*)(proj + ix_gq(h, c_ * 64 + tk0) + dk0); qreg[0] = sq[0]; qreg[1] = sq[1]; } \
        _Pragma("unroll") for (int i = 0; i < 4; ++i) vreg[i] = sv[i]; \
        if (!OUT) { if (wu < 4) __builtin_amdgcn_global_load_lds((const unsigned*)((const float*)(p.ws + WS_GLOW) + (size_t)c_ * 64 * 16 + tid * 4), (PG8_LAS unsigned*)(size_t)(unsigned)(lbase + GL_GLW + wu * 1024), 16, 0, 0); } \
        else { _Pragma("unroll") for (int k_ = 0; k_ < 4; ++k_) __builtin_amdgcn_global_load_lds((const unsigned*)(gB + ((size_t)c_ * 4 + h) * 8192 + (k_ * 512 + tid) * 4), (PG8_LAS unsigned*)(size_t)(unsigned)(lbase + GL_B + k_ * 8192 + wu * 1024), 16, 0, 0); } }
    GLA_REQ(sc * 4);
#pragma unroll 1
    for (int cc = 0; cc < 4; ++cc) {
        const int c = sc * 4 + cc;
        if (!OUT) {
            bsum += gla_decay(lds);
            float* gt_ = gB + ((size_t)c * 4 + h) * 8192;
#pragma unroll
            for (int k_ = 0; k_ < 4; ++k_) *(f32x4*)(gt_ + (k_ * 512 + tid) * 4) = *(const f32x4*)(bl + (k_ * 512 + tid) * 4);
        } else {
            asm volatile("s_waitcnt vmcnt(0)" ::: "memory");
            __syncthreads();
            if (tid < 128) { const float bb = bl[63 * 128 + tid]; tot[tid] = bb; tot[128 + tid] = __expf(bb); }
        }
        if (OUT) {
#pragma unroll
            for (int hlf = 0; hlf < 2; ++hlf) { float fq[8], fk[8]; unpack8(qreg[hlf], fq); unpack8(kreg[hlf], fk);
#pragma unroll
                for (int j = 0; j < 8; ++j) { const float bb = bl[tk0 * 128 + dk0 + hlf * 8 + j]; fq[j] *= __expf(bb) * 0.08838834764831845f; fk[j] *= __expf(-bb); }
                *(u32x4*)(lds + GL_Q + tk0 * KSB + (dk0 + hlf * 8) * 2) = pack8(fq); *(u32x4*)(lds + GL_K + tk0 * KSB + (dk0 + hlf * 8) * 2) = pack8(fk); }
        }
#pragma unroll
        for (int i = 0; i < 4; ++i) *(u32x4*)(lds + GL_V + tk0 * VSB + dv0 * 2 + 16 * i) = vreg[i];
        __syncthreads();
        f32x4 acc[2][4]; u32x2 ggr[4][2]; f32x4 gn[2];
        if (OUT) {
#if GLA_PROBE == 2
#pragma unroll 1
            for (int pr_ = 0; pr_ < 5; ++pr_)
#endif
            { const int mj = wave >> 1;
              f32x4 at[2] = {(f32x4){0.f, 0.f, 0.f, 0.f}, (f32x4){0.f, 0.f, 0.f, 0.f}};
#pragma unroll
              for (int ks = 0; ks < 4; ++ks) {
                  const bf16x8 A = *(const bf16x8*)(lds + GL_K + (16 * mj + l15) * KSB + (32 * ks + 8 * g) * 2);
#pragma unroll
                  for (int t2 = 0; t2 < 2; ++t2) { const int ni = 2 * (wave & 1) + t2; const bf16x8 B = *(const bf16x8*)(lds + GL_Q + (16 * ni + l15) * KSB + (32 * ks + 8 * g) * 2); at[t2] = MFMA16(A, B, at[t2]); }
              }
#pragma unroll
              for (int t2 = 0; t2 < 2; ++t2) { const int ni = 2 * (wave & 1) + t2, i = 16 * ni + l15, j0 = 16 * mj + 4 * g;
                  float v[4];
#pragma unroll
                  for (int r = 0; r < 4; ++r) v[r] = (i >= j0 + r) ? at[t2][r] : 0.f;
                  u32x2 w; w.x = cvt_pk(v[0], v[1]); w.y = cvt_pk(v[2], v[3]); *(u32x2*)(lds + GL_AT + i * ASB + j0 * 2) = w; }
            }
            __syncthreads();
        }
#pragma unroll
        for (int hlf = 0; hlf < 2; ++hlf) { float f[8]; unpack8(kreg[hlf], f);
#pragma unroll
            for (int j = 0; j < 8; ++j) f[j] *= __expf(tot[dk0 + hlf * 8 + j] - bl[tk0 * 128 + dk0 + hlf * 8 + j]);
            *(u32x4*)(lds + GL_K + tk0 * KSB + (dk0 + hlf * 8) * 2) = pack8(f); }
        if (!OUT) GLA_REQ(sc * 4 + (cc < 3 ? cc + 1 : 3));
        if (OUT) {
#pragma unroll
            for (int mm = 0; mm < 2; ++mm)
#pragma unroll
                for (int n = 0; n < 4; ++n) acc[mm][n] = (f32x4){0.f, 0.f, 0.f, 0.f};
#if GLA_PROBE == 3
#pragma unroll 1
            for (int pr_ = 0; pr_ < 5; ++pr_) {
            if (pr_ > 0) {
#pragma unroll
                for (int mm = 0; mm < 2; ++mm)
#pragma unroll
                    for (int n = 0; n < 4; ++n) acc[mm][n] *= 1e-30f; }
#endif
#pragma unroll
            for (int ks = 0; ks < 2; ++ks) {
                const int kb = 32 * ks + 8 * g + trow;
                s16x4 vl[2], vh[2]; bf16x8 B[4];
#pragma unroll
                for (int mm = 0; mm < 2; ++mm) { const int a = lbase + GL_V + kb * VSB + (32 * wave + 16 * mm + tcol) * 2; vl[mm] = tr_rd(a); vh[mm] = tr_rd(a + 4 * VSB); }
#pragma unroll
                for (int n = 0; n < 4; ++n) B[n] = *(const bf16x8*)(lds + GL_AT + (16 * n + l15) * ASB + (32 * ks + 8 * g) * 2);
                LGKM0();
#pragma unroll
                for (int mm = 0; mm < 2; ++mm)
#pragma unroll
                    for (int n = 0; n < 4; ++n) acc[mm][n] = MFMA16(PK8(vl[mm], vh[mm]), B[n], acc[mm][n]);
            }
            if (sc > 0 || cc > 0) {
#pragma unroll
                for (int s = 0; s < 4; ++s) {
                    bf16x8 A[2], B[4];
#pragma unroll
                    for (int mm = 0; mm < 2; ++mm) { u32x4 w; w.x = cvt_pk(S[2 * s][mm][0], S[2 * s][mm][1]); w.y = cvt_pk(S[2 * s][mm][2], S[2 * s][mm][3]);
                        w.z = cvt_pk(S[2 * s + 1][mm][0], S[2 * s + 1][mm][1]); w.w = cvt_pk(S[2 * s + 1][mm][2], S[2 * s + 1][mm][3]); A[mm] = __builtin_bit_cast(bf16x8, w); }
#pragma unroll
                    for (int n = 0; n < 4; ++n) { const unsigned char* qr = lds + GL_Q + (16 * n + l15) * KSB + (32 * s + 4 * g) * 2;
                        const u32x2 lo = *(const u32x2*)qr, hi = *(const u32x2*)(qr + 32); u32x4 w; w.x = lo.x; w.y = lo.y; w.z = hi.x; w.w = hi.y; B[n] = __builtin_bit_cast(bf16x8, w); }
#pragma unroll
                    for (int mm = 0; mm < 2; ++mm)
#pragma unroll
                        for (int n = 0; n < 4; ++n) acc[mm][n] = MFMA16(A[mm], B[n], acc[mm][n]);
                    __builtin_amdgcn_sched_barrier(0);
                }
            }
#if GLA_PROBE == 3
            }
#endif
            GLA_REQ(sc * 4 + (cc < 3 ? cc + 1 : 3));
#pragma unroll
            for (int n = 0; n < 4; ++n)
#pragma unroll
                for (int mm = 0; mm < 2; ++mm) ggr[n][mm] = *(const u32x2*)(proj + ix_gg(h, c * 64 + 16 * n + l15) + 32 * wave + 16 * mm + 4 * g);
#pragma unroll
            for (int mm = 0; mm < 2; ++mm) gn[mm] = *(const f32x4*)(p.in[5] + layer * 256 + 32 * wave + 16 * mm + 4 * g);
            float* red = (float*)(lds + GL_RED);
            float ss[4];
#pragma unroll
            for (int n = 0; n < 4; ++n) { float s = 0.f;
#pragma unroll
                for (int mm = 0; mm < 2; ++mm)
#pragma unroll
                    for (int r = 0; r < 4; ++r) s += acc[mm][n][r] * acc[mm][n][r];
                s += __shfl_xor(s, 16); s += __shfl_xor(s, 32); ss[n] = s; }
            if (g == 0) {
#pragma unroll
                for (int n = 0; n < 4; ++n) red[(16 * n + l15) * 8 + wave] = ss[n]; }
        }
        __syncthreads();
        if (OUT) {
#if GLA_PROBE == 4
#pragma unroll 1
            for (int pr_ = 0; pr_ < 5; ++pr_) {
#endif
            const float* red = (const float*)(lds + GL_RED);
            bf16_t* mix = (bf16_t*)(p.ws + WS_MIX);
#pragma unroll
            for (int n = 0; n < 4; ++n) {
                const int tk = 16 * n + l15; const f32x4 r0 = *(const f32x4*)(red + tk * 8), r1 = *(const f32x4*)(red + tk * 8 + 4);
                const float rstd = rsqrtf(((r0[0] + r0[1]) + (r0[2] + r0[3]) + (r1[0] + r1[1]) + (r1[2] + r1[3])) * (1.0f / 256.0f) + 1e-6f);
                const size_t tg = (size_t)c * 64 + tk;
#pragma unroll
                for (int mm = 0; mm < 2; ++mm) { const int dv = 32 * wave + 16 * mm + 4 * g;
                    const u32x2 gg = ggr[n][mm]; const f32x4 nr = gn[mm];
                    const float o0 = acc[mm][n][0] * rstd * nr[0] * silu_f(bflo(gg.x)), o1 = acc[mm][n][1] * rstd * nr[1] * silu_f(bfhi(gg.x));
                    const float o2 = acc[mm][n][2] * rstd * nr[2] * silu_f(bflo(gg.y)), o3 = acc[mm][n][3] * rstd * nr[3] * silu_f(bfhi(gg.y));
#if OUT8
                    *(unsigned*)((unsigned char*)mix + tg * DM + h * 256 + dv) = pk4_fp8(o0 * (float)(1 << MIX8_SH), o1 * (float)(1 << MIX8_SH), o2 * (float)(1 << MIX8_SH), o3 * (float)(1 << MIX8_SH)); }
#else
                    u32x2 w; w.x = cvt_pk(o0, o1); w.y = cvt_pk(o2, o3); *(u32x2*)(mix + tg * DM + h * 256 + dv) = w; }
#endif
            }
#if GLA_PROBE == 4
            }
#endif
        }
        if (!OUT || cc < 3) {
#pragma unroll
            for (int m = 0; m < 8; ++m) { const f32x4 av = *(const f32x4*)(tot + 128 + 16 * m + 4 * g);
#pragma unroll
                for (int nn = 0; nn < 2; ++nn) { S[m][nn][0] *= av[0]; S[m][nn][1] *= av[1]; S[m][nn][2] *= av[2]; S[m][nn][3] *= av[3]; } }
#pragma unroll
            for (int ks = 0; ks < 2; ++ks) {
                const int kb = 32 * ks + 8 * g + trow;
                s16x4 al[4], ah[4], vl[2], vh[2];
#pragma unroll
                for (int nn = 0; nn < 2; ++nn) { const int a = lbase + GL_V + kb * VSB + (32 * wave + 16 * nn + tcol) * 2; vl[nn] = tr_rd(a); vh[nn] = tr_rd(a + 4 * VSB); }
#pragma unroll
                for (int mh = 0; mh < 2; ++mh) {
#pragma unroll
                    for (int m = 0; m < 4; ++m) { const int a = lbase + GL_K + kb * KSB + (16 * (4 * mh + m) + tcol) * 2; al[m] = tr_rd(a); ah[m] = tr_rd(a + 4 * KSB); }
                    LGKM0();
#pragma unroll
                    for (int m = 0; m < 4; ++m)
#pragma unroll
                        for (int nn = 0; nn < 2; ++nn) S[4 * mh + m][nn] = MFMA16(PK8(al[m], ah[m]), PK8(vl[nn], vh[nn]), S[4 * mh + m][nn]);
                    __builtin_amdgcn_sched_barrier(0);
                }
            }
        }
        __syncthreads();
    }
    if (!OUT) {
        bf16_t* E = (bf16_t*)(p.ws + WS_U);
#pragma unroll
        for (int m = 0; m < 8; ++m)
#pragma unroll
            for (int nn = 0; nn < 2; ++nn) { const int dv = 32 * wave + 16 * nn + l15, dk = 16 * m + 4 * g;
                u32x2 w; w.x = cvt_pk(S[m][nn][0], S[m][nn][1]); w.y = cvt_pk(S[m][nn][2], S[m][nn][3]);
                *(u32x2*)(E + (((size_t)sc * 4 + h) * 256 + dv) * 128 + dk) = w; }
        if (tid < 32) *(f32x4*)((float*)(p.ws + WS_GDEC) + ((size_t)sc * 4 + h) * 128 + 4 * tid) = (f32x4){__expf(bsum[0]), __expf(bsum[1]), __expf(bsum[2]), __expf(bsum[3])};
    }
}
#undef GLA_REQ
static __device__ void gla_scan(const Params& p, int bi, int nblk, unsigned char* lds) {
    const unsigned* U32 = (const unsigned*)(p.ws + WS_U); unsigned* S32 = (unsigned*)(p.ws + WS_S); const float* gdec = (const float*)(p.ws + WS_GDEC);
    const int tid = opq_tid();
    float* dl = (float*)lds;
    for (int i0 = bi * 256; i0 < 65536; i0 += nblk * 256) {
        const int idx = i0 + (tid & 255), h = i0 >> 14, dk = (2 * idx) & 127;
        unsigned u[64];
        if (tid < 256) {
#pragma unroll
            for (int i = 0; i < 64; ++i) u[i] = U32[(size_t)i * 65536 + idx]; }
#pragma unroll
        for (int k = 0; k < 4; ++k) { const int e = (tid + 512 * k) * 4, c = e >> 7, d = e & 127; *(f32x4*)(dl + e) = *(const f32x4*)(gdec + ((size_t)c * 4 + h) * 128 + d); }
        __syncthreads();
        if (tid < 256) {
            float s0 = 0.f, s1 = 0.f;
#pragma unroll
            for (int i = 0; i < 64; ++i) { S32[(size_t)i * 65536 + idx] = cvt_pk(s0, s1); const f32x2 a = *(const f32x2*)(dl + i * 128 + dk); s0 = a[0] * s0 + bflo(u[i]); s1 = a[1] * s1 + bfhi(u[i]); } }
        __syncthreads();
    }
}

static __device__ void moba_kmean_unit(const Params& p, int h, int j, unsigned char* lds) {
    const int tid = opq_tid(), d0 = (tid & 15) * 8, kg = tid >> 4;
    const bf16_t* proj = (const bf16_t*)(p.ws + WS_PROJ);
    float acc[8];
#pragma unroll
    for (int i = 0; i < 8; ++i) acc[i] = 0.f;
#pragma unroll
    for (int kk = 0; kk < 8; ++kk) { float f[8]; unpack8(*(const u32x4*)(proj + ix_mk(h, j * 256 + kg * 8 + kk) + d0), f);
#pragma unroll
        for (int i = 0; i < 8; ++i) acc[i] += f[i]; }
    float* red = (float*)lds;
#pragma unroll
    for (int i = 0; i < 8; ++i) red[kg * 128 + d0 + i] = acc[i];
    __syncthreads();
    if (tid < 128) { float s = 0.f;
#pragma unroll 8
        for (int q = 0; q < 32; ++q) s += red[q * 128 + tid];
        ((float*)(p.ws + WS_KMEAN))[((size_t)h * 64 + j) * 128 + tid] = s * (1.0f / 256.0f); }
    __syncthreads();
}

#define TOP3_INS_IF(ok, s, j) do { const float _s = (s); const int _j = (j); const bool _ok = (ok); \
    const bool _c0 = _ok & ((_s > v0) | ((_s == v0) & (_j < i0))), _c1 = _ok & ((_s > v1) | ((_s == v1) & (_j < i1))), _c2 = _ok & ((_s > v2) | ((_s == v2) & (_j < i2))); \
    v2 = _c1 ? v1 : (_c2 ? _s : v2); i2 = _c1 ? i1 : (_c2 ? _j : i2); \
    v1 = _c0 ? v0 : (_c1 ? _s : v1); i1 = _c0 ? i0 : (_c1 ? _j : i1); \
    v0 = _c0 ? _s : v0;              i0 = _c0 ? _j : i0; } while (0)
#define TOP3_INS(s, j) TOP3_INS_IF(true, s, j)

static __device__ void moba_gate_unit(const Params& p, int h, int qb, unsigned char* lds) {
    const int tid = opq_tid(), lane = tid & 63, wave = tid >> 6, g = lane >> 4, l15 = lane & 15;
    const bf16_t* proj = (const bf16_t*)(p.ws + WS_PROJ);
    unsigned* selp = (unsigned*)(p.ws + WS_SEL) + (size_t)h * T + qb * 256;
    if (qb == 0) { if (tid < 256) selp[tid] = 0xFFFFFFFFu; return; }
    constexpr int GSB = 272, GLO = 64 * GSB;
    bf16x8 B[2][4];
#pragma unroll
    for (int t2 = 0; t2 < 2; ++t2)
#pragma unroll
        for (int s2 = 0; s2 < 4; ++s2) B[t2][s2] = *(const bf16x8*)(proj + ix_mq(h, qb * 256 + 32 * wave + 16 * t2 + l15) + 32 * s2 + 8 * g);
    { const int j = tid >> 3, c0 = (tid & 7) * 16;
      {
          const f32x4* src = (const f32x4*)((const float*)(p.ws + WS_KMEAN) + ((size_t)h * 64 + j) * 128 + c0);
          u32x4 hi[2], lo[2];
#pragma unroll
          for (int k = 0; k < 2; ++k) { const f32x4 a = src[2 * k], b = src[2 * k + 1];
              hi[k].x = cvt_pk(a[0], a[1]); hi[k].y = cvt_pk(a[2], a[3]); hi[k].z = cvt_pk(b[0], b[1]); hi[k].w = cvt_pk(b[2], b[3]);
              lo[k].x = cvt_pk(a[0] - bflo(hi[k].x), a[1] - bfhi(hi[k].x)); lo[k].y = cvt_pk(a[2] - bflo(hi[k].y), a[3] - bfhi(hi[k].y));
              lo[k].z = cvt_pk(b[0] - bflo(hi[k].z), b[1] - bfhi(hi[k].z)); lo[k].w = cvt_pk(b[2] - bflo(hi[k].w), b[3] - bfhi(hi[k].w)); }
          *(u32x4*)(lds + j * GSB + c0 * 2) = hi[0]; *(u32x4*)(lds + j * GSB + c0 * 2 + 16) = hi[1];
          *(u32x4*)(lds + GLO + j * GSB + c0 * 2) = lo[0]; *(u32x4*)(lds + GLO + j * GSB + c0 * 2 + 16) = lo[1]; } }
    __syncthreads();
    f32x4 acc[2][4];
#pragma unroll
    for (int t2 = 0; t2 < 2; ++t2)
#pragma unroll
        for (int n = 0; n < 4; ++n) acc[t2][n] = (f32x4){0.f, 0.f, 0.f, 0.f};
#pragma unroll
    for (int n = 0; n < 4; ++n) {
        {
#pragma unroll
            for (int s2 = 0; s2 < 4; ++s2) {
                const bf16x8 Ah = *(const bf16x8*)(lds + (16 * n + l15) * GSB + (32 * s2 + 8 * g) * 2), Al = *(const bf16x8*)(lds + GLO + (16 * n + l15) * GSB + (32 * s2 + 8 * g) * 2);
#pragma unroll
                for (int t2 = 0; t2 < 2; ++t2) { acc[t2][n] = MFMA16(Ah, B[t2][s2], acc[t2][n]); acc[t2][n] = MFMA16(Al, B[t2][s2], acc[t2][n]); }
            }
        }
    }
#pragma unroll
    for (int t2 = 0; t2 < 2; ++t2) {
        float v0 = -3.0e38f, v1 = -3.0e38f, v2 = -3.0e38f; int i0 = 255, i1 = 255, i2 = 255;
#pragma unroll
        for (int n = 0; n < 4; ++n)
#pragma unroll
            for (int r = 0; r < 4; ++r) { const int j = 16 * n + 4 * g + r; TOP3_INS_IF(j < qb, acc[t2][n][r], j); }
#pragma unroll
        for (int o = 16; o <= 32; o <<= 1) {
            const float c0 = __shfl_xor(v0, o), c1 = __shfl_xor(v1, o), c2 = __shfl_xor(v2, o); const int j0 = __shfl_xor(i0, o), j1 = __shfl_xor(i1, o), j2 = __shfl_xor(i2, o);
            TOP3_INS_IF(j0 != 255, c0, j0);
            TOP3_INS_IF(j1 != 255, c1, j1);
            TOP3_INS_IF(j2 != 255, c2, j2);
        }
        if (g == 0) selp[32 * wave + 16 * t2 + l15] = (unsigned)i0 | ((unsigned)i1 << 8) | ((unsigned)i2 << 16) | 0xFF000000u;
    }
    __syncthreads();
}

__device__ __forceinline__ int list_off(int j) { return 256 * (63 * j - (j * (j - 1)) / 2); }

static __device__ void moba_list_unit(const Params& p, int layer, int h, int j, unsigned char* lds) {
    const int tid = opq_tid(), lane = tid & 63, wave = tid >> 6;
    const unsigned* sel = (const unsigned*)(p.ws + WS_SEL) + (size_t)h * T;
    unsigned* list = (unsigned*)(p.ws + WS_LIST) + (size_t)h * LISTH + list_off(j);
    int* wcnt = (int*)lds;
    int total = 0;
    const u32x4 none = {0xFFFFFFFFu, 0xFFFFFFFFu, 0xFFFFFFFFu, 0xFFFFFFFFu};
    const int qs = (j + 1) * 256 + 4 * tid;
    u32x4 wa = none, wb = none, wc = none;
    if (qs < T) wa = *(const u32x4*)(sel + qs);
    if (qs + 4 * NTHR < T) wb = *(const u32x4*)(sel + qs + 4 * NTHR);
    if (qs + 8 * NTHR < T) wc = *(const u32x4*)(sel + qs + 8 * NTHR);
#pragma unroll 1
    for (int q0 = (j + 1) * 256; q0 < T; q0 += 4 * NTHR) {
        const int q = q0 + 4 * tid;
        const u32x4 w4 = wa; wa = wb; wb = wc; wc = none;
        if (q + 12 * NTHR < T) wc = *(const u32x4*)(sel + q + 12 * NTHR);
        int slot[4], cntl = 0;
#pragma unroll
        for (int i = 0; i < 4; ++i) { const unsigned w = w4[i];
            slot[i] = ((w & 0xFF) == (unsigned)j) ? 0 : (((w >> 8) & 0xFF) == (unsigned)j) ? 1 : (((w >> 16) & 0xFF) == (unsigned)j) ? 2 : -1; cntl += slot[i] >= 0; }
        int incl = cntl;
#pragma unroll
        for (int o = 1; o < 64; o <<= 1) { const int t2 = __shfl_up(incl, o); if (lane >= o) incl += t2; }
        if (lane == 63) wcnt[wave] = incl;
        __syncthreads();
        int off = total + incl - cntl, tot = 0;
#pragma unroll
        for (int w2 = 0; w2 < 8; ++w2) { const int cw = wcnt[w2]; off += (w2 < wave) ? cw : 0; tot += cw; }
#pragma unroll
        for (int i = 0; i < 4; ++i) if (slot[i] >= 0) { list[off] = (unsigned)(q + i) | ((unsigned)slot[i] << 16); ++off; }
        total += tot;
        __syncthreads();
    }
    if (tid == 0) {
        unsigned* ctl = (unsigned*)(p.ws + WS_CTL);
        const int nit = total > 0 ? (total + ATT_QMAX - 1) / ATT_QMAX : 1;
        u32x4* items = (u32x4*)(p.ws + WS_ITEMS) + layer * 4096;
        if (nit > 1) { const unsigned bf = atomicAdd(&ctl[CW_NIT + layer * 64 + 1], (unsigned)(nit - 1));
            for (int c = 0; c < nit - 1; ++c) items[bf + c] = (u32x4){(unsigned)h, (unsigned)j, (unsigned)c, (unsigned)total}; }
        const unsigned bb = atomicAdd(&ctl[CW_NIT + layer * 64 + 2], 1u);
        items[4095 - bb] = (u32x4){(unsigned)h, (unsigned)j, (unsigned)(nit - 1), (unsigned)total};
        atomicAdd(&ctl[CW_NIT + layer * 64], (unsigned)nit);
    }
}
namespace att {
constexpr int D = 128, NW = 8, QBLK = 32, KVBLK = 64, LDK = 128;
constexpr float SCALE = 0.088388347648318440f, THR = 8.f;
constexpr float CEXP = SCALE * 1.4426950408889634f;
constexpr size_t SHM_V = KVBLK * D * 2, SHM_K = KVBLK * D * 2;
#define KSWZ(row, colB) ((row) * 256 + ((colB) ^ (((row) & 7) << 4)))
#define SBAR() __builtin_amdgcn_sched_barrier(0)
__device__ __forceinline__ int crow(int r, int hi) { return (r & 3) + 8 * (r >> 2) + 4 * hi; }
__device__ __forceinline__ unsigned cvtpk(float lo, float hi) { return cvt_pk(lo, hi); }

__device__ __forceinline__ void partialSM(f32x16& p0, f32x16& p1, float& m_reg, float& mn, float& alpha) {
  constexpr float C = CEXP;
  float pmax = p0[0];
#pragma unroll
  for (int r = 1; r < 16; ++r) pmax = fmaxf(pmax, p0[r]);
#pragma unroll
  for (int r = 0; r < 16; ++r) pmax = fmaxf(pmax, p1[r]);
  { auto rr = __builtin_amdgcn_permlane32_swap(__float_as_uint(pmax), __float_as_uint(pmax), false, false);
    pmax = fmaxf(__uint_as_float(rr[0]), __uint_as_float(rr[1])); }
  if (__builtin_expect(__all(pmax - m_reg <= THR / SCALE), 1)) { mn = m_reg; alpha = 1.f; }
  else { mn = fmaxf(m_reg, pmax); alpha = __builtin_amdgcn_exp2f((m_reg - mn) * C); m_reg = mn; }
  const float mnC = -mn * C;
#pragma unroll
  for (int r = 0; r < 16; ++r) p0[r] = fmaf(p0[r], C, mnC);
#pragma unroll
  for (int r = 0; r < 16; ++r) p1[r] = fmaf(p1[r], C, mnC);
#pragma unroll
  for (int r = 0; r < 16; ++r) p0[r] = __builtin_amdgcn_exp2f(p0[r]);
}
__device__ __forceinline__ void finishSM(f32x16& p0, f32x16& p1, float alpha, float& l_reg, bf16x8& pa0, bf16x8& pa1, bf16x8& pa2, bf16x8& pa3) {
#pragma unroll
  for (int r = 0; r < 16; ++r) p1[r] = __builtin_amdgcn_exp2f(p1[r]);
  float ps = 0;
#pragma unroll
  for (int r = 0; r < 16; ++r) ps += p0[r];
#pragma unroll
  for (int r = 0; r < 16; ++r) ps += p1[r];
  { auto rr = __builtin_amdgcn_permlane32_swap(__float_as_uint(ps), __float_as_uint(ps), false, false);
    ps = __uint_as_float(rr[0]) + __uint_as_float(rr[1]); }
  l_reg = l_reg * alpha + ps;
#define PK4(P, BASE, OUT) do { unsigned a0 = cvtpk(P[BASE + 0], P[BASE + 1]), a1 = cvtpk(P[BASE + 2], P[BASE + 3]);   \
    unsigned b0 = cvtpk(P[BASE + 4], P[BASE + 5]), b1 = cvtpk(P[BASE + 6], P[BASE + 7]);                              \
    auto r0 = __builtin_amdgcn_permlane32_swap(a0, b0, false, false); auto r1 = __builtin_amdgcn_permlane32_swap(a1, b1, false, false); \
    u32x4 w = {r0[0], r1[0], r0[1], r1[1]}; OUT = *reinterpret_cast<bf16x8*>(&w); } while (0)
  PK4(p0, 0, pa0); PK4(p0, 8, pa1); PK4(p1, 0, pa2); PK4(p1, 8, pa3);
#undef PK4
}
__device__ __forceinline__ void qkt(f32x16& p0, f32x16& p1, const char* Ks, const bf16x8* qr, int r32, int hi) {
  p0 = f32x16{}; p1 = f32x16{};
#pragma unroll
  for (int d0 = 0; d0 < 8; ++d0) { const int cb = (d0 * 16 + hi * 8) * 2;
    const bf16x8 b0 = *reinterpret_cast<const bf16x8*>(Ks + KSWZ(r32, cb));
    const bf16x8 b1 = *reinterpret_cast<const bf16x8*>(Ks + KSWZ(32 + r32, cb));
    p0 = __builtin_amdgcn_mfma_f32_32x32x16_bf16(b0, qr[d0], p0, 0, 0, 0);
    p1 = __builtin_amdgcn_mfma_f32_32x32x16_bf16(b1, qr[d0], p1, 0, 0, 0); }
}
__device__ __forceinline__ void mask_tile(f32x16& p0, f32x16& p1, int tile, int qrow, int hi) {
#pragma unroll
  for (int r = 0; r < 16; ++r) { const int key = tile * 64 + crow(r, hi); if (key > qrow) p0[r] = -1.0e30f; if (key + 32 > qrow) p1[r] = -1.0e30f; }
}
__device__ __forceinline__ int v_st(int k, int c) { const int kk = (k & ~0xC) | ((k & 4) << 1) | ((k & 8) >> 1); return ((kk >> 3) * 4 + (c >> 5)) * 512 + ((kk & 7) * 32 + (c & 31)) * 2; }
__device__ __forceinline__ int v_rd_base(int lane) { return ((lane & 3) << 3) | (((lane >> 2) & 3) << 6) | (((lane >> 4) & 1) << 5) | (((lane >> 5) & 1) << 8); }
constexpr int v_rd_off(int d0, int ks, int half) { return d0 * 512 + ks * 4096 + half * 2048; }
template <int OFF> __device__ __forceinline__ s16x4 tr_read(int vb) {
  s16x4 r; asm volatile("ds_read_b64_tr_b16 %0, %1 offset:%2" : "=&v"(r) : "v"(vb), "i"(OFF) : "memory"); return r;
}
template <int D0> __device__ __forceinline__ void pv_one(f32x16& od, int vb, bf16x8 pa0, bf16x8 pa1, bf16x8 pa2, bf16x8 pa3) {
  const s16x4 l0 = tr_read<v_rd_off(D0, 0, 0)>(vb), h0 = tr_read<v_rd_off(D0, 0, 1)>(vb), l1 = tr_read<v_rd_off(D0, 1, 0)>(vb), h1 = tr_read<v_rd_off(D0, 1, 1)>(vb);
  const s16x4 l2 = tr_read<v_rd_off(D0, 2, 0)>(vb), h2 = tr_read<v_rd_off(D0, 2, 1)>(vb), l3 = tr_read<v_rd_off(D0, 3, 0)>(vb), h3 = tr_read<v_rd_off(D0, 3, 1)>(vb);
  asm volatile("s_waitcnt lgkmcnt(0)" ::: "memory"); SBAR();
  od = __builtin_amdgcn_mfma_f32_32x32x16_bf16(pa0, PK8(l0, h0), od, 0, 0, 0);
  od = __builtin_amdgcn_mfma_f32_32x32x16_bf16(pa1, PK8(l1, h1), od, 0, 0, 0);
  od = __builtin_amdgcn_mfma_f32_32x32x16_bf16(pa2, PK8(l2, h2), od, 0, 0, 0);
  od = __builtin_amdgcn_mfma_f32_32x32x16_bf16(pa3, PK8(l3, h3), od, 0, 0, 0);
}
__device__ __forceinline__ void pv_d0(f32x16* o, int vb, bf16x8 pa0, bf16x8 pa1, bf16x8 pa2, bf16x8 pa3) {
  pv_one<0>(o[0], vb, pa0, pa1, pa2, pa3); pv_one<1>(o[1], vb, pa0, pa1, pa2, pa3); pv_one<2>(o[2], vb, pa0, pa1, pa2, pa3); pv_one<3>(o[3], vb, pa0, pa1, pa2, pa3);
}

__device__ __forceinline__ void moba_item(const bf16_t* __restrict__ proj, int h, int jblk, const unsigned* list, int nvalid, bf16_t* PO, float* PML, char* lds) {
  const int tid = opq_tid(), wid = tid >> 6, lane = tid & 63, r32 = lane & 31, hi = lane >> 5;
  const bool own = (list == nullptr);
  char* V_lds = lds; char* K_lds = lds + 2 * SHM_V;
  float* ws = (float*)(lds + 2 * SHM_V + 2 * SHM_K) + wid * 64; float* al_l = ws + 32;
  float m_reg = -1e30f, l_reg = 0; f32x16 o[4] = {}; bf16x8 qr[8];
  const int myrow = wid * QBLK + r32;
  int q, slot; bool valid;
  if (own) { q = jblk * 256 + myrow; slot = 3; valid = true; }
  else { const int rr = myrow < nvalid ? myrow : nvalid - 1; const unsigned e = list[rr]; q = (int)(e & 0xFFFFu); slot = (int)(e >> 16); valid = myrow < nvalid; }
  const bf16_t* Qw = proj + ix_mq(h, q) + hi * 8;
#pragma unroll
  for (int d0 = 0; d0 < 8; ++d0) qr[d0] = *reinterpret_cast<const bf16x8*>(Qw + d0 * 16);
  const bf16_t* Kh = proj + ix_mk(h, jblk * 256);
  const bf16_t* Vh = proj + ix_mv(h, jblk * 256);
  const int sr = tid >> 4, sc = (tid & 15) * 8, vst0 = v_st(sr, sc), vst1 = v_st(32 + sr, sc);
  const int vb0 = (int)(uintptr_t)V_lds + v_rd_base(lane);
  struct { bf16x8 vs0, vs1, ks0, ks1; } sr_[2];
#define SLOAD(i, k0) do { sr_[i].vs0 = *(const bf16x8*)(&Vh[(size_t)((k0) + sr) * LDK + sc]); sr_[i].vs1 = *(const bf16x8*)(&Vh[(size_t)((k0) + 32 + sr) * LDK + sc]); \
    sr_[i].ks0 = *(const bf16x8*)(&Kh[(size_t)((k0) + sr) * LDK + sc]); sr_[i].ks1 = *(const bf16x8*)(&Kh[(size_t)((k0) + 32 + sr) * LDK + sc]); } while (0)
#define SWRITE(b, i) do { *(bf16x8*)(V_lds + (b) * SHM_V + vst0) = sr_[i].vs0;          \
    *(bf16x8*)(V_lds + (b) * SHM_V + vst1) = sr_[i].vs1; const int kc = sc * 2;               \
    *(bf16x8*)(K_lds + (b) * SHM_K + KSWZ(sr, kc)) = sr_[i].ks0;                       \
    *(bf16x8*)(K_lds + (b) * SHM_K + KSWZ(32 + sr, kc)) = sr_[i].ks1; } while (0)
#define SWAIT() asm volatile("s_waitcnt vmcnt(4)" ::: "memory")
#define RESC(a) do { if (__any((a) < 1.f)) { if (hi == 0) al_l[r32] = (a); asm volatile("s_waitcnt lgkmcnt(0)" ::: "memory"); \
    _Pragma("unroll") for (int d = 0; d < 4; ++d) _Pragma("unroll") for (int r = 0; r < 16; ++r) o[d][r] *= al_l[crow(r, hi)]; } } while (0)
  f32x16 pA0, pA1, pB0, pB1; float mnA, mnB, alA, alB; bf16x8 pa0, pa1, pa2, pa3;
  constexpr int NT = 4, SE = 0, SO = 1;
  SLOAD(SE, 0); asm volatile("s_waitcnt vmcnt(0)" ::: "memory"); SWRITE(0, SE); __syncthreads();
  qkt(pA0, pA1, K_lds, qr, r32, hi); if (own) mask_tile(pA0, pA1, 0, myrow, hi); partialSM(pA0, pA1, m_reg, mnA, alA);
  SLOAD(SO, KVBLK); SLOAD(SE, 2 * KVBLK);
  SWAIT(); SWRITE(1, SO); __syncthreads();
  {
    SBAR(); qkt(pB0, pB1, K_lds + SHM_K, qr, r32, hi); if (own) mask_tile(pB0, pB1, 1, myrow, hi);
    finishSM(pA0, pA1, alA, l_reg, pa0, pa1, pa2, pa3); SBAR();
    SLOAD(SO, 3 * KVBLK); SBAR();
    pv_d0(o, vb0, pa0, pa1, pa2, pa3); partialSM(pB0, pB1, m_reg, mnB, alB);
    __syncthreads(); SWAIT(); SWRITE(0, SE);
    RESC(alB); __syncthreads();
    SBAR(); qkt(pA0, pA1, K_lds, qr, r32, hi); if (own) mask_tile(pA0, pA1, 2, myrow, hi);
    finishSM(pB0, pB1, alB, l_reg, pa0, pa1, pa2, pa3); SBAR();
    pv_d0(o, vb0 + (int)SHM_V, pa0, pa1, pa2, pa3); partialSM(pA0, pA1, m_reg, mnA, alA);
    __syncthreads(); asm volatile("s_waitcnt vmcnt(0)" ::: "memory"); SWRITE(1, SO);
    RESC(alA); __syncthreads();
  }
  SBAR(); qkt(pB0, pB1, K_lds + SHM_K, qr, r32, hi); if (own) mask_tile(pB0, pB1, 3, myrow, hi);
  finishSM(pA0, pA1, alA, l_reg, pa0, pa1, pa2, pa3); SBAR();
  pv_d0(o, vb0, pa0, pa1, pa2, pa3); partialSM(pB0, pB1, m_reg, mnB, alB);
  __syncthreads(); RESC(alB);
  finishSM(pB0, pB1, alB, l_reg, pa0, pa1, pa2, pa3); SBAR();
  pv_d0(o, vb0 + (int)SHM_V, pa0, pa1, pa2, pa3);
  __syncthreads();
  unsigned short* st = (unsigned short*)(lds + wid * 8192);
#pragma unroll
  for (int d0 = 0; d0 < 4; ++d0)
#pragma unroll
    for (int r = 0; r < 16; ++r) st[crow(r, hi) * 128 + 32 * d0 + r32] = (unsigned short)(cvtpk(o[d0][r], o[d0][r]) & 0xFFFFu);
  const int porow = valid ? ((q * 8 + h) * 4 + slot) : -1;
  if (hi == 0 && valid) { PML[(size_t)porow * 2] = m_reg * CEXP; PML[(size_t)porow * 2 + 1] = l_reg; }
  asm volatile("s_waitcnt lgkmcnt(0)" ::: "memory");
#pragma unroll
  for (int it = 0; it < 8; ++it) {
    const int row = it * 4 + (lane >> 4), ch = lane & 15;
    const int pr = __shfl(porow, row);
    const u32x4 vv = *(const u32x4*)(st + row * 128 + ch * 8);
    if (pr >= 0) *(u32x4*)(PO + (size_t)pr * 128 + ch * 8) = vv;
  }
  __syncthreads();
#undef SLOAD
#undef SWRITE
#undef SWAIT
#undef RESC
}

#ifndef ATT_PROBE
#define ATT_PROBE 0
#endif
constexpr int ATT2_QMAX = 768;
__device__ __forceinline__ void moba_item2(const bf16_t* __restrict__ proj, int h, int jblk, const unsigned* list, int nrows, int nown, bf16_t* PO, float* PML, char* lds,
                                           const unsigned* items, int nit, int nfront, unsigned nxt, unsigned (&dsc)[4], bool ldr) {
  const int tid = opq_tid(), wid = tid >> 6, lane = tid & 63, r32 = lane & 31, hi = lane >> 5;
  char* V_lds = lds; char* K_lds = lds + 65536;
  float* al_l = (float*)(lds + LDS_SCR + 4096) + wid * 32;
  unsigned short* st = (unsigned short*)(lds + LDS_SCR + 4096 + 1024 + wid * 2048);
  const int vb0 = (int)(uintptr_t)V_lds + v_rd_base(lane);
  const int no = nown >> 5, ngroups = no + ((nrows + 31) >> 5);
#define ENTRY(gg) (((gg) < no) ? (unsigned)(jblk * 256 + (gg) * 32 + r32) | (3u << 16) : list[(((gg) - no) * 32 + r32) < nrows ? (((gg) - no) * 32 + r32) : nrows - 1])
  unsigned e_cur = 0u, e_nxt = 0u; bf16x8 qrn[8];
  if (wid < ngroups) { e_cur = ENTRY(wid); if (wid + NW < ngroups) e_nxt = ENTRY(wid + NW); }
#if ATT_PROBE == 1
#pragma unroll 1
  for (int pr_ = 0; pr_ < 3; ++pr_)
#endif
  { const bf16_t* Kh = proj + ix_mk(h, jblk * 256); const bf16_t* Vh = proj + ix_mv(h, jblk * 256);
    const int sc = (tid & 15) * 8;
    bf16x8 kv[8], vv[8];
#pragma unroll
    for (int it = 0; it < 8; ++it) { const int key = it * 32 + (tid >> 4); kv[it] = *(const bf16x8*)(Kh + (size_t)key * 128 + sc); vv[it] = *(const bf16x8*)(Vh + (size_t)key * 128 + sc); }
    if (wid < ngroups) {
      const bf16_t* Qw = proj + ix_mq(h, (int)(e_cur & 0xFFFFu)) + hi * 8;
#pragma unroll
      for (int d0 = 0; d0 < 8; ++d0) qrn[d0] = *reinterpret_cast<const bf16x8*>(Qw + d0 * 16); }
    if (ldr && (int)nxt < nit) { const unsigned sl = (int)nxt < nfront ? nxt : 4095u - (nxt - (unsigned)nfront);
      dsc[0] = ldu(items + sl * 4); dsc[1] = ldu(items + sl * 4 + 1); dsc[2] = ldu(items + sl * 4 + 2); dsc[3] = ldu(items + sl * 4 + 3); }
#pragma unroll
    for (int it = 0; it < 8; ++it) { const int key = it * 32 + (tid >> 4), tl = key >> 6, kr = key & 63;
      *(bf16x8*)(K_lds + tl * 16384 + KSWZ(kr, sc * 2)) = kv[it]; *(bf16x8*)(V_lds + tl * 16384 + v_st(kr, sc)) = vv[it]; }
#if ATT_PROBE == 1
    __syncthreads();
#endif
  }
  __syncthreads();
  for (int g = wid; g < ngroups; g += NW) {
    const bool own = g < no;
    const int myrow = (own ? g : g - no) * 32 + r32;
    const int q = (int)(e_cur & 0xFFFFu), slot = (int)(e_cur >> 16); const bool valid = own || myrow < nrows;
    bf16x8 qr[8];
#pragma unroll
    for (int d0 = 0; d0 < 8; ++d0) qr[d0] = qrn[d0];
    e_cur = e_nxt;
    if (g + NW < ngroups) {
      const bf16_t* Qw = proj + ix_mq(h, (int)(e_cur & 0xFFFFu)) + hi * 8;
#pragma unroll
      for (int d0 = 0; d0 < 8; ++d0) qrn[d0] = *reinterpret_cast<const bf16x8*>(Qw + d0 * 16);
      if (g + 2 * NW < ngroups) e_nxt = ENTRY(g + 2 * NW); }
    float m_reg = -1e30f, l_reg = 0.f; f32x16 o[4] = {};
    const int ntile = own ? ((g * 32 + 31) >> 6) + 1 : 4;
#if ATT_PROBE == 2
#pragma unroll 1
    for (int pr_ = 0; pr_ < 2; ++pr_) {
    if (pr_ == 1) { m_reg = -1e30f; l_reg = 0.f; o[0] = f32x16{}; o[1] = f32x16{}; o[2] = f32x16{}; o[3] = f32x16{}; }
#endif
    for (int tl = 0; tl < ntile; ++tl) {
      f32x16 p0, p1; float mn, alpha; bf16x8 pa0, pa1, pa2, pa3;
      qkt(p0, p1, K_lds + tl * 16384, qr, r32, hi);
      if (own) mask_tile(p0, p1, tl, myrow, hi);
      partialSM(p0, p1, m_reg, mn, alpha);
      if (__any(alpha < 1.f)) { if (hi == 0) al_l[r32] = alpha; asm volatile("s_waitcnt lgkmcnt(0)" ::: "memory");
#pragma unroll
        for (int d = 0; d < 4; ++d)
#pragma unroll
          for (int r = 0; r < 16; ++r) o[d][r] *= al_l[crow(r, hi)]; }
      finishSM(p0, p1, alpha, l_reg, pa0, pa1, pa2, pa3); SBAR();
      pv_d0(o, vb0 + tl * 16384, pa0, pa1, pa2, pa3);
    }
#if ATT_PROBE == 2
    }
#endif
    const int porow = valid ? ((q * 8 + h) * 4 + slot) : -1;
    if (hi == 0 && valid) { PML[(size_t)porow * 2] = m_reg * CEXP; PML[(size_t)porow * 2 + 1] = l_reg; }
    const int pr = __shfl(porow, lane >> 1);
#if PO8
    if (hi == 0) al_l[r32] = __builtin_amdgcn_rcpf(l_reg) * (float)(1 << PO8_SH);
    asm volatile("s_waitcnt lgkmcnt(0)" ::: "memory");
    float rl_[16];
#pragma unroll
    for (int r = 0; r < 16; ++r) rl_[r] = al_l[crow(r, hi)];
    unsigned char* st8 = (unsigned char*)st;
#pragma unroll
    for (int d0 = 0; d0 < 4; ++d0) {
#pragma unroll
      for (int r = 0; r < 16; r += 2) { const unsigned w = (unsigned)__builtin_amdgcn_cvt_pk_fp8_f32(o[d0][r] * rl_[r], o[d0][r + 1] * rl_[r + 1], 0, false);
        st8[crow(r, hi) * 32 + r32] = (unsigned char)w; st8[crow(r + 1, hi) * 32 + r32] = (unsigned char)(w >> 8); }
      asm volatile("s_waitcnt lgkmcnt(0)" ::: "memory");
      const u32x4 a = *(const u32x4*)(st8 + (lane >> 1) * 32 + (lane & 1) * 16);
      if (pr >= 0) *(u32x4*)((unsigned char*)PO + (size_t)pr * 128 + 32 * d0 + (lane & 1) * 16) = a;
      asm volatile("s_waitcnt lgkmcnt(0)" ::: "memory");
    }
#else
#pragma unroll
    for (int d0 = 0; d0 < 4; ++d0) {
#pragma unroll
      for (int r = 0; r < 16; ++r) st[crow(r, hi) * 32 + r32] = (unsigned short)(cvtpk(o[d0][r], o[d0][r]) & 0xFFFFu);
      asm volatile("s_waitcnt lgkmcnt(0)" ::: "memory");
      const u32x4 a = *(const u32x4*)(st + (lane >> 1) * 32 + (lane & 1) * 16), b = *(const u32x4*)(st + (lane >> 1) * 32 + (lane & 1) * 16 + 8);
      if (pr >= 0) { *(u32x4*)(PO + (size_t)pr * 128 + 32 * d0 + (lane & 1) * 16) = a; *(u32x4*)(PO + (size_t)pr * 128 + 32 * d0 + (lane & 1) * 16 + 8) = b; }
      asm volatile("s_waitcnt lgkmcnt(0)" ::: "memory");
    }
#endif
  }
  __syncthreads();
#undef ENTRY
}
#undef KSWZ
#undef SBAR
}

static __device__ void moba_combine(const Params& p) {
    const bf16_t* PO = (const bf16_t*)(p.ws + WS_PO); const float* PML = (const float*)(p.ws + WS_PML); bf16_t* mix = (bf16_t*)(p.ws + WS_MIX);
    const int stride = (int)gridDim.x * NTHR;
    for (int base = blockIdx.x * NTHR + opq_tid(); base < T * 8 * 16; base += 4 * stride) {
        u32x4 po[4][4]; f32x2 ml[4][4];
#pragma unroll
        for (int u = 0; u < 4; ++u) { const int idx = base + u * stride, ch = idx & 15, qh = idx >> 4, qb = qh >> 11, nv = qb < 3 ? qb : 3;
#pragma unroll
            for (int k = 0; k < 4; ++k) { const bool ok = (k == 3) || (k < nv);
                ml[u][k] = (f32x2){-3.0e38f, 0.f}; po[u][k] = (u32x4){0u, 0u, 0u, 0u};
#if PO8
                if (ok) { ml[u][k] = *(const f32x2*)(PML + ((size_t)qh * 4 + k) * 2); const u32x2 t8 = *(const u32x2*)((const unsigned char*)PO + ((size_t)qh * 4 + k) * 128 + ch * 8); po[u][k].x = t8.x; po[u][k].y = t8.y; } } }
#else
                if (ok) { ml[u][k] = *(const f32x2*)(PML + ((size_t)qh * 4 + k) * 2); po[u][k] = *(const u32x4*)(PO + ((size_t)qh * 4 + k) * 128 + ch * 8); } } }
#endif
#pragma unroll
        for (int u = 0; u < 4; ++u) { const int idx = base + u * stride, ch = idx & 15, qh = idx >> 4, q = qh >> 3, h = qh & 7;
            float M = -3.0e38f;
#pragma unroll
            for (int k = 0; k < 4; ++k) M = fmaxf(M, ml[u][k][0]);
            float o[8], L = 0.f;
#pragma unroll
            for (int i = 0; i < 8; ++i) o[i] = 0.f;
#pragma unroll
#if PO8
            for (int k = 0; k < 4; ++k) { const float wl = __builtin_amdgcn_exp2f(ml[u][k][0] - M) * ml[u][k][1]; L += wl; const float w = wl * (1.0f / (float)(1 << PO8_SH)); float f[8];
                const f32x2 f01 = __builtin_amdgcn_cvt_pk_f32_fp8((int)po[u][k].x, false), f23 = __builtin_amdgcn_cvt_pk_f32_fp8((int)po[u][k].x, true), f45 = __builtin_amdgcn_cvt_pk_f32_fp8((int)po[u][k].y, false), f67 = __builtin_amdgcn_cvt_pk_f32_fp8((int)po[u][k].y, true);
                f[0] = f01[0]; f[1] = f01[1]; f[2] = f23[0]; f[3] = f23[1]; f[4] = f45[0]; f[5] = f45[1]; f[6] = f67[0]; f[7] = f67[1];
#pragma unroll
                for (int i = 0; i < 8; ++i) o[i] += w * f[i]; }
#else
            for (int k = 0; k < 4; ++k) { const float w = __builtin_amdgcn_exp2f(ml[u][k][0] - M); L += w * ml[u][k][1]; float f[8]; unpack8(po[u][k], f);
#pragma unroll
                for (int i = 0; i < 8; ++i) o[i] += w * f[i]; }
#endif
            const float rl = 1.0f / L;
#pragma unroll
            for (int i = 0; i < 8; ++i) o[i] *= rl;
#if OUT8
            { u32x2 w8; w8.x = pk4_fp8(o[0] * (float)(1 << MIX8_SH), o[1] * (float)(1 << MIX8_SH), o[2] * (float)(1 << MIX8_SH), o[3] * (float)(1 << MIX8_SH));
              w8.y = pk4_fp8(o[4] * (float)(1 << MIX8_SH), o[5] * (float)(1 << MIX8_SH), o[6] * (float)(1 << MIX8_SH), o[7] * (float)(1 << MIX8_SH));
              *(u32x2*)((unsigned char*)mix + (size_t)q * DM + 1024 + h * 128 + ch * 8) = w8; } }
#else
            *(u32x4*)(mix + (size_t)q * DM + 1024 + h * 128 + ch * 8) = pack8(o); }
#endif
    }
}
#ifndef DBL_MASK
#define DBL_MASK 0
#endif
#define REP(k) for (int rep_ = 0; rep_ < (((DBL_MASK >> (k)) & 1) ? 2 : 1); ++rep_)
#ifndef NCV
#define NCV 0
#endif
#ifndef PROBE_MASK
#define PROBE_MASK 0
#endif
#ifndef PHMASK
#define PHMASK 0xFFFF
#endif
enum { PH_CVT = 0, PH_INPROJ, PH_MIXA, PH_MIXB, PH_MIXC, PH_ATT, PH_COMB, PH_OUTPROJ, PH_LN1, PH_PERM, PH_MOE1, PH_MOE2, PH_LN2, NPH };
constexpr int NSLOT = 2 * NPH;
#ifndef MK_DEBUG
#define MK_DEBUG 0
#endif
#if MK_DEBUG
#include "part_chk.inc"
#endif

__device__ __forceinline__ Params opq_params(const Params& p) {
#if !defined(__HIP_DEVICE_COMPILE__)
    return p;
#else
    const __attribute__((address_space(4))) Params* kp = (const __attribute__((address_space(4))) Params*)__builtin_amdgcn_kernarg_segment_ptr();
    asm volatile("" : "+s"(kp));
    return *kp;
#endif
}
#ifndef SUBREP_MASK
#define SUBREP_MASK 0
#endif
#define SUBREP(k) (((SUBREP_MASK >> (k)) & 1) ? 2 : 1)
#ifndef CVT_REPS
#define CVT_REPS 1
#endif
__global__ void __launch_bounds__(NTHR, 2) mk_fwd(Params p) {
    extern __shared__ __attribute__((aligned(16))) unsigned char lds[];
    const int tid = threadIdx.x;
    for (int u = tid; u < (LDS_BYTES - LDS_SCR) / 4; u += NTHR) ((unsigned*)(lds + LDS_SCR))[u] = 0u;
    __syncthreads();
    unsigned* ctl = (unsigned*)(p.ws + WS_CTL);
    XcdBarrier bar; bar.bar = ctl + CW_BAR; bar.x = 0; bar.st = (volatile LAS unsigned*)(lds + LDS_SCR + 32);
    constexpr int STEP = 2;
    if (p.g_hi - p.g_lo > STEP) bar = xcd_barrier_post(ctl + CW_BAR, (volatile LAS unsigned*)(lds + LDS_SCR + 32));
    if (p.g_hi - p.g_lo > STEP) xcd_barrier_census(bar);
    const int G = (int)gridDim.x, bx = (int)blockIdx.x;
    PG8_LAS unsigned char* lds3 = (PG8_LAS unsigned char*)lds;

#if PROBE_MASK
    unsigned long long tacc = 0ull, tprev = __builtin_amdgcn_s_memrealtime();
#endif
    for (int layer = -1; layer < NLAYER; ++layer) {
        const int s0 = (layer + 1) * NSLOT;
#define IN(k) (((PHMASK >> (k)) & 1) && (layer >= 0 || (k) <= PH_INPROJ) && p.g_lo <= s0 + 2 * (k) && s0 + 2 * (k) < p.g_hi)
#if PROBE_MASK
#define SEAM(k) do { xcd_barrier(bar); if (bx == 0 && tid == 0) { const unsigned long long now = __builtin_amdgcn_s_memrealtime(); if ((PROBE_MASK >> (k)) & 1) tacc += now - tprev; tprev = now; } } while (0)
#else
#ifndef BAR2
#define BAR2 0
#endif
#define SEAM(k) do { if (s0 + 2 * (k) + STEP < p.g_hi) { xcd_barrier(bar); if ((BAR2 >> (k)) & 1) xcd_barrier(bar); } } while (0)
#endif
        if (IN(PH_CVT)) { if (layer < 0) { const Params q = opq_params(p); phase_rope(q); phase_rows<0>(q, 0, lds); } }
        if (IN(PH_INPROJ)) REP(PH_INPROJ) { const Params q = opq_params(p);
#pragma unroll 1
            for (int stp = 0; stp < 2; ++stp) {
                const bool cv = (layer < 0) ? (stp == 0) : (((bx & 1) != 0) == (stp == 0));
                if (cv) { if (rep_ == 0) {
_Pragma("unroll 1")
                    for (int r2_ = 0; r2_ < CVT_REPS; ++r2_) phase_cvt<false, 7>(q, layer < 0 ? 0 : layer, layer < 0 ? 0 : 256, layer < 0 ? 256 : 1024, bx, G, lds); } }
                else if (layer >= 0) {
                    pg8::Gemm g{(const bf16_t*)(q.ws + WS_HBQ), (const bf16_t*)(q.ws + ((layer & 1) ? WS_WIN2 : WS_WIN)), T, NPROJ, DM / 2, 127 - WIN8_SH, 127 - X8_SH}; pg8::StaticOrder S; S.init(T, NPROJ, G, bx);
                    pg8::EpiProj E{(bf16_t*)(q.ws + WS_PROJ), (const float*)(q.ws + WS_ROPE), (const float*)(q.ws + WS_ROPE) + (size_t)T * 64};
                    pg8::gemm_phase<pg8::EpiProj, pg8::StaticOrder, true, true, true>(lds3, g, S, E);
                }
            }
            SEAM(PH_INPROJ); }
        if (IN(PH_MIXA)) REP(PH_MIXA) { const Params q = opq_params(p);
            for (int u = bx; u < 768; u += G) { if (u < 256) { _Pragma("unroll 1") for (int r_ = 0; r_ < SUBREP(0); ++r_) gla_super_unit<false>(q, layer, u >> 2, u & 3, lds); } else { _Pragma("unroll 1") for (int r_ = 0; r_ < SUBREP(1); ++r_) moba_kmean_unit(q, (u - 256) >> 6, (u - 256) & 63, lds); } }
            SEAM(PH_MIXA); }
        if (IN(PH_MIXB)) REP(PH_MIXB) { const Params q = opq_params(p);
            { _Pragma("unroll 1") for (int r_ = 0; r_ < SUBREP(2); ++r_) gla_scan(q, bx, G, lds); }
            { int kk = 0; for (int u = bx; u < 512; u += G, ++kk) { const int q0 = u & 63; _Pragma("unroll 1") for (int r_ = 0; r_ < SUBREP(3); ++r_) moba_gate_unit(q, u >> 6, (kk & 1) ? 63 - q0 : q0, lds); } }
            SEAM(PH_MIXB); }
        if (IN(PH_MIXC)) REP(PH_MIXC) { const Params q = opq_params(p);
            for (int u = bx; u < 768; u += G) { if (u < 256) { _Pragma("unroll 1") for (int r_ = 0; r_ < SUBREP(4); ++r_) gla_super_unit<true>(q, layer, u >> 2, u & 3, lds); } else if (rep_ == 0) { const int v = u - 256, j0 = v & 63; moba_list_unit(q, layer, v >> 6, ((v / G) & 1) ? 63 - j0 : j0, lds); } }
            SEAM(PH_MIXC); }
        if (IN(PH_ATT)) REP(PH_ATT) { const Params q = opq_params(p);
            const int nit = __builtin_amdgcn_readfirstlane((int)ldu(ctl + CW_NIT + layer * 64));
            const int nfront = __builtin_amdgcn_readfirstlane((int)ldu(ctl + CW_NIT + layer * 64 + 1));
            const unsigned* items = (const unsigned*)(q.ws + WS_ITEMS) + layer * 4096 * 4;
            unsigned* qhead = ctl + CW_NIT + layer * 64 + 16 + rep_;
            volatile LAS unsigned* qslot = (volatile LAS unsigned*)(lds + LDS_SCR + 64);
            const int qt = opq_tid();
            if (qt == 0) { const unsigned f = atomicAdd(qhead, 1u); qslot[0] = f;
                if ((int)f < nit) { const unsigned sl = (int)f < nfront ? f : 4095u - (f - (unsigned)nfront); qslot[1] = ldu(items + sl * 4); qslot[2] = ldu(items + sl * 4 + 1); qslot[3] = ldu(items + sl * 4 + 2); qslot[4] = ldu(items + sl * 4 + 3); } }
            __syncthreads();
            int it = __builtin_amdgcn_readfirstlane((int)qslot[0]);
            while (it < nit) {
                const int h = __builtin_amdgcn_readfirstlane((int)qslot[1]), j = __builtin_amdgcn_readfirstlane((int)qslot[2]), c = __builtin_amdgcn_readfirstlane((int)qslot[3]), n = __builtin_amdgcn_readfirstlane((int)qslot[4]);
                unsigned nxt = 0u, dsc[4] = {0u, 0u, 0u, 0u};
                if (qt == 0) nxt = atomicAdd(qhead, 1u);
                const unsigned* list = (const unsigned*)(q.ws + WS_LIST) + (size_t)h * LISTH + list_off(j) + c * ATT_QMAX;
                const int rem = n - c * ATT_QMAX, nrows = rem < 0 ? 0 : (rem < ATT_QMAX ? rem : ATT_QMAX);
                __syncthreads();
                att::moba_item2((bf16_t*)(q.ws + WS_PROJ), h, j, list, nrows, c == 0 ? 256 : 0, (bf16_t*)(q.ws + WS_PO), (float*)(q.ws + WS_PML), (char*)lds, items, nit, nfront, nxt, dsc, qt == 0);
                if (qt == 0) { qslot[0] = nxt; qslot[1] = dsc[0]; qslot[2] = dsc[1]; qslot[3] = dsc[2]; qslot[4] = dsc[3]; }
                __syncthreads();
                it = __builtin_amdgcn_readfirstlane((int)qslot[0]);
            }
            SEAM(PH_ATT); }
        if (IN(PH_COMB)) REP(PH_COMB) { const Params q = opq_params(p); moba_combine(q); SEAM(PH_COMB); }
        if (IN(PH_OUTPROJ)) REP(PH_OUTPROJ) { const Params q = opq_params(p);
#if OUT8
            pg8::Gemm g{(const bf16_t*)(q.ws + WS_MIX), (const bf16_t*)(q.ws + WS_WO), T, DM, DM / 2, 127 - WO8_SH, 127 - MIX8_SH}; pg8::StaticOrder S; S.init(T, DM, G, bx);
#else
            pg8::Gemm g{(const bf16_t*)(q.ws + WS_MIX), (const bf16_t*)(q.ws + WS_WO), T, DM, DM}; pg8::StaticOrder S; S.init(T, DM, G, bx);
#endif
            pg8::EpiOut E{layer == 0 ? q.in[0] : nullptr, (const bf16_t*)(q.ws + WS_HB), (bf16_t*)(q.ws + WS_PRE), DN_ALPHA};
            pg8::gemm_phase<pg8::EpiOut, pg8::StaticOrder, true, true, OUT8 != 0>(lds3, g, S, E);
            SEAM(PH_OUTPROJ); }
#ifndef LNPROBE
#define LNPROBE 0
#endif
        if (IN(PH_LN1)) { const Params q = opq_params(p); if (LNPROBE & 1) { phase_rows<1, true>(q, layer, lds); SEAM(PH_LN1); } phase_rows<1>(q, layer, lds); SEAM(PH_LN1); }
        if (IN(PH_MOE1)) REP(PH_MOE1) { const Params q = opq_params(p);
            int* sbm = (int*)(lds + LDS_SCR + 128);
            moe_bases(ctl + CW_CNT + layer * 64, sbm);
            const int np = __builtin_amdgcn_readfirstlane(sbm[16]) >> 8;
            pg8::Gemm g{(const bf16_t*)(q.ws + WS_HB8), (const bf16_t*)(q.ws + WS_WGU), np * 256, 2048, DM / 2, 127 - WGU8_SH, 127 - X8_SH}; pg8::MoeOrder S; S.init(np * 256, 2048, G, bx); S.sb = sbm; S.idx = (const unsigned*)(q.ws + WS_IDX); S.rowbytes = DM;
            pg8::EpiGU E{q.ws + WS_HS};
            pg8::gemm_phase<pg8::EpiGU, pg8::MoeOrder, true, true, true, true>(lds3, g, S, E);
            if (rep_ == 0) phase_cvt<true, 8>(q, layer, 1280, 512, 0, 1, lds, ctl + CW_CVQ + layer * 64);
            SEAM(PH_MOE1); }
        if (IN(PH_MOE2)) REP(PH_MOE2) { const Params q = opq_params(p);
            int* sbm = (int*)(lds + LDS_SCR + 128);
            moe_bases(ctl + CW_CNT + layer * 64, sbm);
            const int np = __builtin_amdgcn_readfirstlane(sbm[16]) >> 8;
            pg8::Gemm g{(const bf16_t*)(q.ws + WS_HS), (const bf16_t*)(q.ws + WS_WD), np * 256, 2048, DEXP / 2, 127 - WD8_SH, 127 - H8_SH}; pg8::MoeOrder S; S.init(np * 256, 2048, G, bx); S.sb = sbm; S.idx = (const unsigned*)(q.ws + WS_IDX); S.rowbytes = DEXP;
            pg8::EpiY E{(bf16_t*)(q.ws + WS_YS)};
            pg8::gemm_phase<pg8::EpiY, pg8::MoeOrder, true, true, true>(lds3, g, S, E);
            if (rep_ == 0 && layer + 1 < NLAYER) phase_cvt<true, 3>(q, layer + 1, 0, 256, 0, 1, lds, ctl + CW_CVQ + layer * 64 + 16);
            SEAM(PH_MOE2); }
        if (IN(PH_LN2)) { const Params q = opq_params(p); if (LNPROBE & 2) { phase_rows<2, true>(q, layer, lds); xcd_barrier(bar); } phase_rows<2>(q, layer, lds); SEAM(PH_LN2); }
#undef IN
#undef SEAM
    }
#if PROBE_MASK
    if (bx == 0 && tid == 0) __hip_atomic_store(ctl + CW_DBG, (unsigned)tacc, __ATOMIC_RELAXED, __HIP_MEMORY_SCOPE_AGENT);
    xcd_barrier(bar);
    { const float sc = 1.0f + (float)ldu(ctl + CW_DBG) * (1.0f / 40000.0f);
      for (size_t i = (size_t)bx * NTHR + tid; i < (size_t)T * DM / 4; i += (size_t)G * NTHR) { f32x4 v = ((f32x4*)p.out)[i]; ((f32x4*)p.out)[i] = v * sc; } }
#endif
}

#if MK_DEBUG
__global__ void __launch_bounds__(NTHR, 2) mk_chk(Params p, int layer, int k) { if (k >= 0) chk_phase(p, layer, k); else chk_final(p); }
#endif
#ifndef MK_ONE_LAUNCH
#define MK_ONE_LAUNCH 1
#endif
extern "C" void kernel_launch(void* const* d_in, const int* in_sizes, int n_in, void* d_out, int out_size, void* d_ws, size_t ws_size, hipStream_t stream) {
    static int grid = 0;
    if (grid == 0) {
        if (n_in != 16 || in_sizes[0] != T * DM || out_size != T * DM || ws_size < WS_END) {
            fprintf(stderr, "kernel_launch: unexpected problem: n_in %d in0 %d out %d ws %zu (need >= %zu); nothing launched\n", n_in, n_in > 0 ? in_sizes[0] : -1, out_size, ws_size, (size_t)WS_END); grid = -1; return; }
        int dev = 0, cus = 0, per_cu = 0;
        if (hipGetDevice(&dev) != hipSuccess || hipDeviceGetAttribute(&cus, hipDeviceAttributeMultiprocessorCount, dev) != hipSuccess) { grid = -1; return; }
        if (hipFuncSetAttribute((const void*)mk_fwd, hipFuncAttributeMaxDynamicSharedMemorySize, LDS_BYTES) != hipSuccess) { fprintf(stderr, "kernel_launch: hipFuncSetAttribute failed\n"); grid = -1; return; }
        if (hipOccupancyMaxActiveBlocksPerMultiprocessor(&per_cu, (const void*)mk_fwd, NTHR, LDS_BYTES) != hipSuccess || per_cu < 1)
            fprintf(stderr, "kernel_launch: note: occupancy query reports %d blocks per CU\n", per_cu);
        (void)hipGetLastError();
        grid = cus;
        if (grid != 256) fprintf(stderr, "kernel_launch: note: %d CUs (row phases assume the grid divides 2048 row groups)\n", grid);
        if (2048 % grid != 0) grid = 256;
    }
    if (grid < 0) return;
    if (hipMemsetAsync((char*)d_ws + WS_CTL, 0, CTL_BYTES, stream) != hipSuccess) return;
    Params p{};
    for (int i = 0; i < 16; ++i) p.in[i] = (const float*)d_in[i];
    p.out = (float*)d_out; p.ws = (unsigned char*)d_ws;
#if MK_ONE_LAUNCH
    p.g_lo = 0; p.g_hi = (NLAYER + 1) * NSLOT;
    hipLaunchKernelGGL(mk_fwd, dim3(grid), dim3(NTHR), LDS_BYTES, stream, p);
#else
    for (int s = 0; s < (NLAYER + 1) * NSLOT; s += 2) { p.g_lo = s; p.g_hi = s + 1; hipLaunchKernelGGL(mk_fwd, dim3(grid), dim3(NTHR), LDS_BYTES, stream, p);
#if MK_DEBUG
        if (s >= NSLOT) hipLaunchKernelGGL(mk_chk, dim3(8), dim3(NTHR), 0, stream, p, s / NSLOT - 1, (s % NSLOT) / 2);
#endif
    }
#if MK_DEBUG
    hipLaunchKernelGGL(mk_chk, dim3(grid), dim3(NTHR), 0, stream, p, 0, -1);
#endif
#endif
    const hipError_t le = hipPeekAtLastError();
    if (le != hipSuccess) fprintf(stderr, "kernel_launch: launch failed: %s\n", hipGetErrorName(le));
}
```

```cpp
#define MK_DEBUG 0
#define MK_ONE_LAUNCH 1
#define RECOMP 0
#include <hip/hip_runtime.h>
#include <cstdio>
#include <cstdint>
__device__ __forceinline__ int opq_tid() { int t = (int)threadIdx.x; asm volatile("" : "+v"(t)); return t; }
#ifndef EPI_PROBE
#define EPI_PROBE 0
#endif
namespace pg8 {
#define PG8_LAS __attribute__((address_space(3)))
typedef unsigned short bf16_t;
typedef short bf16x8 __attribute__((ext_vector_type(8)));
typedef float f32x4 __attribute__((ext_vector_type(4)));
typedef unsigned u32x4 __attribute__((ext_vector_type(4)));
constexpr int BM = 256, BK = 64, HALF = 128, HTB = HALF * BK * 2  , STAGE_BYTES = 8 * HTB, NXCD = 8, WGM = 8;

__host__ __device__ __forceinline__ int lds_byte(int r, int c) { const int st = (r >> 4) * 2 + (c >> 5), rr = r & 15, cc = c & 31, ob = rr * 64 + cc * 2; return st * 1024 + (ob ^ (((ob >> 9) & 1) << 5)); }
__host__ __device__ __forceinline__ void stage_rc(int b, int& R, int& C) { const int st = b / 1024, sb = b % 1024, swz = sb ^ (((sb >> 9) & 1) << 5); R = (st >> 1) * 16 + swz / 64; C = (st & 1) * 32 + (swz % 64) / 2; }
__host__ __device__ __forceinline__ int perm32(int rho) { const int n = rho >> 4, i = rho & 15; return 8 * (i >> 2) + 4 * n + (i & 3); }

struct Unit { int pm, pn; };
struct Gemm { const bf16_t* A; const bf16_t* Bt; int M, N, K; int sa, sb; };

struct StaticOrder {
    int nM, nN, nwg, G, c;
    __host__ __device__ void init(int M, int N, int G_, int c_) { nM = M / BM; nN = N / BM; nwg = nM * nN; G = G_; c = c_; }
    __host__ __device__ bool next(int i, Unit& u) const {
        const long L = (long)i * G + c; if (L >= nwg) return false;
        int wgid = (int)L; { const int q = nwg / NXCD, r = nwg % NXCD, xcd = wgid % NXCD, off = wgid / NXCD; wgid = (xcd < r ? xcd * (q + 1) : r * (q + 1) + (xcd - r) * q) + off; }
        const int nig = WGM * nN, gid = wgid / nig, fm = gid * WGM, gsz = (nM - fm) < WGM ? (nM - fm) : WGM;
        u.pm = fm + ((wgid % nig) % gsz); u.pn = (wgid % nig) / gsz; return true;
    }
    __device__ __forceinline__ void a_ready(const Unit&) const {}
    __device__ __forceinline__ void done(const Unit&) const {}
    __device__ __forceinline__ unsigned arow(const Unit&, int) const { return 0u; }
};
__device__ __forceinline__ unsigned cvt_pk_bf16(float lo, float hi) { unsigned r; asm volatile("v_cvt_pk_bf16_f32 %0, %1, %2" : "=v"(r) : "v"(lo), "v"(hi)); return r; }

typedef int v8i32 __attribute__((ext_vector_type(8)));
typedef int v4i32 __attribute__((ext_vector_type(4)));
__device__ __forceinline__ v8i32 cat8(bf16x8 lo, bf16x8 hi) { const v4i32 a = __builtin_bit_cast(v4i32, lo), b = __builtin_bit_cast(v4i32, hi); return __builtin_shufflevector(a, b, 0, 1, 2, 3, 4, 5, 6, 7); }
template <class Epi, class Sched, bool ALIGN_EPI = false, bool SP2 = false, bool FP8 = false, bool GATHER = false>
__device__ __forceinline__ void gemm_phase(PG8_LAS unsigned char* lds, const Gemm g, const Sched& S, const Epi& E) {
    const int tid = opq_tid(), wid = __builtin_amdgcn_readfirstlane(tid >> 6), lane = tid & 63, wr = wid >> 2, wc = wid & 3, fr = lane & 15, fq = lane >> 4;
    int Kq = g.K; asm volatile("" : "+s"(Kq));
    const int K = Kq, nt = K / BK;
    unsigned voffA[2], voffB[2];
#pragma unroll
    for (int i = 0; i < 2; ++i) { int R, C; stage_rc(tid * 16 + i * 8192, R, C); const int Rb = Epi::PERM ? ((R & ~31) + perm32(R & 31)) : R;
        voffA[i] = (unsigned)(R * K + C) * 2u; voffB[i] = (unsigned)(Rb * K + C) * 2u; }
    unsigned va[2][2] = {{0u, 0u}, {0u, 0u}};
    PG8_LAS unsigned* vnl = (PG8_LAS unsigned*)(lds + STAGE_BYTES + 8192) + tid * 4;
#define PG8_GCALC(v, u) do { _Pragma("unroll") for (int _h = 0; _h < 2; ++_h) _Pragma("unroll") for (int _i = 0; _i < 2; ++_i) { int _R, _C; stage_rc(tid * 16 + _i * 8192, _R, _C); (v)[_h][_i] = S.arow((u), _h * HALF + _R) + (unsigned)_C * 2u; } } while (0)
#define PG8_STAGE_A(bufoff, gbase, h, v) do { if constexpr (GATHER) { _Pragma("unroll") for (int _i = 0; _i < 2; ++_i) \
        __builtin_amdgcn_global_load_lds((const unsigned*)((const char*)(gbase) + (v)[h][_i]), (PG8_LAS unsigned*)(lds + (bufoff) + ldsw + _i * 8192), 16, 0, 0); } \
        else { PG8_STAGE(bufoff, (gbase) + (h) * hstep, voffA); } } while (0)
    const size_t kstep = (size_t)(BK * 2);
    const size_t hstep = (size_t)HALF * K * 2;
    const size_t tstep = 2 * hstep;
    const unsigned ldsw = (unsigned)wid * 1024u;
    const int aoff = lds_byte(wr * 64 + fr, fq * 8), boff = lds_byte(wc * 32 + fr, fq * 8);
#define PG8_SA(b, h) (((b) * 2 + (h)) * HTB)
#define PG8_SB(b, h) ((4 + (b) * 2 + (h)) * HTB)
#define PG8_STAGE(bufoff, gbase, voff) do { _Pragma("unroll") for (int _i = 0; _i < 2; ++_i) \
        __builtin_amdgcn_global_load_lds((const unsigned*)((const char*)(gbase) + (voff)[_i]), (PG8_LAS unsigned*)(lds + (bufoff) + ldsw + _i * 8192), 16, 0, 0); } while (0)
#define PG8_LDA(dst, b, h) do { _Pragma("unroll") for (int m = 0; m < 4; ++m) _Pragma("unroll") for (int k = 0; k < 2; ++k) dst[m][k] = *(const PG8_LAS bf16x8*)(lds + PG8_SA(b, h) + aoff + m * 2048 + k * 1024); } while (0)
#define PG8_LDB(dst, b, h) do { _Pragma("unroll") for (int n = 0; n < 2; ++n) _Pragma("unroll") for (int k = 0; k < 2; ++k) dst[n][k] = *(const PG8_LAS bf16x8*)(lds + PG8_SB(b, h) + boff + n * 2048 + k * 1024); } while (0)
#define PG8_MMA(ai, bj, At, Bt) do { __builtin_amdgcn_s_setprio(1); _Pragma("unroll") for (int m = 0; m < 4; ++m) _Pragma("unroll") for (int n = 0; n < 2; ++n) { \
        if constexpr (FP8) { const v8i32 wq = cat8(Bt[n][0], Bt[n][1]), aq = cat8(At[m][0], At[m][1]); \
            asm volatile("s_nop 1\n\tv_mfma_scale_f32_16x16x128_f8f6f4 %0, %1, %2, %0, %3, %4 op_sel_hi:[0,0,0]" : "+v"(acc[ai][bj][m][n]) : "v"(wq), "v"(aq), "v"(g.sa), "v"(g.sb)); } \
        else { _Pragma("unroll") for (int k = 0; k < 2; ++k) acc[ai][bj][m][n] = __builtin_amdgcn_mfma_f32_16x16x32_bf16(Bt[n][k], At[m][k], acc[ai][bj][m][n], 0, 0, 0); } } \
        __builtin_amdgcn_s_setprio(0); } while (0)
#define PG8_WAIT_V(n) asm volatile("s_waitcnt vmcnt(" #n ")" ::: "memory")
#define PG8_WAIT_L(n) asm volatile("s_waitcnt lgkmcnt(" #n ")" ::: "memory")
#define PG8_BAR __builtin_amdgcn_s_barrier()
#define PG8_SCHED __builtin_amdgcn_sched_barrier(0)
    Unit cur, nxt; int ui = 0;
    if (!S.next(0, cur)) return;
    f32x4 acc[2][2][4][2];
#pragma unroll
    for (int a = 0; a < 2; ++a)
#pragma unroll
        for (int b = 0; b < 2; ++b)
#pragma unroll
            for (int m = 0; m < 4; ++m)
#pragma unroll
                for (int n = 0; n < 2; ++n) acc[a][b][m][n] = (f32x4){0.f, 0.f, 0.f, 0.f};
    bf16x8 At[4][2], B0[2][2], B1[2][2];
    const char* cA = (const char*)g.A + (GATHER ? (size_t)0 : (size_t)cur.pm * tstep); const char* cB = (const char*)g.Bt + (size_t)cur.pn * tstep;
    if constexpr (GATHER) PG8_GCALC(va, cur);
    S.a_ready(cur);
    if constexpr (SP2) {
        PG8_STAGE(PG8_SB(0, 0), cB, voffB); PG8_STAGE(PG8_SB(0, 1), cB + hstep, voffB); PG8_STAGE_A(PG8_SA(0, 0), cA, 0, va); PG8_STAGE_A(PG8_SA(0, 1), cA, 1, va);
        if (wr == 1) PG8_BAR;
        PG8_WAIT_V(2); PG8_BAR;
        PG8_STAGE(PG8_SB(1, 0), cB + kstep, voffB); PG8_STAGE_A(PG8_SA(1, 0), cA + kstep, 0, va); PG8_STAGE(PG8_SB(1, 1), cB + hstep + kstep, voffB);
        PG8_WAIT_V(6); PG8_BAR;
    } else {
        PG8_STAGE(PG8_SB(0, 0), cB, voffB); PG8_STAGE(PG8_SA(0, 0), cA, voffA); PG8_STAGE(PG8_SB(0, 1), cB + hstep, voffB); PG8_STAGE(PG8_SA(0, 1), cA + hstep, voffA);
        if (wr == 1) PG8_BAR;
        PG8_WAIT_V(4); PG8_BAR;
        PG8_STAGE(PG8_SB(1, 0), cB + kstep, voffB); PG8_STAGE(PG8_SA(1, 0), cA + kstep, voffA); PG8_STAGE(PG8_SB(1, 1), cB + hstep + kstep, voffB);
        PG8_WAIT_V(6); PG8_BAR;
    }
    for (;;) {
        const bool has_next = S.next(ui + 1, nxt);
        const char* nA = (has_next && !GATHER) ? (const char*)g.A + (size_t)nxt.pm * tstep : cA; const char* nB = has_next ? (const char*)g.Bt + (size_t)nxt.pn * tstep : cB;
        if constexpr (GATHER) { unsigned vn[2][2]; if (has_next) PG8_GCALC(vn, nxt); else { _Pragma("unroll") for (int _h = 0; _h < 2; ++_h) _Pragma("unroll") for (int _i = 0; _i < 2; ++_i) vn[_h][_i] = va[_h][_i]; }
            vnl[0] = vn[0][0]; vnl[1] = vn[0][1]; vnl[2] = vn[1][0]; vnl[3] = vn[1][1]; }
        for (int t = 0; t < nt; t += 2) {
            const bool last = (t == nt - 2);
            const char* a1 = cA + (size_t)(t + 1) * kstep;
            const char* a2 = last ? nA : cA + (size_t)(t + 2) * kstep; const char* b2 = last ? nB : cB + (size_t)(t + 2) * kstep;
            const char* a3 = a2 + kstep; const char* b3 = b2 + kstep;
            if (last && has_next) S.a_ready(nxt);
            unsigned v2[2][2];
            if constexpr (GATHER) { _Pragma("unroll") for (int _h = 0; _h < 2; ++_h) _Pragma("unroll") for (int _i = 0; _i < 2; ++_i) v2[_h][_i] = va[_h][_i];
                if (last) { v2[0][0] = vnl[0]; v2[0][1] = vnl[1]; v2[1][0] = vnl[2]; v2[1][1] = vnl[3]; } }
            if constexpr (SP2) {
            PG8_LDB(B0, 0, 0); PG8_LDB(B1, 0, 1); PG8_SCHED; PG8_LDA(At, 0, 0); PG8_STAGE_A(PG8_SA(1, 1), a1, 1, va);
            PG8_WAIT_V(8); PG8_WAIT_L(0); PG8_BAR; PG8_MMA(0, 0, At, B0); PG8_MMA(0, 1, At, B1); PG8_BAR; PG8_SCHED;
            PG8_LDA(At, 0, 1); PG8_STAGE(PG8_SB(0, 0), b2, voffB); PG8_STAGE(PG8_SB(0, 1), b2 + hstep, voffB); PG8_STAGE_A(PG8_SA(0, 0), a2, 0, v2);
            PG8_WAIT_V(8); PG8_WAIT_L(0); PG8_BAR; PG8_MMA(1, 0, At, B0); PG8_MMA(1, 1, At, B1); PG8_BAR; PG8_SCHED;
            PG8_LDB(B0, 1, 0); PG8_LDB(B1, 1, 1); PG8_SCHED; PG8_LDA(At, 1, 0); PG8_STAGE_A(PG8_SA(0, 1), a2, 1, v2);
            PG8_WAIT_V(8); PG8_WAIT_L(0); PG8_BAR; PG8_MMA(0, 0, At, B0); PG8_MMA(0, 1, At, B1); PG8_BAR; PG8_SCHED;
            PG8_LDA(At, 1, 1); PG8_STAGE(PG8_SB(1, 0), b3, voffB); PG8_STAGE(PG8_SB(1, 1), b3 + hstep, voffB); PG8_STAGE_A(PG8_SA(1, 0), a3, 0, v2);
            PG8_WAIT_V(8); PG8_WAIT_L(0); PG8_BAR; PG8_MMA(1, 0, At, B0); PG8_MMA(1, 1, At, B1); PG8_BAR; PG8_SCHED;
            } else {
            PG8_LDB(B0, 0, 0); PG8_SCHED; PG8_LDA(At, 0, 0); PG8_STAGE(PG8_SA(1, 1), a1 + hstep, voffA);
            PG8_WAIT_L(8); PG8_BAR; PG8_WAIT_L(0); PG8_MMA(0, 0, At, B0); PG8_BAR; PG8_SCHED;
            PG8_LDB(B1, 0, 1); PG8_STAGE(PG8_SB(0, 0), b2, voffB);
            PG8_BAR; PG8_WAIT_L(0); PG8_MMA(0, 1, At, B1); PG8_BAR;
            PG8_LDA(At, 0, 1); PG8_STAGE(PG8_SA(0, 0), a2, voffA);
            PG8_BAR; PG8_WAIT_L(0); PG8_MMA(1, 0, At, B0); PG8_BAR; PG8_SCHED;
            PG8_STAGE(PG8_SB(0, 1), b2 + hstep, voffB);
            PG8_WAIT_V(6); PG8_BAR; PG8_MMA(1, 1, At, B1); PG8_BAR;
            PG8_LDB(B0, 1, 0); PG8_SCHED; PG8_LDA(At, 1, 0); PG8_STAGE(PG8_SA(0, 1), a2 + hstep, voffA);
            PG8_WAIT_L(8); PG8_BAR; PG8_WAIT_L(0); PG8_MMA(0, 0, At, B0); PG8_BAR; PG8_SCHED;
            PG8_LDB(B1, 1, 1); PG8_STAGE(PG8_SB(1, 0), b3, voffB);
            PG8_BAR; PG8_WAIT_L(0); PG8_MMA(0, 1, At, B1); PG8_BAR;
            PG8_LDA(At, 1, 1); PG8_STAGE(PG8_SA(1, 0), a3, voffA);
            PG8_BAR; PG8_WAIT_L(0); PG8_MMA(1, 0, At, B0); PG8_BAR; PG8_SCHED;
            PG8_STAGE(PG8_SB(1, 1), b3 + hstep, voffB);
            PG8_WAIT_V(6); PG8_BAR; PG8_MMA(1, 1, At, B1); PG8_BAR;
            }
        }
        if constexpr (FP8) { asm volatile("s_nop 15\n\ts_nop 15" ::: "memory"); }
        if constexpr (ALIGN_EPI) { if (wr == 0) PG8_BAR; }
        if constexpr (!Epi::AFTER_DRAIN) { E(acc, cur, wr, wc, fr, fq);
#if EPI_PROBE
            _Pragma("unroll 1") for (int pr_ = 0; pr_ < 2; ++pr_) { asm volatile("" ::: "memory"); E(acc, cur, wr, wc, fr, fq); }
#endif
            S.done(cur); }
        if (!has_next) break;
#pragma unroll
        for (int a = 0; a < 2; ++a)
#pragma unroll
            for (int b = 0; b < 2; ++b)
#pragma unroll
                for (int m = 0; m < 4; ++m)
#pragma unroll
                    for (int n = 0; n < 2; ++n) acc[a][b][m][n] = (f32x4){0.f, 0.f, 0.f, 0.f};
        cur = nxt; cA = nA; cB = nB; ++ui;
        if constexpr (GATHER) { va[0][0] = vnl[0]; va[0][1] = vnl[1]; va[1][0] = vnl[2]; va[1][1] = vnl[3]; }
        if constexpr (ALIGN_EPI) { if (wr == 1) PG8_BAR; }
    }
    PG8_WAIT_V(0);
    if constexpr (!ALIGN_EPI) { if (wr == 0) PG8_BAR; }
    PG8_BAR;
    if constexpr (Epi::AFTER_DRAIN) { E.fused(acc, cur, wr, wc, fr, fq, lds, wid, lane); S.done(cur); }
#undef PG8_SA
#undef PG8_SB
#undef PG8_STAGE
#undef PG8_STAGE_A
#undef PG8_GCALC
#undef PG8_LDA
#undef PG8_LDB
#undef PG8_MMA
#undef PG8_WAIT_V
#undef PG8_WAIT_L
#undef PG8_BAR
#undef PG8_SCHED
}
}
#define LAS __attribute__((address_space(3)))
#define XB_TMO      128
#define XB_XCNT(j)  (256  + 64 * (j))
#define XB_XSUB(j)  (1280 + 64 * (j))
#define XB_XGEN(j)  (2304 + 64 * (j))
#define XB_TOP      3328
#define XB_TOPGEN   3392
#define XCD_BAR_WORDS 3456
#define XB_SPIN_CAP (1u << 18)

__device__ __forceinline__ unsigned xb_ld(unsigned* p)              { return __hip_atomic_load(p, __ATOMIC_RELAXED, __HIP_MEMORY_SCOPE_AGENT); }
__device__ __forceinline__ unsigned xb_add(unsigned* p, unsigned v) { return __hip_atomic_fetch_add(p, v, __ATOMIC_RELAXED, __HIP_MEMORY_SCOPE_AGENT); }
__device__ __forceinline__ unsigned xb_xcc_id() { return (unsigned)__builtin_amdgcn_s_getreg((3 << 11) | 20) & 0xFu; }
#define XB_SPIN(cond, bar) do { unsigned _sp = 0; while (cond) { __builtin_amdgcn_s_sleep(1); \
    if ((++_sp & 255u) == 0u) { if (xb_ld(&(bar)[XB_TMO])) break; if (_sp > XB_SPIN_CAP) { atomicAdd(&(bar)[XB_TMO], 1u); break; } } } } while (0)

struct XcdBarrier {
    unsigned* bar; unsigned x;
    volatile LAS unsigned* st;
};

__device__ __forceinline__ XcdBarrier xcd_barrier_post(unsigned* bar, volatile LAS unsigned* st) {
    XcdBarrier b; b.bar = bar; b.x = xb_xcc_id(); b.st = st;
    if (threadIdx.x == 0) (void)xb_add(&bar[XB_XCNT(b.x)], 1u);
    return b;
}
__device__ __forceinline__ void xcd_barrier_complete(unsigned* bar, unsigned x, unsigned& nloc, unsigned& nx) {
    const unsigned G = gridDim.x * gridDim.y * gridDim.z;
    unsigned sum, cnt, mine, sp = 0u;
    for (;;) {
        sum = 0u; cnt = 0u; mine = 0u;
#pragma unroll 1
        for (unsigned j = 0; j < 16; ++j) { const unsigned c = xb_ld(&bar[XB_XCNT(j)]); sum += c; cnt += (c > 0u) ? 1u : 0u; mine = (j == x) ? c : mine; }
        if (sum == G) break;
        __builtin_amdgcn_s_sleep(1);
        if ((++sp & 255u) == 0u) { if (xb_ld(&bar[XB_TMO])) break; if (sp > XB_SPIN_CAP) { atomicAdd(&bar[XB_TMO], 1u); break; } }
    }
    nloc = mine > 0u ? mine : 1u; nx = cnt > 0u ? cnt : 1u;
}

__device__ __forceinline__ void xcd_barrier_census(const XcdBarrier& b) {
    if (threadIdx.x == 0) { unsigned nloc, nx; xcd_barrier_complete(b.bar, b.x, nloc, nx); b.st[0] = nloc; b.st[1] = nx; }
    __syncthreads();
}
__device__ __forceinline__ void xcd_barrier(const XcdBarrier& b) {
    asm volatile("s_waitcnt vmcnt(0)" ::: "memory");
    __syncthreads();
    if (threadIdx.x == 0) {
        unsigned* bar = b.bar;
        __builtin_amdgcn_s_waitcnt(0);
        unsigned nloc = b.st[0], nx = b.st[1];
        const unsigned old = xb_add(&bar[XB_XSUB(b.x)], 1u);
        const unsigned gen = old / nloc;
        if (old + 1u == (gen + 1u) * nloc) {
            __builtin_amdgcn_fence(__ATOMIC_RELEASE, "agent");
            asm volatile("s_waitcnt vmcnt(0)" ::: "memory");
            const unsigned og = xb_add(&bar[XB_TOP], 1u);
            const unsigned tg = og / nx;
            if (og + 1u == (tg + 1u) * nx) xb_add(&bar[XB_TOPGEN], 1u);
            else XB_SPIN(xb_ld(&bar[XB_TOPGEN]) == tg, bar);
            __builtin_amdgcn_fence(__ATOMIC_ACQUIRE, "agent");
            xb_add(&bar[XB_XGEN(b.x)], 1u);
            asm volatile("s_waitcnt vmcnt(0)" ::: "memory");
        } else {
            XB_SPIN(xb_ld(&bar[XB_XGEN(b.x)]) == gen, bar);
            __builtin_amdgcn_fence(__ATOMIC_ACQUIRE, "agent");
            asm volatile("s_waitcnt vmcnt(0)" ::: "memory");
        }
    }
    __syncthreads();
}

#define GAS __attribute__((address_space(1)))
typedef unsigned short bf16_t;
typedef short bf16x8 __attribute__((ext_vector_type(8)));
typedef short s16x4 __attribute__((ext_vector_type(4)));
typedef float f32x4 __attribute__((ext_vector_type(4)));
typedef float f32x2 __attribute__((ext_vector_type(2)));
typedef float f32x16 __attribute__((ext_vector_type(16)));
typedef unsigned u32x4 __attribute__((ext_vector_type(4)));
typedef unsigned u32x2 __attribute__((ext_vector_type(2)));

constexpr int T = 16384, DM = 2048, DIN = 6160, NPROJ = 6144, NLAYER = 2, NE = 16, DEXP = 1024;
constexpr int PQ = 0, PK = 512, PV = 1024, PG = 2048, PMQ = 3072, PMK = 4096, PMV = 5120;
__host__ __device__ __forceinline__ size_t ix_gq(int h, int t) { return ((size_t)(0 + h) * T + t) * 128; }
__host__ __device__ __forceinline__ size_t ix_gk(int h, int t) { return ((size_t)(4 + h) * T + t) * 128; }
__host__ __device__ __forceinline__ size_t ix_gv(int h, int t) { return (size_t)(8 + 2 * h) * T * 128 + (size_t)t * 256; }
__host__ __device__ __forceinline__ size_t ix_gg(int h, int t) { return (size_t)(16 + 2 * h) * T * 128 + (size_t)t * 256; }
__host__ __device__ __forceinline__ size_t ix_mq(int h, int t) { return ((size_t)(24 + h) * T + t) * 128; }
__host__ __device__ __forceinline__ size_t ix_mk(int h, int t) { return ((size_t)(32 + h) * T + t) * 128; }
__host__ __device__ __forceinline__ size_t ix_mv(int h, int t) { return ((size_t)(40 + h) * T + t) * 128; }
constexpr float DN_ALPHA = 1.4142135623730951f;
constexpr int MAXROWS = 36864;
constexpr int LISTH = 516096;
constexpr int NTHR = 512;

constexpr size_t MiB = 1u << 20;
constexpr size_t WS_CTL = 0, CTL_BYTES = 1 * MiB;
constexpr size_t WS_MISC = 1 * MiB;
constexpr size_t WS_ITEMS = 1 * MiB + 65536;
constexpr size_t WS_TOK = 2 * MiB, WS_SEL = 3 * MiB, WS_KMEAN = 4 * MiB, WS_GDEC = 5 * MiB, WS_GLOW = 6 * MiB, WS_PML = 8 * MiB;
constexpr size_t WS_HBQ = 228 * MiB;
constexpr int WIN8_SH = 5;
constexpr size_t WS_IDX = 7 * MiB;
constexpr size_t WS_HB8 = 456 * MiB;
constexpr size_t WS_ROPE = 12 * MiB, WS_LIST = 20 * MiB;
constexpr size_t WS_WIN = 36 * MiB, WS_WO = 60 * MiB, WS_WGU = 68 * MiB, WS_WIN2 = 132 * MiB, WS_WD = 196 * MiB;
constexpr size_t WS_HB = 260 * MiB, WS_MIX = 324 * MiB;
constexpr size_t WS_PROJ = 388 * MiB, WS_U = 580 * MiB, WS_S = 644 * MiB, WS_PO = 708 * MiB;
constexpr size_t WS_BDEC = 708 * MiB;
constexpr size_t WS_PRE = 388 * MiB;
constexpr size_t WS_XS = 388 * MiB, WS_HS = 532 * MiB, WS_YS = 604 * MiB;
constexpr size_t WS_END = 836 * MiB;
constexpr int CW_BAR = 4096, CW_CNT = 8192, CW_NIT = 8448, CW_DBG = 8704, CW_CVQ = 9216;
constexpr int LDS_SCR = 131072, LDS_BYTES = 155648;

struct Params { const float* in[16]; float* out; unsigned char* ws; int g_lo, g_hi; };

__device__ __forceinline__ unsigned cvt_pk(float lo, float hi) { return pg8::cvt_pk_bf16(lo, hi); }
__device__ __forceinline__ float bflo(unsigned u) { return __uint_as_float(u << 16); }
__device__ __forceinline__ float bfhi(unsigned u) { return __uint_as_float(u & 0xffff0000u); }
__device__ __forceinline__ float bf2f(bf16_t u) { return __uint_as_float(((unsigned)u) << 16); }
__device__ __forceinline__ unsigned ldu(const unsigned* p) { return __hip_atomic_load(p, __ATOMIC_RELAXED, __HIP_MEMORY_SCOPE_AGENT); }
__device__ __forceinline__ float ldf(const float* p) { return __uint_as_float(__hip_atomic_load((const unsigned*)p, __ATOMIC_RELAXED, __HIP_MEMORY_SCOPE_AGENT)); }
#ifndef OUT8
#define OUT8 1
#endif
constexpr int MIX8_SH = 3, WO8_SH = 5;
#ifndef YS8
#define YS8 1
#endif
constexpr int Y8_SH = 4;
#ifndef RECOMP
#define RECOMP 1
#endif
#ifndef PO8
#define PO8 1
#endif
constexpr int PO8_SH = 4;
constexpr int X8_SH = 2, H8_SH = 2, WGU8_SH = 5, WD8_SH = 6;
__device__ __forceinline__ unsigned pk4_fp8(float a, float b, float c, float d) { int t = __builtin_amdgcn_cvt_pk_fp8_f32(a, b, 0, false); t = __builtin_amdgcn_cvt_pk_fp8_f32(c, d, t, true); return (unsigned)t; }
__device__ __forceinline__ float fp8_dec(unsigned b) { const unsigned s = b >> 7, e = (b >> 3) & 15u, m = b & 7u; const float v = e ? (1.0f + 0.125f * (float)m) * __builtin_ldexpf(1.0f, (int)e - 7) : 0.125f * (float)m * 0.015625f; return s ? -v : v; }
__device__ __forceinline__ void unpack8(const u32x4 x, float (&f)[8]) { f[0] = bflo(x.x); f[1] = bfhi(x.x); f[2] = bflo(x.y); f[3] = bfhi(x.y); f[4] = bflo(x.z); f[5] = bfhi(x.z); f[6] = bflo(x.w); f[7] = bfhi(x.w); }
__device__ __forceinline__ u32x4 pack8(const float (&f)[8]) { u32x4 w; w.x = cvt_pk(f[0], f[1]); w.y = cvt_pk(f[2], f[3]); w.z = cvt_pk(f[4], f[5]); w.w = cvt_pk(f[6], f[7]); return w; }

__device__ __forceinline__ void moe_bases(const unsigned* cnt, int* sb) {
    const int tid = opq_tid();
    if (tid < 64) { const int lane = tid;
        const int c = (lane < NE) ? (int)ldu(cnt + lane) : 0; const int nP = (c + 255) >> 8; int incl = nP;
#pragma unroll
        for (int o = 1; o < 16; o <<= 1) { const int t = __shfl_up(incl, o); if (lane >= o) incl += t; }
        if (lane < NE) { sb[lane] = (incl - nP) * 256; sb[32 + lane] = c; if (lane == NE - 1) sb[16] = incl * 256; } }
    __syncthreads();
}
__device__ __forceinline__ float wave_sum(float v) {
#define WS_DPP(ctrl) v += __int_as_float(__builtin_amdgcn_update_dpp(0, __float_as_int(v), (ctrl), 0xF, 0xF, true))
    WS_DPP(0xB1); WS_DPP(0x4E); WS_DPP(0x141); WS_DPP(0x140);
#undef WS_DPP
    const int vi = __float_as_int(v);
    return (__int_as_float(__builtin_amdgcn_readlane(vi, 0)) + __int_as_float(__builtin_amdgcn_readlane(vi, 16))) + (__int_as_float(__builtin_amdgcn_readlane(vi, 32)) + __int_as_float(__builtin_amdgcn_readlane(vi, 48)));
}
__device__ __forceinline__ float silu_f(float x) { return x * __builtin_amdgcn_rcpf(1.0f + __expf(-x)); }
__device__ __forceinline__ s16x4 tr_rd(int addr) { s16x4 r; asm volatile("ds_read_b64_tr_b16 %0, %1" : "=&v"(r) : "v"(addr) : "memory"); return r; }
#define LGKM0() do { asm volatile("s_waitcnt lgkmcnt(0)" ::: "memory"); __builtin_amdgcn_sched_barrier(0); } while (0)
#define PK8(L, H) ((bf16x8){L[0], L[1], L[2], L[3], H[0], H[1], H[2], H[3]})
#define MFMA16(a, b, c) __builtin_amdgcn_mfma_f32_16x16x32_bf16((a), (b), (c), 0, 0, 0)

namespace pg8 {
struct EpiProj {
    static constexpr bool PERM = true, AFTER_DRAIN = false;
    bf16_t* O; const float* cs; const float* sn;
    __device__ __forceinline__ void operator()(const f32x4 (&acc)[2][2][4][2], const Unit& u, int wr, int wc, int fr, int fq) const {
        const int row0 = u.pm * BM + wr * 64 + fr, cin = wc * 32 + 8 * fq;
        const bool rope = (u.pn >= 12 && u.pn < 20);
        size_t hb0[2]; int rs;
        if (u.pn < 4) { rs = 128; for (int bj = 0; bj < 2; ++bj) hb0[bj] = (size_t)((u.pn < 2 ? 0 : 4) + 2 * (u.pn & 1) + bj) * T * 128; }
        else if (u.pn < 12) { rs = 256; for (int bj = 0; bj < 2; ++bj) hb0[bj] = (size_t)((u.pn < 8 ? 8 : 16) + 2 * ((u.pn - 4) & 3)) * T * 128 + bj * 128; }
        else { rs = 128; for (int bj = 0; bj < 2; ++bj) hb0[bj] = (size_t)(24 + 8 * ((u.pn - 12) >> 2) + 2 * ((u.pn - 12) & 3) + bj) * T * 128; }
#pragma unroll
        for (int ai = 0; ai < 2; ++ai) {
            f32x4 c[4], s[4];
#pragma unroll
            for (int m = 0; m < 4; ++m) { c[m] = (f32x4){1.f, 1.f, 1.f, 1.f}; s[m] = (f32x4){0.f, 0.f, 0.f, 0.f}; }
            if (rope) {
#pragma unroll
                for (int m = 0; m < 4; ++m) { const int row = row0 + ai * HALF + m * 16; c[m] = *(const f32x4*)(cs + (size_t)row * 64 + 16 * wc + 4 * fq); s[m] = *(const f32x4*)(sn + (size_t)row * 64 + 16 * wc + 4 * fq); } }
#pragma unroll
            for (int m = 0; m < 4; ++m) {
                const int row = row0 + ai * HALF + m * 16;
#pragma unroll
                for (int bj = 0; bj < 2; ++bj) {
                    const f32x4 a0 = acc[ai][bj][m][0], a1 = acc[ai][bj][m][1];
                    const f32x4 v0 = a0 * c[m] - a1 * s[m], v1 = a1 * c[m] + a0 * s[m];
                    u32x4 w; w.x = cvt_pk_bf16(v0[0], v0[1]); w.y = cvt_pk_bf16(v0[2], v0[3]); w.z = cvt_pk_bf16(v1[0], v1[1]); w.w = cvt_pk_bf16(v1[2], v1[3]);
                    *(u32x4*)(O + hb0[bj] + (size_t)row * rs + cin) = w; }
            }
        }
    }
};
struct EpiOut {
    static constexpr bool PERM = true, AFTER_DRAIN = false;
    const float* res32; const bf16_t* res16; bf16_t* out; float alpha;
    __device__ __forceinline__ void operator()(const f32x4 (&acc)[2][2][4][2], const Unit& u, int wr, int wc, int fr, int fq) const {
        const int row0 = u.pm * BM + wr * 64 + fr, col0 = u.pn * BM + wc * 32 + 8 * fq;
        if (res32) {
#pragma unroll
            for (int ai = 0; ai < 2; ++ai)
#pragma unroll
                for (int mh = 0; mh < 2; ++mh) { f32x4 r[2][2][2];
#pragma unroll
                    for (int m2 = 0; m2 < 2; ++m2)
#pragma unroll
                        for (int bj = 0; bj < 2; ++bj) { const size_t off = (size_t)(row0 + ai * HALF + (2 * mh + m2) * 16) * 2048 + col0 + bj * HALF; r[m2][bj][0] = *(const f32x4*)(res32 + off); r[m2][bj][1] = *(const f32x4*)(res32 + off + 4); }
#pragma unroll
                    for (int m2 = 0; m2 < 2; ++m2)
#pragma unroll
                        for (int bj = 0; bj < 2; ++bj) { const int m = 2 * mh + m2; const size_t off = (size_t)(row0 + ai * HALF + m * 16) * 2048 + col0 + bj * HALF;
                            const f32x4 v0 = r[m2][bj][0] * alpha + acc[ai][bj][m][0], v1 = r[m2][bj][1] * alpha + acc[ai][bj][m][1];
                            u32x4 w; w.x = cvt_pk_bf16(v0[0], v0[1]); w.y = cvt_pk_bf16(v0[2], v0[3]); w.z = cvt_pk_bf16(v1[0], v1[1]); w.w = cvt_pk_bf16(v1[2], v1[3]);
                            *(u32x4*)(out + off) = w; } }
        } else {
#pragma unroll
            for (int ai = 0; ai < 2; ++ai) { u32x4 b[4][2];
#pragma unroll
                for (int m = 0; m < 4; ++m)
#pragma unroll
                    for (int bj = 0; bj < 2; ++bj) b[m][bj] = *(const u32x4*)(res16 + (size_t)(row0 + ai * HALF + m * 16) * 2048 + col0 + bj * HALF);
#pragma unroll
                for (int m = 0; m < 4; ++m)
#pragma unroll
                    for (int bj = 0; bj < 2; ++bj) { const size_t off = (size_t)(row0 + ai * HALF + m * 16) * 2048 + col0 + bj * HALF; const u32x4 bb = b[m][bj];
                        const f32x4 r0 = (f32x4){bflo(bb.x), bfhi(bb.x), bflo(bb.y), bfhi(bb.y)}, r1 = (f32x4){bflo(bb.z), bfhi(bb.z), bflo(bb.w), bfhi(bb.w)};
                        const f32x4 v0 = r0 * alpha + acc[ai][bj][m][0], v1 = r1 * alpha + acc[ai][bj][m][1];
                        u32x4 w; w.x = cvt_pk_bf16(v0[0], v0[1]); w.y = cvt_pk_bf16(v0[2], v0[3]); w.z = cvt_pk_bf16(v1[0], v1[1]); w.w = cvt_pk_bf16(v1[2], v1[3]);
                        *(u32x4*)(out + off) = w; } }
        }
    }
};
struct EpiGU {
    static constexpr bool PERM = true, AFTER_DRAIN = false;
    unsigned char* H;
    __device__ __forceinline__ void operator()(const f32x4 (&acc)[2][2][4][2], const Unit& u, int wr, int wc, int fr, int fq) const {
        const int row0 = u.pm * BM + wr * 64 + fr, col0 = ((u.pn & 7) * BM + wc * 32 + 8 * fq) >> 1;
#pragma unroll
        for (int ai = 0; ai < 2; ++ai)
#pragma unroll
            for (int m = 0; m < 4; ++m) { unsigned char* rowp = H + (size_t)(row0 + ai * HALF + m * 16) * 1024 + col0;
#pragma unroll
                for (int bj = 0; bj < 2; ++bj) { const f32x4 g = acc[ai][bj][m][0], up = acc[ai][bj][m][1]; f32x4 h;
#pragma unroll
                    for (int j = 0; j < 4; ++j) h[j] = g[j] * __builtin_amdgcn_rcpf(1.0f + __expf(-g[j])) * up[j] * (float)(1 << H8_SH);
                    *(unsigned*)(rowp + bj * (HALF / 2)) = pk4_fp8(h[0], h[1], h[2], h[3]); } }
    }
};
struct EpiY {
    static constexpr bool PERM = true, AFTER_DRAIN = false;
    bf16_t* Y;
    __device__ __forceinline__ void operator()(const f32x4 (&acc)[2][2][4][2], const Unit& u, int wr, int wc, int fr, int fq) const {
        const int row0 = u.pm * BM + wr * 64 + fr, col0 = (u.pn & 7) * BM + wc * 32 + 8 * fq;
#pragma unroll
        for (int ai = 0; ai < 2; ++ai)
#pragma unroll
            for (int m = 0; m < 4; ++m) { bf16_t* rowp = Y + (size_t)(row0 + ai * HALF + m * 16) * 2048 + col0;
#pragma unroll
                for (int bj = 0; bj < 2; ++bj) { const f32x4 v0 = acc[ai][bj][m][0], v1 = acc[ai][bj][m][1];
#if YS8
                    u32x2 w; w.x = pk4_fp8(v0[0] * (float)(1 << Y8_SH), v0[1] * (float)(1 << Y8_SH), v0[2] * (float)(1 << Y8_SH), v0[3] * (float)(1 << Y8_SH));
                    w.y = pk4_fp8(v1[0] * (float)(1 << Y8_SH), v1[1] * (float)(1 << Y8_SH), v1[2] * (float)(1 << Y8_SH), v1[3] * (float)(1 << Y8_SH));
                    *(u32x2*)((unsigned char*)Y + (size_t)(row0 + ai * HALF + m * 16) * 2048 + col0 + bj * HALF) = w; } }
#else
                    u32x4 w; w.x = cvt_pk_bf16(v0[0], v0[1]); w.y = cvt_pk_bf16(v0[2], v0[3]); w.z = cvt_pk_bf16(v1[0], v1[1]); w.w = cvt_pk_bf16(v1[2], v1[3]);
                    *(u32x4*)(rowp + bj * HALF) = w; } }
#endif
    }
};
struct MoeOrder : StaticOrder {
    const int* sb; const unsigned* idx; int rowbytes;
    __device__ __forceinline__ int expert_of(int pm) const { const int r = pm * BM; int e = 0;
#pragma unroll
        for (int k = 1; k < 16; ++k) e += (sb[k] <= r) ? 1 : 0;
        return e; }
    __device__ __forceinline__ bool next(int i, Unit& u) const {
        if (!StaticOrder::next(i, u)) return false;
        u.pn += 8 * __builtin_amdgcn_readfirstlane(expert_of(u.pm));
        return true; }
    __device__ __forceinline__ unsigned arow(const Unit& u, int r) const {
        const int e = u.pn >> 3, slot = u.pm * BM - sb[e] + r;
        const unsigned t = (slot < sb[32 + e]) ? __hip_atomic_load(idx + (size_t)e * 16384 + slot, __ATOMIC_RELAXED, __HIP_MEMORY_SCOPE_AGENT) : 0u;
        return t * (unsigned)rowbytes; }
};
}
__device__ __forceinline__ int rope_src_col(int n) {
    const int seg = (n - PMQ) >> 7, pp = (n - PMQ) & 127, g = pp >> 3, e = pp & 7;
    return 3088 + seg * 128 + (e < 4 ? 4 * g + e : 64 + 4 * g + (e - 4));
}
constexpr int CVT_NT = 1792, CVT_NT_IN = 192;
template <bool DYN, int JOBS>
static __device__ void phase_cvt(const Params& p, int tl, int t0, int ntot, int w, int nwk, unsigned char* lds, unsigned* qw = nullptr) {
    const int tid = opq_tid(), lane = tid & 63, wave = __builtin_amdgcn_readfirstlane(tid >> 6);
    volatile unsigned* qs = (volatile unsigned*)(lds + LDS_SCR + 96);
    int tt = w;
    if (DYN) { if (tid == 0) *qs = atomicAdd(qw, 1u); __syncthreads(); tt = (int)*qs; }
    while (tt < ntot) {
        unsigned qn = 0u; if (DYN && tid == 0) qn = atomicAdd(qw, 1u);
        int t = t0 + tt;
        int job, e = 0, kt, nt;
        if ((JOBS & 1) && (t < 192 || JOBS == 1)) { job = 0; kt = t / 12; nt = t % 12; }
        else if ((JOBS & 2) && (t < 256 || !(JOBS & 12))) { t -= 192; job = 1; kt = t >> 2; nt = t & 3; }
        else if ((JOBS & 4) && (t < 1280 || !(JOBS & 8))) { t -= 256; job = 2; e = t >> 6; t &= 63; kt = t >> 2; nt = t & 3; }
        else { t -= 1280; job = 3; e = t >> 5; t &= 31; kt = t >> 2; nt = t & 3; }
        const int n0 = nt * 512, k0 = kt * 128;
        const float* s0; const float* s1; size_t ld; int nl0, nl1;
        if (job == 0) { const float* wi = p.in[2] + (size_t)tl * DM * DIN + (size_t)k0 * DIN; ld = DIN;
            const int na = n0 + 4 * lane, nb = n0 + 256 + 4 * lane;
            s0 = wi + ((na < PMQ) ? na : (na < PMV ? rope_src_col(na) : na + 16)); s1 = wi + ((nb < PMQ) ? nb : (nb < PMV ? rope_src_col(nb) : nb + 16)); nl0 = 4 * lane; nl1 = 256 + 4 * lane; }
        else if (job == 1) { const float* wo = p.in[6] + (size_t)tl * DM * DM + (size_t)k0 * DM + n0; ld = DM; s0 = wo + 4 * lane; s1 = wo + 256 + 4 * lane; nl0 = 4 * lane; nl1 = 256 + 4 * lane; }
        else if (job == 2) { const size_t off = ((size_t)(tl * NE + e) * DM + k0) * DEXP + (n0 >> 1) + 4 * lane; ld = DEXP; s0 = p.in[11] + off; s1 = p.in[12] + off; nl0 = 8 * lane; nl1 = 8 * lane + 4; }
        else { const float* wd = p.in[13] + ((size_t)(tl * NE + e) * DEXP + k0) * DM + n0; ld = DM; s0 = wd + 4 * lane; s1 = wd + 256 + 4 * lane; nl0 = 4 * lane; nl1 = 256 + 4 * lane; }
        const bool f8 = OUT8 ? true : (job != 1); const float sc = (job == 0) ? (float)(1 << WIN8_SH) : (job == 1) ? (float)(1 << WO8_SH) : (job == 2) ? (float)(1 << WGU8_SH) : (float)(1 << WD8_SH);
        f32x4 v[3][8];
#pragma unroll
        for (int pb = 0; pb < 2; ++pb)
#pragma unroll
            for (int i = 0; i < 4; ++i) { const size_t ro = (size_t)(wave + 8 * (4 * pb + i)) * ld; v[pb][2 * i] = *(const f32x4*)(s0 + ro); v[pb][2 * i + 1] = *(const f32x4*)(s1 + ro); }
#pragma unroll
        for (int bt = 0; bt < 4; ++bt) {
            if (bt < 2) {
#pragma unroll
                for (int i = 0; i < 4; ++i) { const size_t ro = (size_t)(wave + 8 * (4 * (bt + 2) + i)) * ld; v[(bt + 2) % 3][2 * i] = *(const f32x4*)(s0 + ro); v[(bt + 2) % 3][2 * i + 1] = *(const f32x4*)(s1 + ro); } }
#pragma unroll
            for (int i = 0; i < 4; ++i) { const int r = wave + 8 * (4 * bt + i); const f32x4 x0 = v[bt % 3][2 * i], x1 = v[bt % 3][2 * i + 1];
                if (f8) { *(unsigned*)(lds + r * 512 + nl0) = pk4_fp8(x0[0] * sc, x0[1] * sc, x0[2] * sc, x0[3] * sc); *(unsigned*)(lds + r * 512 + nl1) = pk4_fp8(x1[0] * sc, x1[1] * sc, x1[2] * sc, x1[3] * sc); }
                else { u32x2 a; a.x = cvt_pk(x0[0], x0[1]); a.y = cvt_pk(x0[2], x0[3]); u32x2 c2; c2.x = cvt_pk(x1[0], x1[1]); c2.y = cvt_pk(x1[2], x1[3]);
                       *(u32x2*)(lds + r * 1024 + 2 * nl0) = a; *(u32x2*)(lds + r * 1024 + 2 * nl1) = c2; } }
        }
        __syncthreads();
        if (f8) {
            unsigned char* d = (job == 0) ? p.ws + ((tl & 1) ? WS_WIN2 : WS_WIN) + (size_t)(n0 + tid) * DM + k0
                             : (job == 1) ? p.ws + WS_WO + (size_t)(n0 + tid) * DM + k0
                             : (job == 2) ? p.ws + WS_WGU + ((size_t)e * 2048 + n0 + tid) * DM + k0 : p.ws + WS_WD + ((size_t)e * 2048 + n0 + tid) * DEXP + k0;
#pragma unroll
            for (int c = 0; c < 8; ++c) { unsigned wq[4];
#pragma unroll
                for (int j = 0; j < 4; ++j) { const unsigned char* s8 = lds + (16 * c + 4 * j) * 512 + tid; wq[j] = (unsigned)s8[0] | ((unsigned)s8[512] << 8) | ((unsigned)s8[1024] << 16) | ((unsigned)s8[1536] << 24); }
                *(u32x4*)(d + 16 * c) = (u32x4){wq[0], wq[1], wq[2], wq[3]}; }
        } else {
            unsigned char* d = p.ws + WS_WO + ((size_t)(n0 + tid) * DM + k0) * 2;
#pragma unroll
            for (int c = 0; c < 16; ++c) { unsigned wq[4];
#pragma unroll
                for (int j = 0; j < 4; ++j) { const unsigned lo = *(const unsigned short*)(lds + (8 * c + 2 * j) * 1024 + 2 * tid), hi = *(const unsigned short*)(lds + (8 * c + 2 * j + 1) * 1024 + 2 * tid); wq[j] = lo | (hi << 16); }
                *(u32x4*)(d + 16 * c) = (u32x4){wq[0], wq[1], wq[2], wq[3]}; }
        }
        if (DYN) { if (tid == 0) *qs = qn; }
        __syncthreads();
        if (DYN) tt = (int)*qs; else tt += nwk;
    }
}

static __device__ void phase_rope(const Params& p) {
    float* cs = (float*)(p.ws + WS_ROPE); float* sn = cs + (size_t)T * 64;
    const int* pos = (const int*)p.in[1];
    for (int idx = blockIdx.x * NTHR + opq_tid(); idx < T * 64; idx += gridDim.x * NTHR) {
        const int t = idx >> 6, i = idx & 63;
        double pw = 1.0; for (int k = 0; k < i; ++k) pw *= 1.1547819846894583;
        const float inv = 1.0f / (float)pw;
        const float ang = (float)pos[t] * inv;
        const double rev = (double)ang * 0.15915494309189535; const float fr = (float)(rev - floor(rev));
        cs[idx] = __builtin_amdgcn_cosf(fr); sn[idx] = __builtin_amdgcn_sinf(fr);
    }
}

__device__ __forceinline__ float reduce16(const float (&a)[16], int lane) {
    float b[8], c[4], d[2];
    const bool x = lane & 1, y = lane & 2, z = lane & 4, w = lane & 8;
#pragma unroll
    for (int m = 0; m < 8; ++m) { const float keep = x ? a[2 * m + 1] : a[2 * m], give = x ? a[2 * m] : a[2 * m + 1]; b[m] = keep + __shfl_xor(give, 1); }
#pragma unroll
    for (int m = 0; m < 4; ++m) { const float keep = y ? b[2 * m + 1] : b[2 * m], give = y ? b[2 * m] : b[2 * m + 1]; c[m] = keep + __shfl_xor(give, 2); }
#pragma unroll
    for (int m = 0; m < 2; ++m) { const float keep = z ? c[2 * m + 1] : c[2 * m], give = z ? c[2 * m] : c[2 * m + 1]; d[m] = keep + __shfl_xor(give, 4); }
    float e = (w ? d[1] : d[0]) + __shfl_xor(w ? d[0] : d[1], 8);
    e += __shfl_xor(e, 16); e += __shfl_xor(e, 32);
    return e;
}
#ifndef ROW_PROBE
#define ROW_PROBE 0
#endif
template <class Tp> __device__ __forceinline__ Tp* opq_uniform(Tp* ptr) { unsigned long long w = (unsigned long long)ptr; asm volatile("" : "+s"(w)); return (Tp*)w; }
template <int MODE, bool DUMMY = false> static __device__ void phase_rows(const Params& p, int layer, unsigned char* lds) {
    const int tid = opq_tid(), lane = tid & 63, wave = (MODE == 1) ? (tid >> 6) : __builtin_amdgcn_readfirstlane(tid >> 6);
    float* wT = (float*)lds;
    constexpr bool SK16 = false;
    float* rlog = (float*)(lds + LDS_SCR + 20480);
    int* lcnt = (int*)(lds + LDS_SCR + 512); int* gbase = lcnt + 16; float* rinfo = (float*)(lds + LDS_SCR + 1024);
    const bool last = (layer == NLAYER - 1);
    const bool do_skinny = !(MODE == 2 && last);
    const float* W; int ld, c0;
    if (MODE == 0) { W = p.in[2]; ld = DIN; c0 = 3072; }
    else if (MODE == 1) { W = p.in[9]; ld = 16; c0 = 0; }
    else { W = p.in[2] + (size_t)(last ? layer : layer + 1) * DM * DIN; ld = DIN; c0 = 3072; }
    bf16_t* hb = (bf16_t*)(p.ws + (DUMMY ? (MODE == 1 ? WS_U : WS_MIX) : WS_HB));
    float* glow = (float*)(p.ws + (DUMMY ? WS_PML + 2 * MiB : WS_GLOW));
    unsigned* tok = (unsigned*)(p.ws + (DUMMY && MODE == 1 ? WS_PML : WS_TOK));
    float* outw = DUMMY ? (float*)(p.ws + (MODE == 1 ? WS_PROJ : WS_WGU)) : p.out;
    const bf16_t* Ys = (const bf16_t*)(p.ws + WS_YS);
    int* sbm = (int*)(lds + LDS_SCR + 128);
#ifndef NR2_DEF
#define NR2_DEF 1
#endif
    constexpr int NR = (MODE == 2) ? NR2_DEF : 2;
    const int nit = T / (8 * (int)gridDim.x);
    constexpr bool PF = true;
#if YS8
    u32x2 nx[NR][8]; unsigned ny0[8], ny1[8]; f32x4 nf[NR][8];
#else
    u32x2 nx[NR][8], ny0[8], ny1[8]; f32x4 nf[NR][8];
#endif
    float nw0 = 0.f, nw1 = 0.f; unsigned nt[6];
    const bf16_t* srcb0 = (const bf16_t*)(p.ws + ((MODE == 2 && !RECOMP) ? WS_HB : WS_PRE));
    if (PF) {
#pragma unroll
        for (int rr = 0; rr < NR; ++rr) { const int r = (rr * (int)gridDim.x + (int)blockIdx.x) * 8 + wave;
#pragma unroll
            for (int i = 0; i < 8; ++i) { if (MODE == 1) nx[rr][i] = *(const u32x2*)(srcb0 + (size_t)r * DM + 256 * i + 4 * lane); else if (MODE == 2) nx[rr][i] = *(const u32x2*)(opq_uniform(srcb0 + (size_t)r * DM) + 256 * i + 4 * lane); else nf[rr][i] = *(const f32x4*)(opq_uniform(p.in[0] + (size_t)r * DM) + 256 * i + 4 * lane); } }
        if (MODE == 2) {
            const int r = (int)blockIdx.x * 8 + wave;
#pragma unroll
            for (int j = 0; j < 6; ++j) nt[j] = ldu(tok + r * 8 + j);
        }
    }
    if (MODE == 2) moe_bases((const unsigned*)(p.ws + WS_CTL) + CW_CNT + layer * 64, sbm);
    if (PF && MODE == 2) {
        nw0 = __uint_as_float(nt[2]); nw1 = __uint_as_float(nt[3]);
#if YS8
        const unsigned char* y0 = opq_uniform((const unsigned char*)Ys + (size_t)__builtin_amdgcn_readfirstlane((int)((unsigned)sbm[nt[0]] + nt[4])) * DM); const unsigned char* y1 = opq_uniform((const unsigned char*)Ys + (size_t)__builtin_amdgcn_readfirstlane((int)((unsigned)sbm[nt[1]] + nt[5])) * DM);
#pragma unroll
        for (int i = 0; i < 8; ++i) { ny0[i] = *(const unsigned*)(y0 + 256 * i + 4 * lane); ny1[i] = *(const unsigned*)(y1 + 256 * i + 4 * lane); }
#else
        const bf16_t* y0 = Ys + (size_t)((unsigned)sbm[nt[0]] + nt[4]) * DM; const bf16_t* y1 = Ys + (size_t)((unsigned)sbm[nt[1]] + nt[5]) * DM;
#pragma unroll
        for (int i = 0; i < 8; ++i) { ny0[i] = *(const u32x2*)(y0 + 256 * i + 4 * lane); ny1[i] = *(const u32x2*)(y1 + 256 * i + 4 * lane); }
#endif
        const int r2 = ((nit > 1 ? 1 : 0) * (int)gridDim.x + (int)blockIdx.x) * 8 + wave;
#pragma unroll
        for (int j = 0; j < 6; ++j) nt[j] = ldu(tok + r2 * 8 + j);
    }
    if (do_skinny) {
#pragma unroll
        for (int hb2 = 0; hb2 < 2; ++hb2) { f32x4 wv[8];
#pragma unroll
            for (int i = 0; i < 8; ++i) { const int i4 = tid + NTHR * (8 * hb2 + i), k = i4 >> 2, e4 = (i4 & 3) * 4; wv[i] = *(const f32x4*)(W + (size_t)k * ld + c0 + e4); }
#pragma unroll
            for (int i = 0; i < 8; ++i) { const int i4 = tid + NTHR * (8 * hb2 + i), k = i4 >> 2, e4 = (i4 & 3) * 4;
#pragma unroll
                for (int j = 0; j < 4; ++j) { if (SK16) ((unsigned short*)wT)[(e4 + j) * DM + k] = (unsigned short)(cvt_pk(wv[i][j], 0.f) & 0xFFFFu); else wT[(((e4 + j) >> 1) * DM + k) * 2 + ((e4 + j) & 1)] = wv[i][j]; } } }
    }
    if (MODE == 1 && tid < 16) lcnt[tid] = 0;
    float* gl = (float*)(lds + LDS_SCR + 4096); float* bl2 = gl + DM;
    unsigned short* tb2 = (unsigned short*)(lds + LDS_SCR + 12288); unsigned short* tg1 = tb2 + DM; unsigned short* tb1 = tg1 + DM;
    if (MODE != 0) {
        const float* gp = p.in[MODE == 1 ? 7 : 14] + (size_t)layer * DM; const float* bp = p.in[MODE == 1 ? 8 : 15] + (size_t)layer * DM;
        if (MODE == 2 && RECOMP) {
            const float* g1p = p.in[7] + (size_t)layer * DM; const float* b1p = p.in[8] + (size_t)layer * DM;
#pragma unroll
            for (int k = 0; k < DM / NTHR; ++k) { const int idx = tid + NTHR * k; gl[idx] = gp[idx];
                tb2[idx] = (unsigned short)(cvt_pk(bp[idx], 0.f) & 0xFFFFu); tg1[idx] = (unsigned short)(cvt_pk(g1p[idx], 0.f) & 0xFFFFu); tb1[idx] = (unsigned short)(cvt_pk(b1p[idx], 0.f) & 0xFFFFu); }
        } else {
#pragma unroll
            for (int k = 0; k < DM / NTHR; ++k) { const int idx = tid + NTHR * k; gl[idx] = gp[idx]; bl2[idx] = bp[idx]; }
        }
    }
    __syncthreads();
    for (int it = 0; it < nit; it += NR) {
        int row[NR]; float v[NR][32];
#pragma unroll
        for (int rr = 0; rr < NR; ++rr) { row[rr] = ((it + rr) * (int)gridDim.x + (int)blockIdx.x) * 8 + wave;
            if (MODE != 0) {
#pragma unroll
                for (int i = 0; i < 8; ++i) { const u32x2 x = nx[rr][i]; v[rr][4 * i] = bflo(x.x); v[rr][4 * i + 1] = bfhi(x.x); v[rr][4 * i + 2] = bflo(x.y); v[rr][4 * i + 3] = bfhi(x.y); }
            } else {
#pragma unroll
                for (int i = 0; i < 8; ++i) { const f32x4 x = nf[rr][i];
#pragma unroll
                    for (int j = 0; j < 4; ++j) v[rr][4 * i + j] = x[j]; } } }
        if (MODE == 2 && RECOMP) {
            __builtin_amdgcn_sched_barrier(0);
            float s = 0.f;
#pragma unroll
            for (int i = 0; i < 32; ++i) s += v[0][i];
            const float mean = wave_sum(s) * (1.0f / DM);
            float qq = 0.f;
#pragma unroll
            for (int i = 0; i < 32; ++i) { const float d = v[0][i] - mean; qq += d * d; }
            const float rstd = rsqrtf(wave_sum(qq) * (1.0f / DM) + 1e-5f);
#pragma unroll
            for (int i = 0; i < 8; ++i) { const u32x2 g4 = *(const u32x2*)(tg1 + 256 * i + 4 * lane), b4 = *(const u32x2*)(tb1 + 256 * i + 4 * lane);
                v[0][4 * i + 0] = (v[0][4 * i + 0] - mean) * rstd * bflo(g4.x) + bflo(b4.x); v[0][4 * i + 1] = (v[0][4 * i + 1] - mean) * rstd * bfhi(g4.x) + bfhi(b4.x);
                v[0][4 * i + 2] = (v[0][4 * i + 2] - mean) * rstd * bflo(g4.y) + bflo(b4.y); v[0][4 * i + 3] = (v[0][4 * i + 3] - mean) * rstd * bfhi(g4.y) + bfhi(b4.y);
                asm volatile("" ::: "memory"); }
            __builtin_amdgcn_sched_barrier(0);
        }
        if (MODE == 2) {
#if YS8
            const float w0 = nw0 * (1.0f / (float)(1 << Y8_SH)), w1 = nw1 * (1.0f / (float)(1 << Y8_SH));
#pragma unroll
            for (int i = 0; i < 8; ++i) { const unsigned a = ny0[i], c = ny1[i];
                const f32x2 a01 = __builtin_amdgcn_cvt_pk_f32_fp8((int)a, false), a23 = __builtin_amdgcn_cvt_pk_f32_fp8((int)a, true), c01 = __builtin_amdgcn_cvt_pk_f32_fp8((int)c, false), c23 = __builtin_amdgcn_cvt_pk_f32_fp8((int)c, true);
                v[0][4 * i + 0] = DN_ALPHA * v[0][4 * i + 0] + w0 * a01[0] + w1 * c01[0]; v[0][4 * i + 1] = DN_ALPHA * v[0][4 * i + 1] + w0 * a01[1] + w1 * c01[1];
                v[0][4 * i + 2] = DN_ALPHA * v[0][4 * i + 2] + w0 * a23[0] + w1 * c23[0]; v[0][4 * i + 3] = DN_ALPHA * v[0][4 * i + 3] + w0 * a23[1] + w1 * c23[1]; }
#else
            const float w0 = nw0, w1 = nw1;
#pragma unroll
            for (int i = 0; i < 8; ++i) { const u32x2 a = ny0[i], c = ny1[i];
                v[0][4 * i + 0] = DN_ALPHA * v[0][4 * i + 0] + w0 * bflo(a.x) + w1 * bflo(c.x); v[0][4 * i + 1] = DN_ALPHA * v[0][4 * i + 1] + w0 * bfhi(a.x) + w1 * bfhi(c.x);
                v[0][4 * i + 2] = DN_ALPHA * v[0][4 * i + 2] + w0 * bflo(a.y) + w1 * bflo(c.y); v[0][4 * i + 3] = DN_ALPHA * v[0][4 * i + 3] + w0 * bfhi(a.y) + w1 * bfhi(c.y); }
#endif
        }
        if (PF) {
            const int itn = (it + NR < nit) ? it + NR : it;
#pragma unroll
            for (int rr = 0; rr < NR; ++rr) { const int r = ((itn + rr) * (int)gridDim.x + (int)blockIdx.x) * 8 + wave;
#pragma unroll
                for (int i = 0; i < 8; ++i) { if (MODE == 1) nx[rr][i] = *(const u32x2*)(srcb0 + (size_t)r * DM + 256 * i + 4 * lane); else if (MODE == 2) nx[rr][i] = *(const u32x2*)(opq_uniform(srcb0 + (size_t)r * DM) + 256 * i + 4 * lane); else nf[rr][i] = *(const f32x4*)(opq_uniform(p.in[0] + (size_t)r * DM) + 256 * i + 4 * lane); } }
            if (MODE == 2) {
                nw0 = __uint_as_float(nt[2]); nw1 = __uint_as_float(nt[3]);
#if YS8
                        const unsigned char* y0 = opq_uniform((const unsigned char*)Ys + (size_t)__builtin_amdgcn_readfirstlane((int)((unsigned)sbm[nt[0]] + nt[4])) * DM); const unsigned char* y1 = opq_uniform((const unsigned char*)Ys + (size_t)__builtin_amdgcn_readfirstlane((int)((unsigned)sbm[nt[1]] + nt[5])) * DM);
#pragma unroll
                for (int i = 0; i < 8; ++i) { ny0[i] = *(const unsigned*)(y0 + 256 * i + 4 * lane); ny1[i] = *(const unsigned*)(y1 + 256 * i + 4 * lane); }
#else
                const bf16_t* y0 = Ys + (size_t)((unsigned)sbm[nt[0]] + nt[4]) * DM; const bf16_t* y1 = Ys + (size_t)((unsigned)sbm[nt[1]] + nt[5]) * DM;
#pragma unroll
                for (int i = 0; i < 8; ++i) { ny0[i] = *(const u32x2*)(y0 + 256 * i + 4 * lane); ny1[i] = *(const u32x2*)(y1 + 256 * i + 4 * lane); }
#endif
                const int it2 = (it + 2 < nit) ? it + 2 : nit - 1;
                const int r2 = (it2 * (int)gridDim.x + (int)blockIdx.x) * 8 + wave;
#pragma unroll
                for (int j = 0; j < 6; ++j) nt[j] = ldu(tok + r2 * 8 + j);
            }
        }
#pragma unroll
        for (int rr = 0; rr < NR; ++rr) {
            __builtin_amdgcn_sched_barrier(0);
            if (MODE != 0) {
                float s = 0.f;
#pragma unroll
                for (int i = 0; i < 32; ++i) s += v[rr][i];
                const float mean = wave_sum(s) * (1.0f / DM);
                float q = 0.f;
#pragma unroll
                for (int i = 0; i < 32; ++i) { const float d = v[rr][i] - mean; q += d * d; }
                const float rstd = rsqrtf(wave_sum(q) * (1.0f / DM) + 1e-5f);
#pragma unroll
                for (int i = 0; i < 8; ++i) { const f32x4 gv = *(const f32x4*)(gl + 256 * i + 4 * lane); f32x4 bv;
                    if (MODE == 2 && RECOMP) { const u32x2 b4 = *(const u32x2*)(tb2 + 256 * i + 4 * lane); bv = (f32x4){bflo(b4.x), bfhi(b4.x), bflo(b4.y), bfhi(b4.y)}; }
                    else bv = *(const f32x4*)(bl2 + 256 * i + 4 * lane);
#pragma unroll
                    for (int j = 0; j < 4; ++j) v[rr][4 * i + j] = (v[rr][4 * i + j] - mean) * rstd * gv[j] + bv[j]; }
                if (MODE == 2 && last) {
                    float* dst = (MODE == 1) ? outw + (size_t)row[rr] * DM : opq_uniform(outw + (size_t)row[rr] * DM);
#pragma unroll
                    for (int i = 0; i < 8; ++i) *(f32x4*)(dst + 256 * i + 4 * lane) = (f32x4){v[rr][4 * i], v[rr][4 * i + 1], v[rr][4 * i + 2], v[rr][4 * i + 3]}; }
            }
            if (MODE != 0 && !(MODE == 2 && last) && !(MODE == 1 && RECOMP)) {
#pragma unroll
                for (int i = 0; i < 8; ++i) { u32x2 w; w.x = cvt_pk(v[rr][4 * i], v[rr][4 * i + 1]); w.y = cvt_pk(v[rr][4 * i + 2], v[rr][4 * i + 3]); *(u32x2*)(((MODE == 1) ? hb + (size_t)row[rr] * DM : opq_uniform(hb + (size_t)row[rr] * DM)) + 256 * i + 4 * lane) = w; }
            }
            if (MODE == 1 || !(MODE == 2 && last)) {
                unsigned char* hb8 = p.ws + (DUMMY ? WS_S : (MODE == 1 ? WS_HB8 : WS_HBQ));
#pragma unroll
                for (int i = 0; i < 8; ++i) *(unsigned*)(((MODE == 1) ? hb8 + (size_t)row[rr] * DM : opq_uniform(hb8 + (size_t)row[rr] * DM)) + 256 * i + 4 * lane) = pk4_fp8(v[rr][4 * i] * (float)(1 << X8_SH), v[rr][4 * i + 1] * (float)(1 << X8_SH), v[rr][4 * i + 2] * (float)(1 << X8_SH), v[rr][4 * i + 3] * (float)(1 << X8_SH));
            }
            asm volatile("" ::: "memory"); __builtin_amdgcn_sched_barrier(0);
        }
        if (do_skinny) {
            float tots[NR];
#pragma unroll
            for (int rr = 0; rr < NR; ++rr) {
                asm volatile("" ::: "memory"); __builtin_amdgcn_sched_barrier(0);
                float acc1[16];
                {
                    f32x2 acc2[8];
#pragma unroll
                    for (int ep = 0; ep < 8; ++ep) acc2[ep] = (f32x2){0.f, 0.f};
#pragma unroll
                    for (int i = 0; i < 8; ++i) {
                        const f32x2 s0 = (f32x2){v[rr][4 * i], v[rr][4 * i]}, s1 = (f32x2){v[rr][4 * i + 1], v[rr][4 * i + 1]}, s2 = (f32x2){v[rr][4 * i + 2], v[rr][4 * i + 2]}, s3 = (f32x2){v[rr][4 * i + 3], v[rr][4 * i + 3]};
#pragma unroll
                        for (int eh = 0; eh < 2; ++eh) {
#pragma unroll
                            for (int ep = 4 * eh; ep < 4 * eh + 4; ++ep) { const f32x4 wa = *(const f32x4*)(wT + (ep * DM + 256 * i + 4 * lane) * 2), wb = *(const f32x4*)(wT + (ep * DM + 256 * i + 4 * lane) * 2 + 4);
                                acc2[ep] += s0 * (f32x2){wa[0], wa[1]}; acc2[ep] += s1 * (f32x2){wa[2], wa[3]}; acc2[ep] += s2 * (f32x2){wb[0], wb[1]}; acc2[ep] += s3 * (f32x2){wb[2], wb[3]}; }
                            asm volatile("" ::: "memory"); } }
#pragma unroll
                    for (int ep = 0; ep < 8; ++ep) { acc1[2 * ep] = acc2[ep][0]; acc1[2 * ep + 1] = acc2[ep][1]; }
                }
                tots[rr] = reduce16(acc1, lane);
                if (MODE != 1) { if (lane < 16) glow[(size_t)row[rr] * 16 + lane] = tots[rr]; }
            }
            if (MODE == 1) {
#pragma unroll
              for (int rr = 0; rr < NR; ++rr) { if (lane < 16) rlog[((it + rr) * 8 + wave) * 16 + lane] = tots[rr]; }
            }
        }
    }
    if (MODE == 1) {
        unsigned* cnt = (unsigned*)(p.ws + WS_CTL) + (DUMMY ? CW_DBG + 64 : CW_CNT + layer * 64);
        __syncthreads();
        int e0 = 0, e1 = 0, ls0 = 0, ls1 = 0; float rw0 = 0.f, rw1 = 0.f;
        if (tid < 8 * nit) {
                    float lg[16];
#pragma unroll
                    for (int e = 0; e < 16; ++e) lg[e] = rlog[tid * 16 + e];
                    float mx = lg[0];
#pragma unroll
                    for (int e = 1; e < 16; ++e) mx = fmaxf(mx, lg[e]);
                    float aff[16], bi[16], sum = 0.f;
#pragma unroll
                    for (int e = 0; e < 16; ++e) { aff[e] = __expf(lg[e] - mx); sum += aff[e]; }
                    const float rs = 1.0f / sum;
#pragma unroll
                    for (int e = 0; e < 16; ++e) { aff[e] *= rs; bi[e] = aff[e] + p.in[10][e]; }
                    float gs[4];
#pragma unroll
                    for (int gi = 0; gi < 4; ++gi) { const float a0 = bi[4 * gi], a1 = bi[4 * gi + 1], a2 = bi[4 * gi + 2], a3 = bi[4 * gi + 3];
                        gs[gi] = fmaxf(fmaxf(fmaxf(a0 + a1, a0 + a2), fmaxf(a0 + a3, a1 + a2)), fmaxf(a1 + a3, a2 + a3)); }
                    int best = 0; float bv = gs[0];
#pragma unroll
                    for (int gi = 1; gi < 4; ++gi) if (gs[gi] > bv) { bv = gs[gi]; best = gi; }
                    float ab[4], aa[4];
#pragma unroll
                    for (int k = 0; k < 4; ++k) { ab[k] = best == 0 ? bi[k] : best == 1 ? bi[4 + k] : best == 2 ? bi[8 + k] : bi[12 + k];
                                                  aa[k] = best == 0 ? aff[k] : best == 1 ? aff[4 + k] : best == 2 ? aff[8 + k] : aff[12 + k]; }
                    int i1 = 0; float v1 = ab[0];
#pragma unroll
                    for (int k = 1; k < 4; ++k) if (ab[k] > v1) { v1 = ab[k]; i1 = k; }
                    int i2 = -1; float v2 = -3.0e38f;
#pragma unroll
                    for (int k = 0; k < 4; ++k) if (k != i1 && ab[k] > v2) { v2 = ab[k]; i2 = k; }
                    const float a1 = i1 == 0 ? aa[0] : i1 == 1 ? aa[1] : i1 == 2 ? aa[2] : aa[3];
                    const float a2 = i2 == 0 ? aa[0] : i2 == 1 ? aa[1] : i2 == 2 ? aa[2] : aa[3];
                    const float ws = 1.0f / (a1 + a2);
                    e0 = 4 * best + i1; e1 = 4 * best + i2; rw0 = a1 * ws; rw1 = a2 * ws;
                    ls0 = atomicAdd(&lcnt[e0], 1); ls1 = atomicAdd(&lcnt[e1], 1);
        }
        __syncthreads();
        if (tid < 16) gbase[tid] = (int)atomicAdd(&cnt[tid], (unsigned)lcnt[tid]);
        __syncthreads();
        if (tid < 8 * nit) {
            const int it = tid >> 3, wv = tid & 7, row = (it * (int)gridDim.x + (int)blockIdx.x) * 8 + wv;
            u32x4 a; a.x = (unsigned)e0; a.y = (unsigned)e1; a.z = __float_as_uint(rw0); a.w = __float_as_uint(rw1);
            u32x4 c; c.x = (unsigned)(gbase[e0] + ls0); c.y = (unsigned)(gbase[e1] + ls1); c.z = 0u; c.w = 0u;
            *(u32x4*)(tok + row * 8) = a; *(u32x4*)(tok + row * 8 + 4) = c;
            if (!DUMMY) { unsigned* idx = (unsigned*)(p.ws + WS_IDX); idx[(size_t)e0 * 16384 + c.x] = (unsigned)row; idx[(size_t)e1 * 16384 + c.y] = (unsigned)row; }
        }
        __syncthreads();
    }
    __syncthreads();
}

__device__ void phase_perm(const Params& p, int layer, unsigned char* lds) {
    const int tid = opq_tid(), lane = tid & 63, wave = __builtin_amdgcn_readfirstlane(tid >> 6);
    int* sb = (int*)lds;
    const unsigned* cnt = (const unsigned*)(p.ws + WS_CTL) + CW_CNT + layer * 64;
    unsigned* misc = (unsigned*)(p.ws + WS_MISC) + layer * 256;
    if (tid < 64) {
        const int c = (lane < NE) ? (int)ldu(cnt + lane) : 0;
        const int nP = (c + 255) >> 8;
        int incl = nP;
#pragma unroll
        for (int o = 1; o < 16; o <<= 1) { const int t = __shfl_up(incl, o); if (lane >= o) incl += t; }
        const int excl = incl - nP;
        if (lane < NE) {
            sb[lane] = excl * 256;
            if (blockIdx.x == 0) { misc[16 + lane] = (unsigned)(excl * 256); for (int q = 0; q < nP; ++q) misc[64 + excl + q] = (unsigned)lane; if (lane == NE - 1) misc[0] = (unsigned)incl; }
        }
    }
    __syncthreads();
    unsigned* tok = (unsigned*)(p.ws + WS_TOK);
    const bf16_t* hb = (const bf16_t*)(p.ws + WS_HB); unsigned char* Xs = p.ws + WS_XS;
    const int nit = T / (8 * (int)gridDim.x);
    for (int it = 0; it < nit; ++it) {
        const int row = (it * (int)gridDim.x + (int)blockIdx.x) * 8 + wave;
        const int e0 = (int)ldu(tok + row * 8), e1 = (int)ldu(tok + row * 8 + 1);
        const int r0 = sb[e0] + (int)ldu(tok + row * 8 + 4), r1 = sb[e1] + (int)ldu(tok + row * 8 + 5);
        const u32x4* s = (const u32x4*)(hb + (size_t)row * DM);
#pragma unroll
        for (int hh = 0; hh < 2; ++hh) {
            float f[16]; { float fa[8], fb[8]; unpack8(s[2 * lane + 128 * hh], fa); unpack8(s[2 * lane + 1 + 128 * hh], fb);
#pragma unroll
                for (int i = 0; i < 8; ++i) { f[i] = fa[i] * (float)(1 << X8_SH); f[8 + i] = fb[i] * (float)(1 << X8_SH); } }
            const u32x4 x = {pk4_fp8(f[0], f[1], f[2], f[3]), pk4_fp8(f[4], f[5], f[6], f[7]), pk4_fp8(f[8], f[9], f[10], f[11]), pk4_fp8(f[12], f[13], f[14], f[15])};
            *(u32x4*)(Xs + (size_t)r0 * DM + 16 * lane + 1024 * hh) = x; *(u32x4*)(Xs + (size_t)r1 * DM + 16 * lane + 1024 * hh) = x; }
        if (lane == 0) { tok[row * 8 + 6] = (unsigned)r0; tok[row * 8 + 7] = (unsigned)r1; }
    }
    __syncthreads();
}
constexpr int GL_V = 0, GL_K = 33792, GL_Q = 51200, GL_B = 68608, GL_GLW = 101376, GL_TOT = 105472, GL_AT = 107520, GL_RED = 116736, GL_W = 118784;
#ifndef GLA_PROBE
#define GLA_PROBE 0
#endif
#ifndef GLA_NOTR
#define GLA_NOTR 0
#endif
#ifndef ATT_QMAX_DEF
#define ATT_QMAX_DEF 512
#endif
constexpr int ATT_QMAX = ATT_QMAX_DEF;
constexpr int KSB = 272, VSB = 528, ASB = 144;
__device__ __forceinline__ int blx(int row, int col) { return row * 128 + ((((col >> 2) ^ (row & 7))) << 2) + (col & 3); }

__device__ __forceinline__ f32x4 gla_decay(unsigned char* lds) {
    const int tid = opq_tid();
    float* bl = (float*)(lds + GL_B); const float* glw = (const float*)(lds + GL_GLW); float* tot = (float*)(lds + GL_TOT); float* gt = (float*)(lds + GL_AT);
    const int dq = tid & 31, tg = tid >> 5;
    asm volatile("s_waitcnt vmcnt(0)" ::: "memory");
    __syncthreads();
    f32x4 all = (f32x4){0.f, 0.f, 0.f, 0.f};
#pragma unroll 1
    for (int pr_ = 0; pr_ < (GLA_PROBE == 1 ? 5 : 1); ++pr_) {
    const f32x4 bg = *(const f32x4*)((const float*)(lds + GL_W) + 2048 + 4 * dq);
    f32x4 x[4] = {bg, bg, bg, bg};
#pragma unroll
    for (int hf = 0; hf < 2; ++hf) {
        f32x4 w[8];
#pragma unroll
        for (int r = 0; r < 8; ++r) w[r] = *(const f32x4*)((const float*)(lds + GL_W) + (8 * hf + r) * 128 + 4 * dq);
#pragma unroll
        for (int tt = 0; tt < 4; ++tt) { const f32x4* gr = (const f32x4*)(glw + (tg * 4 + tt) * 16 + 8 * hf); const f32x4 g0 = gr[0], g1 = gr[1];
            x[tt] += g0[0] * w[0] + g0[1] * w[1] + g0[2] * w[2] + g0[3] * w[3] + g1[0] * w[4] + g1[1] * w[5] + g1[2] * w[6] + g1[3] * w[7]; }
        __builtin_amdgcn_sched_barrier(0);
    }
    f32x4 run = (f32x4){0.f, 0.f, 0.f, 0.f};
#pragma unroll
    for (int tt = 0; tt < 4; ++tt) {
        const int tk = tg * 4 + tt;
#pragma unroll
        for (int j = 0; j < 4; ++j) run[j] += (fminf(x[tt][j], 0.f) - __logf(1.0f + __expf(-fabsf(x[tt][j])))) * 0.0625f;
        *(f32x4*)(bl + tk * 128 + 4 * dq) = run;
    }
    *(f32x4*)(gt + tg * 128 + 4 * dq) = run;
    __syncthreads();
    f32x4 pre = (f32x4){0.f, 0.f, 0.f, 0.f}; all = pre;
#pragma unroll
    for (int g2 = 0; g2 < 16; ++g2) { const f32x4 tv = *(const f32x4*)(gt + g2 * 128 + 4 * dq); if (g2 < tg) pre += tv; all += tv; }
#pragma unroll
    for (int tt = 0; tt < 4; ++tt) { f32x4* bp = (f32x4*)(bl + (tg * 4 + tt) * 128 + 4 * dq); *bp = *bp + pre; }
    if (tg == 0) { *(f32x4*)(tot + 4 * dq) = all; *(f32x4*)(tot + 128 + 4 * dq) = (f32x4){__expf(all[0]), __expf(all[1]), __expf(all[2]), __expf(all[3])}; }
    __syncthreads();
    }
    return all;
}
__device__ __forceinline__ void gla_stage_v(const bf16_t* proj, int c, int h, unsigned char* lds) {
    const int tid = opq_tid(), tk = tid >> 3, dv0 = (tid & 7) * 32;
    const u32x4* s = (const u32x4*)(proj + ix_gv(h, c * 64 + tk) + dv0);
    u32x4* d = (u32x4*)(lds + GL_V + tk * VSB + dv0 * 2);
#pragma unroll
    for (int i = 0; i < 4; ++i) d[i] = s[i];
}

template <bool OUT>
static __device__ void gla_super_unit(const Params& p, int layer, int sc, int h, unsigned char* lds) {
    const int tid = opq_tid(), lane = tid & 63, wave = tid >> 6, g = lane >> 4, l15 = lane & 15;
    const bf16_t* proj = (const bf16_t*)(p.ws + WS_PROJ);
    const int tk0 = tid >> 3, dk0 = (tid & 7) * 16, dv0 = (tid & 7) * 32;
    const int lbase = (int)(uintptr_t)lds, trow = l15 >> 2, tcol = 4 * (lane & 3);
    const float* bl = (const float*)(lds + GL_B); float* tot = (float*)(lds + GL_TOT);
    f32x4 S[8][2];
    if (OUT && sc > 0) {
        const bf16_t* Sst = (const bf16_t*)(p.ws + WS_S) + ((size_t)sc * 4 + h) * 256 * 128;
#pragma unroll
        for (int m = 0; m < 8; ++m)
#pragma unroll
            for (int nn = 0; nn < 2; ++nn) { const u32x2 w = *(const u32x2*)(Sst + (size_t)(32 * wave + 16 * nn + l15) * 128 + 16 * m + 4 * g);
                S[m][nn] = (f32x4){bflo(w.x), bfhi(w.x), bflo(w.y), bfhi(w.y)}; }
    } else {
#pragma unroll
        for (int m = 0; m < 8; ++m) { S[m][0] = (f32x4){0.f, 0.f, 0.f, 0.f}; S[m][1] = (f32x4){0.f, 0.f, 0.f, 0.f}; }
    }
    f32x4 bsum = (f32x4){0.f, 0.f, 0.f, 0.f};
    if (!OUT) { float* wl = (float*)(lds + GL_W);
#pragma unroll
      for (int j = 0; j < 4; ++j) { const int idx = tid + 512 * j; wl[idx] = p.in[3][(size_t)layer * 16 * 512 + (idx >> 7) * 512 + h * 128 + (idx & 127)]; }
      if (tid < 128) wl[2048 + tid] = p.in[4][layer * 512 + h * 128 + tid]; }
    float* gB = (float*)(p.ws + WS_BDEC);
    u32x4 qreg[2], kreg[2], vreg[4];
    const int wu = __builtin_amdgcn_readfirstlane(wave);
#define GLA_REQ(cq) { const int c_ = (cq); \
        const u32x4* sk = (const u32x4*)(proj + ix_gk(h, c_ * 64 + tk0) + dk0); const u32x4* sv = (const u32x4*)(proj + ix_gv(h, c_ * 64 + tk0) + dv0); \
        kreg[0] = sk[0]; kreg[1] = sk[1]; \
        if (OUT) { const u32x4* sq = (const u32x4*)(proj + ix_gq(h, c_ * 64 + tk0) + dk0); qreg[0] = sq[0]; qreg[1] = sq[1]; } \
        _Pragma("unroll") for (int i = 0; i < 4; ++i) vreg[i] = sv[i]; \
        if (!OUT) { if (wu < 4) __builtin_amdgcn_global_load_lds((const unsigned*)((const float*)(p.ws + WS_GLOW) + (size_t)c_ * 64 * 16 + tid * 4), (PG8_LAS unsigned*)(size_t)(unsigned)(lbase + GL_GLW + wu * 1024), 16, 0, 0); } \
        else { _Pragma("unroll") for (int k_ = 0; k_ < 4; ++k_) __builtin_amdgcn_global_load_lds((const unsigned*)(gB + ((size_t)c_ * 4 + h) * 8192 + (k_ * 512 + tid) * 4), (PG8_LAS unsigned*)(size_t)(unsigned)(lbase + GL_B + k_ * 8192 + wu * 1024), 16, 0, 0); } }
    GLA_REQ(sc * 4);
#pragma unroll 1
    for (int cc = 0; cc < 4; ++cc) {
        const int c = sc * 4 + cc;
        if (!OUT) {
            bsum += gla_decay(lds);
            float* gt_ = gB + ((size_t)c * 4 + h) * 8192;
#pragma unroll
            for (int k_ = 0; k_ < 4; ++k_) *(f32x4*)(gt_ + (k_ * 512 + tid) * 4) = *(const f32x4*)(bl + (k_ * 512 + tid) * 4);
        } else {
            asm volatile("s_waitcnt vmcnt(0)" ::: "memory");
            __syncthreads();
            if (tid < 128) { const float bb = bl[63 * 128 + tid]; tot[tid] = bb; tot[128 + tid] = __expf(bb); }
        }
        if (OUT) {
#pragma unroll
            for (int hlf = 0; hlf < 2; ++hlf) { float fq[8], fk[8]; unpack8(qreg[hlf], fq); unpack8(kreg[hlf], fk);
#pragma unroll
                for (int j = 0; j < 8; ++j) { const float bb = bl[tk0 * 128 + dk0 + hlf * 8 + j]; fq[j] *= __expf(bb) * 0.08838834764831845f; fk[j] *= __expf(-bb); }
                *(u32x4*)(lds + GL_Q + tk0 * KSB + (dk0 + hlf * 8) * 2) = pack8(fq); *(u32x4*)(lds + GL_K + tk0 * KSB + (dk0 + hlf * 8) * 2) = pack8(fk); }
        }
#pragma unroll
        for (int i = 0; i < 4; ++i) *(u32x4*)(lds + GL_V + tk0 * VSB + dv0 * 2 + 16 * i) = vreg[i];
        __syncthreads();
        f32x4 acc[2][4]; u32x2 ggr[4][2]; f32x4 gn[2];
        if (OUT) {
#if GLA_PROBE == 2
#pragma unroll 1
            for (int pr_ = 0; pr_ < 5; ++pr_)
#endif
            { const int mj = wave >> 1;
              f32x4 at[2] = {(f32x4){0.f, 0.f, 0.f, 0.f}, (f32x4){0.f, 0.f, 0.f, 0.f}};
#pragma unroll
              for (int ks = 0; ks < 4; ++ks) {
                  const bf16x8 A = *(const bf16x8*)(lds + GL_K + (16 * mj + l15) * KSB + (32 * ks + 8 * g) * 2);
#pragma unroll
                  for (int t2 = 0; t2 < 2; ++t2) { const int ni = 2 * (wave & 1) + t2; const bf16x8 B = *(const bf16x8*)(lds + GL_Q + (16 * ni + l15) * KSB + (32 * ks + 8 * g) * 2); at[t2] = MFMA16(A, B, at[t2]); }
              }
#pragma unroll
              for (int t2 = 0; t2 < 2; ++t2) { const int ni = 2 * (wave & 1) + t2, i = 16 * ni + l15, j0 = 16 * mj + 4 * g;
                  float v[4];
#pragma unroll
                  for (int r = 0; r < 4; ++r) v[r] = (i >= j0 + r) ? at[t2][r] : 0.f;
                  u32x2 w; w.x = cvt_pk(v[0], v[1]); w.y = cvt_pk(v[2], v[3]); *(u32x2*)(lds + GL_AT + i * ASB + j0 * 2) = w; }
            }
            __syncthreads();
        }
#pragma unroll
        for (int hlf = 0; hlf < 2; ++hlf) { float f[8]; unpack8(kreg[hlf], f);
#pragma unroll
            for (int j = 0; j < 8; ++j) f[j] *= __expf(tot[dk0 + hlf * 8 + j] - bl[tk0 * 128 + dk0 + hlf * 8 + j]);
            *(u32x4*)(lds + GL_K + tk0 * KSB + (dk0 + hlf * 8) * 2) = pack8(f); }
        if (!OUT) GLA_REQ(sc * 4 + (cc < 3 ? cc + 1 : 3));
        if (OUT) {
#pragma unroll
            for (int mm = 0; mm < 2; ++mm)
#pragma unroll
                for (int n = 0; n < 4; ++n) acc[mm][n] = (f32x4){0.f, 0.f, 0.f, 0.f};
#if GLA_PROBE == 3
#pragma unroll 1
            for (int pr_ = 0; pr_ < 5; ++pr_) {
            if (pr_ > 0) {
#pragma unroll
                for (int mm = 0; mm < 2; ++mm)
#pragma unroll
                    for (int n = 0; n < 4; ++n) acc[mm][n] *= 1e-30f; }
#endif
#pragma unroll
            for (int ks = 0; ks < 2; ++ks) {
                const int kb = 32 * ks + 8 * g + trow;
                s16x4 vl[2], vh[2]; bf16x8 B[4];
#pragma unroll
                for (int mm = 0; mm < 2; ++mm) { const int a = lbase + GL_V + kb * VSB + (32 * wave + 16 * mm + tcol) * 2; vl[mm] = tr_rd(a); vh[mm] = tr_rd(a + 4 * VSB); }
#pragma unroll
                for (int n = 0; n < 4; ++n) B[n] = *(const bf16x8*)(lds + GL_AT + (16 * n + l15) * ASB + (32 * ks + 8 * g) * 2);
                LGKM0();
#pragma unroll
                for (int mm = 0; mm < 2; ++mm)
#pragma unroll
                    for (int n = 0; n < 4; ++n) acc[mm][n] = MFMA16(PK8(vl[mm], vh[mm]), B[n], acc[mm][n]);
            }
            if (sc > 0 || cc > 0) {
#pragma unroll
                for (int s = 0; s < 4; ++s) {
                    bf16x8 A[2], B[4];
#pragma unroll
                    for (int mm = 0; mm < 2; ++mm) { u32x4 w; w.x = cvt_pk(S[2 * s][mm][0], S[2 * s][mm][1]); w.y = cvt_pk(S[2 * s][mm][2], S[2 * s][mm][3]);
                        w.z = cvt_pk(S[2 * s + 1][mm][0], S[2 * s + 1][mm][1]); w.w = cvt_pk(S[2 * s + 1][mm][2], S[2 * s + 1][mm][3]); A[mm] = __builtin_bit_cast(bf16x8, w); }
#pragma unroll
                    for (int n = 0; n < 4; ++n) { const unsigned char* qr = lds + GL_Q + (16 * n + l15) * KSB + (32 * s + 4 * g) * 2;
                        const u32x2 lo = *(const u32x2*)qr, hi = *(const u32x2*)(qr + 32); u32x4 w; w.x = lo.x; w.y = lo.y; w.z = hi.x; w.w = hi.y; B[n] = __builtin_bit_cast(bf16x8, w); }
#pragma unroll
                    for (int mm = 0; mm < 2; ++mm)
#pragma unroll
                        for (int n = 0; n < 4; ++n) acc[mm][n] = MFMA16(A[mm], B[n], acc[mm][n]);
                    __builtin_amdgcn_sched_barrier(0);
                }
            }
#if GLA_PROBE == 3
            }
#endif
            GLA_REQ(sc * 4 + (cc < 3 ? cc + 1 : 3));
#pragma unroll
            for (int n = 0; n < 4; ++n)
#pragma unroll
                for (int mm = 0; mm < 2; ++mm) ggr[n][mm] = *(const u32x2*)(proj + ix_gg(h, c * 64 + 16 * n + l15) + 32 * wave + 16 * mm + 4 * g);
#pragma unroll
            for (int mm = 0; mm < 2; ++mm) gn[mm] = *(const f32x4*)(p.in[5] + layer * 256 + 32 * wave + 16 * mm + 4 * g);
            float* red = (float*)(lds + GL_RED);
            float ss[4];
#pragma unroll
            for (int n = 0; n < 4; ++n) { float s = 0.f;
#pragma unroll
                for (int mm = 0; mm < 2; ++mm)
#pragma unroll
                    for (int r = 0; r < 4; ++r) s += acc[mm][n][r] * acc[mm][n][r];
                s += __shfl_xor(s, 16); s += __shfl_xor(s, 32); ss[n] = s; }
            if (g == 0) {
#pragma unroll
                for (int n = 0; n < 4; ++n) red[(16 * n + l15) * 8 + wave] = ss[n]; }
        }
        __syncthreads();
        if (OUT) {
#if GLA_PROBE == 4
#pragma unroll 1
            for (int pr_ = 0; pr_ < 5; ++pr_) {
#endif
            const float* red = (const float*)(lds + GL_RED);
            bf16_t* mix = (bf16_t*)(p.ws + WS_MIX);
#pragma unroll
            for (int n = 0; n < 4; ++n) {
                const int tk = 16 * n + l15; const f32x4 r0 = *(const f32x4*)(red + tk * 8), r1 = *(const f32x4*)(red + tk * 8 + 4);
                const float rstd = rsqrtf(((r0[0] + r0[1]) + (r0[2] + r0[3]) + (r1[0] + r1[1]) + (r1[2] + r1[3])) * (1.0f / 256.0f) + 1e-6f);
                const size_t tg = (size_t)c * 64 + tk;
#pragma unroll
                for (int mm = 0; mm < 2; ++mm) { const int dv = 32 * wave + 16 * mm + 4 * g;
                    const u32x2 gg = ggr[n][mm]; const f32x4 nr = gn[mm];
                    const float o0 = acc[mm][n][0] * rstd * nr[0] * silu_f(bflo(gg.x)), o1 = acc[mm][n][1] * rstd * nr[1] * silu_f(bfhi(gg.x));
                    const float o2 = acc[mm][n][2] * rstd * nr[2] * silu_f(bflo(gg.y)), o3 = acc[mm][n][3] * rstd * nr[3] * silu_f(bfhi(gg.y));
#if OUT8
                    *(unsigned*)((unsigned char*)mix + tg * DM + h * 256 + dv) = pk4_fp8(o0 * (float)(1 << MIX8_SH), o1 * (float)(1 << MIX8_SH), o2 * (float)(1 << MIX8_SH), o3 * (float)(1 << MIX8_SH)); }
#else
                    u32x2 w; w.x = cvt_pk(o0, o1); w.y = cvt_pk(o2, o3); *(u32x2*)(mix + tg * DM + h * 256 + dv) = w; }
#endif
            }
#if GLA_PROBE == 4
            }
#endif
        }
        if (!OUT || cc < 3) {
#pragma unroll
            for (int m = 0; m < 8; ++m) { const f32x4 av = *(const f32x4*)(tot + 128 + 16 * m + 4 * g);
#pragma unroll
                for (int nn = 0; nn < 2; ++nn) { S[m][nn][0] *= av[0]; S[m][nn][1] *= av[1]; S[m][nn][2] *= av[2]; S[m][nn][3] *= av[3]; } }
#pragma unroll
            for (int ks = 0; ks < 2; ++ks) {
                const int kb = 32 * ks + 8 * g + trow;
                s16x4 al[4], ah[4], vl[2], vh[2];
#pragma unroll
                for (int nn = 0; nn < 2; ++nn) { const int a = lbase + GL_V + kb * VSB + (32 * wave + 16 * nn + tcol) * 2; vl[nn] = tr_rd(a); vh[nn] = tr_rd(a + 4 * VSB); }
#pragma unroll
                for (int mh = 0; mh < 2; ++mh) {
#pragma unroll
                    for (int m = 0; m < 4; ++m) { const int a = lbase + GL_K + kb * KSB + (16 * (4 * mh + m) + tcol) * 2; al[m] = tr_rd(a); ah[m] = tr_rd(a + 4 * KSB); }
                    LGKM0();
#pragma unroll
                    for (int m = 0; m < 4; ++m)
#pragma unroll
                        for (int nn = 0; nn < 2; ++nn) S[4 * mh + m][nn] = MFMA16(PK8(al[m], ah[m]), PK8(vl[nn], vh[nn]), S[4 * mh + m][nn]);
                    __builtin_amdgcn_sched_barrier(0);
                }
            }
        }
        __syncthreads();
    }
    if (!OUT) {
        bf16_t* E = (bf16_t*)(p.ws + WS_U);
#pragma unroll
        for (int m = 0; m < 8; ++m)
#pragma unroll
            for (int nn = 0; nn < 2; ++nn) { const int dv = 32 * wave + 16 * nn + l15, dk = 16 * m + 4 * g;
                u32x2 w; w.x = cvt_pk(S[m][nn][0], S[m][nn][1]); w.y = cvt_pk(S[m][nn][2], S[m][nn][3]);
                *(u32x2*)(E + (((size_t)sc * 4 + h) * 256 + dv) * 128 + dk) = w; }
        if (tid < 32) *(f32x4*)((float*)(p.ws + WS_GDEC) + ((size_t)sc * 4 + h) * 128 + 4 * tid) = (f32x4){__expf(bsum[0]), __expf(bsum[1]), __expf(bsum[2]), __expf(bsum[3])};
    }
}
#undef GLA_REQ
static __device__ void gla_scan(const Params& p, int bi, int nblk, unsigned char* lds) {
    const unsigned* U32 = (const unsigned*)(p.ws + WS_U); unsigned* S32 = (unsigned*)(p.ws + WS_S); const float* gdec = (const float*)(p.ws + WS_GDEC);
    const int tid = opq_tid();
    float* dl = (float*)lds;
    for (int i0 = bi * 256; i0 < 65536; i0 += nblk * 256) {
        const int idx = i0 + (tid & 255), h = i0 >> 14, dk = (2 * idx) & 127;
        unsigned u[64];
        if (tid < 256) {
#pragma unroll
            for (int i = 0; i < 64; ++i) u[i] = U32[(size_t)i * 65536 + idx]; }
#pragma unroll
        for (int k = 0; k < 4; ++k) { const int e = (tid + 512 * k) * 4, c = e >> 7, d = e & 127; *(f32x4*)(dl + e) = *(const f32x4*)(gdec + ((size_t)c * 4 + h) * 128 + d); }
        __syncthreads();
        if (tid < 256) {
            float s0 = 0.f, s1 = 0.f;
#pragma unroll
            for (int i = 0; i < 64; ++i) { S32[(size_t)i * 65536 + idx] = cvt_pk(s0, s1); const f32x2 a = *(const f32x2*)(dl + i * 128 + dk); s0 = a[0] * s0 + bflo(u[i]); s1 = a[1] * s1 + bfhi(u[i]); } }
        __syncthreads();
    }
}

static __device__ void moba_kmean_unit(const Params& p, int h, int j, unsigned char* lds) {
    const int tid = opq_tid(), d0 = (tid & 15) * 8, kg = tid >> 4;
    const bf16_t* proj = (const bf16_t*)(p.ws + WS_PROJ);
    float acc[8];
#pragma unroll
    for (int i = 0; i < 8; ++i) acc[i] = 0.f;
#pragma unroll
    for (int kk = 0; kk < 8; ++kk) { float f[8]; unpack8(*(const u32x4*)(proj + ix_mk(h, j * 256 + kg * 8 + kk) + d0), f);
#pragma unroll
        for (int i = 0; i < 8; ++i) acc[i] += f[i]; }
    float* red = (float*)lds;
#pragma unroll
    for (int i = 0; i < 8; ++i) red[kg * 128 + d0 + i] = acc[i];
    __syncthreads();
    if (tid < 128) { float s = 0.f;
#pragma unroll 8
        for (int q = 0; q < 32; ++q) s += red[q * 128 + tid];
        ((float*)(p.ws + WS_KMEAN))[((size_t)h * 64 + j) * 128 + tid] = s * (1.0f / 256.0f); }
    __syncthreads();
}

#define TOP3_INS_IF(ok, s, j) do { const float _s = (s); const int _j = (j); const bool _ok = (ok); \
    const bool _c0 = _ok & ((_s > v0) | ((_s == v0) & (_j < i0))), _c1 = _ok & ((_s > v1) | ((_s == v1) & (_j < i1))), _c2 = _ok & ((_s > v2) | ((_s == v2) & (_j < i2))); \
    v2 = _c1 ? v1 : (_c2 ? _s : v2); i2 = _c1 ? i1 : (_c2 ? _j : i2); \
    v1 = _c0 ? v0 : (_c1 ? _s : v1); i1 = _c0 ? i0 : (_c1 ? _j : i1); \
    v0 = _c0 ? _s : v0;              i0 = _c0 ? _j : i0; } while (0)
#define TOP3_INS(s, j) TOP3_INS_IF(true, s, j)

static __device__ void moba_gate_unit(const Params& p, int h, int qb, unsigned char* lds) {
    const int tid = opq_tid(), lane = tid & 63, wave = tid >> 6, g = lane >> 4, l15 = lane & 15;
    const bf16_t* proj = (const bf16_t*)(p.ws + WS_PROJ);
    unsigned* selp = (unsigned*)(p.ws + WS_SEL) + (size_t)h * T + qb * 256;
    if (qb == 0) { if (tid < 256) selp[tid] = 0xFFFFFFFFu; return; }
    constexpr int GSB = 272, GLO = 64 * GSB;
    bf16x8 B[2][4];
#pragma unroll
    for (int t2 = 0; t2 < 2; ++t2)
#pragma unroll
        for (int s2 = 0; s2 < 4; ++s2) B[t2][s2] = *(const bf16x8*)(proj + ix_mq(h, qb * 256 + 32 * wave + 16 * t2 + l15) + 32 * s2 + 8 * g);
    { const int j = tid >> 3, c0 = (tid & 7) * 16;
      {
          const f32x4* src = (const f32x4*)((const float*)(p.ws + WS_KMEAN) + ((size_t)h * 64 + j) * 128 + c0);
          u32x4 hi[2], lo[2];
#pragma unroll
          for (int k = 0; k < 2; ++k) { const f32x4 a = src[2 * k], b = src[2 * k + 1];
              hi[k].x = cvt_pk(a[0], a[1]); hi[k].y = cvt_pk(a[2], a[3]); hi[k].z = cvt_pk(b[0], b[1]); hi[k].w = cvt_pk(b[2], b[3]);
              lo[k].x = cvt_pk(a[0] - bflo(hi[k].x), a[1] - bfhi(hi[k].x)); lo[k].y = cvt_pk(a[2] - bflo(hi[k].y), a[3] - bfhi(hi[k].y));
              lo[k].z = cvt_pk(b[0] - bflo(hi[k].z), b[1] - bfhi(hi[k].z)); lo[k].w = cvt_pk(b[2] - bflo(hi[k].w), b[3] - bfhi(hi[k].w)); }
          *(u32x4*)(lds + j * GSB + c0 * 2) = hi[0]; *(u32x4*)(lds + j * GSB + c0 * 2 + 16) = hi[1];
          *(u32x4*)(lds + GLO + j * GSB + c0 * 2) = lo[0]; *(u32x4*)(lds + GLO + j * GSB + c0 * 2 + 16) = lo[1]; } }
    __syncthreads();
    f32x4 acc[2][4];
#pragma unroll
    for (int t2 = 0; t2 < 2; ++t2)
#pragma unroll
        for (int n = 0; n < 4; ++n) acc[t2][n] = (f32x4){0.f, 0.f, 0.f, 0.f};
#pragma unroll
    for (int n = 0; n < 4; ++n) {
        {
#pragma unroll
            for (int s2 = 0; s2 < 4; ++s2) {
                const bf16x8 Ah = *(const bf16x8*)(lds + (16 * n + l15) * GSB + (32 * s2 + 8 * g) * 2), Al = *(const bf16x8*)(lds + GLO + (16 * n + l15) * GSB + (32 * s2 + 8 * g) * 2);
#pragma unroll
                for (int t2 = 0; t2 < 2; ++t2) { acc[t2][n] = MFMA16(Ah, B[t2][s2], acc[t2][n]); acc[t2][n] = MFMA16(Al, B[t2][s2], acc[t2][n]); }
            }
        }
    }
#pragma unroll
    for (int t2 = 0; t2 < 2; ++t2) {
        float v0 = -3.0e38f, v1 = -3.0e38f, v2 = -3.0e38f; int i0 = 255, i1 = 255, i2 = 255;
#pragma unroll
        for (int n = 0; n < 4; ++n)
#pragma unroll
            for (int r = 0; r < 4; ++r) { const int j = 16 * n + 4 * g + r; TOP3_INS_IF(j < qb, acc[t2][n][r], j); }
#pragma unroll
        for (int o = 16; o <= 32; o <<= 1) {
            const float c0 = __shfl_xor(v0, o), c1 = __shfl_xor(v1, o), c2 = __shfl_xor(v2, o); const int j0 = __shfl_xor(i0, o), j1 = __shfl_xor(i1, o), j2 = __shfl_xor(i2, o);
            TOP3_INS_IF(j0 != 255, c0, j0);
            TOP3_INS_IF(j1 != 255, c1, j1);
            TOP3_INS_IF(j2 != 255, c2, j2);
        }
        if (g == 0) selp[32 * wave + 16 * t2 + l15] = (unsigned)i0 | ((unsigned)i1 << 8) | ((unsigned)i2 << 16) | 0xFF000000u;
    }
    __syncthreads();
}

__device__ __forceinline__ int list_off(int j) { return 256 * (63 * j - (j * (j - 1)) / 2); }

static __device__ void moba_list_unit(const Params& p, int layer, int h, int j, unsigned char* lds) {
    const int tid = opq_tid(), lane = tid & 63, wave = tid >> 6;
    const unsigned* sel = (const unsigned*)(p.ws + WS_SEL) + (size_t)h * T;
    unsigned* list = (unsigned*)(p.ws + WS_LIST) + (size_t)h * LISTH + list_off(j);
    int* wcnt = (int*)lds;
    int total = 0;
    const u32x4 none = {0xFFFFFFFFu, 0xFFFFFFFFu, 0xFFFFFFFFu, 0xFFFFFFFFu};
    const int qs = (j + 1) * 256 + 4 * tid;
    u32x4 wa = none, wb = none, wc = none;
    if (qs < T) wa = *(const u32x4*)(sel + qs);
    if (qs + 4 * NTHR < T) wb = *(const u32x4*)(sel + qs + 4 * NTHR);
    if (qs + 8 * NTHR < T) wc = *(const u32x4*)(sel + qs + 8 * NTHR);
#pragma unroll 1
    for (int q0 = (j + 1) * 256; q0 < T; q0 += 4 * NTHR) {
        const int q = q0 + 4 * tid;
        const u32x4 w4 = wa; wa = wb; wb = wc; wc = none;
        if (q + 12 * NTHR < T) wc = *(const u32x4*)(sel + q + 12 * NTHR);
        int slot[4], cntl = 0;
#pragma unroll
        for (int i = 0; i < 4; ++i) { const unsigned w = w4[i];
            slot[i] = ((w & 0xFF) == (unsigned)j) ? 0 : (((w >> 8) & 0xFF) == (unsigned)j) ? 1 : (((w >> 16) & 0xFF) == (unsigned)j) ? 2 : -1; cntl += slot[i] >= 0; }
        int incl = cntl;
#pragma unroll
        for (int o = 1; o < 64; o <<= 1) { const int t2 = __shfl_up(incl, o); if (lane >= o) incl += t2; }
        if (lane == 63) wcnt[wave] = incl;
        __syncthreads();
        int off = total + incl - cntl, tot = 0;
#pragma unroll
        for (int w2 = 0; w2 < 8; ++w2) { const int cw = wcnt[w2]; off += (w2 < wave) ? cw : 0; tot += cw; }
#pragma unroll
        for (int i = 0; i < 4; ++i) if (slot[i] >= 0) { list[off] = (unsigned)(q + i) | ((unsigned)slot[i] << 16); ++off; }
        total += tot;
        __syncthreads();
    }
    if (tid == 0) {
        unsigned* ctl = (unsigned*)(p.ws + WS_CTL);
        const int nit = total > 0 ? (total + ATT_QMAX - 1) / ATT_QMAX : 1;
        u32x4* items = (u32x4*)(p.ws + WS_ITEMS) + layer * 4096;
        if (nit > 1) { const unsigned bf = atomicAdd(&ctl[CW_NIT + layer * 64 + 1], (unsigned)(nit - 1));
            for (int c = 0; c < nit - 1; ++c) items[bf + c] = (u32x4){(unsigned)h, (unsigned)j, (unsigned)c, (unsigned)total}; }
        const unsigned bb = atomicAdd(&ctl[CW_NIT + layer * 64 + 2], 1u);
        items[4095 - bb] = (u32x4){(unsigned)h, (unsigned)j, (unsigned)(nit - 1), (unsigned)total};
        atomicAdd(&ctl[CW_NIT + layer * 64], (unsigned)nit);
    }
}
namespace att {
constexpr int D = 128, NW = 8, QBLK = 32, KVBLK = 64, LDK = 128;
constexpr float SCALE = 0.088388347648318440f, THR = 8.f;
constexpr float CEXP = SCALE * 1.4426950408889634f;
constexpr size_t SHM_V = KVBLK * D * 2, SHM_K = KVBLK * D * 2;
#define KSWZ(row, colB) ((row) * 256 + ((colB) ^ (((row) & 7) << 4)))
#define SBAR() __builtin_amdgcn_sched_barrier(0)
__device__ __forceinline__ int crow(int r, int hi) { return (r & 3) + 8 * (r >> 2) + 4 * hi; }
__device__ __forceinline__ unsigned cvtpk(float lo, float hi) { return cvt_pk(lo, hi); }

__device__ __forceinline__ void partialSM(f32x16& p0, f32x16& p1, float& m_reg, float& mn, float& alpha) {
  constexpr float C = CEXP;
  float pmax = p0[0];
#pragma unroll
  for (int r = 1; r < 16; ++r) pmax = fmaxf(pmax, p0[r]);
#pragma unroll
  for (int r = 0; r < 16; ++r) pmax = fmaxf(pmax, p1[r]);
  { auto rr = __builtin_amdgcn_permlane32_swap(__float_as_uint(pmax), __float_as_uint(pmax), false, false);
    pmax = fmaxf(__uint_as_float(rr[0]), __uint_as_float(rr[1])); }
  if (__builtin_expect(__all(pmax - m_reg <= THR / SCALE), 1)) { mn = m_reg; alpha = 1.f; }
  else { mn = fmaxf(m_reg, pmax); alpha = __builtin_amdgcn_exp2f((m_reg - mn) * C); m_reg = mn; }
  const float mnC = -mn * C;
#pragma unroll
  for (int r = 0; r < 16; ++r) p0[r] = fmaf(p0[r], C, mnC);
#pragma unroll
  for (int r = 0; r < 16; ++r) p1[r] = fmaf(p1[r], C, mnC);
#pragma unroll
  for (int r = 0; r < 16; ++r) p0[r] = __builtin_amdgcn_exp2f(p0[r]);
}
__device__ __forceinline__ void finishSM(f32x16& p0, f32x16& p1, float alpha, float& l_reg, bf16x8& pa0, bf16x8& pa1, bf16x8& pa2, bf16x8& pa3) {
#pragma unroll
  for (int r = 0; r < 16; ++r) p1[r] = __builtin_amdgcn_exp2f(p1[r]);
  float ps = 0;
#pragma unroll
  for (int r = 0; r < 16; ++r) ps += p0[r];
#pragma unroll
  for (int r = 0; r < 16; ++r) ps += p1[r];
  { auto rr = __builtin_amdgcn_permlane32_swap(__float_as_uint(ps), __float_as_uint(ps), false, false);
    ps = __uint_as_float(rr[0]) + __uint_as_float(rr[1]); }
  l_reg = l_reg * alpha + ps;
#define PK4(P, BASE, OUT) do { unsigned a0 = cvtpk(P[BASE + 0], P[BASE + 1]), a1 = cvtpk(P[BASE + 2], P[BASE + 3]);   \
    unsigned b0 = cvtpk(P[BASE + 4], P[BASE + 5]), b1 = cvtpk(P[BASE + 6], P[BASE + 7]);                              \
    auto r0 = __builtin_amdgcn_permlane32_swap(a0, b0, false, false); auto r1 = __builtin_amdgcn_permlane32_swap(a1, b1, false, false); \
    u32x4 w = {r0[0], r1[0], r0[1], r1[1]}; OUT = *reinterpret_cast<bf16x8*>(&w); } while (0)
  PK4(p0, 0, pa0); PK4(p0, 8, pa1); PK4(p1, 0, pa2); PK4(p1, 8, pa3);
#undef PK4
}
__device__ __forceinline__ void qkt(f32x16& p0, f32x16& p1, const char* Ks, const bf16x8* qr, int r32, int hi) {
  p0 = f32x16{}; p1 = f32x16{};
#pragma unroll
  for (int d0 = 0; d0 < 8; ++d0) { const int cb = (d0 * 16 + hi * 8) * 2;
    const bf16x8 b0 = *reinterpret_cast<const bf16x8*>(Ks + KSWZ(r32, cb));
    const bf16x8 b1 = *reinterpret_cast<const bf16x8*>(Ks + KSWZ(32 + r32, cb));
    p0 = __builtin_amdgcn_mfma_f32_32x32x16_bf16(b0, qr[d0], p0, 0, 0, 0);
    p1 = __builtin_amdgcn_mfma_f32_32x32x16_bf16(b1, qr[d0], p1, 0, 0, 0); }
}
__device__ __forceinline__ void mask_tile(f32x16& p0, f32x16& p1, int tile, int qrow, int hi) {
#pragma unroll
  for (int r = 0; r < 16; ++r) { const int key = tile * 64 + crow(r, hi); if (key > qrow) p0[r] = -1.0e30f; if (key + 32 > qrow) p1[r] = -1.0e30f; }
}
__device__ __forceinline__ int v_st(int k, int c) { const int kk = (k & ~0xC) | ((k & 4) << 1) | ((k & 8) >> 1); return ((kk >> 3) * 4 + (c >> 5)) * 512 + ((kk & 7) * 32 + (c & 31)) * 2; }
__device__ __forceinline__ int v_rd_base(int lane) { return ((lane & 3) << 3) | (((lane >> 2) & 3) << 6) | (((lane >> 4) & 1) << 5) | (((lane >> 5) & 1) << 8); }
constexpr int v_rd_off(int d0, int ks, int half) { return d0 * 512 + ks * 4096 + half * 2048; }
template <int OFF> __device__ __forceinline__ s16x4 tr_read(int vb) {
  s16x4 r; asm volatile("ds_read_b64_tr_b16 %0, %1 offset:%2" : "=&v"(r) : "v"(vb), "i"(OFF) : "memory"); return r;
}
template <int D0> __device__ __forceinline__ void pv_one(f32x16& od, int vb, bf16x8 pa0, bf16x8 pa1, bf16x8 pa2, bf16x8 pa3) {
  const s16x4 l0 = tr_read<v_rd_off(D0, 0, 0)>(vb), h0 = tr_read<v_rd_off(D0, 0, 1)>(vb), l1 = tr_read<v_rd_off(D0, 1, 0)>(vb), h1 = tr_read<v_rd_off(D0, 1, 1)>(vb);
  const s16x4 l2 = tr_read<v_rd_off(D0, 2, 0)>(vb), h2 = tr_read<v_rd_off(D0, 2, 1)>(vb), l3 = tr_read<v_rd_off(D0, 3, 0)>(vb), h3 = tr_read<v_rd_off(D0, 3, 1)>(vb);
  asm volatile("s_waitcnt lgkmcnt(0)" ::: "memory"); SBAR();
  od = __builtin_amdgcn_mfma_f32_32x32x16_bf16(pa0, PK8(l0, h0), od, 0, 0, 0);
  od = __builtin_amdgcn_mfma_f32_32x32x16_bf16(pa1, PK8(l1, h1), od, 0, 0, 0);
  od = __builtin_amdgcn_mfma_f32_32x32x16_bf16(pa2, PK8(l2, h2), od, 0, 0, 0);
  od = __builtin_amdgcn_mfma_f32_32x32x16_bf16(pa3, PK8(l3, h3), od, 0, 0, 0);
}
__device__ __forceinline__ void pv_d0(f32x16* o, int vb, bf16x8 pa0, bf16x8 pa1, bf16x8 pa2, bf16x8 pa3) {
  pv_one<0>(o[0], vb, pa0, pa1, pa2, pa3); pv_one<1>(o[1], vb, pa0, pa1, pa2, pa3); pv_one<2>(o[2], vb, pa0, pa1, pa2, pa3); pv_one<3>(o[3], vb, pa0, pa1, pa2, pa3);
}

__device__ __forceinline__ void moba_item(const bf16_t* __restrict__ proj, int h, int jblk, const unsigned* list, int nvalid, bf16_t* PO, float* PML, char* lds) {
  const int tid = opq_tid(), wid = tid >> 6, lane = tid & 63, r32 = lane & 31, hi = lane >> 5;
  const bool own = (list == nullptr);
  char* V_lds = lds; char* K_lds = lds + 2 * SHM_V;
  float* ws = (float*)(lds + 2 * SHM_V + 2 * SHM_K) + wid * 64; float* al_l = ws + 32;
  float m_reg = -1e30f, l_reg = 0; f32x16 o[4] = {}; bf16x8 qr[8];
  const int myrow = wid * QBLK + r32;
  int q, slot; bool valid;
  if (own) { q = jblk * 256 + myrow; slot = 3; valid = true; }
  else { const int rr = myrow < nvalid ? myrow : nvalid - 1; const unsigned e = list[rr]; q = (int)(e & 0xFFFFu); slot = (int)(e >> 16); valid = myrow < nvalid; }
  const bf16_t* Qw = proj + ix_mq(h, q) + hi * 8;
#pragma unroll
  for (int d0 = 0; d0 < 8; ++d0) qr[d0] = *reinterpret_cast<const bf16x8*>(Qw + d0 * 16);
  const bf16_t* Kh = proj + ix_mk(h, jblk * 256);
  const bf16_t* Vh = proj + ix_mv(h, jblk * 256);
  const int sr = tid >> 4, sc = (tid & 15) * 8, vst0 = v_st(sr, sc), vst1 = v_st(32 + sr, sc);
  const int vb0 = (int)(uintptr_t)V_lds + v_rd_base(lane);
  struct { bf16x8 vs0, vs1, ks0, ks1; } sr_[2];
#define SLOAD(i, k0) do { sr_[i].vs0 = *(const bf16x8*)(&Vh[(size_t)((k0) + sr) * LDK + sc]); sr_[i].vs1 = *(const bf16x8*)(&Vh[(size_t)((k0) + 32 + sr) * LDK + sc]); \
    sr_[i].ks0 = *(const bf16x8*)(&Kh[(size_t)((k0) + sr) * LDK + sc]); sr_[i].ks1 = *(const bf16x8*)(&Kh[(size_t)((k0) + 32 + sr) * LDK + sc]); } while (0)
#define SWRITE(b, i) do { *(bf16x8*)(V_lds + (b) * SHM_V + vst0) = sr_[i].vs0;          \
    *(bf16x8*)(V_lds + (b) * SHM_V + vst1) = sr_[i].vs1; const int kc = sc * 2;               \
    *(bf16x8*)(K_lds + (b) * SHM_K + KSWZ(sr, kc)) = sr_[i].ks0;                       \
    *(bf16x8*)(K_lds + (b) * SHM_K + KSWZ(32 + sr, kc)) = sr_[i].ks1; } while (0)
#define SWAIT() asm volatile("s_waitcnt vmcnt(4)" ::: "memory")
#define RESC(a) do { if (__any((a) < 1.f)) { if (hi == 0) al_l[r32] = (a); asm volatile("s_waitcnt lgkmcnt(0)" ::: "memory"); \
    _Pragma("unroll") for (int d = 0; d < 4; ++d) _Pragma("unroll") for (int r = 0; r < 16; ++r) o[d][r] *= al_l[crow(r, hi)]; } } while (0)
  f32x16 pA0, pA1, pB0, pB1; float mnA, mnB, alA, alB; bf16x8 pa0, pa1, pa2, pa3;
  constexpr int NT = 4, SE = 0, SO = 1;
  SLOAD(SE, 0); asm volatile("s_waitcnt vmcnt(0)" ::: "memory"); SWRITE(0, SE); __syncthreads();
  qkt(pA0, pA1, K_lds, qr, r32, hi); if (own) mask_tile(pA0, pA1, 0, myrow, hi); partialSM(pA0, pA1, m_reg, mnA, alA);
  SLOAD(SO, KVBLK); SLOAD(SE, 2 * KVBLK);
  SWAIT(); SWRITE(1, SO); __syncthreads();
  {
    SBAR(); qkt(pB0, pB1, K_lds + SHM_K, qr, r32, hi); if (own) mask_tile(pB0, pB1, 1, myrow, hi);
    finishSM(pA0, pA1, alA, l_reg, pa0, pa1, pa2, pa3); SBAR();
    SLOAD(SO, 3 * KVBLK); SBAR();
    pv_d0(o, vb0, pa0, pa1, pa2, pa3); partialSM(pB0, pB1, m_reg, mnB, alB);
    __syncthreads(); SWAIT(); SWRITE(0, SE);
    RESC(alB); __syncthreads();
    SBAR(); qkt(pA0, pA1, K_lds, qr, r32, hi); if (own) mask_tile(pA0, pA1, 2, myrow, hi);
    finishSM(pB0, pB1, alB, l_reg, pa0, pa1, pa2, pa3); SBAR();
    pv_d0(o, vb0 + (int)SHM_V, pa0, pa1, pa2, pa3); partialSM(pA0, pA1, m_reg, mnA, alA);
    __syncthreads(); asm volatile("s_waitcnt vmcnt(0)" ::: "memory"); SWRITE(1, SO);
    RESC(alA); __syncthreads();
  }
  SBAR(); qkt(pB0, pB1, K_lds + SHM_K, qr, r32, hi); if (own) mask_tile(pB0, pB1, 3, myrow, hi);
  finishSM(pA0, pA1, alA, l_reg, pa0, pa1, pa2, pa3); SBAR();
  pv_d0(o, vb0, pa0, pa1, pa2, pa3); partialSM(pB0, pB1, m_reg, mnB, alB);
  __syncthreads(); RESC(alB);
  finishSM(pB0, pB1, alB, l_reg, pa0, pa1, pa2, pa3); SBAR();
  pv_d0(o, vb0 + (int)SHM_V, pa0, pa1, pa2, pa3);
  __syncthreads();
  unsigned short* st = (unsigned short*)(lds + wid * 8192);
#pragma unroll
  for (int d0 = 0; d0 < 4; ++d0)
#pragma unroll
    for (int r = 0; r < 16; ++r) st[crow(r, hi) * 128 + 32 * d0 + r32] = (unsigned short)(cvtpk(o[d0][r], o[d0][r]) & 0xFFFFu);
  const int porow = valid ? ((q * 8 + h) * 4 + slot) : -1;
  if (hi == 0 && valid) { PML[(size_t)porow * 2] = m_reg * CEXP; PML[(size_t)porow * 2 + 1] = l_reg; }
  asm volatile("s_waitcnt lgkmcnt(0)" ::: "memory");
#pragma unroll
  for (int it = 0; it < 8; ++it) {
    const int row = it * 4 + (lane >> 4), ch = lane & 15;
    const int pr = __shfl(porow, row);
    const u32x4 vv = *(const u32x4*)(st + row * 128 + ch * 8);
    if (pr >= 0) *(u32x4*)(PO + (size_t)pr * 128 + ch * 8) = vv;
  }
  __syncthreads();
#undef SLOAD
#undef SWRITE
#undef SWAIT
#undef RESC
}

#ifndef ATT_PROBE
#define ATT_PROBE 0
#endif
constexpr int ATT2_QMAX = 768;
__device__ __forceinline__ void moba_item2(const bf16_t* __restrict__ proj, int h, int jblk, const unsigned* list, int nrows, int nown, bf16_t* PO, float* PML, char* lds,
                                           const unsigned* items, int nit, int nfront, unsigned nxt, unsigned (&dsc)[4], bool ldr) {
  const int tid = opq_tid(), wid = tid >> 6, lane = tid & 63, r32 = lane & 31, hi = lane >> 5;
  char* V_lds = lds; char* K_lds = lds + 65536;
  float* al_l = (float*)(lds + LDS_SCR + 4096) + wid * 32;
  unsigned short* st = (unsigned short*)(lds + LDS_SCR + 4096 + 1024 + wid * 2048);
  const int vb0 = (int)(uintptr_t)V_lds + v_rd_base(lane);
  const int no = nown >> 5, ngroups = no + ((nrows + 31) >> 5);
#define ENTRY(gg) (((gg) < no) ? (unsigned)(jblk * 256 + (gg) * 32 + r32) | (3u << 16) : list[(((gg) - no) * 32 + r32) < nrows ? (((gg) - no) * 32 + r32) : nrows - 1])
  unsigned e_cur = 0u, e_nxt = 0u; bf16x8 qrn[8];
  if (wid < ngroups) { e_cur = ENTRY(wid); if (wid + NW < ngroups) e_nxt = ENTRY(wid + NW); }
#if ATT_PROBE == 1
#pragma unroll 1
  for (int pr_ = 0; pr_ < 3; ++pr_)
#endif
  { const bf16_t* Kh = proj + ix_mk(h, jblk * 256); const bf16_t* Vh = proj + ix_mv(h, jblk * 256);
    const int sc = (tid & 15) * 8;
    bf16x8 kv[8], vv[8];
#pragma unroll
    for (int it = 0; it < 8; ++it) { const int key = it * 32 + (tid >> 4); kv[it] = *(const bf16x8*)(Kh + (size_t)key * 128 + sc); vv[it] = *(const bf16x8*)(Vh + (size_t)key * 128 + sc); }
    if (wid < ngroups) {
      const bf16_t* Qw = proj + ix_mq(h, (int)(e_cur & 0xFFFFu)) + hi * 8;
#pragma unroll
      for (int d0 = 0; d0 < 8; ++d0) qrn[d0] = *reinterpret_cast<const bf16x8*>(Qw + d0 * 16); }
    if (ldr && (int)nxt < nit) { const unsigned sl = (int)nxt < nfront ? nxt : 4095u - (nxt - (unsigned)nfront);
      dsc[0] = ldu(items + sl * 4); dsc[1] = ldu(items + sl * 4 + 1); dsc[2] = ldu(items + sl * 4 + 2); dsc[3] = ldu(items + sl * 4 + 3); }
#pragma unroll
    for (int it = 0; it < 8; ++it) { const int key = it * 32 + (tid >> 4), tl = key >> 6, kr = key & 63;
      *(bf16x8*)(K_lds + tl * 16384 + KSWZ(kr, sc * 2)) = kv[it]; *(bf16x8*)(V_lds + tl * 16384 + v_st(kr, sc)) = vv[it]; }
#if ATT_PROBE == 1
    __syncthreads();
#endif
  }
  __syncthreads();
  for (int g = wid; g < ngroups; g += NW) {
    const bool own = g < no;
    const int myrow = (own ? g : g - no) * 32 + r32;
    const int q = (int)(e_cur & 0xFFFFu), slot = (int)(e_cur >> 16); const bool valid = own || myrow < nrows;
    bf16x8 qr[8];
#pragma unroll
    for (int d0 = 0; d0 < 8; ++d0) qr[d0] = qrn[d0];
    e_cur = e_nxt;
    if (g + NW < ngroups) {
      const bf16_t* Qw = proj + ix_mq(h, (int)(e_cur & 0xFFFFu)) + hi * 8;
#pragma unroll
      for (int d0 = 0; d0 < 8; ++d0) qrn[d0] = *reinterpret_cast<const bf16x8*>(Qw + d0 * 16);
      if (g + 2 * NW < ngroups) e_nxt = ENTRY(g + 2 * NW); }
    float m_reg = -1e30f, l_reg = 0.f; f32x16 o[4] = {};
    const int ntile = own ? ((g * 32 + 31) >> 6) + 1 : 4;
#if ATT_PROBE == 2
#pragma unroll 1
    for (int pr_ = 0; pr_ < 2; ++pr_) {
    if (pr_ == 1) { m_reg = -1e30f; l_reg = 0.f; o[0] = f32x16{}; o[1] = f32x16{}; o[2] = f32x16{}; o[3] = f32x16{}; }
#endif
    for (int tl = 0; tl < ntile; ++tl) {
      f32x16 p0, p1; float mn, alpha; bf16x8 pa0, pa1, pa2, pa3;
      qkt(p0, p1, K_lds + tl * 16384, qr, r32, hi);
      if (own) mask_tile(p0, p1, tl, myrow, hi);
      partialSM(p0, p1, m_reg, mn, alpha);
      if (__any(alpha < 1.f)) { if (hi == 0) al_l[r32] = alpha; asm volatile("s_waitcnt lgkmcnt(0)" ::: "memory");
#pragma unroll
        for (int d = 0; d < 4; ++d)
#pragma unroll
          for (int r = 0; r < 16; ++r) o[d][r] *= al_l[crow(r, hi)]; }
      finishSM(p0, p1, alpha, l_reg, pa0, pa1, pa2, pa3); SBAR();
      pv_d0(o, vb0 + tl * 16384, pa0, pa1, pa2, pa3);
    }
#if ATT_PROBE == 2
    }
#endif
    const int porow = valid ? ((q * 8 + h) * 4 + slot) : -1;
    if (hi == 0 && valid) { PML[(size_t)porow * 2] = m_reg * CEXP; PML[(size_t)porow * 2 + 1] = l_reg; }
    const int pr = __shfl(porow, lane >> 1);
#if PO8
    if (hi == 0) al_l[r32] = __builtin_amdgcn_rcpf(l_reg) * (float)(1 << PO8_SH);
    asm volatile("s_waitcnt lgkmcnt(0)" ::: "memory");
    float rl_[16];
#pragma unroll
    for (int r = 0; r < 16; ++r) rl_[r] = al_l[crow(r, hi)];
    unsigned char* st8 = (unsigned char*)st;
#pragma unroll
    for (int d0 = 0; d0 < 4; ++d0) {
#pragma unroll
      for (int r = 0; r < 16; r += 2) { const unsigned w = (unsigned)__builtin_amdgcn_cvt_pk_fp8_f32(o[d0][r] * rl_[r], o[d0][r + 1] * rl_[r + 1], 0, false);
        st8[crow(r, hi) * 32 + r32] = (unsigned char)w; st8[crow(r + 1, hi) * 32 + r32] = (unsigned char)(w >> 8); }
      asm volatile("s_waitcnt lgkmcnt(0)" ::: "memory");
      const u32x4 a = *(const u32x4*)(st8 + (lane >> 1) * 32 + (lane & 1) * 16);
      if (pr >= 0) *(u32x4*)((unsigned char*)PO + (size_t)pr * 128 + 32 * d0 + (lane & 1) * 16) = a;
      asm volatile("s_waitcnt lgkmcnt(0)" ::: "memory");
    }
#else
#pragma unroll
    for (int d0 = 0; d0 < 4; ++d0) {
#pragma unroll
      for (int r = 0; r < 16; ++r) st[crow(r, hi) * 32 + r32] = (unsigned short)(cvtpk(o[d0][r], o[d0][r]) & 0xFFFFu);
      asm volatile("s_waitcnt lgkmcnt(0)" ::: "memory");
      const u32x4 a = *(const u32x4*)(st + (lane >> 1) * 32 + (lane & 1) * 16), b = *(const u32x4*)(st + (lane >> 1) * 32 + (lane & 1) * 16 + 8);
      if (pr >= 0) { *(u32x4*)(PO + (size_t)pr * 128 + 32 * d0 + (lane & 1) * 16) = a; *(u32x4*)(PO + (size_t)pr * 128 + 32 * d0 + (lane & 1) * 16 + 8) = b; }
      asm volatile("s_waitcnt lgkmcnt(0)" ::: "memory");
    }
#endif
  }
  __syncthreads();
#undef ENTRY
}
#undef KSWZ
#undef SBAR
}

static __device__ void moba_combine(const Params& p) {
    const bf16_t* PO = (const bf16_t*)(p.ws + WS_PO); const float* PML = (const float*)(p.ws + WS_PML); bf16_t* mix = (bf16_t*)(p.ws + WS_MIX);
    const int stride = (int)gridDim.x * NTHR;
    for (int base = blockIdx.x * NTHR + opq_tid(); base < T * 8 * 16; base += 4 * stride) {
        u32x4 po[4][4]; f32x2 ml[4][4];
#pragma unroll
        for (int u = 0; u < 4; ++u) { const int idx = base + u * stride, ch = idx & 15, qh = idx >> 4, qb = qh >> 11, nv = qb < 3 ? qb : 3;
#pragma unroll
            for (int k = 0; k < 4; ++k) { const bool ok = (k == 3) || (k < nv);
                ml[u][k] = (f32x2){-3.0e38f, 0.f}; po[u][k] = (u32x4){0u, 0u, 0u, 0u};
#if PO8
                if (ok) { ml[u][k] = *(const f32x2*)(PML + ((size_t)qh * 4 + k) * 2); const u32x2 t8 = *(const u32x2*)((const unsigned char*)PO + ((size_t)qh * 4 + k) * 128 + ch * 8); po[u][k].x = t8.x; po[u][k].y = t8.y; } } }
#else
                if (ok) { ml[u][k] = *(const f32x2*)(PML + ((size_t)qh * 4 + k) * 2); po[u][k] = *(const u32x4*)(PO + ((size_t)qh * 4 + k) * 128 + ch * 8); } } }
#endif
#pragma unroll
        for (int u = 0; u < 4; ++u) { const int idx = base + u * stride, ch = idx & 15, qh = idx >> 4, q = qh >> 3, h = qh & 7;
            float M = -3.0e38f;
#pragma unroll
            for (int k = 0; k < 4; ++k) M = fmaxf(M, ml[u][k][0]);
            float o[8], L = 0.f;
#pragma unroll
            for (int i = 0; i < 8; ++i) o[i] = 0.f;
#pragma unroll
#if PO8
            for (int k = 0; k < 4; ++k) { const float wl = __builtin_amdgcn_exp2f(ml[u][k][0] - M) * ml[u][k][1]; L += wl; const float w = wl * (1.0f / (float)(1 << PO8_SH)); float f[8];
                const f32x2 f01 = __builtin_amdgcn_cvt_pk_f32_fp8((int)po[u][k].x, false), f23 = __builtin_amdgcn_cvt_pk_f32_fp8((int)po[u][k].x, true), f45 = __builtin_amdgcn_cvt_pk_f32_fp8((int)po[u][k].y, false), f67 = __builtin_amdgcn_cvt_pk_f32_fp8((int)po[u][k].y, true);
                f[0] = f01[0]; f[1] = f01[1]; f[2] = f23[0]; f[3] = f23[1]; f[4] = f45[0]; f[5] = f45[1]; f[6] = f67[0]; f[7] = f67[1];
#pragma unroll
                for (int i = 0; i < 8; ++i) o[i] += w * f[i]; }
#else
            for (int k = 0; k < 4; ++k) { const float w = __builtin_amdgcn_exp2f(ml[u][k][0] - M); L += w * ml[u][k][1]; float f[8]; unpack8(po[u][k], f);
#pragma unroll
                for (int i = 0; i < 8; ++i) o[i] += w * f[i]; }
#endif
            const float rl = 1.0f / L;
#pragma unroll
            for (int i = 0; i < 8; ++i) o[i] *= rl;
#if OUT8
            { u32x2 w8; w8.x = pk4_fp8(o[0] * (float)(1 << MIX8_SH), o[1] * (float)(1 << MIX8_SH), o[2] * (float)(1 << MIX8_SH), o[3] * (float)(1 << MIX8_SH));
              w8.y = pk4_fp8(o[4] * (float)(1 << MIX8_SH), o[5] * (float)(1 << MIX8_SH), o[6] * (float)(1 << MIX8_SH), o[7] * (float)(1 << MIX8_SH));
              *(u32x2*)((unsigned char*)mix + (size_t)q * DM + 1024 + h * 128 + ch * 8) = w8; } }
#else
            *(u32x4*)(mix + (size_t)q * DM + 1024 + h * 128 + ch * 8) = pack8(o); }
#endif
    }
}
#ifndef DBL_MASK
#define DBL_MASK 0
#endif
#define REP(k) for (int rep_ = 0; rep_ < (((DBL_MASK >> (k)) & 1) ? 2 : 1); ++rep_)
#ifndef NCV
#define NCV 0
#endif
#ifndef PROBE_MASK
#define PROBE_MASK 0
#endif
#ifndef PHMASK
#define PHMASK 0xFFFF
#endif
enum { PH_CVT = 0, PH_INPROJ, PH_MIXA, PH_MIXB, PH_MIXC, PH_ATT, PH_COMB, PH_OUTPROJ, PH_LN1, PH_PERM, PH_MOE1, PH_MOE2, PH_LN2, NPH };
constexpr int NSLOT = 2 * NPH;
#ifndef MK_DEBUG
#define MK_DEBUG 0
#endif
#if MK_DEBUG
#include "part_chk.inc"
#endif

__device__ __forceinline__ Params opq_params(const Params& p) {
#if !defined(__HIP_DEVICE_COMPILE__)
    return p;
#else
    const __attribute__((address_space(4))) Params* kp = (const __attribute__((address_space(4))) Params*)__builtin_amdgcn_kernarg_segment_ptr();
    asm volatile("" : "+s"(kp));
    return *kp;
#endif
}
#ifndef SUBREP_MASK
#define SUBREP_MASK 0
#endif
#define SUBREP(k) (((SUBREP_MASK >> (k)) & 1) ? 2 : 1)
#ifndef CVT_REPS
#define CVT_REPS 1
#endif
__global__ void __launch_bounds__(NTHR, 2) mk_fwd(Params p) {
    extern __shared__ __attribute__((aligned(16))) unsigned char lds[];
    const int tid = threadIdx.x;
    for (int u = tid; u < (LDS_BYTES - LDS_SCR) / 4; u += NTHR) ((unsigned*)(lds + LDS_SCR))[u] = 0u;
    __syncthreads();
    unsigned* ctl = (unsigned*)(p.ws + WS_CTL);
    XcdBarrier bar; bar.bar = ctl + CW_BAR; bar.x = 0; bar.st = (volatile LAS unsigned*)(lds + LDS_SCR + 32);
    constexpr int STEP = 2;
    if (p.g_hi - p.g_lo > STEP) bar = xcd_barrier_post(ctl + CW_BAR, (volatile LAS unsigned*)(lds + LDS_SCR + 32));
    if (p.g_hi - p.g_lo > STEP) xcd_barrier_census(bar);
    const int G = (int)gridDim.x, bx = (int)blockIdx.x;
    PG8_LAS unsigned char* lds3 = (PG8_LAS unsigned char*)lds;

#if PROBE_MASK
    unsigned long long tacc = 0ull, tprev = __builtin_amdgcn_s_memrealtime();
#endif
    for (int layer = -1; layer < NLAYER; ++layer) {
        const int s0 = (layer + 1) * NSLOT;
#define IN(k) (((PHMASK >> (k)) & 1) && (layer >= 0 || (k) <= PH_INPROJ) && p.g_lo <= s0 + 2 * (k) && s0 + 2 * (k) < p.g_hi)
#if PROBE_MASK
#define SEAM(k) do { xcd_barrier(bar); if (bx == 0 && tid == 0) { const unsigned long long now = __builtin_amdgcn_s_memrealtime(); if ((PROBE_MASK >> (k)) & 1) tacc += now - tprev; tprev = now; } } while (0)
#else
#ifndef BAR2
#define BAR2 0
#endif
#define SEAM(k) do { if (s0 + 2 * (k) + STEP < p.g_hi) { xcd_barrier(bar); if ((BAR2 >> (k)) & 1) xcd_barrier(bar); } } while (0)
#endif
        if (IN(PH_CVT)) { if (layer < 0) { const Params q = opq_params(p); phase_rope(q); phase_rows<0>(q, 0, lds); } }
        if (IN(PH_INPROJ)) REP(PH_INPROJ) { const Params q = opq_params(p);
#pragma unroll 1
            for (int stp = 0; stp < 2; ++stp) {
                const bool cv = (layer < 0) ? (stp == 0) : (((bx & 1) != 0) == (stp == 0));
                if (cv) { if (rep_ == 0) {
_Pragma("unroll 1")
                    for (int r2_ = 0; r2_ < CVT_REPS; ++r2_) phase_cvt<false, 7>(q, layer < 0 ? 0 : layer, layer < 0 ? 0 : 256, layer < 0 ? 256 : 1024, bx, G, lds); } }
                else if (layer >= 0) {
                    pg8::Gemm g{(const bf16_t*)(q.ws + WS_HBQ), (const bf16_t*)(q.ws + ((layer & 1) ? WS_WIN2 : WS_WIN)), T, NPROJ, DM / 2, 127 - WIN8_SH, 127 - X8_SH}; pg8::StaticOrder S; S.init(T, NPROJ, G, bx);
                    pg8::EpiProj E{(bf16_t*)(q.ws + WS_PROJ), (const float*)(q.ws + WS_ROPE), (const float*)(q.ws + WS_ROPE) + (size_t)T * 64};
                    pg8::gemm_phase<pg8::EpiProj, pg8::StaticOrder, true, true, true>(lds3, g, S, E);
                }
            }
            SEAM(PH_INPROJ); }
        if (IN(PH_MIXA)) REP(PH_MIXA) { const Params q = opq_params(p);
            for (int u = bx; u < 768; u += G) { if (u < 256) { _Pragma("unroll 1") for (int r_ = 0; r_ < SUBREP(0); ++r_) gla_super_unit<false>(q, layer, u >> 2, u & 3, lds); } else { _Pragma("unroll 1") for (int r_ = 0; r_ < SUBREP(1); ++r_) moba_kmean_unit(q, (u - 256) >> 6, (u - 256) & 63, lds); } }
            SEAM(PH_MIXA); }
        if (IN(PH_MIXB)) REP(PH_MIXB) { const Params q = opq_params(p);
            { _Pragma("unroll 1") for (int r_ = 0; r_ < SUBREP(2); ++r_) gla_scan(q, bx, G, lds); }
            { int kk = 0; for (int u = bx; u < 512; u += G, ++kk) { const int q0 = u & 63; _Pragma("unroll 1") for (int r_ = 0; r_ < SUBREP(3); ++r_) moba_gate_unit(q, u >> 6, (kk & 1) ? 63 - q0 : q0, lds); } }
            SEAM(PH_MIXB); }
        if (IN(PH_MIXC)) REP(PH_MIXC) { const Params q = opq_params(p);
            for (int u = bx; u < 768; u += G) { if (u < 256) { _Pragma("unroll 1") for (int r_ = 0; r_ < SUBREP(4); ++r_) gla_super_unit<true>(q, layer, u >> 2, u & 3, lds); } else if (rep_ == 0) { const int v = u - 256, j0 = v & 63; moba_list_unit(q, layer, v >> 6, ((v / G) & 1) ? 63 - j0 : j0, lds); } }
            SEAM(PH_MIXC); }
        if (IN(PH_ATT)) REP(PH_ATT) { const Params q = opq_params(p);
            const int nit = __builtin_amdgcn_readfirstlane((int)ldu(ctl + CW_NIT + layer * 64));
            const int nfront = __builtin_amdgcn_readfirstlane((int)ldu(ctl + CW_NIT + layer * 64 + 1));
            const unsigned* items = (const unsigned*)(q.ws + WS_ITEMS) + layer * 4096 * 4;
            unsigned* qhead = ctl + CW_NIT + layer * 64 + 16 + rep_;
            volatile LAS unsigned* qslot = (volatile LAS unsigned*)(lds + LDS_SCR + 64);
            const int qt = opq_tid();
            if (qt == 0) { const unsigned f = atomicAdd(qhead, 1u); qslot[0] = f;
                if ((int)f < nit) { const unsigned sl = (int)f < nfront ? f : 4095u - (f - (unsigned)nfront); qslot[1] = ldu(items + sl * 4); qslot[2] = ldu(items + sl * 4 + 1); qslot[3] = ldu(items + sl * 4 + 2); qslot[4] = ldu(items + sl * 4 + 3); } }
            __syncthreads();
            int it = __builtin_amdgcn_readfirstlane((int)qslot[0]);
            while (it < nit) {
                const int h = __builtin_amdgcn_readfirstlane((int)qslot[1]), j = __builtin_amdgcn_readfirstlane((int)qslot[2]), c = __builtin_amdgcn_readfirstlane((int)qslot[3]), n = __builtin_amdgcn_readfirstlane((int)qslot[4]);
                unsigned nxt = 0u, dsc[4] = {0u, 0u, 0u, 0u};
                if (qt == 0) nxt = atomicAdd(qhead, 1u);
                const unsigned* list = (const unsigned*)(q.ws + WS_LIST) + (size_t)h * LISTH + list_off(j) + c * ATT_QMAX;
                const int rem = n - c * ATT_QMAX, nrows = rem < 0 ? 0 : (rem < ATT_QMAX ? rem : ATT_QMAX);
                __syncthreads();
                att::moba_item2((bf16_t*)(q.ws + WS_PROJ), h, j, list, nrows, c == 0 ? 256 : 0, (bf16_t*)(q.ws + WS_PO), (float*)(q.ws + WS_PML), (char*)lds, items, nit, nfront, nxt, dsc, qt == 0);
                if (qt == 0) { qslot[0] = nxt; qslot[1] = dsc[0]; qslot[2] = dsc[1]; qslot[3] = dsc[2]; qslot[4] = dsc[3]; }
                __syncthreads();
                it = __builtin_amdgcn_readfirstlane((int)qslot[0]);
            }
            SEAM(PH_ATT); }
        if (IN(PH_COMB)) REP(PH_COMB) { const Params q = opq_params(p); moba_combine(q); SEAM(PH_COMB); }
        if (IN(PH_OUTPROJ)) REP(PH_OUTPROJ) { const Params q = opq_params(p);
#if OUT8
            pg8::Gemm g{(const bf16_t*)(q.ws + WS_MIX), (const bf16_t*)(q.ws + WS_WO), T, DM, DM / 2, 127 - WO8_SH, 127 - MIX8_SH}; pg8::StaticOrder S; S.init(T, DM, G, bx);
#else
            pg8::Gemm g{(const bf16_t*)(q.ws + WS_MIX), (const bf16_t*)(q.ws + WS_WO), T, DM, DM}; pg8::StaticOrder S; S.init(T, DM, G, bx);
#endif
            pg8::EpiOut E{layer == 0 ? q.in[0] : nullptr, (const bf16_t*)(q.ws + WS_HB), (bf16_t*)(q.ws + WS_PRE), DN_ALPHA};
            pg8::gemm_phase<pg8::EpiOut, pg8::StaticOrder, true, true, OUT8 != 0>(lds3, g, S, E);
            SEAM(PH_OUTPROJ); }
#ifndef LNPROBE
#define LNPROBE 0
#endif
        if (IN(PH_LN1)) { const Params q = opq_params(p); if (LNPROBE & 1) { phase_rows<1, true>(q, layer, lds); SEAM(PH_LN1); } phase_rows<1>(q, layer, lds); SEAM(PH_LN1); }
        if (IN(PH_MOE1)) REP(PH_MOE1) { const Params q = opq_params(p);
            int* sbm = (int*)(lds + LDS_SCR + 128);
            moe_bases(ctl + CW_CNT + layer * 64, sbm);
            const int np = __builtin_amdgcn_readfirstlane(sbm[16]) >> 8;
            pg8::Gemm g{(const bf16_t*)(q.ws + WS_HB8), (const bf16_t*)(q.ws + WS_WGU), np * 256, 2048, DM / 2, 127 - WGU8_SH, 127 - X8_SH}; pg8::MoeOrder S; S.init(np * 256, 2048, G, bx); S.sb = sbm; S.idx = (const unsigned*)(q.ws + WS_IDX); S.rowbytes = DM;
            pg8::EpiGU E{q.ws + WS_HS};
            pg8::gemm_phase<pg8::EpiGU, pg8::MoeOrder, true, true, true, true>(lds3, g, S, E);
            if (rep_ == 0) phase_cvt<true, 8>(q, layer, 1280, 512, 0, 1, lds, ctl + CW_CVQ + layer * 64);
            SEAM(PH_MOE1); }
        if (IN(PH_MOE2)) REP(PH_MOE2) { const Params q = opq_params(p);
            int* sbm = (int*)(lds + LDS_SCR + 128);
            moe_bases(ctl + CW_CNT + layer * 64, sbm);
            const int np = __builtin_amdgcn_readfirstlane(sbm[16]) >> 8;
            pg8::Gemm g{(const bf16_t*)(q.ws + WS_HS), (const bf16_t*)(q.ws + WS_WD), np * 256, 2048, DEXP / 2, 127 - WD8_SH, 127 - H8_SH}; pg8::MoeOrder S; S.init(np * 256, 2048, G, bx); S.sb = sbm; S.idx = (const unsigned*)(q.ws + WS_IDX); S.rowbytes = DEXP;
            pg8::EpiY E{(bf16_t*)(q.ws + WS_YS)};
            pg8::gemm_phase<pg8::EpiY, pg8::MoeOrder, true, true, true>(lds3, g, S, E);
            if (rep_ == 0 && layer + 1 < NLAYER) phase_cvt<true, 3>(q, layer + 1, 0, 256, 0, 1, lds, ctl + CW_CVQ + layer * 64 + 16);
            SEAM(PH_MOE2); }
        if (IN(PH_LN2)) { const Params q = opq_params(p); if (LNPROBE & 2) { phase_rows<2, true>(q, layer, lds); xcd_barrier(bar); } phase_rows<2>(q, layer, lds); SEAM(PH_LN2); }
#undef IN
#undef SEAM
    }
#if PROBE_MASK
    if (bx == 0 && tid == 0) __hip_atomic_store(ctl + CW_DBG, (unsigned)tacc, __ATOMIC_RELAXED, __HIP_MEMORY_SCOPE_AGENT);
    xcd_barrier(bar);
    { const float sc = 1.0f + (float)ldu(ctl + CW_DBG) * (1.0f / 40000.0f);
      for (size_t i = (size_t)bx * NTHR + tid; i < (size_t)T * DM / 4; i += (size_t)G * NTHR) { f32x4 v = ((f32x4*)p.out)[i]; ((f32x4*)p.out)[i] = v * sc; } }
#endif
}

#if MK_DEBUG
__global__ void __launch_bounds__(NTHR, 2) mk_chk(Params p, int layer, int k) { if (k >= 0) chk_phase(p, layer, k); else chk_final(p); }
#endif
#ifndef MK_ONE_LAUNCH
#define MK_ONE_LAUNCH 1
#endif
extern "C" void kernel_launch(void* const* d_in, const int* in_sizes, int n_in, void* d_out, int out_size, void* d_ws, size_t ws_size, hipStream_t stream) {
    static int grid = 0;
    if (grid == 0) {
        if (n_in != 16 || in_sizes[0] != T * DM || out_size != T * DM || ws_size < WS_END) {
            fprintf(stderr, "kernel_launch: unexpected problem: n_in %d in0 %d out %d ws %zu (need >= %zu); nothing launched\n", n_in, n_in > 0 ? in_sizes[0] : -1, out_size, ws_size, (size_t)WS_END); grid = -1; return; }
        int dev = 0, cus = 0, per_cu = 0;
        if (hipGetDevice(&dev) != hipSuccess || hipDeviceGetAttribute(&cus, hipDeviceAttributeMultiprocessorCount, dev) != hipSuccess) { grid = -1; return; }
        if (hipFuncSetAttribute((const void*)mk_fwd, hipFuncAttributeMaxDynamicSharedMemorySize, LDS_BYTES) != hipSuccess) { fprintf(stderr, "kernel_launch: hipFuncSetAttribute failed\n"); grid = -1; return; }
        if (hipOccupancyMaxActiveBlocksPerMultiprocessor(&per_cu, (const void*)mk_fwd, NTHR, LDS_BYTES) != hipSuccess || per_cu < 1)
            fprintf(stderr, "kernel_launch: note: occupancy query reports %d blocks per CU\n", per_cu);
        (void)hipGetLastError();
        grid = cus;
        if (grid != 256) fprintf(stderr, "kernel_launch: note: %d CUs (row phases assume the grid divides 2048 row groups)\n", grid);
        if (2048 % grid != 0) grid = 256;
    }
    if (grid < 0) return;
    if (hipMemsetAsync((char*)d_ws + WS_CTL, 0, CTL_BYTES, stream) != hipSuccess) return;
    Params p{};
    for (int i = 0; i < 16; ++i) p.in[i] = (const float*)d_in[i];
    p.out = (float*)d_out; p.ws = (unsigned char*)d_ws;
#if MK_ONE_LAUNCH
    p.g_lo = 0; p.g_hi = (NLAYER + 1) * NSLOT;
    hipLaunchKernelGGL(mk_fwd, dim3(grid), dim3(NTHR), LDS_BYTES, stream, p);
#else
    for (int s = 0; s < (NLAYER + 1) * NSLOT; s += 2) { p.g_lo = s; p.g_hi = s + 1; hipLaunchKernelGGL(mk_fwd, dim3(grid), dim3(NTHR), LDS_BYTES, stream, p);
#if MK_DEBUG
        if (s >= NSLOT) hipLaunchKernelGGL(mk_chk, dim3(8), dim3(NTHR), 0, stream, p, s / NSLOT - 1, (s % NSLOT) / 2);
#endif
    }
#if MK_DEBUG
    hipLaunchKernelGGL(mk_chk, dim3(grid), dim3(NTHR), 0, stream, p, 0, -1);
#endif
#endif
    const hipError_t le = hipPeekAtLastError();
    if (le != hipSuccess) fprintf(stderr, "kernel_launch: launch failed: %s\n", hipGetErrorName(le));
}
```

```cpp
#define MK_DEBUG 0
#define MK_ONE_LAUNCH 1
#define RECOMP 0
#include <hip/hip_runtime.h>
#include <cstdio>
#include <cstdint>
__device__ __forceinline__ int opq_tid() { int t = (int)threadIdx.x; asm volatile("" : "+v"(t)); return t; }
#ifndef EPI_PROBE
#define EPI_PROBE 0
#endif
namespace pg8 {
#define PG8_LAS __attribute__((address_space(3)))
typedef unsigned short bf16_t;
typedef short bf16x8 __attribute__((ext_vector_type(8)));
typedef float f32x4 __attribute__((ext_vector_type(4)));
typedef unsigned u32x4 __attribute__((ext_vector_type(4)));
constexpr int BM = 256, BK = 64, HALF = 128, HTB = HALF * BK * 2  , STAGE_BYTES = 8 * HTB, NXCD = 8, WGM = 8;

__host__ __device__ __forceinline__ int lds_byte(int r, int c) { const int st = (r >> 4) * 2 + (c >> 5), rr = r & 15, cc = c & 31, ob = rr * 64 + cc * 2; return st * 1024 + (ob ^ (((ob >> 9) & 1) << 5)); }
__host__ __device__ __forceinline__ void stage_rc(int b, int& R, int& C) { const int st = b / 1024, sb = b % 1024, swz = sb ^ (((sb >> 9) & 1) << 5); R = (st >> 1) * 16 + swz / 64; C = (st & 1) * 32 + (swz % 64) / 2; }
__host__ __device__ __forceinline__ int perm32(int rho) { const int n = rho >> 4, i = rho & 15; return 8 * (i >> 2) + 4 * n + (i & 3); }

struct Unit { int pm, pn; };
struct Gemm { const bf16_t* A; const bf16_t* Bt; int M, N, K; int sa, sb; };

struct StaticOrder {
    int nM, nN, nwg, G, c;
    __host__ __device__ void init(int M, int N, int G_, int c_) { nM = M / BM; nN = N / BM; nwg = nM * nN; G = G_; c = c_; }
    __host__ __device__ bool next(int i, Unit& u) const {
        const long L = (long)i * G + c; if (L >= nwg) return false;
        int wgid = (int)L; { const int q = nwg / NXCD, r = nwg % NXCD, xcd = wgid % NXCD, off = wgid / NXCD; wgid = (xcd < r ? xcd * (q + 1) : r * (q + 1) + (xcd - r) * q) + off; }
        const int nig = WGM * nN, gid = wgid / nig, fm = gid * WGM, gsz = (nM - fm) < WGM ? (nM - fm) : WGM;
        u.pm = fm + ((wgid % nig) % gsz); u.pn = (wgid % nig) / gsz; return true;
    }
    __device__ __forceinline__ void a_ready(const Unit&) const {}
    __device__ __forceinline__ void done(const Unit&) const {}
    __device__ __forceinline__ unsigned arow(const Unit&, int) const { return 0u; }
};
__device__ __forceinline__ unsigned cvt_pk_bf16(float lo, float hi) { unsigned r; asm volatile("v_cvt_pk_bf16_f32 %0, %1, %2" : "=v"(r) : "v"(lo), "v"(hi)); return r; }

typedef int v8i32 __attribute__((ext_vector_type(8)));
typedef int v4i32 __attribute__((ext_vector_type(4)));
__device__ __forceinline__ v8i32 cat8(bf16x8 lo, bf16x8 hi) { const v4i32 a = __builtin_bit_cast(v4i32, lo), b = __builtin_bit_cast(v4i32, hi); return __builtin_shufflevector(a, b, 0, 1, 2, 3, 4, 5, 6, 7); }
template <class Epi, class Sched, bool ALIGN_EPI = false, bool SP2 = false, bool FP8 = false, bool GATHER = false>
__device__ __forceinline__ void gemm_phase(PG8_LAS unsigned char* lds, const Gemm g, const Sched& S, const Epi& E) {
    const int tid = opq_tid(), wid = __builtin_amdgcn_readfirstlane(tid >> 6), lane = tid & 63, wr = wid >> 2, wc = wid & 3, fr = lane & 15, fq = lane >> 4;
    int Kq = g.K; asm volatile("" : "+s"(Kq));
    const int K = Kq, nt = K / BK;
    unsigned voffA[2], voffB[2];
#pragma unroll
    for (int i = 0; i < 2; ++i) { int R, C; stage_rc(tid * 16 + i * 8192, R, C); const int Rb = Epi::PERM ? ((R & ~31) + perm32(R & 31)) : R;
        voffA[i] = (unsigned)(R * K + C) * 2u; voffB[i] = (unsigned)(Rb * K + C) * 2u; }
    unsigned va[2][2] = {{0u, 0u}, {0u, 0u}};
    PG8_LAS unsigned* vnl = (PG8_LAS unsigned*)(lds + STAGE_BYTES + 8192) + tid * 4;
#define PG8_GCALC(v, u) do { _Pragma("unroll") for (int _h = 0; _h < 2; ++_h) _Pragma("unroll") for (int _i = 0; _i < 2; ++_i) { int _R, _C; stage_rc(tid * 16 + _i * 8192, _R, _C); (v)[_h][_i] = S.arow((u), _h * HALF + _R) + (unsigned)_C * 2u; } } while (0)
#define PG8_STAGE_A(bufoff, gbase, h, v) do { if constexpr (GATHER) { _Pragma("unroll") for (int _i = 0; _i < 2; ++_i) \
        __builtin_amdgcn_global_load_lds((const unsigned*)((const char*)(gbase) + (v)[h][_i]), (PG8_LAS unsigned*)(lds + (bufoff) + ldsw + _i * 8192), 16, 0, 0); } \
        else { PG8_STAGE(bufoff, (gbase) + (h) * hstep, voffA); } } while (0)
    const size_t kstep = (size_t)(BK * 2);
    const size_t hstep = (size_t)HALF * K * 2;
    const size_t tstep = 2 * hstep;
    const unsigned ldsw = (unsigned)wid * 1024u;
    const int aoff = lds_byte(wr * 64 + fr, fq * 8), boff = lds_byte(wc * 32 + fr, fq * 8);
#define PG8_SA(b, h) (((b) * 2 + (h)) * HTB)
#define PG8_SB(b, h) ((4 + (b) * 2 + (h)) * HTB)
#define PG8_STAGE(bufoff, gbase, voff) do { _Pragma("unroll") for (int _i = 0; _i < 2; ++_i) \
        __builtin_amdgcn_global_load_lds((const unsigned*)((const char*)(gbase) + (voff)[_i]), (PG8_LAS unsigned*)(lds + (bufoff) + ldsw + _i * 8192), 16, 0, 0); } while (0)
#define PG8_LDA(dst, b, h) do { _Pragma("unroll") for (int m = 0; m < 4; ++m) _Pragma("unroll") for (int k = 0; k < 2; ++k) dst[m][k] = *(const PG8_LAS bf16x8*)(lds + PG8_SA(b, h) + aoff + m * 2048 + k * 1024); } while (0)
#define PG8_LDB(dst, b, h) do { _Pragma("unroll") for (int n = 0; n < 2; ++n) _Pragma("unroll") for (int k = 0; k < 2; ++k) dst[n][k] = *(const PG8_LAS bf16x8*)(lds + PG8_SB(b, h) + boff + n * 2048 + k * 1024); } while (0)
#define PG8_MMA(ai, bj, At, Bt) do { __builtin_amdgcn_s_setprio(1); _Pragma("unroll") for (int m = 0; m < 4; ++m) _Pragma("unroll") for (int n = 0; n < 2; ++n) { \
        if constexpr (FP8) { const v8i32 wq = cat8(Bt[n][0], Bt[n][1]), aq = cat8(At[m][0], At[m][1]); \
            asm volatile("s_nop 1\n\tv_mfma_scale_f32_16x16x128_f8f6f4 %0, %1, %2, %0, %3, %4 op_sel_hi:[0,0,0]" : "+v"(acc[ai][bj][m][n]) : "v"(wq), "v"(aq), "v"(g.sa), "v"(g.sb)); } \
        else { _Pragma("unroll") for (int k = 0; k < 2; ++k) acc[ai][bj][m][n] = __builtin_amdgcn_mfma_f32_16x16x32_bf16(Bt[n][k], At[m][k], acc[ai][bj][m][n], 0, 0, 0); } } \
        __builtin_amdgcn_s_setprio(0); } while (0)
#define PG8_WAIT_V(n) asm volatile("s_waitcnt vmcnt(" #n ")" ::: "memory")
#define PG8_WAIT_L(n) asm volatile("s_waitcnt lgkmcnt(" #n ")" ::: "memory")
#define PG8_BAR __builtin_amdgcn_s_barrier()
#define PG8_SCHED __builtin_amdgcn_sched_barrier(0)
    Unit cur, nxt; int ui = 0;
    if (!S.next(0, cur)) return;
    f32x4 acc[2][2][4][2];
#pragma unroll
    for (int a = 0; a < 2; ++a)
#pragma unroll
        for (int b = 0; b < 2; ++b)
#pragma unroll
            for (int m = 0; m < 4; ++m)
#pragma unroll
                for (int n = 0; n < 2; ++n) acc[a][b][m][n] = (f32x4){0.f, 0.f, 0.f, 0.f};
    bf16x8 At[4][2], B0[2][2], B1[2][2];
    const char* cA = (const char*)g.A + (GATHER ? (size_t)0 : (size_t)cur.pm * tstep); const char* cB = (const char*)g.Bt + (size_t)cur.pn * tstep;
    if constexpr (GATHER) PG8_GCALC(va, cur);
    S.a_ready(cur);
    if constexpr (SP2) {
        PG8_STAGE(PG8_SB(0, 0), cB, voffB); PG8_STAGE(PG8_SB(0, 1), cB + hstep, voffB); PG8_STAGE_A(PG8_SA(0, 0), cA, 0, va); PG8_STAGE_A(PG8_SA(0, 1), cA, 1, va);
        if (wr == 1) PG8_BAR;
        PG8_WAIT_V(2); PG8_BAR;
        PG8_STAGE(PG8_SB(1, 0), cB + kstep, voffB); PG8_STAGE_A(PG8_SA(1, 0), cA + kstep, 0, va); PG8_STAGE(PG8_SB(1, 1), cB + hstep + kstep, voffB);
        PG8_WAIT_V(6); PG8_BAR;
    } else {
        PG8_STAGE(PG8_SB(0, 0), cB, voffB); PG8_STAGE(PG8_SA(0, 0), cA, voffA); PG8_STAGE(PG8_SB(0, 1), cB + hstep, voffB); PG8_STAGE(PG8_SA(0, 1), cA + hstep, voffA);
        if (wr == 1) PG8_BAR;
        PG8_WAIT_V(4); PG8_BAR;
        PG8_STAGE(PG8_SB(1, 0), cB + kstep, voffB); PG8_STAGE(PG8_SA(1, 0), cA + kstep, voffA); PG8_STAGE(PG8_SB(1, 1), cB + hstep + kstep, voffB);
        PG8_WAIT_V(6); PG8_BAR;
    }
    for (;;) {
        const bool has_next = S.next(ui + 1, nxt);
        const char* nA = (has_next && !GATHER) ? (const char*)g.A + (size_t)nxt.pm * tstep : cA; const char* nB = has_next ? (const char*)g.Bt + (size_t)nxt.pn * tstep : cB;
        if constexpr (GATHER) { unsigned vn[2][2]; if (has_next) PG8_GCALC(vn, nxt); else { _Pragma("unroll") for (int _h = 0; _h < 2; ++_h) _Pragma("unroll") for (int _i = 0; _i < 2; ++_i) vn[_h][_i] = va[_h][_i]; }
            vnl[0] = vn[0][0]; vnl[1] = vn[0][1]; vnl[2] = vn[1][0]; vnl[3] = vn[1][1]; }
        for (int t = 0; t < nt; t += 2) {
            const bool last = (t == nt - 2);
            const char* a1 = cA + (size_t)(t + 1) * kstep;
            const char* a2 = last ? nA : cA + (size_t)(t + 2) * kstep; const char* b2 = last ? nB : cB + (size_t)(t + 2) * kstep;
            const char* a3 = a2 + kstep; const char* b3 = b2 + kstep;
            if (last && has_next) S.a_ready(nxt);
            unsigned v2[2][2];
            if constexpr (GATHER) { _Pragma("unroll") for (int _h = 0; _h < 2; ++_h) _Pragma("unroll") for (int _i = 0; _i < 2; ++_i) v2[_h][_i] = va[_h][_i];
                if (last) { v2[0][0] = vnl[0]; v2[0][1] = vnl[1]; v2[1][0] = vnl[2]; v2[1][1] = vnl[3]; } }
            if constexpr (SP2) {
            PG8_LDB(B0, 0, 0); PG8_LDB(B1, 0, 1); PG8_SCHED; PG8_LDA(At, 0, 0); PG8_STAGE_A(PG8_SA(1, 1), a1, 1, va);
            PG8_WAIT_V(8); PG8_WAIT_L(0); PG8_BAR; PG8_MMA(0, 0, At, B0); PG8_MMA(0, 1, At, B1); PG8_BAR; PG8_SCHED;
            PG8_LDA(At, 0, 1); PG8_STAGE(PG8_SB(0, 0), b2, voffB); PG8_STAGE(PG8_SB(0, 1), b2 + hstep, voffB); PG8_STAGE_A(PG8_SA(0, 0), a2, 0, v2);
            PG8_WAIT_V(8); PG8_WAIT_L(0); PG8_BAR; PG8_MMA(1, 0, At, B0); PG8_MMA(1, 1, At, B1); PG8_BAR; PG8_SCHED;
            PG8_LDB(B0, 1, 0); PG8_LDB(B1, 1, 1); PG8_SCHED; PG8_LDA(At, 1, 0); PG8_STAGE_A(PG8_SA(0, 1), a2, 1, v2);
            PG8_WAIT_V(8); PG8_WAIT_L(0); PG8_BAR; PG8_MMA(0, 0, At, B0); PG8_MMA(0, 1, At, B1); PG8_BAR; PG8_SCHED;
            PG8_LDA(At, 1, 1); PG8_STAGE(PG8_SB(1, 0), b3, voffB); PG8_STAGE(PG8_SB(1, 1), b3 + hstep, voffB); PG8_STAGE_A(PG8_SA(1, 0), a3, 0, v2);
            PG8_WAIT_V(8); PG8_WAIT_L(0); PG8_BAR; PG8_MMA(1, 0, At, B0); PG8_MMA(1, 1, At, B1); PG8_BAR; PG8_SCHED;
            } else {
            PG8_LDB(B0, 0, 0); PG8_SCHED; PG8_LDA(At, 0, 0); PG8_STAGE(PG8_SA(1, 1), a1 + hstep, voffA);
            PG8_WAIT_L(8); PG8_BAR; PG8_WAIT_L(0); PG8_MMA(0, 0, At, B0); PG8_BAR; PG8_SCHED;
            PG8_LDB(B1, 0, 1); PG8_STAGE(PG8_SB(0, 0), b2, voffB);
            PG8_BAR; PG8_WAIT_L(0); PG8_MMA(0, 1, At, B1); PG8_BAR;
            PG8_LDA(At, 0, 1); PG8_STAGE(PG8_SA(0, 0), a2, voffA);
            PG8_BAR; PG8_WAIT_L(0); PG8_MMA(1, 0, At, B0); PG8_BAR; PG8_SCHED;
            PG8_STAGE(PG8_SB(0, 1), b2 + hstep, voffB);
            PG8_WAIT_V(6); PG8_BAR; PG8_MMA(1, 1, At, B1); PG8_BAR;
            PG8_LDB(B0, 1, 0); PG8_SCHED; PG8_LDA(At, 1, 0); PG8_STAGE(PG8_SA(0, 1), a2 + hstep, voffA);
            PG8_WAIT_L(8); PG8_BAR; PG8_WAIT_L(0); PG8_MMA(0, 0, At, B0); PG8_BAR; PG8_SCHED;
            PG8_LDB(B1, 1, 1); PG8_STAGE(PG8_SB(1, 0), b3, voffB);
            PG8_BAR; PG8_WAIT_L(0); PG8_MMA(0, 1, At, B1); PG8_BAR;
            PG8_LDA(At, 1, 1); PG8_STAGE(PG8_SA(1, 0), a3, voffA);
            PG8_BAR; PG8_WAIT_L(0); PG8_MMA(1, 0, At, B0); PG8_BAR; PG8_SCHED;
            PG8_STAGE(PG8_SB(1, 1), b3 + hstep, voffB);
            PG8_WAIT_V(6); PG8_BAR; PG8_MMA(1, 1, At, B1); PG8_BAR;
            }
        }
        if constexpr (FP8) { asm volatile("s_nop 15\n\ts_nop 15" ::: "memory"); }
        if constexpr (ALIGN_EPI) { if (wr == 0) PG8_BAR; }
        if constexpr (!Epi::AFTER_DRAIN) { E(acc, cur, wr, wc, fr, fq);
#if EPI_PROBE
            _Pragma("unroll 1") for (int pr_ = 0; pr_ < 2; ++pr_) { asm volatile("" ::: "memory"); E(acc, cur, wr, wc, fr, fq); }
#endif
            S.done(cur); }
        if (!has_next) break;
#pragma unroll
        for (int a = 0; a < 2; ++a)
#pragma unroll
            for (int b = 0; b < 2; ++b)
#pragma unroll
                for (int m = 0; m < 4; ++m)
#pragma unroll
                    for (int n = 0; n < 2; ++n) acc[a][b][m][n] = (f32x4){0.f, 0.f, 0.f, 0.f};
        cur = nxt; cA = nA; cB = nB; ++ui;
        if constexpr (GATHER) { va[0][0] = vnl[0]; va[0][1] = vnl[1]; va[1][0] = vnl[2]; va[1][1] = vnl[3]; }
        if constexpr (ALIGN_EPI) { if (wr == 1) PG8_BAR; }
    }
    PG8_WAIT_V(0);
    if constexpr (!ALIGN_EPI) { if (wr == 0) PG8_BAR; }
    PG8_BAR;
    if constexpr (Epi::AFTER_DRAIN) { E.fused(acc, cur, wr, wc, fr, fq, lds, wid, lane); S.done(cur); }
#undef PG8_SA
#undef PG8_SB
#undef PG8_STAGE
#undef PG8_STAGE_A
#undef PG8_GCALC
#undef PG8_LDA
#undef PG8_LDB
#undef PG8_MMA
#undef PG8_WAIT_V
#undef PG8_WAIT_L
#undef PG8_BAR
#undef PG8_SCHED
}
}
#define LAS __attribute__((address_space(3)))
#define XB_TMO      128
#define XB_XCNT(j)  (256  + 64 * (j))
#define XB_XSUB(j)  (1280 + 64 * (j))
#define XB_XGEN(j)  (2304 + 64 * (j))
#define XB_TOP      3328
#define XB_TOPGEN   3392
#define XCD_BAR_WORDS 3456
#define XB_SPIN_CAP (1u << 18)

__device__ __forceinline__ unsigned xb_ld(unsigned* p)              { return __hip_atomic_load(p, __ATOMIC_RELAXED, __HIP_MEMORY_SCOPE_AGENT); }
__device__ __forceinline__ unsigned xb_add(unsigned* p, unsigned v) { return __hip_atomic_fetch_add(p, v, __ATOMIC_RELAXED, __HIP_MEMORY_SCOPE_AGENT); }
__device__ __forceinline__ unsigned xb_xcc_id() { return (unsigned)__builtin_amdgcn_s_getreg((3 << 11) | 20) & 0xFu; }
#define XB_SPIN(cond, bar) do { unsigned _sp = 0; while (cond) { __builtin_amdgcn_s_sleep(1); \
    if ((++_sp & 255u) == 0u) { if (xb_ld(&(bar)[XB_TMO])) break; if (_sp > XB_SPIN_CAP) { atomicAdd(&(bar)[XB_TMO], 1u); break; } } } } while (0)

struct XcdBarrier {
    unsigned* bar; unsigned x;
    volatile LAS unsigned* st;
};

__device__ __forceinline__ XcdBarrier xcd_barrier_post(unsigned* bar, volatile LAS unsigned* st) {
    XcdBarrier b; b.bar = bar; b.x = xb_xcc_id(); b.st = st;
    if (threadIdx.x == 0) (void)xb_add(&bar[XB_XCNT(b.x)], 1u);
    return b;
}
__device__ __forceinline__ void xcd_barrier_complete(unsigned* bar, unsigned x, unsigned& nloc, unsigned& nx) {
    const unsigned G = gridDim.x * gridDim.y * gridDim.z;
    unsigned sum, cnt, mine, sp = 0u;
    for (;;) {
        sum = 0u; cnt = 0u; mine = 0u;
#pragma unroll 1
        for (unsigned j = 0; j < 16; ++j) { const unsigned c = xb_ld(&bar[XB_XCNT(j)]); sum += c; cnt += (c > 0u) ? 1u : 0u; mine = (j == x) ? c : mine; }
        if (sum == G) break;
        __builtin_amdgcn_s_sleep(1);
        if ((++sp & 255u) == 0u) { if (xb_ld(&bar[XB_TMO])) break; if (sp > XB_SPIN_CAP) { atomicAdd(&bar[XB_TMO], 1u); break; } }
    }
    nloc = mine > 0u ? mine : 1u; nx = cnt > 0u ? cnt : 1u;
}

__device__ __forceinline__ void xcd_barrier_census(const XcdBarrier& b) {
    if (threadIdx.x == 0) { unsigned nloc, nx; xcd_barrier_complete(b.bar, b.x, nloc, nx); b.st[0] = nloc; b.st[1] = nx; }
    __syncthreads();
}
__device__ __forceinline__ void xcd_barrier(const XcdBarrier& b) {
    asm volatile("s_waitcnt vmcnt(0)" ::: "memory");
    __syncthreads();
    if (threadIdx.x == 0) {
        unsigned* bar = b.bar;
        __builtin_amdgcn_s_waitcnt(0);
        unsigned nloc = b.st[0], nx = b.st[1];
        const unsigned old = xb_add(&bar[XB_XSUB(b.x)], 1u);
        const unsigned gen = old / nloc;
        if (old + 1u == (gen + 1u) * nloc) {
            __builtin_amdgcn_fence(__ATOMIC_RELEASE, "agent");
            asm volatile("s_waitcnt vmcnt(0)" ::: "memory");
            const unsigned og = xb_add(&bar[XB_TOP], 1u);
            const unsigned tg = og / nx;
            if (og + 1u == (tg + 1u) * nx) xb_add(&bar[XB_TOPGEN], 1u);
            else XB_SPIN(xb_ld(&bar[XB_TOPGEN]) == tg, bar);
            __builtin_amdgcn_fence(__ATOMIC_ACQUIRE, "agent");
            xb_add(&bar[XB_XGEN(b.x)], 1u);
            asm volatile("s_waitcnt vmcnt(0)" ::: "memory");
        } else {
            XB_SPIN(xb_ld(&bar[XB_XGEN(b.x)]) == gen, bar);
            __builtin_amdgcn_fence(__ATOMIC_ACQUIRE, "agent");
            asm volatile("s_waitcnt vmcnt(0)" ::: "memory");
        }
    }
    __syncthreads();
}

#define GAS __attribute__((address_space(1)))
typedef unsigned short bf16_t;
typedef short bf16x8 __attribute__((ext_vector_type(8)));
typedef short s16x4 __attribute__((ext_vector_type(4)));
typedef float f32x4 __attribute__((ext_vector_type(4)));
typedef float f32x2 __attribute__((ext_vector_type(2)));
typedef float f32x16 __attribute__((ext_vector_type(16)));
typedef unsigned u32x4 __attribute__((ext_vector_type(4)));
typedef unsigned u32x2 __attribute__((ext_vector_type(2)));

constexpr int T = 16384, DM = 2048, DIN = 6160, NPROJ = 6144, NLAYER = 2, NE = 16, DEXP = 1024;
constexpr int PQ = 0, PK = 512, PV = 1024, PG = 2048, PMQ = 3072, PMK = 4096, PMV = 5120;
__host__ __device__ __forceinline__ size_t ix_gq(int h, int t) { return ((size_t)(0 + h) * T + t) * 128; }
__host__ __device__ __forceinline__ size_t ix_gk(int h, int t) { return ((size_t)(4 + h) * T + t) * 128; }
__host__ __device__ __forceinline__ size_t ix_gv(int h, int t) { return (size_t)(8 + 2 * h) * T * 128 + (size_t)t * 256; }
__host__ __device__ __forceinline__ size_t ix_gg(int h, int t) { return (size_t)(16 + 2 * h) * T * 128 + (size_t)t * 256; }
__host__ __device__ __forceinline__ size_t ix_mq(int h, int t) { return ((size_t)(24 + h) * T + t) * 128; }
__host__ __device__ __forceinline__ size_t ix_mk(int h, int t) { return ((size_t)(32 + h) * T + t) * 128; }
__host__ __device__ __forceinline__ size_t ix_mv(int h, int t) { return ((size_t)(40 + h) * T + t) * 128; }
constexpr float DN_ALPHA = 1.4142135623730951f;
constexpr int MAXROWS = 36864;
constexpr int LISTH = 516096;
constexpr int NTHR = 512;

constexpr size_t MiB = 1u << 20;
constexpr size_t WS_CTL = 0, CTL_BYTES = 1 * MiB;
constexpr size_t WS_MISC = 1 * MiB;
constexpr size_t WS_ITEMS = 1 * MiB + 65536;
constexpr size_t WS_TOK = 2 * MiB, WS_SEL = 3 * MiB, WS_KMEAN = 4 * MiB, WS_GDEC = 5 * MiB, WS_GLOW = 6 * MiB, WS_PML = 8 * MiB;
constexpr size_t WS_HBQ = 228 * MiB;
constexpr int WIN8_SH = 5;
constexpr size_t WS_IDX = 7 * MiB;
constexpr size_t WS_HB8 = 456 * MiB;
constexpr size_t WS_ROPE = 12 * MiB, WS_LIST = 20 * MiB;
constexpr size_t WS_WIN = 36 * MiB, WS_WO = 60 * MiB, WS_WGU = 68 * MiB, WS_WIN2 = 132 * MiB, WS_WD = 196 * MiB;
constexpr size_t WS_HB = 260 * MiB, WS_MIX = 324 * MiB;
constexpr size_t WS_PROJ = 388 * MiB, WS_U = 580 * MiB, WS_S = 644 * MiB, WS_PO = 708 * MiB;
constexpr size_t WS_BDEC = 708 * MiB;
constexpr size_t WS_PRE = 388 * MiB;
constexpr size_t WS_XS = 388 * MiB, WS_HS = 532 * MiB, WS_YS = 604 * MiB;
constexpr size_t WS_END = 836 * MiB;
constexpr int CW_BAR = 4096, CW_CNT = 8192, CW_NIT = 8448, CW_DBG = 8704, CW_CVQ = 9216;
constexpr int LDS_SCR = 131072, LDS_BYTES = 155648;

struct Params { const float* in[16]; float* out; unsigned char* ws; int g_lo, g_hi; };

__device__ __forceinline__ unsigned cvt_pk(float lo, float hi) { return pg8::cvt_pk_bf16(lo, hi); }
__device__ __forceinline__ float bflo(unsigned u) { return __uint_as_float(u << 16); }
__device__ __forceinline__ float bfhi(unsigned u) { return __uint_as_float(u & 0xffff0000u); }
__device__ __forceinline__ float bf2f(bf16_t u) { return __uint_as_float(((unsigned)u) << 16); }
__device__ __forceinline__ unsigned ldu(const unsigned* p) { return __hip_atomic_load(p, __ATOMIC_RELAXED, __HIP_MEMORY_SCOPE_AGENT); }
__device__ __forceinline__ float ldf(const float* p) { return __uint_as_float(__hip_atomic_load((const unsigned*)p, __ATOMIC_RELAXED, __HIP_MEMORY_SCOPE_AGENT)); }
#ifndef OUT8
#define OUT8 1
#endif
constexpr int MIX8_SH = 3, WO8_SH = 5;
#ifndef YS8
#define YS8 1
#endif
constexpr int Y8_SH = 4;
#ifndef RECOMP
#define RECOMP 1
#endif
#ifndef PO8
#define PO8 1
#endif
constexpr int PO8_SH = 4;
constexpr int X8_SH = 2, H8_SH = 2, WGU8_SH = 5, WD8_SH = 6;
__device__ __forceinline__ unsigned pk4_fp8(float a, float b, float c, float d) { int t = __builtin_amdgcn_cvt_pk_fp8_f32(a, b, 0, false); t = __builtin_amdgcn_cvt_pk_fp8_f32(c, d, t, true); return (unsigned)t; }
__device__ __forceinline__ float fp8_dec(unsigned b) { const unsigned s = b >> 7, e = (b >> 3) & 15u, m = b & 7u; const float v = e ? (1.0f + 0.125f * (float)m) * __builtin_ldexpf(1.0f, (int)e - 7) : 0.125f * (float)m * 0.015625f; return s ? -v : v; }
__device__ __forceinline__ void unpack8(const u32x4 x, float (&f)[8]) { f[0] = bflo(x.x); f[1] = bfhi(x.x); f[2] = bflo(x.y); f[3] = bfhi(x.y); f[4] = bflo(x.z); f[5] = bfhi(x.z); f[6] = bflo(x.w); f[7] = bfhi(x.w); }
__device__ __forceinline__ u32x4 pack8(const float (&f)[8]) { u32x4 w; w.x = cvt_pk(f[0], f[1]); w.y = cvt_pk(f[2], f[3]); w.z = cvt_pk(f[4], f[5]); w.w = cvt_pk(f[6], f[7]); return w; }

__device__ __forceinline__ void moe_bases(const unsigned* cnt, int* sb) {
    const int tid = opq_tid();
    if (tid < 64) { const int lane = tid;
        const int c = (lane < NE) ? (int)ldu(cnt + lane) : 0; const int nP = (c + 255) >> 8; int incl = nP;
#pragma unroll
        for (int o = 1; o < 16; o <<= 1) { const int t = __shfl_up(incl, o); if (lane >= o) incl += t; }
        if (lane < NE) { sb[lane] = (incl - nP) * 256; sb[32 + lane] = c; if (lane == NE - 1) sb[16] = incl * 256; } }
    __syncthreads();
}
__device__ __forceinline__ float wave_sum(float v) {
#define WS_DPP(ctrl) v += __int_as_float(__builtin_amdgcn_update_dpp(0, __float_as_int(v), (ctrl), 0xF, 0xF, true))
    WS_DPP(0xB1); WS_DPP(0x4E); WS_DPP(0x141); WS_DPP(0x140);
#undef WS_DPP
    const int vi = __float_as_int(v);
    return (__int_as_float(__builtin_amdgcn_readlane(vi, 0)) + __int_as_float(__builtin_amdgcn_readlane(vi, 16))) + (__int_as_float(__builtin_amdgcn_readlane(vi, 32)) + __int_as_float(__builtin_amdgcn_readlane(vi, 48)));
}
__device__ __forceinline__ float silu_f(float x) { return x * __builtin_amdgcn_rcpf(1.0f + __expf(-x)); }
__device__ __forceinline__ s16x4 tr_rd(int addr) { s16x4 r; asm volatile("ds_read_b64_tr_b16 %0, %1" : "=&v"(r) : "v"(addr) : "memory"); return r; }
#define LGKM0() do { asm volatile("s_waitcnt lgkmcnt(0)" ::: "memory"); __builtin_amdgcn_sched_barrier(0); } while (0)
#define PK8(L, H) ((bf16x8){L[0], L[1], L[2], L[3], H[0], H[1], H[2], H[3]})
#define MFMA16(a, b, c) __builtin_amdgcn_mfma_f32_16x16x32_bf16((a), (b), (c), 0, 0, 0)

namespace pg8 {
struct EpiProj {
    static constexpr bool PERM = true, AFTER_DRAIN = false;
    bf16_t* O; const float* cs; const float* sn;
    __device__ __forceinline__ void operator()(const f32x4 (&acc)[2][2][4][2], const Unit& u, int wr, int wc, int fr, int fq) const {
        const int row0 = u.pm * BM + wr * 64 + fr, cin = wc * 32 + 8 * fq;
        const bool rope = (u.pn >= 12 && u.pn < 20);
        size_t hb0[2]; int rs;
        if (u.pn < 4) { rs = 128; for (int bj = 0; bj < 2; ++bj) hb0[bj] = (size_t)((u.pn < 2 ? 0 : 4) + 2 * (u.pn & 1) + bj) * T * 128; }
        else if (u.pn < 12) { rs = 256; for (int bj = 0; bj < 2; ++bj) hb0[bj] = (size_t)((u.pn < 8 ? 8 : 16) + 2 * ((u.pn - 4) & 3)) * T * 128 + bj * 128; }
        else { rs = 128; for (int bj = 0; bj < 2; ++bj) hb0[bj] = (size_t)(24 + 8 * ((u.pn - 12) >> 2) + 2 * ((u.pn - 12) & 3) + bj) * T * 128; }
#pragma unroll
        for (int ai = 0; ai < 2; ++ai) {
            f32x4 c[4], s[4];
#pragma unroll
            for (int m = 0; m < 4; ++m) { c[m] = (f32x4){1.f, 1.f, 1.f, 1.f}; s[m] = (f32x4){0.f, 0.f, 0.f, 0.f}; }
            if (rope) {
#pragma unroll
                for (int m = 0; m < 4; ++m) { const int row = row0 + ai * HALF + m * 16; c[m] = *(const f32x4*)(cs + (size_t)row * 64 + 16 * wc + 4 * fq); s[m] = *(const f32x4*)(sn + (size_t)row * 64 + 16 * wc + 4 * fq); } }
#pragma unroll
            for (int m = 0; m < 4; ++m) {
                const int row = row0 + ai * HALF + m * 16;
#pragma unroll
                for (int bj = 0; bj < 2; ++bj) {
                    const f32x4 a0 = acc[ai][bj][m][0], a1 = acc[ai][bj][m][1];
                    const f32x4 v0 = a0 * c[m] - a1 * s[m], v1 = a1 * c[m] + a0 * s[m];
                    u32x4 w; w.x = cvt_pk_bf16(v0[0], v0[1]); w.y = cvt_pk_bf16(v0[2], v0[3]); w.z = cvt_pk_bf16(v1[0], v1[1]); w.w = cvt_pk_bf16(v1[2], v1[3]);
                    *(u32x4*)(O + hb0[bj] + (size_t)row * rs + cin) = w; }
            }
        }
    }
};
struct EpiOut {
    static constexpr bool PERM = true, AFTER_DRAIN = false;
    const float* res32; const bf16_t* res16; bf16_t* out; float alpha;
    __device__ __forceinline__ void operator()(const f32x4 (&acc)[2][2][4][2], const Unit& u, int wr, int wc, int fr, int fq) const {
        const int row0 = u.pm * BM + wr * 64 + fr, col0 = u.pn * BM + wc * 32 + 8 * fq;
        if (res32) {
#pragma unroll
            for (int ai = 0; ai < 2; ++ai)
#pragma unroll
                for (int mh = 0; mh < 2; ++mh) { f32x4 r[2][2][2];
#pragma unroll
                    for (int m2 = 0; m2 < 2; ++m2)
#pragma unroll
                        for (int bj = 0; bj < 2; ++bj) { const size_t off = (size_t)(row0 + ai * HALF + (2 * mh + m2) * 16) * 2048 + col0 + bj * HALF; r[m2][bj][0] = *(const f32x4*)(res32 + off); r[m2][bj][1] = *(const f32x4*)(res32 + off + 4); }
#pragma unroll
                    for (int m2 = 0; m2 < 2; ++m2)
#pragma unroll
                        for (int bj = 0; bj < 2; ++bj) { const int m = 2 * mh + m2; const size_t off = (size_t)(row0 + ai * HALF + m * 16) * 2048 + col0 + bj * HALF;
                            const f32x4 v0 = r[m2][bj][0] * alpha + acc[ai][bj][m][0], v1 = r[m2][bj][1] * alpha + acc[ai][bj][m][1];
                            u32x4 w; w.x = cvt_pk_bf16(v0[0], v0[1]); w.y = cvt_pk_bf16(v0[2], v0[3]); w.z = cvt_pk_bf16(v1[0], v1[1]); w.w = cvt_pk_bf16(v1[2], v1[3]);
                            *(u32x4*)(out + off) = w; } }
        } else {
#pragma unroll
            for (int ai = 0; ai < 2; ++ai) { u32x4 b[4][2];
#pragma unroll
                for (int m = 0; m < 4; ++m)
#pragma unroll
                    for (int bj = 0; bj < 2; ++bj) b[m][bj] = *(const u32x4*)(res16 + (size_t)(row0 + ai * HALF + m * 16) * 2048 + col0 + bj * HALF);
#pragma unroll
                for (int m = 0; m < 4; ++m)
#pragma unroll
                    for (int bj = 0; bj < 2; ++bj) { const size_t off = (size_t)(row0 + ai * HALF + m * 16) * 2048 + col0 + bj * HALF; const u32x4 bb = b[m][bj];
                        const f32x4 r0 = (f32x4){bflo(bb.x), bfhi(bb.x), bflo(bb.y), bfhi(bb.y)}, r1 = (f32x4){bflo(bb.z), bfhi(bb.z), bflo(bb.w), bfhi(bb.w)};
                        const f32x4 v0 = r0 * alpha + acc[ai][bj][m][0], v1 = r1 * alpha + acc[ai][bj][m][1];
                        u32x4 w; w.x = cvt_pk_bf16(v0[0], v0[1]); w.y = cvt_pk_bf16(v0[2], v0[3]); w.z = cvt_pk_bf16(v1[0], v1[1]); w.w = cvt_pk_bf16(v1[2], v1[3]);
                        *(u32x4*)(out + off) = w; } }
        }
    }
};
struct EpiGU {
    static constexpr bool PERM = true, AFTER_DRAIN = false;
    unsigned char* H;
    __device__ __forceinline__ void operator()(const f32x4 (&acc)[2][2][4][2], const Unit& u, int wr, int wc, int fr, int fq) const {
        const int row0 = u.pm * BM + wr * 64 + fr, col0 = ((u.pn & 7) * BM + wc * 32 + 8 * fq) >> 1;
#pragma unroll
        for (int ai = 0; ai < 2; ++ai)
#pragma unroll
            for (int m = 0; m < 4; ++m) { unsigned char* rowp = H + (size_t)(row0 + ai * HALF + m * 16) * 1024 + col0;
#pragma unroll
                for (int bj = 0; bj < 2; ++bj) { const f32x4 g = acc[ai][bj][m][0], up = acc[ai][bj][m][1]; f32x4 h;
#pragma unroll
                    for (int j = 0; j < 4; ++j) h[j] = g[j] * __builtin_amdgcn_rcpf(1.0f + __expf(-g[j])) * up[j] * (float)(1 << H8_SH);
                    *(unsigned*)(rowp + bj * (HALF / 2)) = pk4_fp8(h[0], h[1], h[2], h[3]); } }
    }
};
struct EpiY {
    static constexpr bool PERM = true, AFTER_DRAIN = false;
    bf16_t* Y;
    __device__ __forceinline__ void operator()(const f32x4 (&acc)[2][2][4][2], const Unit& u, int wr, int wc, int fr, int fq) const {
        const int row0 = u.pm * BM + wr * 64 + fr, col0 = (u.pn & 7) * BM + wc * 32 + 8 * fq;
#pragma unroll
        for (int ai = 0; ai < 2; ++ai)
#pragma unroll
            for (int m = 0; m < 4; ++m) { bf16_t* rowp = Y + (size_t)(row0 + ai * HALF + m * 16) * 2048 + col0;
#pragma unroll
                for (int bj = 0; bj < 2; ++bj) { const f32x4 v0 = acc[ai][bj][m][0], v1 = acc[ai][bj][m][1];
#if YS8
                    u32x2 w; w.x = pk4_fp8(v0[0] * (float)(1 << Y8_SH), v0[1] * (float)(1 << Y8_SH), v0[2] * (float)(1 << Y8_SH), v0[3] * (float)(1 << Y8_SH));
                    w.y = pk4_fp8(v1[0] * (float)(1 << Y8_SH), v1[1] * (float)(1 << Y8_SH), v1[2] * (float)(1 << Y8_SH), v1[3] * (float)(1 << Y8_SH));
                    *(u32x2*)((unsigned char*)Y + (size_t)(row0 + ai * HALF + m * 16) * 2048 + col0 + bj * HALF) = w; } }
#else
                    u32x4 w; w.x = cvt_pk_bf16(v0[0], v0[1]); w.y = cvt_pk_bf16(v0[2], v0[3]); w.z = cvt_pk_bf16(v1[0], v1[1]); w.w = cvt_pk_bf16(v1[2], v1[3]);
                    *(u32x4*)(rowp + bj * HALF) = w; } }
#endif
    }
};
struct MoeOrder : StaticOrder {
    const int* sb; const unsigned* idx; int rowbytes;
    __device__ __forceinline__ int expert_of(int pm) const { const int r = pm * BM; int e = 0;
#pragma unroll
        for (int k = 1; k < 16; ++k) e += (sb[k] <= r) ? 1 : 0;
        return e; }
    __device__ __forceinline__ bool next(int i, Unit& u) const {
        if (!StaticOrder::next(i, u)) return false;
        u.pn += 8 * __builtin_amdgcn_readfirstlane(expert_of(u.pm));
        return true; }
    __device__ __forceinline__ unsigned arow(const Unit& u, int r) const {
        const int e = u.pn >> 3, slot = u.pm * BM - sb[e] + r;
        const unsigned t = (slot < sb[32 + e]) ? __hip_atomic_load(idx + (size_t)e * 16384 + slot, __ATOMIC_RELAXED, __HIP_MEMORY_SCOPE_AGENT) : 0u;
        return t * (unsigned)rowbytes; }
};
}
__device__ __forceinline__ int rope_src_col(int n) {
    const int seg = (n - PMQ) >> 7, pp = (n - PMQ) & 127, g = pp >> 3, e = pp & 7;
    return 3088 + seg * 128 + (e < 4 ? 4 * g + e : 64 + 4 * g + (e - 4));
}
constexpr int CVT_NT = 1792, CVT_NT_IN = 192;
template <bool DYN, int JOBS>
static __device__ void phase_cvt(const Params& p, int tl, int t0, int ntot, int w, int nwk, unsigned char* lds, unsigned* qw = nullptr) {
    const int tid = opq_tid(), lane = tid & 63, wave = __builtin_amdgcn_readfirstlane(tid >> 6);
    volatile unsigned* qs = (volatile unsigned*)(lds + LDS_SCR + 96);
    int tt = w;
    if (DYN) { if (tid == 0) *qs = atomicAdd(qw, 1u); __syncthreads(); tt = (int)*qs; }
    while (tt < ntot) {
        unsigned qn = 0u; if (DYN && tid == 0) qn = atomicAdd(qw, 1u);
        int t = t0 + tt;
        int job, e = 0, kt, nt;
        if ((JOBS & 1) && (t < 192 || JOBS == 1)) { job = 0; kt = t / 12; nt = t % 12; }
        else if ((JOBS & 2) && (t < 256 || !(JOBS & 12))) { t -= 192; job = 1; kt = t >> 2; nt = t & 3; }
        else if ((JOBS & 4) && (t < 1280 || !(JOBS & 8))) { t -= 256; job = 2; e = t >> 6; t &= 63; kt = t >> 2; nt = t & 3; }
        else { t -= 1280; job = 3; e = t >> 5; t &= 31; kt = t >> 2; nt = t & 3; }
        const int n0 = nt * 512, k0 = kt * 128;
        const float* s0; const float* s1; size_t ld; int nl0, nl1;
        if (job == 0) { const float* wi = p.in[2] + (size_t)tl * DM * DIN + (size_t)k0 * DIN; ld = DIN;
            const int na = n0 + 4 * lane, nb = n0 + 256 + 4 * lane;
            s0 = wi + ((na < PMQ) ? na : (na < PMV ? rope_src_col(na) : na + 16)); s1 = wi + ((nb < PMQ) ? nb : (nb < PMV ? rope_src_col(nb) : nb + 16)); nl0 = 4 * lane; nl1 = 256 + 4 * lane; }
        else if (job == 1) { const float* wo = p.in[6] + (size_t)tl * DM * DM + (size_t)k0 * DM + n0; ld = DM; s0 = wo + 4 * lane; s1 = wo + 256 + 4 * lane; nl0 = 4 * lane; nl1 = 256 + 4 * lane; }
        else if (job == 2) { const size_t off = ((size_t)(tl * NE + e) * DM + k0) * DEXP + (n0 >> 1) + 4 * lane; ld = DEXP; s0 = p.in[11] + off; s1 = p.in[12] + off; nl0 = 8 * lane; nl1 = 8 * lane + 4; }
        else { const float* wd = p.in[13] + ((size_t)(tl * NE + e) * DEXP + k0) * DM + n0; ld = DM; s0 = wd + 4 * lane; s1 = wd + 256 + 4 * lane; nl0 = 4 * lane; nl1 = 256 + 4 * lane; }
        const bool f8 = OUT8 ? true : (job != 1); const float sc = (job == 0) ? (float)(1 << WIN8_SH) : (job == 1) ? (float)(1 << WO8_SH) : (job == 2) ? (float)(1 << WGU8_SH) : (float)(1 << WD8_SH);
        f32x4 v[3][8];
#pragma unroll
        for (int pb = 0; pb < 2; ++pb)
#pragma unroll
            for (int i = 0; i < 4; ++i) { const size_t ro = (size_t)(wave + 8 * (4 * pb + i)) * ld; v[pb][2 * i] = *(const f32x4*)(s0 + ro); v[pb][2 * i + 1] = *(const f32x4*)(s1 + ro); }
#pragma unroll
        for (int bt = 0; bt < 4; ++bt) {
            if (bt < 2) {
#pragma unroll
                for (int i = 0; i < 4; ++i) { const size_t ro = (size_t)(wave + 8 * (4 * (bt + 2) + i)) * ld; v[(bt + 2) % 3][2 * i] = *(const f32x4*)(s0 + ro); v[(bt + 2) % 3][2 * i + 1] = *(const f32x4*)(s1 + ro); } }
#pragma unroll
            for (int i = 0; i < 4; ++i) { const int r = wave + 8 * (4 * bt + i); const f32x4 x0 = v[bt % 3][2 * i], x1 = v[bt % 3][2 * i + 1];
                if (f8) { *(unsigned*)(lds + r * 512 + nl0) = pk4_fp8(x0[0] * sc, x0[1] * sc, x0[2] * sc, x0[3] * sc); *(unsigned*)(lds + r * 512 + nl1) = pk4_fp8(x1[0] * sc, x1[1] * sc, x1[2] * sc, x1[3] * sc); }
                else { u32x2 a; a.x = cvt_pk(x0[0], x0[1]); a.y = cvt_pk(x0[2], x0[3]); u32x2 c2; c2.x = cvt_pk(x1[0], x1[1]); c2.y = cvt_pk(x1[2], x1[3]);
                       *(u32x2*)(lds + r * 1024 + 2 * nl0) = a; *(u32x2*)(lds + r * 1024 + 2 * nl1) = c2; } }
        }
        __syncthreads();
        if (f8) {
            unsigned char* d = (job == 0) ? p.ws + ((tl & 1) ? WS_WIN2 : WS_WIN) + (size_t)(n0 + tid) * DM + k0
                             : (job == 1) ? p.ws + WS_WO + (size_t)(n0 + tid) * DM + k0
                             : (job == 2) ? p.ws + WS_WGU + ((size_t)e * 2048 + n0 + tid) * DM + k0 : p.ws + WS_WD + ((size_t)e * 2048 + n0 + tid) * DEXP + k0;
#pragma unroll
            for (int c = 0; c < 8; ++c) { unsigned wq[4];
#pragma unroll
                for (int j = 0; j < 4; ++j) { const unsigned char* s8 = lds + (16 * c + 4 * j) * 512 + tid; wq[j] = (unsigned)s8[0] | ((unsigned)s8[512] << 8) | ((unsigned)s8[1024] << 16) | ((unsigned)s8[1536] << 24); }
                *(u32x4*)(d + 16 * c) = (u32x4){wq[0], wq[1], wq[2], wq[3]}; }
        } else {
            unsigned char* d = p.ws + WS_WO + ((size_t)(n0 + tid) * DM + k0) * 2;
#pragma unroll
            for (int c = 0; c < 16; ++c) { unsigned wq[4];
#pragma unroll
                for (int j = 0; j < 4; ++j) { const unsigned lo = *(const unsigned short*)(lds + (8 * c + 2 * j) * 1024 + 2 * tid), hi = *(const unsigned short*)(lds + (8 * c + 2 * j + 1) * 1024 + 2 * tid); wq[j] = lo | (hi << 16); }
                *(u32x4*)(d + 16 * c) = (u32x4){wq[0], wq[1], wq[2], wq[3]}; }
        }
        if (DYN) { if (tid == 0) *qs = qn; }
        __syncthreads();
        if (DYN) tt = (int)*qs; else tt += nwk;
    }
}

static __device__ void phase_rope(const Params& p) {
    float* cs = (float*)(p.ws + WS_ROPE); float* sn = cs + (size_t)T * 64;
    const int* pos = (const int*)p.in[1];
    for (int idx = blockIdx.x * NTHR + opq_tid(); idx < T * 64; idx += gridDim.x * NTHR) {
        const int t = idx >> 6, i = idx & 63;
        double pw = 1.0; for (int k = 0; k < i; ++k) pw *= 1.1547819846894583;
        const float inv = 1.0f / (float)pw;
        const float ang = (float)pos[t] * inv;
        const double rev = (double)ang * 0.15915494309189535; const float fr = (float)(rev - floor(rev));
        cs[idx] = __builtin_amdgcn_cosf(fr); sn[idx] = __builtin_amdgcn_sinf(fr);
    }
}

__device__ __forceinline__ float reduce16(const float (&a)[16], int lane) {
    float b[8], c[4], d[2];
    const bool x = lane & 1, y = lane & 2, z = lane & 4, w = lane & 8;
#pragma unroll
    for (int m = 0; m < 8; ++m) { const float keep = x ? a[2 * m + 1] : a[2 * m], give = x ? a[2 * m] : a[2 * m + 1]; b[m] = keep + __shfl_xor(give, 1); }
#pragma unroll
    for (int m = 0; m < 4; ++m) { const float keep = y ? b[2 * m + 1] : b[2 * m], give = y ? b[2 * m] : b[2 * m + 1]; c[m] = keep + __shfl_xor(give, 2); }
#pragma unroll
    for (int m = 0; m < 2; ++m) { const float keep = z ? c[2 * m + 1] : c[2 * m], give = z ? c[2 * m] : c[2 * m + 1]; d[m] = keep + __shfl_xor(give, 4); }
    float e = (w ? d[1] : d[0]) + __shfl_xor(w ? d[0] : d[1], 8);
    e += __shfl_xor(e, 16); e += __shfl_xor(e, 32);
    return e;
}
#ifndef ROW_PROBE
#define ROW_PROBE 0
#endif
template <class Tp> __device__ __forceinline__ Tp* opq_uniform(Tp* ptr) { unsigned long long w = (unsigned long long)ptr; asm volatile("" : "+s"(w)); return (Tp*)w; }
template <int MODE, bool DUMMY = false> static __device__ void phase_rows(const Params& p, int layer, unsigned char* lds) {
    const int tid = opq_tid(), lane = tid & 63, wave = (MODE == 1) ? (tid >> 6) : __builtin_amdgcn_readfirstlane(tid >> 6);
    float* wT = (float*)lds;
    constexpr bool SK16 = false;
    float* rlog = (float*)(lds + LDS_SCR + 20480);
    int* lcnt = (int*)(lds + LDS_SCR + 512); int* gbase = lcnt + 16; float* rinfo = (float*)(lds + LDS_SCR + 1024);
    const bool last = (layer == NLAYER - 1);
    const bool do_skinny = !(MODE == 2 && last);
    const float* W; int ld, c0;
    if (MODE == 0) { W = p.in[2]; ld = DIN; c0 = 3072; }
    else if (MODE == 1) { W = p.in[9]; ld = 16; c0 = 0; }
    else { W = p.in[2] + (size_t)(last ? layer : layer + 1) * DM * DIN; ld = DIN; c0 = 3072; }
    bf16_t* hb = (bf16_t*)(p.ws + (DUMMY ? (MODE == 1 ? WS_U : WS_MIX) : WS_HB));
    float* glow = (float*)(p.ws + (DUMMY ? WS_PML + 2 * MiB : WS_GLOW));
    unsigned* tok = (unsigned*)(p.ws + (DUMMY && MODE == 1 ? WS_PML : WS_TOK));
    float* outw = DUMMY ? (float*)(p.ws + (MODE == 1 ? WS_PROJ : WS_WGU)) : p.out;
    const bf16_t* Ys = (const bf16_t*)(p.ws + WS_YS);
    int* sbm = (int*)(lds + LDS_SCR + 128);
#ifndef NR2_DEF
#define NR2_DEF 1
#endif
    constexpr int NR = (MODE == 2) ? NR2_DEF : 2;
    const int nit = T / (8 * (int)gridDim.x);
    constexpr bool PF = true;
#if YS8
    u32x2 nx[NR][8]; unsigned ny0[8], ny1[8]; f32x4 nf[NR][8];
#else
    u32x2 nx[NR][8], ny0[8], ny1[8]; f32x4 nf[NR][8];
#endif
    float nw0 = 0.f, nw1 = 0.f; unsigned nt[6];
    const bf16_t* srcb0 = (const bf16_t*)(p.ws + ((MODE == 2 && !RECOMP) ? WS_HB : WS_PRE));
    if (PF) {
#pragma unroll
        for (int rr = 0; rr < NR; ++rr) { const int r = (rr * (int)gridDim.x + (int)blockIdx.x) * 8 + wave;
#pragma unroll
            for (int i = 0; i < 8; ++i) { if (MODE == 1) nx[rr][i] = *(const u32x2*)(srcb0 + (size_t)r * DM + 256 * i + 4 * lane); else if (MODE == 2) nx[rr][i] = *(const u32x2*)(opq_uniform(srcb0 + (size_t)r * DM) + 256 * i + 4 * lane); else nf[rr][i] = *(const f32x4*)(opq_uniform(p.in[0] + (size_t)r * DM) + 256 * i + 4 * lane); } }
        if (MODE == 2) {
            const int r = (int)blockIdx.x * 8 + wave;
#pragma unroll
            for (int j = 0; j < 6; ++j) nt[j] = ldu(tok + r * 8 + j);
        }
    }
    if (MODE == 2) moe_bases((const unsigned*)(p.ws + WS_CTL) + CW_CNT + layer * 64, sbm);
    if (PF && MODE == 2) {
        nw0 = __uint_as_float(nt[2]); nw1 = __uint_as_float(nt[3]);
#if YS8
        const unsigned char* y0 = opq_uniform((const unsigned char*)Ys + (size_t)__builtin_amdgcn_readfirstlane((int)((unsigned)sbm[nt[0]] + nt[4])) * DM); const unsigned char* y1 = opq_uniform((const unsigned char*)Ys + (size_t)__builtin_amdgcn_readfirstlane((int)((unsigned)sbm[nt[1]] + nt[5])) * DM);
#pragma unroll
        for (int i = 0; i < 8; ++i) { ny0[i] = *(const unsigned*)(y0 + 256 * i + 4 * lane); ny1[i] = *(const unsigned*)(y1 + 256 * i + 4 * lane); }
#else
        const bf16_t* y0 = Ys + (size_t)((unsigned)sbm[nt[0]] + nt[4]) * DM; const bf16_t* y1 = Ys + (size_t)((unsigned)sbm[nt[1]] + nt[5]) * DM;
#pragma unroll
        for (int i = 0; i < 8; ++i) { ny0[i] = *(const u32x2*)(y0 + 256 * i + 4 * lane); ny1[i] = *(const u32x2*)(y1 + 256 * i + 4 * lane); }
#endif
        const int r2 = ((nit > 1 ? 1 : 0) * (int)gridDim.x + (int)blockIdx.x) * 8 + wave;
#pragma unroll
        for (int j = 0; j < 6; ++j) nt[j] = ldu(tok + r2 * 8 + j);
    }
    if (do_skinny) {
#pragma unroll
        for (int hb2 = 0; hb2 < 2; ++hb2) { f32x4 wv[8];
#pragma unroll
            for (int i = 0; i < 8; ++i) { const int i4 = tid + NTHR * (8 * hb2 + i), k = i4 >> 2, e4 = (i4 & 3) * 4; wv[i] = *(const f32x4*)(W + (size_t)k * ld + c0 + e4); }
#pragma unroll
            for (int i = 0; i < 8; ++i) { const int i4 = tid + NTHR * (8 * hb2 + i), k = i4 >> 2, e4 = (i4 & 3) * 4;
#pragma unroll
                for (int j = 0; j < 4; ++j) { if (SK16) ((unsigned short*)wT)[(e4 + j) * DM + k] = (unsigned short)(cvt_pk(wv[i][j], 0.f) & 0xFFFFu); else wT[(((e4 + j) >> 1) * DM + k) * 2 + ((e4 + j) & 1)] = wv[i][j]; } } }
    }
    if (MODE == 1 && tid < 16) lcnt[tid] = 0;
    float* gl = (float*)(lds + LDS_SCR + 4096); float* bl2 = gl + DM;
    unsigned short* tb2 = (unsigned short*)(lds + LDS_SCR + 12288); unsigned short* tg1 = tb2 + DM; unsigned short* tb1 = tg1 + DM;
    if (MODE != 0) {
        const float* gp = p.in[MODE == 1 ? 7 : 14] + (size_t)layer * DM; const float* bp = p.in[MODE == 1 ? 8 : 15] + (size_t)layer * DM;
        if (MODE == 2 && RECOMP) {
            const float* g1p = p.in[7] + (size_t)layer * DM; const float* b1p = p.in[8] + (size_t)layer * DM;
#pragma unroll
            for (int k = 0; k < DM / NTHR; ++k) { const int idx = tid + NTHR * k; gl[idx] = gp[idx];
                tb2[idx] = (unsigned short)(cvt_pk(bp[idx], 0.f) & 0xFFFFu); tg1[idx] = (unsigned short)(cvt_pk(g1p[idx], 0.f) & 0xFFFFu); tb1[idx] = (unsigned short)(cvt_pk(b1p[idx], 0.f) & 0xFFFFu); }
        } else {
#pragma unroll
            for (int k = 0; k < DM / NTHR; ++k) { const int idx = tid + NTHR * k; gl[idx] = gp[idx]; bl2[idx] = bp[idx]; }
        }
    }
    __syncthreads();
    for (int it = 0; it < nit; it += NR) {
        int row[NR]; float v[NR][32];
#pragma unroll
        for (int rr = 0; rr < NR; ++rr) { row[rr] = ((it + rr) * (int)gridDim.x + (int)blockIdx.x) * 8 + wave;
            if (MODE != 0) {
#pragma unroll
                for (int i = 0; i < 8; ++i) { const u32x2 x = nx[rr][i]; v[rr][4 * i] = bflo(x.x); v[rr][4 * i + 1] = bfhi(x.x); v[rr][4 * i + 2] = bflo(x.y); v[rr][4 * i + 3] = bfhi(x.y); }
            } else {
#pragma unroll
                for (int i = 0; i < 8; ++i) { const f32x4 x = nf[rr][i];
#pragma unroll
                    for (int j = 0; j < 4; ++j) v[rr][4 * i + j] = x[j]; } } }
        if (MODE == 2 && RECOMP) {
            __builtin_amdgcn_sched_barrier(0);
            float s = 0.f;
#pragma unroll
            for (int i = 0; i < 32; ++i) s += v[0][i];
            const float mean = wave_sum(s) * (1.0f / DM);
            float qq = 0.f;
#pragma unroll
            for (int i = 0; i < 32; ++i) { const float d = v[0][i] - mean; qq += d * d; }
            const float rstd = rsqrtf(wave_sum(qq) * (1.0f / DM) + 1e-5f);
#pragma unroll
            for (int i = 0; i < 8; ++i) { const u32x2 g4 = *(const u32x2*)(tg1 + 256 * i + 4 * lane), b4 = *(const u32x2*)(tb1 + 256 * i + 4 * lane);
                v[0][4 * i + 0] = (v[0][4 * i + 0] - mean) * rstd * bflo(g4.x) + bflo(b4.x); v[0][4 * i + 1] = (v[0][4 * i + 1] - mean) * rstd * bfhi(g4.x) + bfhi(b4.x);
                v[0][4 * i + 2] = (v[0][4 * i + 2] - mean) * rstd * bflo(g4.y) + bflo(b4.y); v[0][4 * i + 3] = (v[0][4 * i + 3] - mean) * rstd * bfhi(g4.y) + bfhi(b4.y);
                asm volatile("" ::: "memory"); }
            __builtin_amdgcn_sched_barrier(0);
        }
        if (MODE == 2) {
#if YS8
            const float w0 = nw0 * (1.0f / (float)(1 << Y8_SH)), w1 = nw1 * (1.0f / (float)(1 << Y8_SH));
#pragma unroll
            for (int i = 0; i < 8; ++i) { const unsigned a = ny0[i], c = ny1[i];
                const f32x2 a01 = __builtin_amdgcn_cvt_pk_f32_fp8((int)a, false), a23 = __builtin_amdgcn_cvt_pk_f32_fp8((int)a, true), c01 = __builtin_amdgcn_cvt_pk_f32_fp8((int)c, false), c23 = __builtin_amdgcn_cvt_pk_f32_fp8((int)c, true);
                v[0][4 * i + 0] = DN_ALPHA * v[0][4 * i + 0] + w0 * a01[0] + w1 * c01[0]; v[0][4 * i + 1] = DN_ALPHA * v[0][4 * i + 1] + w0 * a01[1] + w1 * c01[1];
                v[0][4 * i + 2] = DN_ALPHA * v[0][4 * i + 2] + w0 * a23[0] + w1 * c23[0]; v[0][4 * i + 3] = DN_ALPHA * v[0][4 * i + 3] + w0 * a23[1] + w1 * c23[1]; }
#else
            const float w0 = nw0, w1 = nw1;
#pragma unroll
            for (int i = 0; i < 8; ++i) { const u32x2 a = ny0[i], c = ny1[i];
                v[0][4 * i + 0] = DN_ALPHA * v[0][4 * i + 0] + w0 * bflo(a.x) + w1 * bflo(c.x); v[0][4 * i + 1] = DN_ALPHA * v[0][4 * i + 1] + w0 * bfhi(a.x) + w1 * bfhi(c.x);
                v[0][4 * i + 2] = DN_ALPHA * v[0][4 * i + 2] + w0 * bflo(a.y) + w1 * bflo(c.y); v[0][4 * i + 3] = DN_ALPHA * v[0][4 * i + 3] + w0 * bfhi(a.y) + w1 * bfhi(c.y); }
#endif
        }
        if (PF) {
            const int itn = (it + NR < nit) ? it + NR : it;
#pragma unroll
            for (int rr = 0; rr < NR; ++rr) { const int r = ((itn + rr) * (int)gridDim.x + (int)blockIdx.x) * 8 + wave;
#pragma unroll
                for (int i = 0; i < 8; ++i) { if (MODE == 1) nx[rr][i] = *(const u32x2*)(srcb0 + (size_t)r * DM + 256 * i + 4 * lane); else if (MODE == 2) nx[rr][i] = *(const u32x2*)(opq_uniform(srcb0 + (size_t)r * DM) + 256 * i + 4 * lane); else nf[rr][i] = *(const f32x4*)(opq_uniform(p.in[0] + (size_t)r * DM) + 256 * i + 4 * lane); } }
            if (MODE == 2) {
                nw0 = __uint_as_float(nt[2]); nw1 = __uint_as_float(nt[3]);
#if YS8
                        const unsigned char* y0 = opq_uniform((const unsigned char*)Ys + (size_t)__builtin_amdgcn_readfirstlane((int)((unsigned)sbm[nt[0]] + nt[4])) * DM); const unsigned char* y1 = opq_uniform((const unsigned char*)Ys + (size_t)__builtin_amdgcn_readfirstlane((int)((unsigned)sbm[nt[1]] + nt[5])) * DM);
#pragma unroll
                for (int i = 0; i < 8; ++i) { ny0[i] = *(const unsigned*)(y0 + 256 * i + 4 * lane); ny1[i] = *(const unsigned*)(y1 + 256 * i + 4 * lane); }
#else
                const bf16_t* y0 = Ys + (size_t)((unsigned)sbm[nt[0]] + nt[4]) * DM; const bf16_t* y1 = Ys + (size_t)((unsigned)sbm[nt[1]] + nt[5]) * DM;
#pragma unroll
                for (int i = 0; i < 8; ++i) { ny0[i] = *(const u32x2*)(y0 + 256 * i + 4 * lane); ny1[i] = *(const u32x2*)(y1 + 256 * i + 4 * lane); }
#endif
                const int it2 = (it + 2 < nit) ? it + 2 : nit - 1;
                const int r2 = (it2 * (int)gridDim.x + (int)blockIdx.x) * 8 + wave;
#pragma unroll
                for (int j = 0; j < 6; ++j) nt[j] = ldu(tok + r2 * 8 + j);
            }
        }
#pragma unroll
        for (int rr = 0; rr < NR; ++rr) {
            __builtin_amdgcn_sched_barrier(0);
            if (MODE != 0) {
                f32x2 s2 = (f32x2){0.f, 0.f};
#pragma unroll
                for (int i = 0; i < 16; ++i) s2 += (f32x2){v[rr][2 * i], v[rr][2 * i + 1]};
                const float mean = wave_sum(s2[0] + s2[1]) * (1.0f / DM);
                const f32x2 m2 = (f32x2){mean, mean};
                f32x2 q2 = (f32x2){0.f, 0.f};
#pragma unroll
                for (int i = 0; i < 16; ++i) { const f32x2 d2 = (f32x2){v[rr][2 * i], v[rr][2 * i + 1]} - m2; q2 += d2 * d2; }
                const float rstd = rsqrtf(wave_sum(q2[0] + q2[1]) * (1.0f / DM) + 1e-5f);
                const f32x4 m4 = (f32x4){mean, mean, mean, mean}, r4 = (f32x4){rstd, rstd, rstd, rstd};
#pragma unroll
                for (int i = 0; i < 8; ++i) { const f32x4 gv = *(const f32x4*)(gl + 256 * i + 4 * lane); f32x4 bv;
                    if (MODE == 2 && RECOMP) { const u32x2 b4 = *(const u32x2*)(tb2 + 256 * i + 4 * lane); bv = (f32x4){bflo(b4.x), bfhi(b4.x), bflo(b4.y), bfhi(b4.y)}; }
                    else bv = *(const f32x4*)(bl2 + 256 * i + 4 * lane);
                    const f32x4 x4 = ((f32x4){v[rr][4 * i], v[rr][4 * i + 1], v[rr][4 * i + 2], v[rr][4 * i + 3]} - m4) * (r4 * gv) + bv;
#pragma unroll
                    for (int j = 0; j < 4; ++j) v[rr][4 * i + j] = x4[j]; }
                if (MODE == 2 && last) {
                    float* dst = (MODE == 1) ? outw + (size_t)row[rr] * DM : opq_uniform(outw + (size_t)row[rr] * DM);
#pragma unroll
                    for (int i = 0; i < 8; ++i) *(f32x4*)(dst + 256 * i + 4 * lane) = (f32x4){v[rr][4 * i], v[rr][4 * i + 1], v[rr][4 * i + 2], v[rr][4 * i + 3]}; }
            }
            if (MODE != 0 && !(MODE == 2 && last) && !(MODE == 1 && RECOMP)) {
#pragma unroll
                for (int i = 0; i < 8; ++i) { u32x2 w; w.x = cvt_pk(v[rr][4 * i], v[rr][4 * i + 1]); w.y = cvt_pk(v[rr][4 * i + 2], v[rr][4 * i + 3]); *(u32x2*)(((MODE == 1) ? hb + (size_t)row[rr] * DM : opq_uniform(hb + (size_t)row[rr] * DM)) + 256 * i + 4 * lane) = w; }
            }
            if (MODE == 1 || !(MODE == 2 && last)) {
                unsigned char* hb8 = p.ws + (DUMMY ? WS_S : (MODE == 1 ? WS_HB8 : WS_HBQ));
#pragma unroll
                for (int i = 0; i < 8; ++i) *(unsigned*)(((MODE == 1) ? hb8 + (size_t)row[rr] * DM : opq_uniform(hb8 + (size_t)row[rr] * DM)) + 256 * i + 4 * lane) = pk4_fp8(v[rr][4 * i] * (float)(1 << X8_SH), v[rr][4 * i + 1] * (float)(1 << X8_SH), v[rr][4 * i + 2] * (float)(1 << X8_SH), v[rr][4 * i + 3] * (float)(1 << X8_SH));
            }
            asm volatile("" ::: "memory"); __builtin_amdgcn_sched_barrier(0);
        }
        if (do_skinny) {
            float tots[NR];
#pragma unroll
            for (int rr = 0; rr < NR; ++rr) {
                asm volatile("" ::: "memory"); __builtin_amdgcn_sched_barrier(0);
                float acc1[16];
                {
                    f32x2 acc2[8];
#pragma unroll
                    for (int ep = 0; ep < 8; ++ep) acc2[ep] = (f32x2){0.f, 0.f};
#pragma unroll
                    for (int i = 0; i < 8; ++i) {
                        const f32x2 s0 = (f32x2){v[rr][4 * i], v[rr][4 * i]}, s1 = (f32x2){v[rr][4 * i + 1], v[rr][4 * i + 1]}, s2 = (f32x2){v[rr][4 * i + 2], v[rr][4 * i + 2]}, s3 = (f32x2){v[rr][4 * i + 3], v[rr][4 * i + 3]};
#pragma unroll
                        for (int eh = 0; eh < 2; ++eh) {
#pragma unroll
                            for (int ep = 4 * eh; ep < 4 * eh + 4; ++ep) { const f32x4 wa = *(const f32x4*)(wT + (ep * DM + 256 * i + 4 * lane) * 2), wb = *(const f32x4*)(wT + (ep * DM + 256 * i + 4 * lane) * 2 + 4);
                                acc2[ep] += s0 * (f32x2){wa[0], wa[1]}; acc2[ep] += s1 * (f32x2){wa[2], wa[3]}; acc2[ep] += s2 * (f32x2){wb[0], wb[1]}; acc2[ep] += s3 * (f32x2){wb[2], wb[3]}; }
                            asm volatile("" ::: "memory"); } }
#pragma unroll
                    for (int ep = 0; ep < 8; ++ep) { acc1[2 * ep] = acc2[ep][0]; acc1[2 * ep + 1] = acc2[ep][1]; }
                }
                tots[rr] = reduce16(acc1, lane);
                if (MODE != 1) { if (lane < 16) glow[(size_t)row[rr] * 16 + lane] = tots[rr]; }
            }
            if (MODE == 1) {
#pragma unroll
              for (int rr = 0; rr < NR; ++rr) { if (lane < 16) rlog[((it + rr) * 8 + wave) * 16 + lane] = tots[rr]; }
            }
        }
    }
    if (MODE == 1) {
        unsigned* cnt = (unsigned*)(p.ws + WS_CTL) + (DUMMY ? CW_DBG + 64 : CW_CNT + layer * 64);
        __syncthreads();
        int e0 = 0, e1 = 0, ls0 = 0, ls1 = 0; float rw0 = 0.f, rw1 = 0.f;
        if (tid < 8 * nit) {
                    float lg[16];
#pragma unroll
                    for (int e = 0; e < 16; ++e) lg[e] = rlog[tid * 16 + e];
                    float mx = lg[0];
#pragma unroll
                    for (int e = 1; e < 16; ++e) mx = fmaxf(mx, lg[e]);
                    float aff[16], bi[16], sum = 0.f;
#pragma unroll
                    for (int e = 0; e < 16; ++e) { aff[e] = __expf(lg[e] - mx); sum += aff[e]; }
                    const float rs = 1.0f / sum;
#pragma unroll
                    for (int e = 0; e < 16; ++e) { aff[e] *= rs; bi[e] = aff[e] + p.in[10][e]; }
                    float gs[4];
#pragma unroll
                    for (int gi = 0; gi < 4; ++gi) { const float a0 = bi[4 * gi], a1 = bi[4 * gi + 1], a2 = bi[4 * gi + 2], a3 = bi[4 * gi + 3];
                        gs[gi] = fmaxf(fmaxf(fmaxf(a0 + a1, a0 + a2), fmaxf(a0 + a3, a1 + a2)), fmaxf(a1 + a3, a2 + a3)); }
                    int best = 0; float bv = gs[0];
#pragma unroll
                    for (int gi = 1; gi < 4; ++gi) if (gs[gi] > bv) { bv = gs[gi]; best = gi; }
                    float ab[4], aa[4];
#pragma unroll
                    for (int k = 0; k < 4; ++k) { ab[k] = best == 0 ? bi[k] : best == 1 ? bi[4 + k] : best == 2 ? bi[8 + k] : bi[12 + k];
                                                  aa[k] = best == 0 ? aff[k] : best == 1 ? aff[4 + k] : best == 2 ? aff[8 + k] : aff[12 + k]; }
                    int i1 = 0; float v1 = ab[0];
#pragma unroll
                    for (int k = 1; k < 4; ++k) if (ab[k] > v1) { v1 = ab[k]; i1 = k; }
                    int i2 = -1; float v2 = -3.0e38f;
#pragma unroll
                    for (int k = 0; k < 4; ++k) if (k != i1 && ab[k] > v2) { v2 = ab[k]; i2 = k; }
                    const float a1 = i1 == 0 ? aa[0] : i1 == 1 ? aa[1] : i1 == 2 ? aa[2] : aa[3];
                    const float a2 = i2 == 0 ? aa[0] : i2 == 1 ? aa[1] : i2 == 2 ? aa[2] : aa[3];
                    const float ws = 1.0f / (a1 + a2);
                    e0 = 4 * best + i1; e1 = 4 * best + i2; rw0 = a1 * ws; rw1 = a2 * ws;
                    ls0 = atomicAdd(&lcnt[e0], 1); ls1 = atomicAdd(&lcnt[e1], 1);
        }
        __syncthreads();
        if (tid < 16) gbase[tid] = (int)atomicAdd(&cnt[tid], (unsigned)lcnt[tid]);
        __syncthreads();
        if (tid < 8 * nit) {
            const int it = tid >> 3, wv = tid & 7, row = (it * (int)gridDim.x + (int)blockIdx.x) * 8 + wv;
            u32x4 a; a.x = (unsigned)e0; a.y = (unsigned)e1; a.z = __float_as_uint(rw0); a.w = __float_as_uint(rw1);
            u32x4 c; c.x = (unsigned)(gbase[e0] + ls0); c.y = (unsigned)(gbase[e1] + ls1); c.z = 0u; c.w = 0u;
            *(u32x4*)(tok + row * 8) = a; *(u32x4*)(tok + row * 8 + 4) = c;
            if (!DUMMY) { unsigned* idx = (unsigned*)(p.ws + WS_IDX); idx[(size_t)e0 * 16384 + c.x] = (unsigned)row; idx[(size_t)e1 * 16384 + c.y] = (unsigned)row; }
        }
        __syncthreads();
    }
    __syncthreads();
}

__device__ void phase_perm(const Params& p, int layer, unsigned char* lds) {
    const int tid = opq_tid(), lane = tid & 63, wave = __builtin_amdgcn_readfirstlane(tid >> 6);
    int* sb = (int*)lds;
    const unsigned* cnt = (const unsigned*)(p.ws + WS_CTL) + CW_CNT + layer * 64;
    unsigned* misc = (unsigned*)(p.ws + WS_MISC) + layer * 256;
    if (tid < 64) {
        const int c = (lane < NE) ? (int)ldu(cnt + lane) : 0;
        const int nP = (c + 255) >> 8;
        int incl = nP;
#pragma unroll
        for (int o = 1; o < 16; o <<= 1) { const int t = __shfl_up(incl, o); if (lane >= o) incl += t; }
        const int excl = incl - nP;
        if (lane < NE) {
            sb[lane] = excl * 256;
            if (blockIdx.x == 0) { misc[16 + lane] = (unsigned)(excl * 256); for (int q = 0; q < nP; ++q) misc[64 + excl + q] = (unsigned)lane; if (lane == NE - 1) misc[0] = (unsigned)incl; }
        }
    }
    __syncthreads();
    unsigned* tok = (unsigned*)(p.ws + WS_TOK);
    const bf16_t* hb = (const bf16_t*)(p.ws + WS_HB); unsigned char* Xs = p.ws + WS_XS;
    const int nit = T / (8 * (int)gridDim.x);
    for (int it = 0; it < nit; ++it) {
        const int row = (it * (int)gridDim.x + (int)blockIdx.x) * 8 + wave;
        const int e0 = (int)ldu(tok + row * 8), e1 = (int)ldu(tok + row * 8 + 1);
        const int r0 = sb[e0] + (int)ldu(tok + row * 8 + 4), r1 = sb[e1] + (int)ldu(tok + row * 8 + 5);
        const u32x4* s = (const u32x4*)(hb + (size_t)row * DM);
#pragma unroll
        for (int hh = 0; hh < 2; ++hh) {
            float f[16]; { float fa[8], fb[8]; unpack8(s[2 * lane + 128 * hh], fa); unpack8(s[2 * lane + 1 + 128 * hh], fb);
#pragma unroll
                for (int i = 0; i < 8; ++i) { f[i] = fa[i] * (float)(1 << X8_SH); f[8 + i] = fb[i] * (float)(1 << X8_SH); } }
            const u32x4 x = {pk4_fp8(f[0], f[1], f[2], f[3]), pk4_fp8(f[4], f[5], f[6], f[7]), pk4_fp8(f[8], f[9], f[10], f[11]), pk4_fp8(f[12], f[13], f[14], f[15])};
            *(u32x4*)(Xs + (size_t)r0 * DM + 16 * lane + 1024 * hh) = x; *(u32x4*)(Xs + (size_t)r1 * DM + 16 * lane + 1024 * hh) = x; }
        if (lane == 0) { tok[row * 8 + 6] = (unsigned)r0; tok[row * 8 + 7] = (unsigned)r1; }
    }
    __syncthreads();
}
constexpr int GL_V = 0, GL_K = 33792, GL_Q = 51200, GL_B = 68608, GL_GLW = 101376, GL_TOT = 105472, GL_AT = 107520, GL_RED = 116736, GL_W = 118784;
#ifndef GLA_PROBE
#define GLA_PROBE 0
#endif
#ifndef GLA_NOTR
#define GLA_NOTR 0
#endif
#ifndef ATT_QMAX_DEF
#define ATT_QMAX_DEF 512
#endif
constexpr int ATT_QMAX = ATT_QMAX_DEF;
constexpr int KSB = 272, VSB = 528, ASB = 144;
__device__ __forceinline__ int blx(int row, int col) { return row * 128 + ((((col >> 2) ^ (row & 7))) << 2) + (col & 3); }

__device__ __forceinline__ f32x4 gla_decay(unsigned char* lds) {
    const int tid = opq_tid();
    float* bl = (float*)(lds + GL_B); const float* glw = (const float*)(lds + GL_GLW); float* tot = (float*)(lds + GL_TOT); float* gt = (float*)(lds + GL_AT);
    const int dq = tid & 31, tg = tid >> 5;
    asm volatile("s_waitcnt vmcnt(0)" ::: "memory");
    __syncthreads();
    f32x4 all = (f32x4){0.f, 0.f, 0.f, 0.f};
#pragma unroll 1
    for (int pr_ = 0; pr_ < (GLA_PROBE == 1 ? 5 : 1); ++pr_) {
    const f32x4 bg = *(const f32x4*)((const float*)(lds + GL_W) + 2048 + 4 * dq);
    f32x4 x[4] = {bg, bg, bg, bg};
#pragma unroll
    for (int hf = 0; hf < 2; ++hf) {
        f32x4 w[8];
#pragma unroll
        for (int r = 0; r < 8; ++r) w[r] = *(const f32x4*)((const float*)(lds + GL_W) + (8 * hf + r) * 128 + 4 * dq);
#pragma unroll
        for (int tt = 0; tt < 4; ++tt) { const f32x4* gr = (const f32x4*)(glw + (tg * 4 + tt) * 16 + 8 * hf); const f32x4 g0 = gr[0], g1 = gr[1];
            x[tt] += g0[0] * w[0] + g0[1] * w[1] + g0[2] * w[2] + g0[3] * w[3] + g1[0] * w[4] + g1[1] * w[5] + g1[2] * w[6] + g1[3] * w[7]; }
        __builtin_amdgcn_sched_barrier(0);
    }
    f32x4 run = (f32x4){0.f, 0.f, 0.f, 0.f};
#pragma unroll
    for (int tt = 0; tt < 4; ++tt) {
        const int tk = tg * 4 + tt;
#pragma unroll
        for (int j = 0; j < 4; ++j) run[j] += (fminf(x[tt][j], 0.f) - __logf(1.0f + __expf(-fabsf(x[tt][j])))) * 0.0625f;
        *(f32x4*)(bl + tk * 128 + 4 * dq) = run;
    }
    *(f32x4*)(gt + tg * 128 + 4 * dq) = run;
    __syncthreads();
    f32x4 pre = (f32x4){0.f, 0.f, 0.f, 0.f}; all = pre;
#pragma unroll
    for (int g2 = 0; g2 < 16; ++g2) { const f32x4 tv = *(const f32x4*)(gt + g2 * 128 + 4 * dq); if (g2 < tg) pre += tv; all += tv; }
#pragma unroll
    for (int tt = 0; tt < 4; ++tt) { f32x4* bp = (f32x4*)(bl + (tg * 4 + tt) * 128 + 4 * dq); *bp = *bp + pre; }
    if (tg == 0) { *(f32x4*)(tot + 4 * dq) = all; *(f32x4*)(tot + 128 + 4 * dq) = (f32x4){__expf(all[0]), __expf(all[1]), __expf(all[2]), __expf(all[3])}; }
    __syncthreads();
    }
    return all;
}
__device__ __forceinline__ void gla_stage_v(const bf16_t* proj, int c, int h, unsigned char* lds) {
    const int tid = opq_tid(), tk = tid >> 3, dv0 = (tid & 7) * 32;
    const u32x4* s = (const u32x4*)(proj + ix_gv(h, c * 64 + tk) + dv0);
    u32x4* d = (u32x4*)(lds + GL_V + tk * VSB + dv0 * 2);
#pragma unroll
    for (int i = 0; i < 4; ++i) d[i] = s[i];
}

template <bool OUT>
static __device__ void gla_super_unit(const Params& p, int layer, int sc, int h, unsigned char* lds) {
    const int tid = opq_tid(), lane = tid & 63, wave = tid >> 6, g = lane >> 4, l15 = lane & 15;
    const bf16_t* proj = (const bf16_t*)(p.ws + WS_PROJ);
    const int tk0 = tid >> 3, dk0 = (tid & 7) * 16, dv0 = (tid & 7) * 32;
    const int lbase = (int)(uintptr_t)lds, trow = l15 >> 2, tcol = 4 * (lane & 3);
    const float* bl = (const float*)(lds + GL_B); float* tot = (float*)(lds + GL_TOT);
    f32x4 S[8][2];
    if (OUT && sc > 0) {
        const bf16_t* Sst = (const bf16_t*)(p.ws + WS_S) + ((size_t)sc * 4 + h) * 256 * 128;
#pragma unroll
        for (int m = 0; m < 8; ++m)
#pragma unroll
            for (int nn = 0; nn < 2; ++nn) { const u32x2 w = *(const u32x2*)(Sst + (size_t)(32 * wave + 16 * nn + l15) * 128 + 16 * m + 4 * g);
                S[m][nn] = (f32x4){bflo(w.x), bfhi(w.x), bflo(w.y), bfhi(w.y)}; }
    } else {
#pragma unroll
        for (int m = 0; m < 8; ++m) { S[m][0] = (f32x4){0.f, 0.f, 0.f, 0.f}; S[m][1] = (f32x4){0.f, 0.f, 0.f, 0.f}; }
    }
    f32x4 bsum = (f32x4){0.f, 0.f, 0.f, 0.f};
    if (!OUT) { float* wl = (float*)(lds + GL_W);
#pragma unroll
      for (int j = 0; j < 4; ++j) { const int idx = tid + 512 * j; wl[idx] = p.in[3][(size_t)layer * 16 * 512 + (idx >> 7) * 512 + h * 128 + (idx & 127)]; }
      if (tid < 128) wl[2048 + tid] = p.in[4][layer * 512 + h * 128 + tid]; }
    float* gB = (float*)(p.ws + WS_BDEC);
    u32x4 qreg[2], kreg[2], vreg[4];
    const int wu = __builtin_amdgcn_readfirstlane(wave);
#define GLA_REQ(cq) { const int c_ = (cq); \
        const u32x4* sk = (const u32x4*)(proj + ix_gk(h, c_ * 64 + tk0) + dk0); const u32x4* sv = (const u32x4*)(proj + ix_gv(h, c_ * 64 + tk0) + dv0); \
        kreg[0] = sk[0]; kreg[1] = sk[1]; \
        if (OUT) { const u32x4* sq = (const u32x4*)(proj + ix_gq(h, c_ * 64 + tk0) + dk0); qreg[0] = sq[0]; qreg[1] = sq[1]; } \
        _Pragma("unroll") for (int i = 0; i < 4; ++i) vreg[i] = sv[i]; \
        if (!OUT) { if (wu < 4) __builtin_amdgcn_global_load_lds((const unsigned*)((const float*)(p.ws + WS_GLOW) + (size_t)c_ * 64 * 16 + tid * 4), (PG8_LAS unsigned*)(size_t)(unsigned)(lbase + GL_GLW + wu * 1024), 16, 0, 0); } \
        else { _Pragma("unroll") for (int k_ = 0; k_ < 4; ++k_) __builtin_amdgcn_global_load_lds((const unsigned*)(gB + ((size_t)c_ * 4 + h) * 8192 + (k_ * 512 + tid) * 4), (PG8_LAS unsigned*)(size_t)(unsigned)(lbase + GL_B + k_ * 8192 + wu * 1024), 16, 0, 0); } }
    GLA_REQ(sc * 4);
#pragma unroll 1
    for (int cc = 0; cc < 4; ++cc) {
        const int c = sc * 4 + cc;
        if (!OUT) {
            bsum += gla_decay(lds);
            float* gt_ = gB + ((size_t)c * 4 + h) * 8192;
#pragma unroll
            for (int k_ = 0; k_ < 4; ++k_) *(f32x4*)(gt_ + (k_ * 512 + tid) * 4) = *(const f32x4*)(bl + (k_ * 512 + tid) * 4);
        } else {
            asm volatile("s_waitcnt vmcnt(0)" ::: "memory");
            __syncthreads();
            if (tid < 128) { const float bb = bl[63 * 128 + tid]; tot[tid] = bb; tot[128 + tid] = __expf(bb); }
        }
        if (OUT) {
#pragma unroll
            for (int hlf = 0; hlf < 2; ++hlf) { float fq[8], fk[8]; unpack8(qreg[hlf], fq); unpack8(kreg[hlf], fk);
#pragma unroll
                for (int j = 0; j < 8; ++j) { const float bb = bl[tk0 * 128 + dk0 + hlf * 8 + j]; fq[j] *= __expf(bb) * 0.08838834764831845f; fk[j] *= __expf(-bb); }
                *(u32x4*)(lds + GL_Q + tk0 * KSB + (dk0 + hlf * 8) * 2) = pack8(fq); *(u32x4*)(lds + GL_K + tk0 * KSB + (dk0 + hlf * 8) * 2) = pack8(fk); }
        }
#pragma unroll
        for (int i = 0; i < 4; ++i) *(u32x4*)(lds + GL_V + tk0 * VSB + dv0 * 2 + 16 * i) = vreg[i];
        __syncthreads();
        f32x4 acc[2][4]; u32x2 ggr[4][2]; f32x4 gn[2];
        if (OUT) {
#if GLA_PROBE == 2
#pragma unroll 1
            for (int pr_ = 0; pr_ < 5; ++pr_)
#endif
            { const int mj = wave >> 1;
              f32x4 at[2] = {(f32x4){0.f, 0.f, 0.f, 0.f}, (f32x4){0.f, 0.f, 0.f, 0.f}};
#pragma unroll
              for (int ks = 0; ks < 4; ++ks) {
                  const bf16x8 A = *(const bf16x8*)(lds + GL_K + (16 * mj + l15) * KSB + (32 * ks + 8 * g) * 2);
#pragma unroll
                  for (int t2 = 0; t2 < 2; ++t2) { const int ni = 2 * (wave & 1) + t2; const bf16x8 B = *(const bf16x8*)(lds + GL_Q + (16 * ni + l15) * KSB + (32 * ks + 8 * g) * 2); at[t2] = MFMA16(A, B, at[t2]); }
              }
#pragma unroll
              for (int t2 = 0; t2 < 2; ++t2) { const int ni = 2 * (wave & 1) + t2, i = 16 * ni + l15, j0 = 16 * mj + 4 * g;
                  float v[4];
#pragma unroll
                  for (int r = 0; r < 4; ++r) v[r] = (i >= j0 + r) ? at[t2][r] : 0.f;
                  u32x2 w; w.x = cvt_pk(v[0], v[1]); w.y = cvt_pk(v[2], v[3]); *(u32x2*)(lds + GL_AT + i * ASB + j0 * 2) = w; }
            }
            __syncthreads();
        }
#pragma unroll
        for (int hlf = 0; hlf < 2; ++hlf) { float f[8]; unpack8(kreg[hlf], f);
#pragma unroll
            for (int j = 0; j < 8; ++j) f[j] *= __expf(tot[dk0 + hlf * 8 + j] - bl[tk0 * 128 + dk0 + hlf * 8 + j]);
            *(u32x4*)(lds + GL_K + tk0 * KSB + (dk0 + hlf * 8) * 2) = pack8(f); }
        if (!OUT) GLA_REQ(sc * 4 + (cc < 3 ? cc + 1 : 3));
        if (OUT) {
#pragma unroll
            for (int mm = 0; mm < 2; ++mm)
#pragma unroll
                for (int n = 0; n < 4; ++n) acc[mm][n] = (f32x4){0.f, 0.f, 0.f, 0.f};
#if GLA_PROBE == 3
#pragma unroll 1
            for (int pr_ = 0; pr_ < 5; ++pr_) {
            if (pr_ > 0) {
#pragma unroll
                for (int mm = 0; mm < 2; ++mm)
#pragma unroll
                    for (int n = 0; n < 4; ++n) acc[mm][n] *= 1e-30f; }
#endif
#pragma unroll
            for (int ks = 0; ks < 2; ++ks) {
                const int kb = 32 * ks + 8 * g + trow;
                s16x4 vl[2], vh[2]; bf16x8 B[4];
#pragma unroll
                for (int mm = 0; mm < 2; ++mm) { const int a = lbase + GL_V + kb * VSB + (32 * wave + 16 * mm + tcol) * 2; vl[mm] = tr_rd(a); vh[mm] = tr_rd(a + 4 * VSB); }
#pragma unroll
                for (int n = 0; n < 4; ++n) B[n] = *(const bf16x8*)(lds + GL_AT + (16 * n + l15) * ASB + (32 * ks + 8 * g) * 2);
                LGKM0();
#pragma unroll
                for (int mm = 0; mm < 2; ++mm)
#pragma unroll
                    for (int n = 0; n < 4; ++n) acc[mm][n] = MFMA16(PK8(vl[mm], vh[mm]), B[n], acc[mm][n]);
            }
            if (sc > 0 || cc > 0) {
#pragma unroll
                for (int s = 0; s < 4; ++s) {
                    bf16x8 A[2], B[4];
#pragma unroll
                    for (int mm = 0; mm < 2; ++mm) { u32x4 w; w.x = cvt_pk(S[2 * s][mm][0], S[2 * s][mm][1]); w.y = cvt_pk(S[2 * s][mm][2], S[2 * s][mm][3]);
                        w.z = cvt_pk(S[2 * s + 1][mm][0], S[2 * s + 1][mm][1]); w.w = cvt_pk(S[2 * s + 1][mm][2], S[2 * s + 1][mm][3]); A[mm] = __builtin_bit_cast(bf16x8, w); }
#pragma unroll
                    for (int n = 0; n < 4; ++n) { const unsigned char* qr = lds + GL_Q + (16 * n + l15) * KSB + (32 * s + 4 * g) * 2;
                        const u32x2 lo = *(const u32x2*)qr, hi = *(const u32x2*)(qr + 32); u32x4 w; w.x = lo.x; w.y = lo.y; w.z = hi.x; w.w = hi.y; B[n] = __builtin_bit_cast(bf16x8, w); }
#pragma unroll
                    for (int mm = 0; mm < 2; ++mm)
#pragma unroll
                        for (int n = 0; n < 4; ++n) acc[mm][n] = MFMA16(A[mm], B[n], acc[mm][n]);
                    __builtin_amdgcn_sched_barrier(0);
                }
            }
#if GLA_PROBE == 3
            }
#endif
            GLA_REQ(sc * 4 + (cc < 3 ? cc + 1 : 3));
#pragma unroll
            for (int n = 0; n < 4; ++n)
#pragma unroll
                for (int mm = 0; mm < 2; ++mm) ggr[n][mm] = *(const u32x2*)(proj + ix_gg(h, c * 64 + 16 * n + l15) + 32 * wave + 16 * mm + 4 * g);
#pragma unroll
            for (int mm = 0; mm < 2; ++mm) gn[mm] = *(const f32x4*)(p.in[5] + layer * 256 + 32 * wave + 16 * mm + 4 * g);
            float* red = (float*)(lds + GL_RED);
            float ss[4];
#pragma unroll
            for (int n = 0; n < 4; ++n) { float s = 0.f;
#pragma unroll
                for (int mm = 0; mm < 2; ++mm)
#pragma unroll
                    for (int r = 0; r < 4; ++r) s += acc[mm][n][r] * acc[mm][n][r];
                s += __shfl_xor(s, 16); s += __shfl_xor(s, 32); ss[n] = s; }
            if (g == 0) {
#pragma unroll
                for (int n = 0; n < 4; ++n) red[(16 * n + l15) * 8 + wave] = ss[n]; }
        }
        __syncthreads();
        if (OUT) {
#if GLA_PROBE == 4
#pragma unroll 1
            for (int pr_ = 0; pr_ < 5; ++pr_) {
#endif
            const float* red = (const float*)(lds + GL_RED);
            bf16_t* mix = (bf16_t*)(p.ws + WS_MIX);
#pragma unroll
            for (int n = 0; n < 4; ++n) {
                const int tk = 16 * n + l15; const f32x4 r0 = *(const f32x4*)(red + tk * 8), r1 = *(const f32x4*)(red + tk * 8 + 4);
                const float rstd = rsqrtf(((r0[0] + r0[1]) + (r0[2] + r0[3]) + (r1[0] + r1[1]) + (r1[2] + r1[3])) * (1.0f / 256.0f) + 1e-6f);
                const size_t tg = (size_t)c * 64 + tk;
#pragma unroll
                for (int mm = 0; mm < 2; ++mm) { const int dv = 32 * wave + 16 * mm + 4 * g;
                    const u32x2 gg = ggr[n][mm]; const f32x4 nr = gn[mm];
                    const f32x4 o4 = acc[mm][n] * ((nr * rstd) * (f32x4){silu_f(bflo(gg.x)), silu_f(bfhi(gg.x)), silu_f(bflo(gg.y)), silu_f(bfhi(gg.y))});
                    const float o0 = o4[0], o1 = o4[1], o2 = o4[2], o3 = o4[3];
#if OUT8
                    *(unsigned*)((unsigned char*)mix + tg * DM + h * 256 + dv) = pk4_fp8(o0 * (float)(1 << MIX8_SH), o1 * (float)(1 << MIX8_SH), o2 * (float)(1 << MIX8_SH), o3 * (float)(1 << MIX8_SH)); }
#else
                    u32x2 w; w.x = cvt_pk(o0, o1); w.y = cvt_pk(o2, o3); *(u32x2*)(mix + tg * DM + h * 256 + dv) = w; }
#endif
            }
#if GLA_PROBE == 4
            }
#endif
        }
        if (!OUT || cc < 3) {
#pragma unroll
            for (int m = 0; m < 8; ++m) { const f32x4 av = *(const f32x4*)(tot + 128 + 16 * m + 4 * g);
#pragma unroll
                for (int nn = 0; nn < 2; ++nn) S[m][nn] *= av; }
#pragma unroll
            for (int ks = 0; ks < 2; ++ks) {
                const int kb = 32 * ks + 8 * g + trow;
                s16x4 al[4], ah[4], vl[2], vh[2];
#pragma unroll
                for (int nn = 0; nn < 2; ++nn) { const int a = lbase + GL_V + kb * VSB + (32 * wave + 16 * nn + tcol) * 2; vl[nn] = tr_rd(a); vh[nn] = tr_rd(a + 4 * VSB); }
#pragma unroll
                for (int mh = 0; mh < 2; ++mh) {
#pragma unroll
                    for (int m = 0; m < 4; ++m) { const int a = lbase + GL_K + kb * KSB + (16 * (4 * mh + m) + tcol) * 2; al[m] = tr_rd(a); ah[m] = tr_rd(a + 4 * KSB); }
                    LGKM0();
#pragma unroll
                    for (int m = 0; m < 4; ++m)
#pragma unroll
                        for (int nn = 0; nn < 2; ++nn) S[4 * mh + m][nn] = MFMA16(PK8(al[m], ah[m]), PK8(vl[nn], vh[nn]), S[4 * mh + m][nn]);
                    __builtin_amdgcn_sched_barrier(0);
                }
            }
        }
        __syncthreads();
    }
    if (!OUT) {
        bf16_t* E = (bf16_t*)(p.ws + WS_U);
#pragma unroll
        for (int m = 0; m < 8; ++m)
#pragma unroll
            for (int nn = 0; nn < 2; ++nn) { const int dv = 32 * wave + 16 * nn + l15, dk = 16 * m + 4 * g;
                u32x2 w; w.x = cvt_pk(S[m][nn][0], S[m][nn][1]); w.y = cvt_pk(S[m][nn][2], S[m][nn][3]);
                *(u32x2*)(E + (((size_t)sc * 4 + h) * 256 + dv) * 128 + dk) = w; }
        if (tid < 32) *(f32x4*)((float*)(p.ws + WS_GDEC) + ((size_t)sc * 4 + h) * 128 + 4 * tid) = (f32x4){__expf(bsum[0]), __expf(bsum[1]), __expf(bsum[2]), __expf(bsum[3])};
    }
}
#undef GLA_REQ
static __device__ void gla_scan(const Params& p, int bi, int nblk, unsigned char* lds) {
    const unsigned* U32 = (const unsigned*)(p.ws + WS_U); unsigned* S32 = (unsigned*)(p.ws + WS_S); const float* gdec = (const float*)(p.ws + WS_GDEC);
    const int tid = opq_tid();
    float* dl = (float*)lds;
    for (int i0 = bi * 256; i0 < 65536; i0 += nblk * 256) {
        const int idx = i0 + (tid & 255), h = i0 >> 14, dk = (2 * idx) & 127;
        unsigned u[64];
        if (tid < 256) {
#pragma unroll
            for (int i = 0; i < 64; ++i) u[i] = U32[(size_t)i * 65536 + idx]; }
#pragma unroll
        for (int k = 0; k < 4; ++k) { const int e = (tid + 512 * k) * 4, c = e >> 7, d = e & 127; *(f32x4*)(dl + e) = *(const f32x4*)(gdec + ((size_t)c * 4 + h) * 128 + d); }
        __syncthreads();
        if (tid < 256) {
            float s0 = 0.f, s1 = 0.f;
#pragma unroll
            for (int i = 0; i < 64; ++i) { S32[(size_t)i * 65536 + idx] = cvt_pk(s0, s1); const f32x2 a = *(const f32x2*)(dl + i * 128 + dk); s0 = a[0] * s0 + bflo(u[i]); s1 = a[1] * s1 + bfhi(u[i]); } }
        __syncthreads();
    }
}

static __device__ void moba_kmean_unit(const Params& p, int h, int j, unsigned char* lds) {
    const int tid = opq_tid(), d0 = (tid & 15) * 8, kg = tid >> 4;
    const bf16_t* proj = (const bf16_t*)(p.ws + WS_PROJ);
    float acc[8];
#pragma unroll
    for (int i = 0; i < 8; ++i) acc[i] = 0.f;
#pragma unroll
    for (int kk = 0; kk < 8; ++kk) { float f[8]; unpack8(*(const u32x4*)(proj + ix_mk(h, j * 256 + kg * 8 + kk) + d0), f);
#pragma unroll
        for (int i = 0; i < 8; ++i) acc[i] += f[i]; }
    float* red = (float*)lds;
#pragma unroll
    for (int i = 0; i < 8; ++i) red[kg * 128 + d0 + i] = acc[i];
    __syncthreads();
    if (tid < 128) { float s = 0.f;
#pragma unroll 8
        for (int q = 0; q < 32; ++q) s += red[q * 128 + tid];
        ((float*)(p.ws + WS_KMEAN))[((size_t)h * 64 + j) * 128 + tid] = s * (1.0f / 256.0f); }
    __syncthreads();
}

#define TOP3_INS_IF(ok, s, j) do { const float _s = (s); const int _j = (j); const bool _ok = (ok); \
    const bool _c0 = _ok & ((_s > v0) | ((_s == v0) & (_j < i0))), _c1 = _ok & ((_s > v1) | ((_s == v1) & (_j < i1))), _c2 = _ok & ((_s > v2) | ((_s == v2) & (_j < i2))); \
    v2 = _c1 ? v1 : (_c2 ? _s : v2); i2 = _c1 ? i1 : (_c2 ? _j : i2); \
    v1 = _c0 ? v0 : (_c1 ? _s : v1); i1 = _c0 ? i0 : (_c1 ? _j : i1); \
    v0 = _c0 ? _s : v0;              i0 = _c0 ? _j : i0; } while (0)
#define TOP3_INS(s, j) TOP3_INS_IF(true, s, j)

static __device__ void moba_gate_unit(const Params& p, int h, int qb, unsigned char* lds) {
    const int tid = opq_tid(), lane = tid & 63, wave = tid >> 6, g = lane >> 4, l15 = lane & 15;
    const bf16_t* proj = (const bf16_t*)(p.ws + WS_PROJ);
    unsigned* selp = (unsigned*)(p.ws + WS_SEL) + (size_t)h * T + qb * 256;
    if (qb == 0) { if (tid < 256) selp[tid] = 0xFFFFFFFFu; return; }
    constexpr int GSB = 272, GLO = 64 * GSB;
    bf16x8 B[2][4];
#pragma unroll
    for (int t2 = 0; t2 < 2; ++t2)
#pragma unroll
        for (int s2 = 0; s2 < 4; ++s2) B[t2][s2] = *(const bf16x8*)(proj + ix_mq(h, qb * 256 + 32 * wave + 16 * t2 + l15) + 32 * s2 + 8 * g);
    { const int j = tid >> 3, c0 = (tid & 7) * 16;
      {
          const f32x4* src = (const f32x4*)((const float*)(p.ws + WS_KMEAN) + ((size_t)h * 64 + j) * 128 + c0);
          u32x4 hi[2], lo[2];
#pragma unroll
          for (int k = 0; k < 2; ++k) { const f32x4 a = src[2 * k], b = src[2 * k + 1];
              hi[k].x = cvt_pk(a[0], a[1]); hi[k].y = cvt_pk(a[2], a[3]); hi[k].z = cvt_pk(b[0], b[1]); hi[k].w = cvt_pk(b[2], b[3]);
              lo[k].x = cvt_pk(a[0] - bflo(hi[k].x), a[1] - bfhi(hi[k].x)); lo[k].y = cvt_pk(a[2] - bflo(hi[k].y), a[3] - bfhi(hi[k].y));
              lo[k].z = cvt_pk(b[0] - bflo(hi[k].z), b[1] - bfhi(hi[k].z)); lo[k].w = cvt_pk(b[2] - bflo(hi[k].w), b[3] - bfhi(hi[k].w)); }
          *(u32x4*)(lds + j * GSB + c0 * 2) = hi[0]; *(u32x4*)(lds + j * GSB + c0 * 2 + 16) = hi[1];
          *(u32x4*)(lds + GLO + j * GSB + c0 * 2) = lo[0]; *(u32x4*)(lds + GLO + j * GSB + c0 * 2 + 16) = lo[1]; } }
    __syncthreads();
    f32x4 acc[2][4];
#pragma unroll
    for (int t2 = 0; t2 < 2; ++t2)
#pragma unroll
        for (int n = 0; n < 4; ++n) acc[t2][n] = (f32x4){0.f, 0.f, 0.f, 0.f};
#pragma unroll
    for (int n = 0; n < 4; ++n) {
        {
#pragma unroll
            for (int s2 = 0; s2 < 4; ++s2) {
                const bf16x8 Ah = *(const bf16x8*)(lds + (16 * n + l15) * GSB + (32 * s2 + 8 * g) * 2), Al = *(const bf16x8*)(lds + GLO + (16 * n + l15) * GSB + (32 * s2 + 8 * g) * 2);
#pragma unroll
                for (int t2 = 0; t2 < 2; ++t2) { acc[t2][n] = MFMA16(Ah, B[t2][s2], acc[t2][n]); acc[t2][n] = MFMA16(Al, B[t2][s2], acc[t2][n]); }
            }
        }
    }
#pragma unroll
    for (int t2 = 0; t2 < 2; ++t2) {
        float v0 = -3.0e38f, v1 = -3.0e38f, v2 = -3.0e38f; int i0 = 255, i1 = 255, i2 = 255;
#pragma unroll
        for (int n = 0; n < 4; ++n)
#pragma unroll
            for (int r = 0; r < 4; ++r) { const int j = 16 * n + 4 * g + r; TOP3_INS_IF(j < qb, acc[t2][n][r], j); }
#pragma unroll
        for (int o = 16; o <= 32; o <<= 1) {
            const float c0 = __shfl_xor(v0, o), c1 = __shfl_xor(v1, o), c2 = __shfl_xor(v2, o); const int j0 = __shfl_xor(i0, o), j1 = __shfl_xor(i1, o), j2 = __shfl_xor(i2, o);
            TOP3_INS_IF(j0 != 255, c0, j0);
            TOP3_INS_IF(j1 != 255, c1, j1);
            TOP3_INS_IF(j2 != 255, c2, j2);
        }
        if (g == 0) selp[32 * wave + 16 * t2 + l15] = (unsigned)i0 | ((unsigned)i1 << 8) | ((unsigned)i2 << 16) | 0xFF000000u;
    }
    __syncthreads();
}

__device__ __forceinline__ int list_off(int j) { return 256 * (63 * j - (j * (j - 1)) / 2); }

static __device__ void moba_list_unit(const Params& p, int layer, int h, int j, unsigned char* lds) {
    const int tid = opq_tid(), lane = tid & 63, wave = tid >> 6;
    const unsigned* sel = (const unsigned*)(p.ws + WS_SEL) + (size_t)h * T;
    unsigned* list = (unsigned*)(p.ws + WS_LIST) + (size_t)h * LISTH + list_off(j);
    int* wcnt = (int*)lds;
    int total = 0;
    const u32x4 none = {0xFFFFFFFFu, 0xFFFFFFFFu, 0xFFFFFFFFu, 0xFFFFFFFFu};
    const int qs = (j + 1) * 256 + 4 * tid;
    u32x4 wa = none, wb = none, wc = none;
    if (qs < T) wa = *(const u32x4*)(sel + qs);
    if (qs + 4 * NTHR < T) wb = *(const u32x4*)(sel + qs + 4 * NTHR);
    if (qs + 8 * NTHR < T) wc = *(const u32x4*)(sel + qs + 8 * NTHR);
#pragma unroll 1
    for (int q0 = (j + 1) * 256; q0 < T; q0 += 4 * NTHR) {
        const int q = q0 + 4 * tid;
        const u32x4 w4 = wa; wa = wb; wb = wc; wc = none;
        if (q + 12 * NTHR < T) wc = *(const u32x4*)(sel + q + 12 * NTHR);
        int slot[4], cntl = 0;
#pragma unroll
        for (int i = 0; i < 4; ++i) { const unsigned w = w4[i];
            slot[i] = ((w & 0xFF) == (unsigned)j) ? 0 : (((w >> 8) & 0xFF) == (unsigned)j) ? 1 : (((w >> 16) & 0xFF) == (unsigned)j) ? 2 : -1; cntl += slot[i] >= 0; }
        int incl = cntl;
#pragma unroll
        for (int o = 1; o < 64; o <<= 1) { const int t2 = __shfl_up(incl, o); if (lane >= o) incl += t2; }
        if (lane == 63) wcnt[wave] = incl;
        __syncthreads();
        int off = total + incl - cntl, tot = 0;
#pragma unroll
        for (int w2 = 0; w2 < 8; ++w2) { const int cw = wcnt[w2]; off += (w2 < wave) ? cw : 0; tot += cw; }
#pragma unroll
        for (int i = 0; i < 4; ++i) if (slot[i] >= 0) { list[off] = (unsigned)(q + i) | ((unsigned)slot[i] << 16); ++off; }
        total += tot;
        __syncthreads();
    }
    if (tid == 0) {
        unsigned* ctl = (unsigned*)(p.ws + WS_CTL);
        const int nit = total > 0 ? (total + ATT_QMAX - 1) / ATT_QMAX : 1;
        u32x4* items = (u32x4*)(p.ws + WS_ITEMS) + layer * 4096;
        if (nit > 1) { const unsigned bf = atomicAdd(&ctl[CW_NIT + layer * 64 + 1], (unsigned)(nit - 1));
            for (int c = 0; c < nit - 1; ++c) items[bf + c] = (u32x4){(unsigned)h, (unsigned)j, (unsigned)c, (unsigned)total}; }
        const unsigned bb = atomicAdd(&ctl[CW_NIT + layer * 64 + 2], 1u);
        items[4095 - bb] = (u32x4){(unsigned)h, (unsigned)j, (unsigned)(nit - 1), (unsigned)total};
        atomicAdd(&ctl[CW_NIT + layer * 64], (unsigned)nit);
    }
}
namespace att {
constexpr int D = 128, NW = 8, QBLK = 32, KVBLK = 64, LDK = 128;
constexpr float SCALE = 0.088388347648318440f, THR = 8.f;
constexpr float CEXP = SCALE * 1.4426950408889634f;
constexpr size_t SHM_V = KVBLK * D * 2, SHM_K = KVBLK * D * 2;
#define KSWZ(row, colB) ((row) * 256 + ((colB) ^ (((row) & 7) << 4)))
#define SBAR() __builtin_amdgcn_sched_barrier(0)
__device__ __forceinline__ int crow(int r, int hi) { return (r & 3) + 8 * (r >> 2) + 4 * hi; }
__device__ __forceinline__ unsigned cvtpk(float lo, float hi) { return cvt_pk(lo, hi); }

__device__ __forceinline__ void partialSM(f32x16& p0, f32x16& p1, float& m_reg, float& mn, float& alpha) {
  constexpr float C = CEXP;
  float pmax = p0[0];
#pragma unroll
  for (int r = 1; r < 16; ++r) pmax = fmaxf(pmax, p0[r]);
#pragma unroll
  for (int r = 0; r < 16; ++r) pmax = fmaxf(pmax, p1[r]);
  { auto rr = __builtin_amdgcn_permlane32_swap(__float_as_uint(pmax), __float_as_uint(pmax), false, false);
    pmax = fmaxf(__uint_as_float(rr[0]), __uint_as_float(rr[1])); }
  if (__builtin_expect(__all(pmax - m_reg <= THR / SCALE), 1)) { mn = m_reg; alpha = 1.f; }
  else { mn = fmaxf(m_reg, pmax); alpha = __builtin_amdgcn_exp2f((m_reg - mn) * C); m_reg = mn; }
  const float mnC = -mn * C;
  { f32x16 cv, mv;
#pragma unroll
    for (int r = 0; r < 16; ++r) { cv[r] = C; mv[r] = mnC; }
    p0 = p0 * cv + mv; p1 = p1 * cv + mv; }
#pragma unroll
  for (int r = 0; r < 16; ++r) p0[r] = __builtin_amdgcn_exp2f(p0[r]);
}
__device__ __forceinline__ void finishSM(f32x16& p0, f32x16& p1, float alpha, float& l_reg, bf16x8& pa0, bf16x8& pa1, bf16x8& pa2, bf16x8& pa3) {
#pragma unroll
  for (int r = 0; r < 16; ++r) p1[r] = __builtin_amdgcn_exp2f(p1[r]);
  float ps;
  { const f32x16 s16 = p0 + p1;
    float t8[8];
#pragma unroll
    for (int r = 0; r < 8; ++r) t8[r] = s16[2 * r] + s16[2 * r + 1];
    ps = ((t8[0] + t8[1]) + (t8[2] + t8[3])) + ((t8[4] + t8[5]) + (t8[6] + t8[7])); }
  { auto rr = __builtin_amdgcn_permlane32_swap(__float_as_uint(ps), __float_as_uint(ps), false, false);
    ps = __uint_as_float(rr[0]) + __uint_as_float(rr[1]); }
  l_reg = l_reg * alpha + ps;
#define PK4(P, BASE, OUT) do { unsigned a0 = cvtpk(P[BASE + 0], P[BASE + 1]), a1 = cvtpk(P[BASE + 2], P[BASE + 3]);   \
    unsigned b0 = cvtpk(P[BASE + 4], P[BASE + 5]), b1 = cvtpk(P[BASE + 6], P[BASE + 7]);                              \
    auto r0 = __builtin_amdgcn_permlane32_swap(a0, b0, false, false); auto r1 = __builtin_amdgcn_permlane32_swap(a1, b1, false, false); \
    u32x4 w = {r0[0], r1[0], r0[1], r1[1]}; OUT = *reinterpret_cast<bf16x8*>(&w); } while (0)
  PK4(p0, 0, pa0); PK4(p0, 8, pa1); PK4(p1, 0, pa2); PK4(p1, 8, pa3);
#undef PK4
}
__device__ __forceinline__ void qkt(f32x16& p0, f32x16& p1, const char* Ks, const bf16x8* qr, int r32, int hi) {
  p0 = f32x16{}; p1 = f32x16{};
#pragma unroll
  for (int d0 = 0; d0 < 8; ++d0) { const int cb = (d0 * 16 + hi * 8) * 2;
    const bf16x8 b0 = *reinterpret_cast<const bf16x8*>(Ks + KSWZ(r32, cb));
    const bf16x8 b1 = *reinterpret_cast<const bf16x8*>(Ks + KSWZ(32 + r32, cb));
    p0 = __builtin_amdgcn_mfma_f32_32x32x16_bf16(b0, qr[d0], p0, 0, 0, 0);
    p1 = __builtin_amdgcn_mfma_f32_32x32x16_bf16(b1, qr[d0], p1, 0, 0, 0); }
}
__device__ __forceinline__ void mask_tile(f32x16& p0, f32x16& p1, int tile, int qrow, int hi) {
  const int t_ = qrow - tile * 64 - 4 * hi;
#pragma unroll
  for (int r = 0; r < 16; ++r) { const int kc = (r & 3) + 8 * (r >> 2); if (kc > t_) p0[r] = -1.0e30f; if (kc + 32 > t_) p1[r] = -1.0e30f; }
}
__device__ __forceinline__ int v_st(int k, int c) { const int kk = (k & ~0xC) | ((k & 4) << 1) | ((k & 8) >> 1); return ((kk >> 3) * 4 + (c >> 5)) * 512 + ((kk & 7) * 32 + (c & 31)) * 2; }
__device__ __forceinline__ int v_rd_base(int lane) { return ((lane & 3) << 3) | (((lane >> 2) & 3) << 6) | (((lane >> 4) & 1) << 5) | (((lane >> 5) & 1) << 8); }
constexpr int v_rd_off(int d0, int ks, int half) { return d0 * 512 + ks * 4096 + half * 2048; }
template <int OFF> __device__ __forceinline__ s16x4 tr_read(int vb) {
  s16x4 r; asm volatile("ds_read_b64_tr_b16 %0, %1 offset:%2" : "=&v"(r) : "v"(vb), "i"(OFF) : "memory"); return r;
}
template <int D0> __device__ __forceinline__ void pv_one(f32x16& od, int vb, bf16x8 pa0, bf16x8 pa1, bf16x8 pa2, bf16x8 pa3) {
  const s16x4 l0 = tr_read<v_rd_off(D0, 0, 0)>(vb), h0 = tr_read<v_rd_off(D0, 0, 1)>(vb), l1 = tr_read<v_rd_off(D0, 1, 0)>(vb), h1 = tr_read<v_rd_off(D0, 1, 1)>(vb);
  const s16x4 l2 = tr_read<v_rd_off(D0, 2, 0)>(vb), h2 = tr_read<v_rd_off(D0, 2, 1)>(vb), l3 = tr_read<v_rd_off(D0, 3, 0)>(vb), h3 = tr_read<v_rd_off(D0, 3, 1)>(vb);
  asm volatile("s_waitcnt lgkmcnt(0)" ::: "memory"); SBAR();
  od = __builtin_amdgcn_mfma_f32_32x32x16_bf16(pa0, PK8(l0, h0), od, 0, 0, 0);
  od = __builtin_amdgcn_mfma_f32_32x32x16_bf16(pa1, PK8(l1, h1), od, 0, 0, 0);
  od = __builtin_amdgcn_mfma_f32_32x32x16_bf16(pa2, PK8(l2, h2), od, 0, 0, 0);
  od = __builtin_amdgcn_mfma_f32_32x32x16_bf16(pa3, PK8(l3, h3), od, 0, 0, 0);
}
__device__ __forceinline__ void pv_d0(f32x16* o, int vb, bf16x8 pa0, bf16x8 pa1, bf16x8 pa2, bf16x8 pa3) {
  pv_one<0>(o[0], vb, pa0, pa1, pa2, pa3); pv_one<1>(o[1], vb, pa0, pa1, pa2, pa3); pv_one<2>(o[2], vb, pa0, pa1, pa2, pa3); pv_one<3>(o[3], vb, pa0, pa1, pa2, pa3);
}

__device__ __forceinline__ void moba_item(const bf16_t* __restrict__ proj, int h, int jblk, const unsigned* list, int nvalid, bf16_t* PO, float* PML, char* lds) {
  const int tid = opq_tid(), wid = tid >> 6, lane = tid & 63, r32 = lane & 31, hi = lane >> 5;
  const bool own = (list == nullptr);
  char* V_lds = lds; char* K_lds = lds + 2 * SHM_V;
  float* ws = (float*)(lds + 2 * SHM_V + 2 * SHM_K) + wid * 64; float* al_l = ws + 32;
  float m_reg = -1e30f, l_reg = 0; f32x16 o[4] = {}; bf16x8 qr[8];
  const int myrow = wid * QBLK + r32;
  int q, slot; bool valid;
  if (own) { q = jblk * 256 + myrow; slot = 3; valid = true; }
  else { const int rr = myrow < nvalid ? myrow : nvalid - 1; const unsigned e = list[rr]; q = (int)(e & 0xFFFFu); slot = (int)(e >> 16); valid = myrow < nvalid; }
  const bf16_t* Qw = proj + ix_mq(h, q) + hi * 8;
#pragma unroll
  for (int d0 = 0; d0 < 8; ++d0) qr[d0] = *reinterpret_cast<const bf16x8*>(Qw + d0 * 16);
  const bf16_t* Kh = proj + ix_mk(h, jblk * 256);
  const bf16_t* Vh = proj + ix_mv(h, jblk * 256);
  const int sr = tid >> 4, sc = (tid & 15) * 8, vst0 = v_st(sr, sc), vst1 = v_st(32 + sr, sc);
  const int vb0 = (int)(uintptr_t)V_lds + v_rd_base(lane);
  struct { bf16x8 vs0, vs1, ks0, ks1; } sr_[2];
#define SLOAD(i, k0) do { sr_[i].vs0 = *(const bf16x8*)(&Vh[(size_t)((k0) + sr) * LDK + sc]); sr_[i].vs1 = *(const bf16x8*)(&Vh[(size_t)((k0) + 32 + sr) * LDK + sc]); \
    sr_[i].ks0 = *(const bf16x8*)(&Kh[(size_t)((k0) + sr) * LDK + sc]); sr_[i].ks1 = *(const bf16x8*)(&Kh[(size_t)((k0) + 32 + sr) * LDK + sc]); } while (0)
#define SWRITE(b, i) do { *(bf16x8*)(V_lds + (b) * SHM_V + vst0) = sr_[i].vs0;          \
    *(bf16x8*)(V_lds + (b) * SHM_V + vst1) = sr_[i].vs1; const int kc = sc * 2;               \
    *(bf16x8*)(K_lds + (b) * SHM_K + KSWZ(sr, kc)) = sr_[i].ks0;                       \
    *(bf16x8*)(K_lds + (b) * SHM_K + KSWZ(32 + sr, kc)) = sr_[i].ks1; } while (0)
#define SWAIT() asm volatile("s_waitcnt vmcnt(4)" ::: "memory")
#define RESC(a) do { if (__any((a) < 1.f)) { if (hi == 0) al_l[r32] = (a); asm volatile("s_waitcnt lgkmcnt(0)" ::: "memory"); \
    _Pragma("unroll") for (int d = 0; d < 4; ++d) _Pragma("unroll") for (int r = 0; r < 16; ++r) o[d][r] *= al_l[crow(r, hi)]; } } while (0)
  f32x16 pA0, pA1, pB0, pB1; float mnA, mnB, alA, alB; bf16x8 pa0, pa1, pa2, pa3;
  constexpr int NT = 4, SE = 0, SO = 1;
  SLOAD(SE, 0); asm volatile("s_waitcnt vmcnt(0)" ::: "memory"); SWRITE(0, SE); __syncthreads();
  qkt(pA0, pA1, K_lds, qr, r32, hi); if (own) mask_tile(pA0, pA1, 0, myrow, hi); partialSM(pA0, pA1, m_reg, mnA, alA);
  SLOAD(SO, KVBLK); SLOAD(SE, 2 * KVBLK);
  SWAIT(); SWRITE(1, SO); __syncthreads();
  {
    SBAR(); qkt(pB0, pB1, K_lds + SHM_K, qr, r32, hi); if (own) mask_tile(pB0, pB1, 1, myrow, hi);
    finishSM(pA0, pA1, alA, l_reg, pa0, pa1, pa2, pa3); SBAR();
    SLOAD(SO, 3 * KVBLK); SBAR();
    pv_d0(o, vb0, pa0, pa1, pa2, pa3); partialSM(pB0, pB1, m_reg, mnB, alB);
    __syncthreads(); SWAIT(); SWRITE(0, SE);
    RESC(alB); __syncthreads();
    SBAR(); qkt(pA0, pA1, K_lds, qr, r32, hi); if (own) mask_tile(pA0, pA1, 2, myrow, hi);
    finishSM(pB0, pB1, alB, l_reg, pa0, pa1, pa2, pa3); SBAR();
    pv_d0(o, vb0 + (int)SHM_V, pa0, pa1, pa2, pa3); partialSM(pA0, pA1, m_reg, mnA, alA);
    __syncthreads(); asm volatile("s_waitcnt vmcnt(0)" ::: "memory"); SWRITE(1, SO);
    RESC(alA); __syncthreads();
  }
  SBAR(); qkt(pB0, pB1, K_lds + SHM_K, qr, r32, hi); if (own) mask_tile(pB0, pB1, 3, myrow, hi);
  finishSM(pA0, pA1, alA, l_reg, pa0, pa1, pa2, pa3); SBAR();
  pv_d0(o, vb0, pa0, pa1, pa2, pa3); partialSM(pB0, pB1, m_reg, mnB, alB);
  __syncthreads(); RESC(alB);
  finishSM(pB0, pB1, alB, l_reg, pa0, pa1, pa2, pa3); SBAR();
  pv_d0(o, vb0 + (int)SHM_V, pa0, pa1, pa2, pa3);
  __syncthreads();
  unsigned short* st = (unsigned short*)(lds + wid * 8192);
#pragma unroll
  for (int d0 = 0; d0 < 4; ++d0)
#pragma unroll
    for (int r = 0; r < 16; ++r) st[crow(r, hi) * 128 + 32 * d0 + r32] = (unsigned short)(cvtpk(o[d0][r], o[d0][r]) & 0xFFFFu);
  const int porow = valid ? ((q * 8 + h) * 4 + slot) : -1;
  if (hi == 0 && valid) { PML[(size_t)porow * 2] = m_reg * CEXP; PML[(size_t)porow * 2 + 1] = l_reg; }
  asm volatile("s_waitcnt lgkmcnt(0)" ::: "memory");
#pragma unroll
  for (int it = 0; it < 8; ++it) {
    const int row = it * 4 + (lane >> 4), ch = lane & 15;
    const int pr = __shfl(porow, row);
    const u32x4 vv = *(const u32x4*)(st + row * 128 + ch * 8);
    if (pr >= 0) *(u32x4*)(PO + (size_t)pr * 128 + ch * 8) = vv;
  }
  __syncthreads();
#undef SLOAD
#undef SWRITE
#undef SWAIT
#undef RESC
}

#ifndef ATT_PROBE
#define ATT_PROBE 0
#endif
constexpr int ATT2_QMAX = 768;
__device__ __forceinline__ void moba_item2(const bf16_t* __restrict__ proj, int h, int jblk, const unsigned* list, int nrows, int nown, bf16_t* PO, float* PML, char* lds,
                                           const unsigned* items, int nit, int nfront, unsigned nxt, unsigned (&dsc)[4], bool ldr) {
  const int tid = opq_tid(), wid = tid >> 6, lane = tid & 63, r32 = lane & 31, hi = lane >> 5;
  char* V_lds = lds; char* K_lds = lds + 65536;
  float* al_l = (float*)(lds + LDS_SCR + 4096) + wid * 32;
  unsigned short* st = (unsigned short*)(lds + LDS_SCR + 4096 + 1024 + wid * 2048);
  const int vb0 = (int)(uintptr_t)V_lds + v_rd_base(lane);
  const int no = nown >> 5, ngroups = no + ((nrows + 31) >> 5);
#define ENTRY(gg) (((gg) < no) ? (unsigned)(jblk * 256 + (gg) * 32 + r32) | (3u << 16) : list[(((gg) - no) * 32 + r32) < nrows ? (((gg) - no) * 32 + r32) : nrows - 1])
  unsigned e_cur = 0u, e_nxt = 0u; bf16x8 qrn[8];
  if (wid < ngroups) { e_cur = ENTRY(wid); if (wid + NW < ngroups) e_nxt = ENTRY(wid + NW); }
#if ATT_PROBE == 1
#pragma unroll 1
  for (int pr_ = 0; pr_ < 3; ++pr_)
#endif
  { const bf16_t* Kh = proj + ix_mk(h, jblk * 256); const bf16_t* Vh = proj + ix_mv(h, jblk * 256);
    const int sc = (tid & 15) * 8;
    bf16x8 kv[8], vv[8];
#pragma unroll
    for (int it = 0; it < 8; ++it) { const int key = it * 32 + (tid >> 4); kv[it] = *(const bf16x8*)(Kh + (size_t)key * 128 + sc); vv[it] = *(const bf16x8*)(Vh + (size_t)key * 128 + sc); }
    if (wid < ngroups) {
      const bf16_t* Qw = proj + ix_mq(h, (int)(e_cur & 0xFFFFu)) + hi * 8;
#pragma unroll
      for (int d0 = 0; d0 < 8; ++d0) qrn[d0] = *reinterpret_cast<const bf16x8*>(Qw + d0 * 16); }
    if (ldr && (int)nxt < nit) { const unsigned sl = (int)nxt < nfront ? nxt : 4095u - (nxt - (unsigned)nfront);
      dsc[0] = ldu(items + sl * 4); dsc[1] = ldu(items + sl * 4 + 1); dsc[2] = ldu(items + sl * 4 + 2); dsc[3] = ldu(items + sl * 4 + 3); }
#pragma unroll
    for (int it = 0; it < 8; ++it) { const int key = it * 32 + (tid >> 4), tl = key >> 6, kr = key & 63;
      *(bf16x8*)(K_lds + tl * 16384 + KSWZ(kr, sc * 2)) = kv[it]; *(bf16x8*)(V_lds + tl * 16384 + v_st(kr, sc)) = vv[it]; }
#if ATT_PROBE == 1
    __syncthreads();
#endif
  }
  __syncthreads();
  for (int g = wid; g < ngroups; g += NW) {
    const bool own = g < no;
    const int myrow = (own ? g : g - no) * 32 + r32;
    const int q = (int)(e_cur & 0xFFFFu), slot = (int)(e_cur >> 16); const bool valid = own || myrow < nrows;
    bf16x8 qr[8];
#pragma unroll
    for (int d0 = 0; d0 < 8; ++d0) qr[d0] = qrn[d0];
    e_cur = e_nxt;
    if (g + NW < ngroups) {
      const bf16_t* Qw = proj + ix_mq(h, (int)(e_cur & 0xFFFFu)) + hi * 8;
#pragma unroll
      for (int d0 = 0; d0 < 8; ++d0) qrn[d0] = *reinterpret_cast<const bf16x8*>(Qw + d0 * 16);
      if (g + 2 * NW < ngroups) e_nxt = ENTRY(g + 2 * NW); }
    float m_reg = -1e30f, l_reg = 0.f; f32x16 o[4] = {};
    const int ntile = own ? ((g * 32 + 31) >> 6) + 1 : 4;
#if ATT_PROBE == 2
#pragma unroll 1
    for (int pr_ = 0; pr_ < 2; ++pr_) {
    if (pr_ == 1) { m_reg = -1e30f; l_reg = 0.f; o[0] = f32x16{}; o[1] = f32x16{}; o[2] = f32x16{}; o[3] = f32x16{}; }
#endif
#pragma unroll 1
    for (int tl = 0; tl < ntile; ++tl) {
      f32x16 p0, p1; float mn, alpha; bf16x8 pa0, pa1, pa2, pa3;
      qkt(p0, p1, K_lds + tl * 16384, qr, r32, hi);
      if (own) mask_tile(p0, p1, tl, myrow, hi);
      partialSM(p0, p1, m_reg, mn, alpha);
      if (__any(alpha < 1.f)) { if (hi == 0) al_l[r32] = alpha; asm volatile("s_waitcnt lgkmcnt(0)" ::: "memory");
#pragma unroll
        for (int d = 0; d < 4; ++d)
#pragma unroll
          for (int r = 0; r < 16; ++r) o[d][r] *= al_l[crow(r, hi)]; }
      finishSM(p0, p1, alpha, l_reg, pa0, pa1, pa2, pa3); SBAR();
      pv_d0(o, vb0 + tl * 16384, pa0, pa1, pa2, pa3);
    }
#if ATT_PROBE == 2
    }
#endif
    const int porow = valid ? ((q * 8 + h) * 4 + slot) : -1;
    if (hi == 0 && valid) { PML[(size_t)porow * 2] = m_reg * CEXP; PML[(size_t)porow * 2 + 1] = l_reg; }
    const int pr = __shfl(porow, lane >> 1);
#if PO8
    if (hi == 0) al_l[r32] = __builtin_amdgcn_rcpf(l_reg) * (float)(1 << PO8_SH);
    asm volatile("s_waitcnt lgkmcnt(0)" ::: "memory");
    float rl_[16];
#pragma unroll
    for (int r = 0; r < 16; ++r) rl_[r] = al_l[crow(r, hi)];
    unsigned char* st8 = (unsigned char*)st;
#pragma unroll
    for (int d0 = 0; d0 < 4; ++d0) {
#pragma unroll
      for (int r = 0; r < 16; r += 2) { const unsigned w = (unsigned)__builtin_amdgcn_cvt_pk_fp8_f32(o[d0][r] * rl_[r], o[d0][r + 1] * rl_[r + 1], 0, false);
        st8[crow(r, hi) * 32 + r32] = (unsigned char)w; st8[crow(r + 1, hi) * 32 + r32] = (unsigned char)(w >> 8); }
      asm volatile("s_waitcnt lgkmcnt(0)" ::: "memory");
      const u32x4 a = *(const u32x4*)(st8 + (lane >> 1) * 32 + (lane & 1) * 16);
      if (pr >= 0) *(u32x4*)((unsigned char*)PO + (size_t)pr * 128 + 32 * d0 + (lane & 1) * 16) = a;
      asm volatile("s_waitcnt lgkmcnt(0)" ::: "memory");
    }
#else
#pragma unroll
    for (int d0 = 0; d0 < 4; ++d0) {
#pragma unroll
      for (int r = 0; r < 16; ++r) st[crow(r, hi) * 32 + r32] = (unsigned short)(cvtpk(o[d0][r], o[d0][r]) & 0xFFFFu);
      asm volatile("s_waitcnt lgkmcnt(0)" ::: "memory");
      const u32x4 a = *(const u32x4*)(st + (lane >> 1) * 32 + (lane & 1) * 16), b = *(const u32x4*)(st + (lane >> 1) * 32 + (lane & 1) * 16 + 8);
      if (pr >= 0) { *(u32x4*)(PO + (size_t)pr * 128 + 32 * d0 + (lane & 1) * 16) = a; *(u32x4*)(PO + (size_t)pr * 128 + 32 * d0 + (lane & 1) * 16 + 8) = b; }
      asm volatile("s_waitcnt lgkmcnt(0)" ::: "memory");
    }
#endif
  }
  __syncthreads();
#undef ENTRY
}
#undef KSWZ
#undef SBAR
}

static __device__ void moba_combine(const Params& p) {
    const bf16_t* PO = (const bf16_t*)(p.ws + WS_PO); const float* PML = (const float*)(p.ws + WS_PML); bf16_t* mix = (bf16_t*)(p.ws + WS_MIX);
    const int stride = (int)gridDim.x * NTHR;
    for (int base = blockIdx.x * NTHR + opq_tid(); base < T * 8 * 16; base += 4 * stride) {
        u32x4 po[4][4]; f32x2 ml[4][4];
#pragma unroll
        for (int u = 0; u < 4; ++u) { const int idx = base + u * stride, ch = idx & 15, qh = idx >> 4, qb = qh >> 11, nv = qb < 3 ? qb : 3;
#pragma unroll
            for (int k = 0; k < 4; ++k) { const bool ok = (k == 3) || (k < nv);
                ml[u][k] = (f32x2){-3.0e38f, 0.f}; po[u][k] = (u32x4){0u, 0u, 0u, 0u};
#if PO8
                if (ok) { ml[u][k] = *(const f32x2*)(PML + ((size_t)qh * 4 + k) * 2); const u32x2 t8 = *(const u32x2*)((const unsigned char*)PO + ((size_t)qh * 4 + k) * 128 + ch * 8); po[u][k].x = t8.x; po[u][k].y = t8.y; } } }
#else
                if (ok) { ml[u][k] = *(const f32x2*)(PML + ((size_t)qh * 4 + k) * 2); po[u][k] = *(const u32x4*)(PO + ((size_t)qh * 4 + k) * 128 + ch * 8); } } }
#endif
#pragma unroll
        for (int u = 0; u < 4; ++u) { const int idx = base + u * stride, ch = idx & 15, qh = idx >> 4, q = qh >> 3, h = qh & 7;
            float M = -3.0e38f;
#pragma unroll
            for (int k = 0; k < 4; ++k) M = fmaxf(M, ml[u][k][0]);
            float o[8], L = 0.f;
#pragma unroll
            for (int i = 0; i < 8; ++i) o[i] = 0.f;
#pragma unroll
#if PO8
            for (int k = 0; k < 4; ++k) { const float wl = __builtin_amdgcn_exp2f(ml[u][k][0] - M) * ml[u][k][1]; L += wl; const float w = wl * (1.0f / (float)(1 << PO8_SH)); float f[8];
                const f32x2 f01 = __builtin_amdgcn_cvt_pk_f32_fp8((int)po[u][k].x, false), f23 = __builtin_amdgcn_cvt_pk_f32_fp8((int)po[u][k].x, true), f45 = __builtin_amdgcn_cvt_pk_f32_fp8((int)po[u][k].y, false), f67 = __builtin_amdgcn_cvt_pk_f32_fp8((int)po[u][k].y, true);
                f[0] = f01[0]; f[1] = f01[1]; f[2] = f23[0]; f[3] = f23[1]; f[4] = f45[0]; f[5] = f45[1]; f[6] = f67[0]; f[7] = f67[1];
#pragma unroll
                for (int i = 0; i < 8; ++i) o[i] += w * f[i]; }
#else
            for (int k = 0; k < 4; ++k) { const float w = __builtin_amdgcn_exp2f(ml[u][k][0] - M); L += w * ml[u][k][1]; float f[8]; unpack8(po[u][k], f);
#pragma unroll
                for (int i = 0; i < 8; ++i) o[i] += w * f[i]; }
#endif
            const float rl = 1.0f / L;
#pragma unroll
            for (int i = 0; i < 8; ++i) o[i] *= rl;
#if OUT8
            { u32x2 w8; w8.x = pk4_fp8(o[0] * (float)(1 << MIX8_SH), o[1] * (float)(1 << MIX8_SH), o[2] * (float)(1 << MIX8_SH), o[3] * (float)(1 << MIX8_SH));
              w8.y = pk4_fp8(o[4] * (float)(1 << MIX8_SH), o[5] * (float)(1 << MIX8_SH), o[6] * (float)(1 << MIX8_SH), o[7] * (float)(1 << MIX8_SH));
              *(u32x2*)((unsigned char*)mix + (size_t)q * DM + 1024 + h * 128 + ch * 8) = w8; } }
#else
            *(u32x4*)(mix + (size_t)q * DM + 1024 + h * 128 + ch * 8) = pack8(o); }
#endif
    }
}
#ifndef DBL_MASK
#define DBL_MASK 0
#endif
#define REP(k) for (int rep_ = 0; rep_ < (((DBL_MASK >> (k)) & 1) ? 2 : 1); ++rep_)
#ifndef NCV
#define NCV 0
#endif
#ifndef PROBE_MASK
#define PROBE_MASK 0
#endif
#ifndef PHMASK
#define PHMASK 0xFFFF
#endif
enum { PH_CVT = 0, PH_INPROJ, PH_MIXA, PH_MIXB, PH_MIXC, PH_ATT, PH_COMB, PH_OUTPROJ, PH_LN1, PH_PERM, PH_MOE1, PH_MOE2, PH_LN2, NPH };
constexpr int NSLOT = 2 * NPH;
#ifndef MK_DEBUG
#define MK_DEBUG 0
#endif
#if MK_DEBUG
#include "part_chk.inc"
#endif

__device__ __forceinline__ Params opq_params(const Params& p) {
#if !defined(__HIP_DEVICE_COMPILE__)
    return p;
#else
    const __attribute__((address_space(4))) Params* kp = (const __attribute__((address_space(4))) Params*)__builtin_amdgcn_kernarg_segment_ptr();
    asm volatile("" : "+s"(kp));
    return *kp;
#endif
}
#ifndef SUBREP_MASK
#define SUBREP_MASK 0
#endif
#define SUBREP(k) (((SUBREP_MASK >> (k)) & 1) ? 2 : 1)
#ifndef CVT_REPS
#define CVT_REPS 1
#endif
__global__ void __launch_bounds__(NTHR, 2) mk_fwd(Params p) {
    extern __shared__ __attribute__((aligned(16))) unsigned char lds[];
    const int tid = threadIdx.x;
    for (int u = tid; u < (LDS_BYTES - LDS_SCR) / 4; u += NTHR) ((unsigned*)(lds + LDS_SCR))[u] = 0u;
    __syncthreads();
    unsigned* ctl = (unsigned*)(p.ws + WS_CTL);
    XcdBarrier bar; bar.bar = ctl + CW_BAR; bar.x = 0; bar.st = (volatile LAS unsigned*)(lds + LDS_SCR + 32);
    constexpr int STEP = 2;
    if (p.g_hi - p.g_lo > STEP) bar = xcd_barrier_post(ctl + CW_BAR, (volatile LAS unsigned*)(lds + LDS_SCR + 32));
    if (p.g_hi - p.g_lo > STEP) xcd_barrier_census(bar);
    const int G = (int)gridDim.x, bx = (int)blockIdx.x;
    PG8_LAS unsigned char* lds3 = (PG8_LAS unsigned char*)lds;

#if PROBE_MASK
    unsigned long long tacc = 0ull, tprev = __builtin_amdgcn_s_memrealtime();
#endif
    for (int layer = -1; layer < NLAYER; ++layer) {
        const int s0 = (layer + 1) * NSLOT;
#define IN(k) (((PHMASK >> (k)) & 1) && (layer >= 0 || (k) <= PH_INPROJ) && p.g_lo <= s0 + 2 * (k) && s0 + 2 * (k) < p.g_hi)
#if PROBE_MASK
#define SEAM(k) do { xcd_barrier(bar); if (bx == 0 && tid == 0) { const unsigned long long now = __builtin_amdgcn_s_memrealtime(); if ((PROBE_MASK >> (k)) & 1) tacc += now - tprev; tprev = now; } } while (0)
#else
#ifndef BAR2
#define BAR2 0
#endif
#define SEAM(k) do { if (s0 + 2 * (k) + STEP < p.g_hi) { xcd_barrier(bar); if ((BAR2 >> (k)) & 1) xcd_barrier(bar); } } while (0)
#endif
        if (IN(PH_CVT)) { if (layer < 0) { const Params q = opq_params(p); phase_rope(q); phase_rows<0>(q, 0, lds); } }
        if (IN(PH_INPROJ)) REP(PH_INPROJ) { const Params q = opq_params(p);
#pragma unroll 1
            for (int stp = 0; stp < 2; ++stp) {
                const bool cv = (layer < 0) ? (stp == 0) : (((bx & 1) != 0) == (stp == 0));
                if (cv) { if (rep_ == 0) {
_Pragma("unroll 1")
                    for (int r2_ = 0; r2_ < CVT_REPS; ++r2_) phase_cvt<false, 7>(q, layer < 0 ? 0 : layer, layer < 0 ? 0 : 256, layer < 0 ? 256 : 1024, bx, G, lds); } }
                else if (layer >= 0) {
                    pg8::Gemm g{(const bf16_t*)(q.ws + WS_HBQ), (const bf16_t*)(q.ws + ((layer & 1) ? WS_WIN2 : WS_WIN)), T, NPROJ, DM / 2, 127 - WIN8_SH, 127 - X8_SH}; pg8::StaticOrder S; S.init(T, NPROJ, G, bx);
                    pg8::EpiProj E{(bf16_t*)(q.ws + WS_PROJ), (const float*)(q.ws + WS_ROPE), (const float*)(q.ws + WS_ROPE) + (size_t)T * 64};
                    pg8::gemm_phase<pg8::EpiProj, pg8::StaticOrder, true, true, true>(lds3, g, S, E);
                }
            }
            SEAM(PH_INPROJ); }
        if (IN(PH_MIXA)) REP(PH_MIXA) { const Params q = opq_params(p);
            for (int u = bx; u < 768; u += G) { if (u < 256) { _Pragma("unroll 1") for (int r_ = 0; r_ < SUBREP(0); ++r_) gla_super_unit<false>(q, layer, u >> 2, u & 3, lds); } else { _Pragma("unroll 1") for (int r_ = 0; r_ < SUBREP(1); ++r_) moba_kmean_unit(q, (u - 256) >> 6, (u - 256) & 63, lds); } }
            SEAM(PH_MIXA); }
        if (IN(PH_MIXB)) REP(PH_MIXB) { const Params q = opq_params(p);
            { _Pragma("unroll 1") for (int r_ = 0; r_ < SUBREP(2); ++r_) gla_scan(q, bx, G, lds); }
            { int kk = 0; for (int u = bx; u < 512; u += G, ++kk) { const int q0 = u & 63; _Pragma("unroll 1") for (int r_ = 0; r_ < SUBREP(3); ++r_) moba_gate_unit(q, u >> 6, (kk & 1) ? 63 - q0 : q0, lds); } }
            SEAM(PH_MIXB); }
        if (IN(PH_MIXC)) REP(PH_MIXC) { const Params q = opq_params(p);
            for (int u = bx; u < 768; u += G) { if (u < 256) { _Pragma("unroll 1") for (int r_ = 0; r_ < SUBREP(4); ++r_) gla_super_unit<true>(q, layer, u >> 2, u & 3, lds); } else if (rep_ == 0) { const int v = u - 256, j0 = v & 63; moba_list_unit(q, layer, v >> 6, ((v / G) & 1) ? 63 - j0 : j0, lds); } }
            SEAM(PH_MIXC); }
        if (IN(PH_ATT)) REP(PH_ATT) { const Params q = opq_params(p);
            const int nit = __builtin_amdgcn_readfirstlane((int)ldu(ctl + CW_NIT + layer * 64));
            const int nfront = __builtin_amdgcn_readfirstlane((int)ldu(ctl + CW_NIT + layer * 64 + 1));
            const unsigned* items = (const unsigned*)(q.ws + WS_ITEMS) + layer * 4096 * 4;
            unsigned* qhead = ctl + CW_NIT + layer * 64 + 16 + rep_;
            volatile LAS unsigned* qslot = (volatile LAS unsigned*)(lds + LDS_SCR + 64);
            const int qt = opq_tid();
            if (qt == 0) { const unsigned f = atomicAdd(qhead, 1u); qslot[0] = f;
                if ((int)f < nit) { const unsigned sl = (int)f < nfront ? f : 4095u - (f - (unsigned)nfront); qslot[1] = ldu(items + sl * 4); qslot[2] = ldu(items + sl * 4 + 1); qslot[3] = ldu(items + sl * 4 + 2); qslot[4] = ldu(items + sl * 4 + 3); } }
            __syncthreads();
            int it = __builtin_amdgcn_readfirstlane((int)qslot[0]);
            while (it < nit) {
                const int h = __builtin_amdgcn_readfirstlane((int)qslot[1]), j = __builtin_amdgcn_readfirstlane((int)qslot[2]), c = __builtin_amdgcn_readfirstlane((int)qslot[3]), n = __builtin_amdgcn_readfirstlane((int)qslot[4]);
                unsigned nxt = 0u, dsc[4] = {0u, 0u, 0u, 0u};
                if (qt == 0) nxt = atomicAdd(qhead, 1u);
                const unsigned* list = (const unsigned*)(q.ws + WS_LIST) + (size_t)h * LISTH + list_off(j) + c * ATT_QMAX;
                const int rem = n - c * ATT_QMAX, nrows = rem < 0 ? 0 : (rem < ATT_QMAX ? rem : ATT_QMAX);
                __syncthreads();
                att::moba_item2((bf16_t*)(q.ws + WS_PROJ), h, j, list, nrows, c == 0 ? 256 : 0, (bf16_t*)(q.ws + WS_PO), (float*)(q.ws + WS_PML), (char*)lds, items, nit, nfront, nxt, dsc, qt == 0);
                if (qt == 0) { qslot[0] = nxt; qslot[1] = dsc[0]; qslot[2] = dsc[1]; qslot[3] = dsc[2]; qslot[4] = dsc[3]; }
                __syncthreads();
                it = __builtin_amdgcn_readfirstlane((int)qslot[0]);
            }
            SEAM(PH_ATT); }
        if (IN(PH_COMB)) REP(PH_COMB) { const Params q = opq_params(p); moba_combine(q); SEAM(PH_COMB); }
        if (IN(PH_OUTPROJ)) REP(PH_OUTPROJ) { const Params q = opq_params(p);
#if OUT8
            pg8::Gemm g{(const bf16_t*)(q.ws + WS_MIX), (const bf16_t*)(q.ws + WS_WO), T, DM, DM / 2, 127 - WO8_SH, 127 - MIX8_SH}; pg8::StaticOrder S; S.init(T, DM, G, bx);
#else
            pg8::Gemm g{(const bf16_t*)(q.ws + WS_MIX), (const bf16_t*)(q.ws + WS_WO), T, DM, DM}; pg8::StaticOrder S; S.init(T, DM, G, bx);
#endif
            pg8::EpiOut E{layer == 0 ? q.in[0] : nullptr, (const bf16_t*)(q.ws + WS_HB), (bf16_t*)(q.ws + WS_PRE), DN_ALPHA};
            pg8::gemm_phase<pg8::EpiOut, pg8::StaticOrder, true, true, OUT8 != 0>(lds3, g, S, E);
            SEAM(PH_OUTPROJ); }
#ifndef LNPROBE
#define LNPROBE 0
#endif
        if (IN(PH_LN1)) { const Params q = opq_params(p); if (LNPROBE & 1) { phase_rows<1, true>(q, layer, lds); SEAM(PH_LN1); } phase_rows<1>(q, layer, lds); SEAM(PH_LN1); }
        if (IN(PH_MOE1)) REP(PH_MOE1) { const Params q = opq_params(p);
            int* sbm = (int*)(lds + LDS_SCR + 128);
            moe_bases(ctl + CW_CNT + layer * 64, sbm);
            const int np = __builtin_amdgcn_readfirstlane(sbm[16]) >> 8;
            pg8::Gemm g{(const bf16_t*)(q.ws + WS_HB8), (const bf16_t*)(q.ws + WS_WGU), np * 256, 2048, DM / 2, 127 - WGU8_SH, 127 - X8_SH}; pg8::MoeOrder S; S.init(np * 256, 2048, G, bx); S.sb = sbm; S.idx = (const unsigned*)(q.ws + WS_IDX); S.rowbytes = DM;
            pg8::EpiGU E{q.ws + WS_HS};
            pg8::gemm_phase<pg8::EpiGU, pg8::MoeOrder, true, true, true, true>(lds3, g, S, E);
            if (rep_ == 0) phase_cvt<true, 8>(q, layer, 1280, 512, 0, 1, lds, ctl + CW_CVQ + layer * 64);
            SEAM(PH_MOE1); }
        if (IN(PH_MOE2)) REP(PH_MOE2) { const Params q = opq_params(p);
            int* sbm = (int*)(lds + LDS_SCR + 128);
            moe_bases(ctl + CW_CNT + layer * 64, sbm);
            const int np = __builtin_amdgcn_readfirstlane(sbm[16]) >> 8;
            pg8::Gemm g{(const bf16_t*)(q.ws + WS_HS), (const bf16_t*)(q.ws + WS_WD), np * 256, 2048, DEXP / 2, 127 - WD8_SH, 127 - H8_SH}; pg8::MoeOrder S; S.init(np * 256, 2048, G, bx); S.sb = sbm; S.idx = (const unsigned*)(q.ws + WS_IDX); S.rowbytes = DEXP;
            pg8::EpiY E{(bf16_t*)(q.ws + WS_YS)};
            pg8::gemm_phase<pg8::EpiY, pg8::MoeOrder, true, true, true>(lds3, g, S, E);
            if (rep_ == 0 && layer + 1 < NLAYER) phase_cvt<true, 3>(q, layer + 1, 0, 256, 0, 1, lds, ctl + CW_CVQ + layer * 64 + 16);
            SEAM(PH_MOE2); }
        if (IN(PH_LN2)) { const Params q = opq_params(p); if (LNPROBE & 2) { phase_rows<2, true>(q, layer, lds); xcd_barrier(bar); } phase_rows<2>(q, layer, lds); SEAM(PH_LN2); }
#undef IN
#undef SEAM
    }
#if PROBE_MASK
    if (bx == 0 && tid == 0) __hip_atomic_store(ctl + CW_DBG, (unsigned)tacc, __ATOMIC_RELAXED, __HIP_MEMORY_SCOPE_AGENT);
    xcd_barrier(bar);
    { const float sc = 1.0f + (float)ldu(ctl + CW_DBG) * (1.0f / 40000.0f);
      for (size_t i = (size_t)bx * NTHR + tid; i < (size_t)T * DM / 4; i += (size_t)G * NTHR) { f32x4 v = ((f32x4*)p.out)[i]; ((f32x4*)p.out)[i] = v * sc; } }
#endif
}

#if MK_DEBUG
__global__ void __launch_bounds__(NTHR, 2) mk_chk(Params p, int layer, int k) { if (k >= 0) chk_phase(p, layer, k); else chk_final(p); }
#endif
#ifndef MK_ONE_LAUNCH
#define MK_ONE_LAUNCH 1
#endif
extern "C" void kernel_launch(void* const* d_in, const int* in_sizes, int n_in, void* d_out, int out_size, void* d_ws, size_t ws_size, hipStream_t stream) {
    static int grid = 0;
    if (grid == 0) {
        if (n_in != 16 || in_sizes[0] != T * DM || out_size != T * DM || ws_size < WS_END) {
            fprintf(stderr, "kernel_launch: unexpected problem: n_in %d in0 %d out %d ws %zu (need >= %zu); nothing launched\n", n_in, n_in > 0 ? in_sizes[0] : -1, out_size, ws_size, (size_t)WS_END); grid = -1; return; }
        int dev = 0, cus = 0, per_cu = 0;
        if (hipGetDevice(&dev) != hipSuccess || hipDeviceGetAttribute(&cus, hipDeviceAttributeMultiprocessorCount, dev) != hipSuccess) { grid = -1; return; }
        if (hipFuncSetAttribute((const void*)mk_fwd, hipFuncAttributeMaxDynamicSharedMemorySize, LDS_BYTES) != hipSuccess) { fprintf(stderr, "kernel_launch: hipFuncSetAttribute failed\n"); grid = -1; return; }
        if (hipOccupancyMaxActiveBlocksPerMultiprocessor(&per_cu, (const void*)mk_fwd, NTHR, LDS_BYTES) != hipSuccess || per_cu < 1)
            fprintf(stderr, "kernel_launch: note: occupancy query reports %d blocks per CU\n", per_cu);
        (void)hipGetLastError();
        grid = cus;
        if (grid != 256) fprintf(stderr, "kernel_launch: note: %d CUs (row phases assume the grid divides 2048 row groups)\n", grid);
        if (2048 % grid != 0) grid = 256;
    }
    if (grid < 0) return;
    if (hipMemsetAsync((char*)d_ws + WS_CTL, 0, CTL_BYTES, stream) != hipSuccess) return;
    Params p{};
    for (int i = 0; i < 16; ++i) p.in[i] = (const float*)d_in[i];
    p.out = (float*)d_out; p.ws = (unsigned char*)d_ws;
#if MK_ONE_LAUNCH
    p.g_lo = 0; p.g_hi = (NLAYER + 1) * NSLOT;
    hipLaunchKernelGGL(mk_fwd, dim3(grid), dim3(NTHR), LDS_BYTES, stream, p);
#else
    for (int s = 0; s < (NLAYER + 1) * NSLOT; s += 2) { p.g_lo = s; p.g_hi = s + 1; hipLaunchKernelGGL(mk_fwd, dim3(grid), dim3(NTHR), LDS_BYTES, stream, p);
#if MK_DEBUG
        if (s >= NSLOT) hipLaunchKernelGGL(mk_chk, dim3(8), dim3(NTHR), 0, stream, p, s / NSLOT - 1, (s % NSLOT) / 2);
#endif
    }
#if MK_DEBUG
    hipLaunchKernelGGL(mk_chk, dim3(grid), dim3(NTHR), 0, stream, p, 0, -1);
#endif
#endif
    const hipError_t le = hipPeekAtLastError();
    if (le != hipSuccess) fprintf(stderr, "kernel_launch: launch failed: %s\n", hipGetErrorName(le));
}
```

```cpp
#define MK_DEBUG 0
#define MK_ONE_LAUNCH 1
#define RECOMP 0
#include <hip/hip_runtime.h>
#include <cstdio>
#include <cstdint>
__device__ __forceinline__ int opq_tid() { int t = (int)threadIdx.x; asm volatile("" : "+v"(t)); return t; }
#ifndef EPI_PROBE
#define EPI_PROBE 0
#endif
namespace pg8 {
#define PG8_LAS __attribute__((address_space(3)))
typedef unsigned short bf16_t;
typedef short bf16x8 __attribute__((ext_vector_type(8)));
typedef float f32x4 __attribute__((ext_vector_type(4)));
typedef unsigned u32x4 __attribute__((ext_vector_type(4)));
constexpr int BM = 256, BK = 64, HALF = 128, HTB = HALF * BK * 2  , STAGE_BYTES = 8 * HTB, NXCD = 8, WGM = 4;

__host__ __device__ __forceinline__ int lds_byte(int r, int c) { const int st = (r >> 4) * 2 + (c >> 5), rr = r & 15, cc = c & 31, ob = rr * 64 + cc * 2; return st * 1024 + (ob ^ (((ob >> 9) & 1) << 5)); }
__host__ __device__ __forceinline__ void stage_rc(int b, int& R, int& C) { const int st = b / 1024, sb = b % 1024, swz = sb ^ (((sb >> 9) & 1) << 5); R = (st >> 1) * 16 + swz / 64; C = (st & 1) * 32 + (swz % 64) / 2; }
__host__ __device__ __forceinline__ int perm32(int rho) { const int n = rho >> 4, i = rho & 15; return 8 * (i >> 2) + 4 * n + (i & 3); }

struct Unit { int pm, pn; };
struct Gemm { const bf16_t* A; const bf16_t* Bt; int M, N, K; int sa, sb; };

struct StaticOrder {
    int nM, nN, nwg, G, c;
    __host__ __device__ void init(int M, int N, int G_, int c_) { nM = M / BM; nN = N / BM; nwg = nM * nN; G = G_; c = c_; }
    __host__ __device__ bool next(int i, Unit& u) const {
        const long L = (long)i * G + c; if (L >= nwg) return false;
        int wgid = (int)L; { const int q = nwg / NXCD, r = nwg % NXCD, xcd = wgid % NXCD, off = wgid / NXCD; wgid = (xcd < r ? xcd * (q + 1) : r * (q + 1) + (xcd - r) * q) + off; }
        const int nig = WGM * nN, gid = wgid / nig, fm = gid * WGM, gsz = (nM - fm) < WGM ? (nM - fm) : WGM;
        u.pm = fm + ((wgid % nig) % gsz); u.pn = (wgid % nig) / gsz; return true;
    }
    __device__ __forceinline__ void a_ready(const Unit&) const {}
    __device__ __forceinline__ void done(const Unit&) const {}
    __device__ __forceinline__ unsigned arow(const Unit&, int) const { return 0u; }
};
__device__ __forceinline__ unsigned cvt_pk_bf16(float lo, float hi) { unsigned r; asm volatile("v_cvt_pk_bf16_f32 %0, %1, %2" : "=v"(r) : "v"(lo), "v"(hi)); return r; }

typedef int v8i32 __attribute__((ext_vector_type(8)));
typedef int v4i32 __attribute__((ext_vector_type(4)));
__device__ __forceinline__ v8i32 cat8(bf16x8 lo, bf16x8 hi) { const v4i32 a = __builtin_bit_cast(v4i32, lo), b = __builtin_bit_cast(v4i32, hi); return __builtin_shufflevector(a, b, 0, 1, 2, 3, 4, 5, 6, 7); }
template <class Epi, class Sched, bool ALIGN_EPI = false, bool SP2 = false, bool FP8 = false, bool GATHER = false>
__device__ __forceinline__ void gemm_phase(PG8_LAS unsigned char* lds, const Gemm g, const Sched& S, const Epi& E) {
    const int tid = opq_tid(), wid = __builtin_amdgcn_readfirstlane(tid >> 6), lane = tid & 63, wr = wid >> 2, wc = wid & 3, fr = lane & 15, fq = lane >> 4;
    int Kq = g.K; asm volatile("" : "+s"(Kq));
    const int K = Kq, nt = K / BK;
    unsigned voffA[2], voffB[2];
#pragma unroll
    for (int i = 0; i < 2; ++i) { int R, C; stage_rc(tid * 16 + i * 8192, R, C); const int Rb = Epi::PERM ? ((R & ~31) + perm32(R & 31)) : R;
        voffA[i] = (unsigned)(R * K + C) * 2u; voffB[i] = (unsigned)(Rb * K + C) * 2u; }
    unsigned va[2][2] = {{0u, 0u}, {0u, 0u}};
    PG8_LAS unsigned* vnl = (PG8_LAS unsigned*)(lds + STAGE_BYTES + 8192) + tid * 4;
#define PG8_GCALC(v, u) do { _Pragma("unroll") for (int _h = 0; _h < 2; ++_h) _Pragma("unroll") for (int _i = 0; _i < 2; ++_i) { int _R, _C; stage_rc(tid * 16 + _i * 8192, _R, _C); (v)[_h][_i] = S.arow((u), _h * HALF + _R) + (unsigned)_C * 2u; } } while (0)
#define PG8_STAGE_A(bufoff, gbase, h, v) do { if constexpr (GATHER) { _Pragma("unroll") for (int _i = 0; _i < 2; ++_i) \
        __builtin_amdgcn_global_load_lds((const unsigned*)((const char*)(gbase) + (v)[h][_i]), (PG8_LAS unsigned*)(lds + (bufoff) + ldsw + _i * 8192), 16, 0, 0); } \
        else { PG8_STAGE(bufoff, (gbase) + (h) * hstep, voffA); } } while (0)
    const size_t kstep = (size_t)(BK * 2);
    const size_t hstep = (size_t)HALF * K * 2;
    const size_t tstep = 2 * hstep;
    const unsigned ldsw = (unsigned)wid * 1024u;
    const int aoff = lds_byte(wr * 64 + fr, fq * 8), boff = lds_byte(wc * 32 + fr, fq * 8);
#define PG8_SA(b, h) (((b) * 2 + (h)) * HTB)
#define PG8_SB(b, h) ((4 + (b) * 2 + (h)) * HTB)
#define PG8_STAGE(bufoff, gbase, voff) do { _Pragma("unroll") for (int _i = 0; _i < 2; ++_i) \
        __builtin_amdgcn_global_load_lds((const unsigned*)((const char*)(gbase) + (voff)[_i]), (PG8_LAS unsigned*)(lds + (bufoff) + ldsw + _i * 8192), 16, 0, 0); } while (0)
#define PG8_LDA(dst, b, h) do { _Pragma("unroll") for (int m = 0; m < 4; ++m) _Pragma("unroll") for (int k = 0; k < 2; ++k) dst[m][k] = *(const PG8_LAS bf16x8*)(lds + PG8_SA(b, h) + aoff + m * 2048 + k * 1024); } while (0)
#define PG8_LDB(dst, b, h) do { _Pragma("unroll") for (int n = 0; n < 2; ++n) _Pragma("unroll") for (int k = 0; k < 2; ++k) dst[n][k] = *(const PG8_LAS bf16x8*)(lds + PG8_SB(b, h) + boff + n * 2048 + k * 1024); } while (0)
#define PG8_MMA(ai, bj, At, Bt) do { __builtin_amdgcn_s_setprio(1); _Pragma("unroll") for (int m = 0; m < 4; ++m) _Pragma("unroll") for (int n = 0; n < 2; ++n) { \
        if constexpr (FP8) { const v8i32 wq = cat8(Bt[n][0], Bt[n][1]), aq = cat8(At[m][0], At[m][1]); \
            asm volatile("s_nop 1\n\tv_mfma_scale_f32_16x16x128_f8f6f4 %0, %1, %2, %0, %3, %4 op_sel_hi:[0,0,0]" : "+v"(acc[ai][bj][m][n]) : "v"(wq), "v"(aq), "v"(g.sa), "v"(g.sb)); } \
        else { _Pragma("unroll") for (int k = 0; k < 2; ++k) acc[ai][bj][m][n] = __builtin_amdgcn_mfma_f32_16x16x32_bf16(Bt[n][k], At[m][k], acc[ai][bj][m][n], 0, 0, 0); } } \
        __builtin_amdgcn_s_setprio(0); } while (0)
#define PG8_WAIT_V(n) asm volatile("s_waitcnt vmcnt(" #n ")" ::: "memory")
#define PG8_WAIT_L(n) asm volatile("s_waitcnt lgkmcnt(" #n ")" ::: "memory")
#define PG8_BAR __builtin_amdgcn_s_barrier()
#define PG8_SCHED __builtin_amdgcn_sched_barrier(0)
    Unit cur, nxt; int ui = 0;
    if (!S.next(0, cur)) return;
    f32x4 acc[2][2][4][2];
#pragma unroll
    for (int a = 0; a < 2; ++a)
#pragma unroll
        for (int b = 0; b < 2; ++b)
#pragma unroll
            for (int m = 0; m < 4; ++m)
#pragma unroll
                for (int n = 0; n < 2; ++n) acc[a][b][m][n] = (f32x4){0.f, 0.f, 0.f, 0.f};
    bf16x8 At[4][2], B0[2][2], B1[2][2];
    const char* cA = (const char*)g.A + (GATHER ? (size_t)0 : (size_t)cur.pm * tstep); const char* cB = (const char*)g.Bt + (size_t)cur.pn * tstep;
    if constexpr (GATHER) PG8_GCALC(va, cur);
    S.a_ready(cur);
    if constexpr (SP2) {
        PG8_STAGE(PG8_SB(0, 0), cB, voffB); PG8_STAGE(PG8_SB(0, 1), cB + hstep, voffB); PG8_STAGE_A(PG8_SA(0, 0), cA, 0, va); PG8_STAGE_A(PG8_SA(0, 1), cA, 1, va);
        if (wr == 1) PG8_BAR;
        PG8_WAIT_V(2); PG8_BAR;
        PG8_STAGE(PG8_SB(1, 0), cB + kstep, voffB); PG8_STAGE_A(PG8_SA(1, 0), cA + kstep, 0, va); PG8_STAGE(PG8_SB(1, 1), cB + hstep + kstep, voffB);
        PG8_WAIT_V(6); PG8_BAR;
    } else {
        PG8_STAGE(PG8_SB(0, 0), cB, voffB); PG8_STAGE(PG8_SA(0, 0), cA, voffA); PG8_STAGE(PG8_SB(0, 1), cB + hstep, voffB); PG8_STAGE(PG8_SA(0, 1), cA + hstep, voffA);
        if (wr == 1) PG8_BAR;
        PG8_WAIT_V(4); PG8_BAR;
        PG8_STAGE(PG8_SB(1, 0), cB + kstep, voffB); PG8_STAGE(PG8_SA(1, 0), cA + kstep, voffA); PG8_STAGE(PG8_SB(1, 1), cB + hstep + kstep, voffB);
        PG8_WAIT_V(6); PG8_BAR;
    }
    for (;;) {
        const bool has_next = S.next(ui + 1, nxt);
        const char* nA = (has_next && !GATHER) ? (const char*)g.A + (size_t)nxt.pm * tstep : cA; const char* nB = has_next ? (const char*)g.Bt + (size_t)nxt.pn * tstep : cB;
        if constexpr (GATHER) { unsigned vn[2][2]; if (has_next) PG8_GCALC(vn, nxt); else { _Pragma("unroll") for (int _h = 0; _h < 2; ++_h) _Pragma("unroll") for (int _i = 0; _i < 2; ++_i) vn[_h][_i] = va[_h][_i]; }
            vnl[0] = vn[0][0]; vnl[1] = vn[0][1]; vnl[2] = vn[1][0]; vnl[3] = vn[1][1]; }
        for (int t = 0; t < nt; t += 2) {
            const bool last = (t == nt - 2);
            const char* a1 = cA + (size_t)(t + 1) * kstep;
            const char* a2 = last ? nA : cA + (size_t)(t + 2) * kstep; const char* b2 = last ? nB : cB + (size_t)(t + 2) * kstep;
            const char* a3 = a2 + kstep; const char* b3 = b2 + kstep;
            if (last && has_next) S.a_ready(nxt);
            unsigned v2[2][2];
            if constexpr (GATHER) { _Pragma("unroll") for (int _h = 0; _h < 2; ++_h) _Pragma("unroll") for (int _i = 0; _i < 2; ++_i) v2[_h][_i] = va[_h][_i];
                if (last) { v2[0][0] = vnl[0]; v2[0][1] = vnl[1]; v2[1][0] = vnl[2]; v2[1][1] = vnl[3]; } }
            if constexpr (SP2) {
            PG8_LDB(B0, 0, 0); PG8_LDB(B1, 0, 1); PG8_SCHED; PG8_LDA(At, 0, 0); PG8_STAGE_A(PG8_SA(1, 1), a1, 1, va);
            PG8_WAIT_V(8); PG8_WAIT_L(0); PG8_BAR; PG8_MMA(0, 0, At, B0); PG8_MMA(0, 1, At, B1); PG8_BAR; PG8_SCHED;
            PG8_LDA(At, 0, 1); PG8_STAGE(PG8_SB(0, 0), b2, voffB); PG8_STAGE(PG8_SB(0, 1), b2 + hstep, voffB); PG8_STAGE_A(PG8_SA(0, 0), a2, 0, v2);
            PG8_WAIT_V(8); PG8_WAIT_L(0); PG8_BAR; PG8_MMA(1, 0, At, B0); PG8_MMA(1, 1, At, B1); PG8_BAR; PG8_SCHED;
            PG8_LDB(B0, 1, 0); PG8_LDB(B1, 1, 1); PG8_SCHED; PG8_LDA(At, 1, 0); PG8_STAGE_A(PG8_SA(0, 1), a2, 1, v2);
            PG8_WAIT_V(8); PG8_WAIT_L(0); PG8_BAR; PG8_MMA(0, 0, At, B0); PG8_MMA(0, 1, At, B1); PG8_BAR; PG8_SCHED;
            PG8_LDA(At, 1, 1); PG8_STAGE(PG8_SB(1, 0), b3, voffB); PG8_STAGE(PG8_SB(1, 1), b3 + hstep, voffB); PG8_STAGE_A(PG8_SA(1, 0), a3, 0, v2);
            PG8_WAIT_V(8); PG8_WAIT_L(0); PG8_BAR; PG8_MMA(1, 0, At, B0); PG8_MMA(1, 1, At, B1); PG8_BAR; PG8_SCHED;
            } else {
            PG8_LDB(B0, 0, 0); PG8_SCHED; PG8_LDA(At, 0, 0); PG8_STAGE(PG8_SA(1, 1), a1 + hstep, voffA);
            PG8_WAIT_L(8); PG8_BAR; PG8_WAIT_L(0); PG8_MMA(0, 0, At, B0); PG8_BAR; PG8_SCHED;
            PG8_LDB(B1, 0, 1); PG8_STAGE(PG8_SB(0, 0), b2, voffB);
            PG8_BAR; PG8_WAIT_L(0); PG8_MMA(0, 1, At, B1); PG8_BAR;
            PG8_LDA(At, 0, 1); PG8_STAGE(PG8_SA(0, 0), a2, voffA);
            PG8_BAR; PG8_WAIT_L(0); PG8_MMA(1, 0, At, B0); PG8_BAR; PG8_SCHED;
            PG8_STAGE(PG8_SB(0, 1), b2 + hstep, voffB);
            PG8_WAIT_V(6); PG8_BAR; PG8_MMA(1, 1, At, B1); PG8_BAR;
            PG8_LDB(B0, 1, 0); PG8_SCHED; PG8_LDA(At, 1, 0); PG8_STAGE(PG8_SA(0, 1), a2 + hstep, voffA);
            PG8_WAIT_L(8); PG8_BAR; PG8_WAIT_L(0); PG8_MMA(0, 0, At, B0); PG8_BAR; PG8_SCHED;
            PG8_LDB(B1, 1, 1); PG8_STAGE(PG8_SB(1, 0), b3, voffB);
            PG8_BAR; PG8_WAIT_L(0); PG8_MMA(0, 1, At, B1); PG8_BAR;
            PG8_LDA(At, 1, 1); PG8_STAGE(PG8_SA(1, 0), a3, voffA);
            PG8_BAR; PG8_WAIT_L(0); PG8_MMA(1, 0, At, B0); PG8_BAR; PG8_SCHED;
            PG8_STAGE(PG8_SB(1, 1), b3 + hstep, voffB);
            PG8_WAIT_V(6); PG8_BAR; PG8_MMA(1, 1, At, B1); PG8_BAR;
            }
        }
        if constexpr (FP8) { asm volatile("s_nop 15\n\ts_nop 15" ::: "memory"); }
        if constexpr (ALIGN_EPI) { if (wr == 0) PG8_BAR; }
        if constexpr (!Epi::AFTER_DRAIN) { E(acc, cur, wr, wc, fr, fq);
#if EPI_PROBE
            _Pragma("unroll 1") for (int pr_ = 0; pr_ < 2; ++pr_) { asm volatile("" ::: "memory"); E(acc, cur, wr, wc, fr, fq); }
#endif
            S.done(cur); }
        if (!has_next) break;
#pragma unroll
        for (int a = 0; a < 2; ++a)
#pragma unroll
            for (int b = 0; b < 2; ++b)
#pragma unroll
                for (int m = 0; m < 4; ++m)
#pragma unroll
                    for (int n = 0; n < 2; ++n) acc[a][b][m][n] = (f32x4){0.f, 0.f, 0.f, 0.f};
        cur = nxt; cA = nA; cB = nB; ++ui;
        if constexpr (GATHER) { va[0][0] = vnl[0]; va[0][1] = vnl[1]; va[1][0] = vnl[2]; va[1][1] = vnl[3]; }
        if constexpr (ALIGN_EPI) { if (wr == 1) PG8_BAR; }
    }
    PG8_WAIT_V(0);
    if constexpr (!ALIGN_EPI) { if (wr == 0) PG8_BAR; }
    PG8_BAR;
    if constexpr (Epi::AFTER_DRAIN) { E.fused(acc, cur, wr, wc, fr, fq, lds, wid, lane); S.done(cur); }
#undef PG8_SA
#undef PG8_SB
#undef PG8_STAGE
#undef PG8_STAGE_A
#undef PG8_GCALC
#undef PG8_LDA
#undef PG8_LDB
#undef PG8_MMA
#undef PG8_WAIT_V
#undef PG8_WAIT_L
#undef PG8_BAR
#undef PG8_SCHED
}
}
#define LAS __attribute__((address_space(3)))
#define XB_TMO      128
#define XB_XCNT(j)  (256  + 64 * (j))
#define XB_XSUB(j)  (1280 + 64 * (j))
#define XB_XGEN(j)  (2304 + 64 * (j))
#define XB_TOP      3328
#define XB_TOPGEN   3392
#define XCD_BAR_WORDS 3456
#define XB_SPIN_CAP (1u << 18)

__device__ __forceinline__ unsigned xb_ld(unsigned* p)              { return __hip_atomic_load(p, __ATOMIC_RELAXED, __HIP_MEMORY_SCOPE_AGENT); }
__device__ __forceinline__ unsigned xb_add(unsigned* p, unsigned v) { return __hip_atomic_fetch_add(p, v, __ATOMIC_RELAXED, __HIP_MEMORY_SCOPE_AGENT); }
__device__ __forceinline__ unsigned xb_xcc_id() { return (unsigned)__builtin_amdgcn_s_getreg((3 << 11) | 20) & 0xFu; }
#define XB_SPIN(cond, bar) do { unsigned _sp = 0; while (cond) { __builtin_amdgcn_s_sleep(1); \
    if ((++_sp & 255u) == 0u) { if (xb_ld(&(bar)[XB_TMO])) break; if (_sp > XB_SPIN_CAP) { atomicAdd(&(bar)[XB_TMO], 1u); break; } } } } while (0)

struct XcdBarrier {
    unsigned* bar; unsigned x;
    volatile LAS unsigned* st;
};

__device__ __forceinline__ XcdBarrier xcd_barrier_post(unsigned* bar, volatile LAS unsigned* st) {
    XcdBarrier b; b.bar = bar; b.x = xb_xcc_id(); b.st = st;
    if (threadIdx.x == 0) (void)xb_add(&bar[XB_XCNT(b.x)], 1u);
    return b;
}
__device__ __forceinline__ void xcd_barrier_complete(unsigned* bar, unsigned x, unsigned& nloc, unsigned& nx) {
    const unsigned G = gridDim.x * gridDim.y * gridDim.z;
    unsigned sum, cnt, mine, sp = 0u;
    for (;;) {
        sum = 0u; cnt = 0u; mine = 0u;
#pragma unroll 1
        for (unsigned j = 0; j < 16; ++j) { const unsigned c = xb_ld(&bar[XB_XCNT(j)]); sum += c; cnt += (c > 0u) ? 1u : 0u; mine = (j == x) ? c : mine; }
        if (sum == G) break;
        __builtin_amdgcn_s_sleep(1);
        if ((++sp & 255u) == 0u) { if (xb_ld(&bar[XB_TMO])) break; if (sp > XB_SPIN_CAP) { atomicAdd(&bar[XB_TMO], 1u); break; } }
    }
    nloc = mine > 0u ? mine : 1u; nx = cnt > 0u ? cnt : 1u;
}

__device__ __forceinline__ void xcd_barrier_census(const XcdBarrier& b) {
    if (threadIdx.x == 0) { unsigned nloc, nx; xcd_barrier_complete(b.bar, b.x, nloc, nx); b.st[0] = nloc; b.st[1] = nx; }
    __syncthreads();
}
__device__ __forceinline__ void xcd_barrier(const XcdBarrier& b) {
    asm volatile("s_waitcnt vmcnt(0)" ::: "memory");
    __syncthreads();
    if (threadIdx.x == 0) {
        unsigned* bar = b.bar;
        __builtin_amdgcn_s_waitcnt(0);
        unsigned nloc = b.st[0], nx = b.st[1];
        const unsigned old = xb_add(&bar[XB_XSUB(b.x)], 1u);
        const unsigned gen = old / nloc;
        if (old + 1u == (gen + 1u) * nloc) {
            __builtin_amdgcn_fence(__ATOMIC_RELEASE, "agent");
            asm volatile("s_waitcnt vmcnt(0)" ::: "memory");
            const unsigned og = xb_add(&bar[XB_TOP], 1u);
            const unsigned tg = og / nx;
            if (og + 1u == (tg + 1u) * nx) xb_add(&bar[XB_TOPGEN], 1u);
            else XB_SPIN(xb_ld(&bar[XB_TOPGEN]) == tg, bar);
            __builtin_amdgcn_fence(__ATOMIC_ACQUIRE, "agent");
            xb_add(&bar[XB_XGEN(b.x)], 1u);
            asm volatile("s_waitcnt vmcnt(0)" ::: "memory");
        } else {
            XB_SPIN(xb_ld(&bar[XB_XGEN(b.x)]) == gen, bar);
            __builtin_amdgcn_fence(__ATOMIC_ACQUIRE, "agent");
            asm volatile("s_waitcnt vmcnt(0)" ::: "memory");
        }
    }
    __syncthreads();
}

#define GAS __attribute__((address_space(1)))
typedef unsigned short bf16_t;
typedef short bf16x8 __attribute__((ext_vector_type(8)));
typedef short s16x4 __attribute__((ext_vector_type(4)));
typedef float f32x4 __attribute__((ext_vector_type(4)));
typedef float f32x2 __attribute__((ext_vector_type(2)));
typedef float f32x16 __attribute__((ext_vector_type(16)));
typedef unsigned u32x4 __attribute__((ext_vector_type(4)));
typedef unsigned u32x2 __attribute__((ext_vector_type(2)));

constexpr int T = 16384, DM = 2048, DIN = 6160, NPROJ = 6144, NLAYER = 2, NE = 16, DEXP = 1024;
constexpr int PQ = 0, PK = 512, PV = 1024, PG = 2048, PMQ = 3072, PMK = 4096, PMV = 5120;
__host__ __device__ __forceinline__ size_t ix_gq(int h, int t) { return ((size_t)(0 + h) * T + t) * 128; }
__host__ __device__ __forceinline__ size_t ix_gk(int h, int t) { return ((size_t)(4 + h) * T + t) * 128; }
__host__ __device__ __forceinline__ size_t ix_gv(int h, int t) { return (size_t)(8 + 2 * h) * T * 128 + (size_t)t * 256; }
__host__ __device__ __forceinline__ size_t ix_gg(int h, int t) { return (size_t)(16 + 2 * h) * T * 128 + (size_t)t * 256; }
__host__ __device__ __forceinline__ size_t ix_mq(int h, int t) { return ((size_t)(24 + h) * T + t) * 128; }
__host__ __device__ __forceinline__ size_t ix_mk(int h, int t) { return ((size_t)(32 + h) * T + t) * 128; }
__host__ __device__ __forceinline__ size_t ix_mv(int h, int t) { return ((size_t)(40 + h) * T + t) * 128; }
constexpr float DN_ALPHA = 1.4142135623730951f;
constexpr int MAXROWS = 36864;
constexpr int LISTH = 516096;
constexpr int NTHR = 512;

constexpr size_t MiB = 1u << 20;
constexpr size_t WS_CTL = 0, CTL_BYTES = 1 * MiB;
constexpr size_t WS_MISC = 1 * MiB;
constexpr size_t WS_ITEMS = 1 * MiB + 65536;
constexpr size_t WS_TOK = 2 * MiB, WS_SEL = 3 * MiB, WS_KMEAN = 4 * MiB, WS_GDEC = 5 * MiB, WS_GLOW = 6 * MiB, WS_PML = 8 * MiB;
constexpr size_t WS_HBQ = 228 * MiB;
constexpr int WIN8_SH = 5;
constexpr size_t WS_IDX = 7 * MiB;
constexpr size_t WS_HB8 = 456 * MiB;
constexpr size_t WS_ROPE = 12 * MiB, WS_LIST = 20 * MiB;
constexpr size_t WS_WIN = 36 * MiB, WS_WO = 60 * MiB, WS_WGU = 68 * MiB, WS_WIN2 = 132 * MiB, WS_WD = 196 * MiB;
constexpr size_t WS_HB = 260 * MiB, WS_MIX = 324 * MiB;
constexpr size_t WS_PROJ = 388 * MiB, WS_U = 580 * MiB, WS_S = 644 * MiB, WS_PO = 708 * MiB;
constexpr size_t WS_BDEC = 708 * MiB;
constexpr size_t WS_PRE = 388 * MiB;
constexpr size_t WS_XS = 388 * MiB, WS_HS = 532 * MiB, WS_YS = 604 * MiB;
constexpr size_t WS_END = 836 * MiB;
constexpr int CW_BAR = 4096, CW_CNT = 8192, CW_NIT = 8448, CW_DBG = 8704, CW_CVQ = 9216;
constexpr int LDS_SCR = 131072, LDS_BYTES = 155648;

struct Params { const float* in[16]; float* out; unsigned char* ws; int g_lo, g_hi; };

__device__ __forceinline__ unsigned cvt_pk(float lo, float hi) { return pg8::cvt_pk_bf16(lo, hi); }
__device__ __forceinline__ float bflo(unsigned u) { return __uint_as_float(u << 16); }
__device__ __forceinline__ float bfhi(unsigned u) { return __uint_as_float(u & 0xffff0000u); }
__device__ __forceinline__ float bf2f(bf16_t u) { return __uint_as_float(((unsigned)u) << 16); }
__device__ __forceinline__ unsigned ldu(const unsigned* p) { return __hip_atomic_load(p, __ATOMIC_RELAXED, __HIP_MEMORY_SCOPE_AGENT); }
__device__ __forceinline__ float ldf(const float* p) { return __uint_as_float(__hip_atomic_load((const unsigned*)p, __ATOMIC_RELAXED, __HIP_MEMORY_SCOPE_AGENT)); }
#ifndef OUT8
#define OUT8 1
#endif
constexpr int MIX8_SH = 3, WO8_SH = 5;
#ifndef YS8
#define YS8 1
#endif
constexpr int Y8_SH = 4;
#ifndef RECOMP
#define RECOMP 1
#endif
#ifndef PO8
#define PO8 1
#endif
constexpr int PO8_SH = 4;
constexpr int X8_SH = 2, H8_SH = 2, WGU8_SH = 5, WD8_SH = 6;
__device__ __forceinline__ unsigned pk4_fp8(float a, float b, float c, float d);
__device__ __forceinline__ unsigned pk4_fp8v(f32x4 x, float s) { const f32x4 y = x * s; return pk4_fp8(y[0], y[1], y[2], y[3]); }
__device__ __forceinline__ unsigned pk4_fp8(float a, float b, float c, float d) { int t = __builtin_amdgcn_cvt_pk_fp8_f32(a, b, 0, false); t = __builtin_amdgcn_cvt_pk_fp8_f32(c, d, t, true); return (unsigned)t; }
__device__ __forceinline__ float fp8_dec(unsigned b) { const unsigned s = b >> 7, e = (b >> 3) & 15u, m = b & 7u; const float v = e ? (1.0f + 0.125f * (float)m) * __builtin_ldexpf(1.0f, (int)e - 7) : 0.125f * (float)m * 0.015625f; return s ? -v : v; }
__device__ __forceinline__ void unpack8(const u32x4 x, float (&f)[8]) { f[0] = bflo(x.x); f[1] = bfhi(x.x); f[2] = bflo(x.y); f[3] = bfhi(x.y); f[4] = bflo(x.z); f[5] = bfhi(x.z); f[6] = bflo(x.w); f[7] = bfhi(x.w); }
__device__ __forceinline__ u32x4 pack8(const float (&f)[8]) { u32x4 w; w.x = cvt_pk(f[0], f[1]); w.y = cvt_pk(f[2], f[3]); w.z = cvt_pk(f[4], f[5]); w.w = cvt_pk(f[6], f[7]); return w; }

__device__ __forceinline__ void moe_bases(const unsigned* cnt, int* sb) {
    const int tid = opq_tid();
    if (tid < 64) { const int lane = tid;
        const int c = (lane < NE) ? (int)ldu(cnt + lane) : 0; const int nP = (c + 255) >> 8; int incl = nP;
#pragma unroll
        for (int o = 1; o < 16; o <<= 1) { const int t = __shfl_up(incl, o); if (lane >= o) incl += t; }
        if (lane < NE) { sb[lane] = (incl - nP) * 256; sb[32 + lane] = c; if (lane == NE - 1) sb[16] = incl * 256; } }
    __syncthreads();
}
__device__ __forceinline__ float wave_sum(float v) {
#define WS_DPP(ctrl) v += __int_as_float(__builtin_amdgcn_update_dpp(0, __float_as_int(v), (ctrl), 0xF, 0xF, true))
    WS_DPP(0xB1); WS_DPP(0x4E); WS_DPP(0x141); WS_DPP(0x140);
#undef WS_DPP
    const int vi = __float_as_int(v);
    return (__int_as_float(__builtin_amdgcn_readlane(vi, 0)) + __int_as_float(__builtin_amdgcn_readlane(vi, 16))) + (__int_as_float(__builtin_amdgcn_readlane(vi, 32)) + __int_as_float(__builtin_amdgcn_readlane(vi, 48)));
}
__device__ __forceinline__ float silu_f(float x) { return x * __builtin_amdgcn_rcpf(1.0f + __expf(-x)); }
__device__ __forceinline__ s16x4 tr_rd(int addr) { s16x4 r; asm volatile("ds_read_b64_tr_b16 %0, %1" : "=&v"(r) : "v"(addr) : "memory"); return r; }
#define LGKM0() do { asm volatile("s_waitcnt lgkmcnt(0)" ::: "memory"); __builtin_amdgcn_sched_barrier(0); } while (0)
#define PK8(L, H) ((bf16x8){L[0], L[1], L[2], L[3], H[0], H[1], H[2], H[3]})
#define MFMA16(a, b, c) __builtin_amdgcn_mfma_f32_16x16x32_bf16((a), (b), (c), 0, 0, 0)

namespace pg8 {
struct EpiProj {
    static constexpr bool PERM = true, AFTER_DRAIN = false;
    bf16_t* O; const float* cs; const float* sn;
    __device__ __forceinline__ void operator()(const f32x4 (&acc)[2][2][4][2], const Unit& u, int wr, int wc, int fr, int fq) const {
        const int row0 = u.pm * BM + wr * 64 + fr, cin = wc * 32 + 8 * fq;
        const bool rope = (u.pn >= 12 && u.pn < 20);
        size_t hb0[2]; int rs;
        if (u.pn < 4) { rs = 128; for (int bj = 0; bj < 2; ++bj) hb0[bj] = (size_t)((u.pn < 2 ? 0 : 4) + 2 * (u.pn & 1) + bj) * T * 128; }
        else if (u.pn < 12) { rs = 256; for (int bj = 0; bj < 2; ++bj) hb0[bj] = (size_t)((u.pn < 8 ? 8 : 16) + 2 * ((u.pn - 4) & 3)) * T * 128 + bj * 128; }
        else { rs = 128; for (int bj = 0; bj < 2; ++bj) hb0[bj] = (size_t)(24 + 8 * ((u.pn - 12) >> 2) + 2 * ((u.pn - 12) & 3) + bj) * T * 128; }
#pragma unroll
        for (int ai = 0; ai < 2; ++ai) {
            f32x4 c[4], s[4];
#pragma unroll
            for (int m = 0; m < 4; ++m) { c[m] = (f32x4){1.f, 1.f, 1.f, 1.f}; s[m] = (f32x4){0.f, 0.f, 0.f, 0.f}; }
            if (rope) {
#pragma unroll
                for (int m = 0; m < 4; ++m) { const int row = row0 + ai * HALF + m * 16; c[m] = *(const f32x4*)(cs + (size_t)row * 64 + 16 * wc + 4 * fq); s[m] = *(const f32x4*)(sn + (size_t)row * 64 + 16 * wc + 4 * fq); } }
#pragma unroll
            for (int m = 0; m < 4; ++m) {
                const int row = row0 + ai * HALF + m * 16;
#pragma unroll
                for (int bj = 0; bj < 2; ++bj) {
                    const f32x4 a0 = acc[ai][bj][m][0], a1 = acc[ai][bj][m][1];
                    const f32x4 v0 = a0 * c[m] - a1 * s[m], v1 = a1 * c[m] + a0 * s[m];
                    u32x4 w; w.x = cvt_pk_bf16(v0[0], v0[1]); w.y = cvt_pk_bf16(v0[2], v0[3]); w.z = cvt_pk_bf16(v1[0], v1[1]); w.w = cvt_pk_bf16(v1[2], v1[3]);
                    *(u32x4*)(O + hb0[bj] + (size_t)row * rs + cin) = w; }
            }
        }
    }
};
struct EpiOut {
    static constexpr bool PERM = true, AFTER_DRAIN = false;
    const float* res32; const bf16_t* res16; bf16_t* out; float alpha;
    __device__ __forceinline__ void operator()(const f32x4 (&acc)[2][2][4][2], const Unit& u, int wr, int wc, int fr, int fq) const {
        const int row0 = u.pm * BM + wr * 64 + fr, col0 = u.pn * BM + wc * 32 + 8 * fq;
        if (res32) {
#pragma unroll
            for (int ai = 0; ai < 2; ++ai)
#pragma unroll
                for (int mh = 0; mh < 2; ++mh) { f32x4 r[2][2][2];
#pragma unroll
                    for (int m2 = 0; m2 < 2; ++m2)
#pragma unroll
                        for (int bj = 0; bj < 2; ++bj) { const size_t off = (size_t)(row0 + ai * HALF + (2 * mh + m2) * 16) * 2048 + col0 + bj * HALF; r[m2][bj][0] = *(const f32x4*)(res32 + off); r[m2][bj][1] = *(const f32x4*)(res32 + off + 4); }
#pragma unroll
                    for (int m2 = 0; m2 < 2; ++m2)
#pragma unroll
                        for (int bj = 0; bj < 2; ++bj) { const int m = 2 * mh + m2; const size_t off = (size_t)(row0 + ai * HALF + m * 16) * 2048 + col0 + bj * HALF;
                            const f32x4 v0 = r[m2][bj][0] * alpha + acc[ai][bj][m][0], v1 = r[m2][bj][1] * alpha + acc[ai][bj][m][1];
                            u32x4 w; w.x = cvt_pk_bf16(v0[0], v0[1]); w.y = cvt_pk_bf16(v0[2], v0[3]); w.z = cvt_pk_bf16(v1[0], v1[1]); w.w = cvt_pk_bf16(v1[2], v1[3]);
                            *(u32x4*)(out + off) = w; } }
        } else {
#pragma unroll
            for (int ai = 0; ai < 2; ++ai) { u32x4 b[4][2];
#pragma unroll
                for (int m = 0; m < 4; ++m)
#pragma unroll
                    for (int bj = 0; bj < 2; ++bj) b[m][bj] = *(const u32x4*)(res16 + (size_t)(row0 + ai * HALF + m * 16) * 2048 + col0 + bj * HALF);
#pragma unroll
                for (int m = 0; m < 4; ++m)
#pragma unroll
                    for (int bj = 0; bj < 2; ++bj) { const size_t off = (size_t)(row0 + ai * HALF + m * 16) * 2048 + col0 + bj * HALF; const u32x4 bb = b[m][bj];
                        const f32x4 r0 = (f32x4){bflo(bb.x), bfhi(bb.x), bflo(bb.y), bfhi(bb.y)}, r1 = (f32x4){bflo(bb.z), bfhi(bb.z), bflo(bb.w), bfhi(bb.w)};
                        const f32x4 v0 = r0 * alpha + acc[ai][bj][m][0], v1 = r1 * alpha + acc[ai][bj][m][1];
                        u32x4 w; w.x = cvt_pk_bf16(v0[0], v0[1]); w.y = cvt_pk_bf16(v0[2], v0[3]); w.z = cvt_pk_bf16(v1[0], v1[1]); w.w = cvt_pk_bf16(v1[2], v1[3]);
                        *(u32x4*)(out + off) = w; } }
        }
    }
};
struct EpiGU {
    static constexpr bool PERM = true, AFTER_DRAIN = false;
    unsigned char* H;
    __device__ __forceinline__ void operator()(const f32x4 (&acc)[2][2][4][2], const Unit& u, int wr, int wc, int fr, int fq) const {
        const int row0 = u.pm * BM + wr * 64 + fr, col0 = ((u.pn & 7) * BM + wc * 32 + 8 * fq) >> 1;
#pragma unroll
        for (int ai = 0; ai < 2; ++ai)
#pragma unroll
            for (int m = 0; m < 4; ++m) { unsigned char* rowp = H + (size_t)(row0 + ai * HALF + m * 16) * 1024 + col0;
#pragma unroll
                for (int bj = 0; bj < 2; ++bj) { const f32x4 g = acc[ai][bj][m][0], up = acc[ai][bj][m][1]; f32x4 h;
#pragma unroll
                    for (int j = 0; j < 4; ++j) h[j] = g[j] * __builtin_amdgcn_rcpf(1.0f + __expf(-g[j])) * up[j] * (float)(1 << H8_SH);
                    *(unsigned*)(rowp + bj * (HALF / 2)) = pk4_fp8(h[0], h[1], h[2], h[3]); } }
    }
};
struct EpiY {
    static constexpr bool PERM = true, AFTER_DRAIN = false;
    bf16_t* Y;
    __device__ __forceinline__ void operator()(const f32x4 (&acc)[2][2][4][2], const Unit& u, int wr, int wc, int fr, int fq) const {
        const int row0 = u.pm * BM + wr * 64 + fr, col0 = (u.pn & 7) * BM + wc * 32 + 8 * fq;
#pragma unroll
        for (int ai = 0; ai < 2; ++ai)
#pragma unroll
            for (int m = 0; m < 4; ++m) { bf16_t* rowp = Y + (size_t)(row0 + ai * HALF + m * 16) * 2048 + col0;
#pragma unroll
                for (int bj = 0; bj < 2; ++bj) { const f32x4 v0 = acc[ai][bj][m][0], v1 = acc[ai][bj][m][1];
#if YS8
                    u32x2 w; w.x = pk4_fp8(v0[0] * (float)(1 << Y8_SH), v0[1] * (float)(1 << Y8_SH), v0[2] * (float)(1 << Y8_SH), v0[3] * (float)(1 << Y8_SH));
                    w.y = pk4_fp8(v1[0] * (float)(1 << Y8_SH), v1[1] * (float)(1 << Y8_SH), v1[2] * (float)(1 << Y8_SH), v1[3] * (float)(1 << Y8_SH));
                    *(u32x2*)((unsigned char*)Y + (size_t)(row0 + ai * HALF + m * 16) * 2048 + col0 + bj * HALF) = w; } }
#else
                    u32x4 w; w.x = cvt_pk_bf16(v0[0], v0[1]); w.y = cvt_pk_bf16(v0[2], v0[3]); w.z = cvt_pk_bf16(v1[0], v1[1]); w.w = cvt_pk_bf16(v1[2], v1[3]);
                    *(u32x4*)(rowp + bj * HALF) = w; } }
#endif
    }
};
struct MoeOrder : StaticOrder {
    const int* sb; const unsigned* idx; int rowbytes;
    __device__ __forceinline__ int expert_of(int pm) const { const int r = pm * BM; int e = 0;
#pragma unroll
        for (int k = 1; k < 16; ++k) e += (sb[k] <= r) ? 1 : 0;
        return e; }
    __device__ __forceinline__ bool next(int i, Unit& u) const {
        if (!StaticOrder::next(i, u)) return false;
        u.pn += 8 * __builtin_amdgcn_readfirstlane(expert_of(u.pm));
        return true; }
    __device__ __forceinline__ unsigned arow(const Unit& u, int r) const {
        const int e = u.pn >> 3, slot = u.pm * BM - sb[e] + r;
        const unsigned t = (slot < sb[32 + e]) ? __hip_atomic_load(idx + (size_t)e * 16384 + slot, __ATOMIC_RELAXED, __HIP_MEMORY_SCOPE_AGENT) : 0u;
        return t * (unsigned)rowbytes; }
};
}
__device__ __forceinline__ int rope_src_col(int n) {
    const int seg = (n - PMQ) >> 7, pp = (n - PMQ) & 127, g = pp >> 3, e = pp & 7;
    return 3088 + seg * 128 + (e < 4 ? 4 * g + e : 64 + 4 * g + (e - 4));
}
constexpr int CVT_NT = 1792, CVT_NT_IN = 192;
template <bool DYN, int JOBS>
static __device__ void phase_cvt(const Params& p, int tl, int t0, int ntot, int w, int nwk, unsigned char* lds, unsigned* qw = nullptr) {
    const int tid = opq_tid(), lane = tid & 63, wave = __builtin_amdgcn_readfirstlane(tid >> 6);
    volatile unsigned* qs = (volatile unsigned*)(lds + LDS_SCR + 96);
    int tt = w;
    if (DYN) { if (tid == 0) *qs = atomicAdd(qw, 1u); __syncthreads(); tt = (int)*qs; }
    while (tt < ntot) {
        unsigned qn = 0u; if (DYN && tid == 0) qn = atomicAdd(qw, 1u);
        int t = t0 + tt;
        int job, e = 0, kt, nt;
        if ((JOBS & 1) && (t < 192 || JOBS == 1)) { job = 0; kt = t / 12; nt = t % 12; }
        else if ((JOBS & 2) && (t < 256 || !(JOBS & 12))) { t -= 192; job = 1; kt = t >> 2; nt = t & 3; }
        else if ((JOBS & 4) && (t < 1280 || !(JOBS & 8))) { t -= 256; job = 2; e = t >> 6; t &= 63; kt = t >> 2; nt = t & 3; }
        else { t -= 1280; job = 3; e = t >> 5; t &= 31; kt = t >> 2; nt = t & 3; }
        const int n0 = nt * 512, k0 = kt * 128;
        const float* s0; const float* s1; size_t ld; int nl0, nl1;
        if (job == 0) { const float* wi = p.in[2] + (size_t)tl * DM * DIN + (size_t)k0 * DIN; ld = DIN;
            const int na = n0 + 4 * lane, nb = n0 + 256 + 4 * lane;
            s0 = wi + ((na < PMQ) ? na : (na < PMV ? rope_src_col(na) : na + 16)); s1 = wi + ((nb < PMQ) ? nb : (nb < PMV ? rope_src_col(nb) : nb + 16)); nl0 = 4 * lane; nl1 = 256 + 4 * lane; }
        else if (job == 1) { const float* wo = p.in[6] + (size_t)tl * DM * DM + (size_t)k0 * DM + n0; ld = DM; s0 = wo + 4 * lane; s1 = wo + 256 + 4 * lane; nl0 = 4 * lane; nl1 = 256 + 4 * lane; }
        else if (job == 2) { const size_t off = ((size_t)(tl * NE + e) * DM + k0) * DEXP + (n0 >> 1) + 4 * lane; ld = DEXP; s0 = p.in[11] + off; s1 = p.in[12] + off; nl0 = 8 * lane; nl1 = 8 * lane + 4; }
        else { const float* wd = p.in[13] + ((size_t)(tl * NE + e) * DEXP + k0) * DM + n0; ld = DM; s0 = wd + 4 * lane; s1 = wd + 256 + 4 * lane; nl0 = 4 * lane; nl1 = 256 + 4 * lane; }
        const bool f8 = OUT8 ? true : (job != 1); const float sc = (job == 0) ? (float)(1 << WIN8_SH) : (job == 1) ? (float)(1 << WO8_SH) : (job == 2) ? (float)(1 << WGU8_SH) : (float)(1 << WD8_SH);
        f32x4 v[3][8];
#pragma unroll
        for (int pb = 0; pb < 2; ++pb)
#pragma unroll
            for (int i = 0; i < 4; ++i) { const size_t ro = (size_t)(wave + 8 * (4 * pb + i)) * ld; v[pb][2 * i] = *(const f32x4*)(s0 + ro); v[pb][2 * i + 1] = *(const f32x4*)(s1 + ro); }
#pragma unroll
        for (int bt = 0; bt < 4; ++bt) {
            if (bt < 2) {
#pragma unroll
                for (int i = 0; i < 4; ++i) { const size_t ro = (size_t)(wave + 8 * (4 * (bt + 2) + i)) * ld; v[(bt + 2) % 3][2 * i] = *(const f32x4*)(s0 + ro); v[(bt + 2) % 3][2 * i + 1] = *(const f32x4*)(s1 + ro); } }
#pragma unroll
            for (int i = 0; i < 4; ++i) { const int r = wave + 8 * (4 * bt + i); const f32x4 x0 = v[bt % 3][2 * i], x1 = v[bt % 3][2 * i + 1];
                if (f8) { *(unsigned*)(lds + r * 512 + nl0) = pk4_fp8(x0[0] * sc, x0[1] * sc, x0[2] * sc, x0[3] * sc); *(unsigned*)(lds + r * 512 + nl1) = pk4_fp8(x1[0] * sc, x1[1] * sc, x1[2] * sc, x1[3] * sc); }
                else { u32x2 a; a.x = cvt_pk(x0[0], x0[1]); a.y = cvt_pk(x0[2], x0[3]); u32x2 c2; c2.x = cvt_pk(x1[0], x1[1]); c2.y = cvt_pk(x1[2], x1[3]);
                       *(u32x2*)(lds + r * 1024 + 2 * nl0) = a; *(u32x2*)(lds + r * 1024 + 2 * nl1) = c2; } }
        }
        __syncthreads();
        if (f8) {
            unsigned char* d = (job == 0) ? p.ws + ((tl & 1) ? WS_WIN2 : WS_WIN) + (size_t)(n0 + tid) * DM + k0
                             : (job == 1) ? p.ws + WS_WO + (size_t)(n0 + tid) * DM + k0
                             : (job == 2) ? p.ws + WS_WGU + ((size_t)e * 2048 + n0 + tid) * DM + k0 : p.ws + WS_WD + ((size_t)e * 2048 + n0 + tid) * DEXP + k0;
#pragma unroll
            for (int c = 0; c < 8; ++c) { unsigned wq[4];
#pragma unroll
                for (int j = 0; j < 4; ++j) { const unsigned char* s8 = lds + (16 * c + 4 * j) * 512 + tid; wq[j] = (unsigned)s8[0] | ((unsigned)s8[512] << 8) | ((unsigned)s8[1024] << 16) | ((unsigned)s8[1536] << 24); }
                *(u32x4*)(d + 16 * c) = (u32x4){wq[0], wq[1], wq[2], wq[3]}; }
        } else {
            unsigned char* d = p.ws + WS_WO + ((size_t)(n0 + tid) * DM + k0) * 2;
#pragma unroll
            for (int c = 0; c < 16; ++c) { unsigned wq[4];
#pragma unroll
                for (int j = 0; j < 4; ++j) { const unsigned lo = *(const unsigned short*)(lds + (8 * c + 2 * j) * 1024 + 2 * tid), hi = *(const unsigned short*)(lds + (8 * c + 2 * j + 1) * 1024 + 2 * tid); wq[j] = lo | (hi << 16); }
                *(u32x4*)(d + 16 * c) = (u32x4){wq[0], wq[1], wq[2], wq[3]}; }
        }
        if (DYN) { if (tid == 0) *qs = qn; }
        __syncthreads();
        if (DYN) tt = (int)*qs; else tt += nwk;
    }
}

static __device__ void phase_rope(const Params& p) {
    float* cs = (float*)(p.ws + WS_ROPE); float* sn = cs + (size_t)T * 64;
    const int* pos = (const int*)p.in[1];
    const int tid0 = opq_tid();
    float inv;
    { const int i = tid0 & 63; double pw = 1.0; for (int k = 0; k < i; ++k) pw *= 1.1547819846894583;
      inv = 1.0f / (float)pw; }
    for (int idx = blockIdx.x * NTHR + tid0; idx < T * 64; idx += gridDim.x * NTHR) {
        const int t = idx >> 6;
        const float ang = (float)pos[t] * inv;
        const double rev = (double)ang * 0.15915494309189535; const float fr = (float)(rev - floor(rev));
        cs[idx] = __builtin_amdgcn_cosf(fr); sn[idx] = __builtin_amdgcn_sinf(fr);
    }
}

__device__ __forceinline__ float reduce16(const float (&a)[16], int lane) {
    float b[8], c[4], d[2];
    const bool x = lane & 1, y = lane & 2, z = lane & 4, w = lane & 8;
#pragma unroll
    for (int m = 0; m < 8; ++m) { const float keep = x ? a[2 * m + 1] : a[2 * m], give = x ? a[2 * m] : a[2 * m + 1]; b[m] = keep + __shfl_xor(give, 1); }
#pragma unroll
    for (int m = 0; m < 4; ++m) { const float keep = y ? b[2 * m + 1] : b[2 * m], give = y ? b[2 * m] : b[2 * m + 1]; c[m] = keep + __shfl_xor(give, 2); }
#pragma unroll
    for (int m = 0; m < 2; ++m) { const float keep = z ? c[2 * m + 1] : c[2 * m], give = z ? c[2 * m] : c[2 * m + 1]; d[m] = keep + __shfl_xor(give, 4); }
    float e = (w ? d[1] : d[0]) + __shfl_xor(w ? d[0] : d[1], 8);
    e += __shfl_xor(e, 16); e += __shfl_xor(e, 32);
    return e;
}
#ifndef ROW_PROBE
#define ROW_PROBE 0
#endif
template <class Tp> __device__ __forceinline__ Tp* opq_uniform(Tp* ptr) { unsigned long long w = (unsigned long long)ptr; asm volatile("" : "+s"(w)); return (Tp*)w; }
template <int MODE, bool DUMMY = false> static __device__ void phase_rows(const Params& p, int layer, unsigned char* lds) {
    const int tid = opq_tid(), lane = tid & 63, wave = (MODE == 1) ? (tid >> 6) : __builtin_amdgcn_readfirstlane(tid >> 6);
    float* wT = (float*)lds;
    constexpr bool SK16 = false;
    float* rlog = (float*)(lds + LDS_SCR + 20480);
    int* lcnt = (int*)(lds + LDS_SCR + 512); int* gbase = lcnt + 16; float* rinfo = (float*)(lds + LDS_SCR + 1024);
    const bool last = (layer == NLAYER - 1);
    const bool do_skinny = !(MODE == 2 && last);
    const float* W; int ld, c0;
    if (MODE == 0) { W = p.in[2]; ld = DIN; c0 = 3072; }
    else if (MODE == 1) { W = p.in[9]; ld = 16; c0 = 0; }
    else { W = p.in[2] + (size_t)(last ? layer : layer + 1) * DM * DIN; ld = DIN; c0 = 3072; }
    bf16_t* hb = (bf16_t*)(p.ws + (DUMMY ? (MODE == 1 ? WS_U : WS_MIX) : WS_HB));
    float* glow = (float*)(p.ws + (DUMMY ? WS_PML + 2 * MiB : WS_GLOW));
    unsigned* tok = (unsigned*)(p.ws + (DUMMY && MODE == 1 ? WS_PML : WS_TOK));
    float* outw = DUMMY ? (float*)(p.ws + (MODE == 1 ? WS_PROJ : WS_WGU)) : p.out;
    const bf16_t* Ys = (const bf16_t*)(p.ws + WS_YS);
    int* sbm = (int*)(lds + LDS_SCR + 128);
#ifndef NR2_DEF
#define NR2_DEF 1
#endif
    constexpr int NR = (MODE == 2) ? NR2_DEF : 2;
    const int nit = T / (8 * (int)gridDim.x);
    constexpr bool PF = true;
#if YS8
    u32x2 nx[NR][8]; unsigned ny0[8], ny1[8]; f32x4 nf[NR][8];
#else
    u32x2 nx[NR][8], ny0[8], ny1[8]; f32x4 nf[NR][8];
#endif
    float nw0 = 0.f, nw1 = 0.f; unsigned nt[6];
    const bf16_t* srcb0 = (const bf16_t*)(p.ws + ((MODE == 2 && !RECOMP) ? WS_HB : WS_PRE));
    if (PF) {
#pragma unroll
        for (int rr = 0; rr < NR; ++rr) { const int r = (rr * (int)gridDim.x + (int)blockIdx.x) * 8 + wave;
#pragma unroll
            for (int i = 0; i < 8; ++i) { if (MODE == 1) nx[rr][i] = *(const u32x2*)(srcb0 + (size_t)r * DM + 256 * i + 4 * lane); else if (MODE == 2) nx[rr][i] = *(const u32x2*)(opq_uniform(srcb0 + (size_t)r * DM) + 256 * i + 4 * lane); else nf[rr][i] = *(const f32x4*)(opq_uniform(p.in[0] + (size_t)r * DM) + 256 * i + 4 * lane); } }
        if (MODE == 2) {
            const int r = (int)blockIdx.x * 8 + wave;
#pragma unroll
            for (int j = 0; j < 6; ++j) nt[j] = ldu(tok + r * 8 + j);
        }
    }
    if (MODE == 2) moe_bases((const unsigned*)(p.ws + WS_CTL) + CW_CNT + layer * 64, sbm);
    if (PF && MODE == 2) {
        nw0 = __uint_as_float(nt[2]); nw1 = __uint_as_float(nt[3]);
#if YS8
        const unsigned char* y0 = opq_uniform((const unsigned char*)Ys + (size_t)__builtin_amdgcn_readfirstlane((int)((unsigned)sbm[nt[0]] + nt[4])) * DM); const unsigned char* y1 = opq_uniform((const unsigned char*)Ys + (size_t)__builtin_amdgcn_readfirstlane((int)((unsigned)sbm[nt[1]] + nt[5])) * DM);
#pragma unroll
        for (int i = 0; i < 8; ++i) { ny0[i] = *(const unsigned*)(y0 + 256 * i + 4 * lane); ny1[i] = *(const unsigned*)(y1 + 256 * i + 4 * lane); }
#else
        const bf16_t* y0 = Ys + (size_t)((unsigned)sbm[nt[0]] + nt[4]) * DM; const bf16_t* y1 = Ys + (size_t)((unsigned)sbm[nt[1]] + nt[5]) * DM;
#pragma unroll
        for (int i = 0; i < 8; ++i) { ny0[i] = *(const u32x2*)(y0 + 256 * i + 4 * lane); ny1[i] = *(const u32x2*)(y1 + 256 * i + 4 * lane); }
#endif
        const int r2 = ((nit > 1 ? 1 : 0) * (int)gridDim.x + (int)blockIdx.x) * 8 + wave;
#pragma unroll
        for (int j = 0; j < 6; ++j) nt[j] = ldu(tok + r2 * 8 + j);
    }
    if (do_skinny) {
#pragma unroll
        for (int hb2 = 0; hb2 < 2; ++hb2) { f32x4 wv[8];
#pragma unroll
            for (int i = 0; i < 8; ++i) { const int i4 = tid + NTHR * (8 * hb2 + i), k = i4 >> 2, e4 = (i4 & 3) * 4; wv[i] = *(const f32x4*)(W + (size_t)k * ld + c0 + e4); }
#pragma unroll
            for (int i = 0; i < 8; ++i) { const int i4 = tid + NTHR * (8 * hb2 + i), k = i4 >> 2, e4 = (i4 & 3) * 4;
#pragma unroll
                for (int j = 0; j < 4; ++j) { if (SK16) ((unsigned short*)wT)[(e4 + j) * DM + k] = (unsigned short)(cvt_pk(wv[i][j], 0.f) & 0xFFFFu); else wT[(((e4 + j) >> 1) * DM + k) * 2 + ((e4 + j) & 1)] = wv[i][j]; } } }
    }
    if (MODE == 1 && tid < 16) lcnt[tid] = 0;
    float* gl = (float*)(lds + LDS_SCR + 4096); float* bl2 = gl + DM;
    unsigned short* tb2 = (unsigned short*)(lds + LDS_SCR + 12288); unsigned short* tg1 = tb2 + DM; unsigned short* tb1 = tg1 + DM;
    if (MODE != 0) {
        const float* gp = p.in[MODE == 1 ? 7 : 14] + (size_t)layer * DM; const float* bp = p.in[MODE == 1 ? 8 : 15] + (size_t)layer * DM;
        if (MODE == 2 && RECOMP) {
            const float* g1p = p.in[7] + (size_t)layer * DM; const float* b1p = p.in[8] + (size_t)layer * DM;
#pragma unroll
            for (int k = 0; k < DM / NTHR; ++k) { const int idx = tid + NTHR * k; gl[idx] = gp[idx];
                tb2[idx] = (unsigned short)(cvt_pk(bp[idx], 0.f) & 0xFFFFu); tg1[idx] = (unsigned short)(cvt_pk(g1p[idx], 0.f) & 0xFFFFu); tb1[idx] = (unsigned short)(cvt_pk(b1p[idx], 0.f) & 0xFFFFu); }
        } else {
#pragma unroll
            for (int k = 0; k < DM / NTHR; ++k) { const int idx = tid + NTHR * k; gl[idx] = gp[idx]; bl2[idx] = bp[idx]; }
        }
    }
    __syncthreads();
    for (int it = 0; it < nit; it += NR) {
        int row[NR]; float v[NR][32];
#pragma unroll
        for (int rr = 0; rr < NR; ++rr) { row[rr] = ((it + rr) * (int)gridDim.x + (int)blockIdx.x) * 8 + wave;
            if (MODE != 0) {
#pragma unroll
                for (int i = 0; i < 8; ++i) { const u32x2 x = nx[rr][i]; v[rr][4 * i] = bflo(x.x); v[rr][4 * i + 1] = bfhi(x.x); v[rr][4 * i + 2] = bflo(x.y); v[rr][4 * i + 3] = bfhi(x.y); }
            } else {
#pragma unroll
                for (int i = 0; i < 8; ++i) { const f32x4 x = nf[rr][i];
#pragma unroll
                    for (int j = 0; j < 4; ++j) v[rr][4 * i + j] = x[j]; } } }
        if (MODE == 2 && RECOMP) {
            __builtin_amdgcn_sched_barrier(0);
            float s = 0.f;
#pragma unroll
            for (int i = 0; i < 32; ++i) s += v[0][i];
            const float mean = wave_sum(s) * (1.0f / DM);
            float qq = 0.f;
#pragma unroll
            for (int i = 0; i < 32; ++i) { const float d = v[0][i] - mean; qq += d * d; }
            const float rstd = rsqrtf(wave_sum(qq) * (1.0f / DM) + 1e-5f);
#pragma unroll
            for (int i = 0; i < 8; ++i) { const u32x2 g4 = *(const u32x2*)(tg1 + 256 * i + 4 * lane), b4 = *(const u32x2*)(tb1 + 256 * i + 4 * lane);
                v[0][4 * i + 0] = (v[0][4 * i + 0] - mean) * rstd * bflo(g4.x) + bflo(b4.x); v[0][4 * i + 1] = (v[0][4 * i + 1] - mean) * rstd * bfhi(g4.x) + bfhi(b4.x);
                v[0][4 * i + 2] = (v[0][4 * i + 2] - mean) * rstd * bflo(g4.y) + bflo(b4.y); v[0][4 * i + 3] = (v[0][4 * i + 3] - mean) * rstd * bfhi(g4.y) + bfhi(b4.y);
                asm volatile("" ::: "memory"); }
            __builtin_amdgcn_sched_barrier(0);
        }
        if (MODE == 2) {
#if YS8
            const float w0 = nw0 * (1.0f / (float)(1 << Y8_SH)), w1 = nw1 * (1.0f / (float)(1 << Y8_SH));
#pragma unroll
            for (int i = 0; i < 8; ++i) { const unsigned a = ny0[i], c = ny1[i];
                const f32x2 a01 = __builtin_amdgcn_cvt_pk_f32_fp8((int)a, false), a23 = __builtin_amdgcn_cvt_pk_f32_fp8((int)a, true), c01 = __builtin_amdgcn_cvt_pk_f32_fp8((int)c, false), c23 = __builtin_amdgcn_cvt_pk_f32_fp8((int)c, true);
                v[0][4 * i + 0] = DN_ALPHA * v[0][4 * i + 0] + w0 * a01[0] + w1 * c01[0]; v[0][4 * i + 1] = DN_ALPHA * v[0][4 * i + 1] + w0 * a01[1] + w1 * c01[1];
                v[0][4 * i + 2] = DN_ALPHA * v[0][4 * i + 2] + w0 * a23[0] + w1 * c23[0]; v[0][4 * i + 3] = DN_ALPHA * v[0][4 * i + 3] + w0 * a23[1] + w1 * c23[1]; }
#else
            const float w0 = nw0, w1 = nw1;
#pragma unroll
            for (int i = 0; i < 8; ++i) { const u32x2 a = ny0[i], c = ny1[i];
                v[0][4 * i + 0] = DN_ALPHA * v[0][4 * i + 0] + w0 * bflo(a.x) + w1 * bflo(c.x); v[0][4 * i + 1] = DN_ALPHA * v[0][4 * i + 1] + w0 * bfhi(a.x) + w1 * bfhi(c.x);
                v[0][4 * i + 2] = DN_ALPHA * v[0][4 * i + 2] + w0 * bflo(a.y) + w1 * bflo(c.y); v[0][4 * i + 3] = DN_ALPHA * v[0][4 * i + 3] + w0 * bfhi(a.y) + w1 * bfhi(c.y); }
#endif
        }
        if (PF) {
            const int itn = (it + NR < nit) ? it + NR : it;
#pragma unroll
            for (int rr = 0; rr < NR; ++rr) { const int r = ((itn + rr) * (int)gridDim.x + (int)blockIdx.x) * 8 + wave;
#pragma unroll
                for (int i = 0; i < 8; ++i) { if (MODE == 1) nx[rr][i] = *(const u32x2*)(srcb0 + (size_t)r * DM + 256 * i + 4 * lane); else if (MODE == 2) nx[rr][i] = *(const u32x2*)(opq_uniform(srcb0 + (size_t)r * DM) + 256 * i + 4 * lane); else nf[rr][i] = *(const f32x4*)(opq_uniform(p.in[0] + (size_t)r * DM) + 256 * i + 4 * lane); } }
            if (MODE == 2) {
                nw0 = __uint_as_float(nt[2]); nw1 = __uint_as_float(nt[3]);
#if YS8
                        const unsigned char* y0 = opq_uniform((const unsigned char*)Ys + (size_t)__builtin_amdgcn_readfirstlane((int)((unsigned)sbm[nt[0]] + nt[4])) * DM); const unsigned char* y1 = opq_uniform((const unsigned char*)Ys + (size_t)__builtin_amdgcn_readfirstlane((int)((unsigned)sbm[nt[1]] + nt[5])) * DM);
#pragma unroll
                for (int i = 0; i < 8; ++i) { ny0[i] = *(const unsigned*)(y0 + 256 * i + 4 * lane); ny1[i] = *(const unsigned*)(y1 + 256 * i + 4 * lane); }
#else
                const bf16_t* y0 = Ys + (size_t)((unsigned)sbm[nt[0]] + nt[4]) * DM; const bf16_t* y1 = Ys + (size_t)((unsigned)sbm[nt[1]] + nt[5]) * DM;
#pragma unroll
                for (int i = 0; i < 8; ++i) { ny0[i] = *(const u32x2*)(y0 + 256 * i + 4 * lane); ny1[i] = *(const u32x2*)(y1 + 256 * i + 4 * lane); }
#endif
                const int it2 = (it + 2 < nit) ? it + 2 : nit - 1;
                const int r2 = (it2 * (int)gridDim.x + (int)blockIdx.x) * 8 + wave;
#pragma unroll
                for (int j = 0; j < 6; ++j) nt[j] = ldu(tok + r2 * 8 + j);
            }
        }
#pragma unroll
        for (int rr = 0; rr < NR; ++rr) {
            __builtin_amdgcn_sched_barrier(0);
            if (MODE != 0) {
                f32x2 s2 = (f32x2){0.f, 0.f};
#pragma unroll
                for (int i = 0; i < 16; ++i) s2 += (f32x2){v[rr][2 * i], v[rr][2 * i + 1]};
                const float mean = wave_sum(s2[0] + s2[1]) * (1.0f / DM);
                const f32x2 m2 = (f32x2){mean, mean};
                f32x2 q2 = (f32x2){0.f, 0.f};
#pragma unroll
                for (int i = 0; i < 16; ++i) { const f32x2 d2 = (f32x2){v[rr][2 * i], v[rr][2 * i + 1]} - m2; q2 += d2 * d2; }
                const float rstd = rsqrtf(wave_sum(q2[0] + q2[1]) * (1.0f / DM) + 1e-5f);
                const f32x4 m4 = (f32x4){mean, mean, mean, mean}, r4 = (f32x4){rstd, rstd, rstd, rstd};
#pragma unroll
                for (int i = 0; i < 8; ++i) { const f32x4 gv = *(const f32x4*)(gl + 256 * i + 4 * lane); f32x4 bv;
                    if (MODE == 2 && RECOMP) { const u32x2 b4 = *(const u32x2*)(tb2 + 256 * i + 4 * lane); bv = (f32x4){bflo(b4.x), bfhi(b4.x), bflo(b4.y), bfhi(b4.y)}; }
                    else bv = *(const f32x4*)(bl2 + 256 * i + 4 * lane);
                    const f32x4 x4 = ((f32x4){v[rr][4 * i], v[rr][4 * i + 1], v[rr][4 * i + 2], v[rr][4 * i + 3]} - m4) * (r4 * gv) + bv;
#pragma unroll
                    for (int j = 0; j < 4; ++j) v[rr][4 * i + j] = x4[j]; }
                if (MODE == 2 && last) {
                    float* dst = (MODE == 1) ? outw + (size_t)row[rr] * DM : opq_uniform(outw + (size_t)row[rr] * DM);
#pragma unroll
                    for (int i = 0; i < 8; ++i) *(f32x4*)(dst + 256 * i + 4 * lane) = (f32x4){v[rr][4 * i], v[rr][4 * i + 1], v[rr][4 * i + 2], v[rr][4 * i + 3]}; }
            }
            if (MODE != 0 && !(MODE == 2 && last) && !(MODE == 1 && RECOMP)) {
#pragma unroll
                for (int i = 0; i < 8; ++i) { u32x2 w; w.x = cvt_pk(v[rr][4 * i], v[rr][4 * i + 1]); w.y = cvt_pk(v[rr][4 * i + 2], v[rr][4 * i + 3]); *(u32x2*)(((MODE == 1) ? hb + (size_t)row[rr] * DM : opq_uniform(hb + (size_t)row[rr] * DM)) + 256 * i + 4 * lane) = w; }
            }
            if (MODE == 1 || !(MODE == 2 && last)) {
                unsigned char* hb8 = p.ws + (DUMMY ? WS_S : (MODE == 1 ? WS_HB8 : WS_HBQ));
#pragma unroll
                for (int i = 0; i < 8; ++i) *(unsigned*)(((MODE == 1) ? hb8 + (size_t)row[rr] * DM : opq_uniform(hb8 + (size_t)row[rr] * DM)) + 256 * i + 4 * lane) = pk4_fp8(v[rr][4 * i] * (float)(1 << X8_SH), v[rr][4 * i + 1] * (float)(1 << X8_SH), v[rr][4 * i + 2] * (float)(1 << X8_SH), v[rr][4 * i + 3] * (float)(1 << X8_SH));
            }
            asm volatile("" ::: "memory"); __builtin_amdgcn_sched_barrier(0);
        }
        if (do_skinny) {
            float tots[NR];
#pragma unroll
            for (int rr = 0; rr < NR; ++rr) {
                asm volatile("" ::: "memory"); __builtin_amdgcn_sched_barrier(0);
                float acc1[16];
                {
                    f32x2 acc2[8];
#pragma unroll
                    for (int ep = 0; ep < 8; ++ep) acc2[ep] = (f32x2){0.f, 0.f};
#pragma unroll
                    for (int i = 0; i < 8; ++i) {
                        const f32x2 s0 = (f32x2){v[rr][4 * i], v[rr][4 * i]}, s1 = (f32x2){v[rr][4 * i + 1], v[rr][4 * i + 1]}, s2 = (f32x2){v[rr][4 * i + 2], v[rr][4 * i + 2]}, s3 = (f32x2){v[rr][4 * i + 3], v[rr][4 * i + 3]};
#pragma unroll
                        for (int eh = 0; eh < 2; ++eh) {
#pragma unroll
                            for (int ep = 4 * eh; ep < 4 * eh + 4; ++ep) { const f32x4 wa = *(const f32x4*)(wT + (ep * DM + 256 * i + 4 * lane) * 2), wb = *(const f32x4*)(wT + (ep * DM + 256 * i + 4 * lane) * 2 + 4);
                                acc2[ep] += s0 * (f32x2){wa[0], wa[1]}; acc2[ep] += s1 * (f32x2){wa[2], wa[3]}; acc2[ep] += s2 * (f32x2){wb[0], wb[1]}; acc2[ep] += s3 * (f32x2){wb[2], wb[3]}; }
                            asm volatile("" ::: "memory"); } }
#pragma unroll
                    for (int ep = 0; ep < 8; ++ep) { acc1[2 * ep] = acc2[ep][0]; acc1[2 * ep + 1] = acc2[ep][1]; }
                }
                tots[rr] = reduce16(acc1, lane);
                if (MODE != 1) { if (lane < 16) glow[(size_t)row[rr] * 16 + lane] = tots[rr]; }
            }
            if (MODE == 1) {
#pragma unroll
              for (int rr = 0; rr < NR; ++rr) { if (lane < 16) rlog[((it + rr) * 8 + wave) * 16 + lane] = tots[rr]; }
            }
        }
    }
    if (MODE == 1) {
        unsigned* cnt = (unsigned*)(p.ws + WS_CTL) + (DUMMY ? CW_DBG + 64 : CW_CNT + layer * 64);
        __syncthreads();
        int e0 = 0, e1 = 0, ls0 = 0, ls1 = 0; float rw0 = 0.f, rw1 = 0.f;
        if (tid < 8 * nit) {
                    float lg[16];
#pragma unroll
                    for (int e = 0; e < 16; ++e) lg[e] = rlog[tid * 16 + e];
                    float mx = lg[0];
#pragma unroll
                    for (int e = 1; e < 16; ++e) mx = fmaxf(mx, lg[e]);
                    float aff[16], bi[16], sum = 0.f;
#pragma unroll
                    for (int e = 0; e < 16; ++e) { aff[e] = __expf(lg[e] - mx); sum += aff[e]; }
                    const float rs = 1.0f / sum;
#pragma unroll
                    for (int e = 0; e < 16; ++e) { aff[e] *= rs; bi[e] = aff[e] + p.in[10][e]; }
                    float gs[4];
#pragma unroll
                    for (int gi = 0; gi < 4; ++gi) { const float a0 = bi[4 * gi], a1 = bi[4 * gi + 1], a2 = bi[4 * gi + 2], a3 = bi[4 * gi + 3];
                        gs[gi] = fmaxf(fmaxf(fmaxf(a0 + a1, a0 + a2), fmaxf(a0 + a3, a1 + a2)), fmaxf(a1 + a3, a2 + a3)); }
                    int best = 0; float bv = gs[0];
#pragma unroll
                    for (int gi = 1; gi < 4; ++gi) if (gs[gi] > bv) { bv = gs[gi]; best = gi; }
                    float ab[4], aa[4];
#pragma unroll
                    for (int k = 0; k < 4; ++k) { ab[k] = best == 0 ? bi[k] : best == 1 ? bi[4 + k] : best == 2 ? bi[8 + k] : bi[12 + k];
                                                  aa[k] = best == 0 ? aff[k] : best == 1 ? aff[4 + k] : best == 2 ? aff[8 + k] : aff[12 + k]; }
                    int i1 = 0; float v1 = ab[0];
#pragma unroll
                    for (int k = 1; k < 4; ++k) if (ab[k] > v1) { v1 = ab[k]; i1 = k; }
                    int i2 = -1; float v2 = -3.0e38f;
#pragma unroll
                    for (int k = 0; k < 4; ++k) if (k != i1 && ab[k] > v2) { v2 = ab[k]; i2 = k; }
                    const float a1 = i1 == 0 ? aa[0] : i1 == 1 ? aa[1] : i1 == 2 ? aa[2] : aa[3];
                    const float a2 = i2 == 0 ? aa[0] : i2 == 1 ? aa[1] : i2 == 2 ? aa[2] : aa[3];
                    const float ws = 1.0f / (a1 + a2);
                    e0 = 4 * best + i1; e1 = 4 * best + i2; rw0 = a1 * ws; rw1 = a2 * ws;
                    ls0 = atomicAdd(&lcnt[e0], 1); ls1 = atomicAdd(&lcnt[e1], 1);
        }
        __syncthreads();
        if (tid < 16) gbase[tid] = (int)atomicAdd(&cnt[tid], (unsigned)lcnt[tid]);
        __syncthreads();
        if (tid < 8 * nit) {
            const int it = tid >> 3, wv = tid & 7, row = (it * (int)gridDim.x + (int)blockIdx.x) * 8 + wv;
            u32x4 a; a.x = (unsigned)e0; a.y = (unsigned)e1; a.z = __float_as_uint(rw0); a.w = __float_as_uint(rw1);
            u32x4 c; c.x = (unsigned)(gbase[e0] + ls0); c.y = (unsigned)(gbase[e1] + ls1); c.z = 0u; c.w = 0u;
            *(u32x4*)(tok + row * 8) = a; *(u32x4*)(tok + row * 8 + 4) = c;
            if (!DUMMY) { unsigned* idx = (unsigned*)(p.ws + WS_IDX); idx[(size_t)e0 * 16384 + c.x] = (unsigned)row; idx[(size_t)e1 * 16384 + c.y] = (unsigned)row; }
        }
        __syncthreads();
    }
    __syncthreads();
}

__device__ void phase_perm(const Params& p, int layer, unsigned char* lds) {
    const int tid = opq_tid(), lane = tid & 63, wave = __builtin_amdgcn_readfirstlane(tid >> 6);
    int* sb = (int*)lds;
    const unsigned* cnt = (const unsigned*)(p.ws + WS_CTL) + CW_CNT + layer * 64;
    unsigned* misc = (unsigned*)(p.ws + WS_MISC) + layer * 256;
    if (tid < 64) {
        const int c = (lane < NE) ? (int)ldu(cnt + lane) : 0;
        const int nP = (c + 255) >> 8;
        int incl = nP;
#pragma unroll
        for (int o = 1; o < 16; o <<= 1) { const int t = __shfl_up(incl, o); if (lane >= o) incl += t; }
        const int excl = incl - nP;
        if (lane < NE) {
            sb[lane] = excl * 256;
            if (blockIdx.x == 0) { misc[16 + lane] = (unsigned)(excl * 256); for (int q = 0; q < nP; ++q) misc[64 + excl + q] = (unsigned)lane; if (lane == NE - 1) misc[0] = (unsigned)incl; }
        }
    }
    __syncthreads();
    unsigned* tok = (unsigned*)(p.ws + WS_TOK);
    const bf16_t* hb = (const bf16_t*)(p.ws + WS_HB); unsigned char* Xs = p.ws + WS_XS;
    const int nit = T / (8 * (int)gridDim.x);
    for (int it = 0; it < nit; ++it) {
        const int row = (it * (int)gridDim.x + (int)blockIdx.x) * 8 + wave;
        const int e0 = (int)ldu(tok + row * 8), e1 = (int)ldu(tok + row * 8 + 1);
        const int r0 = sb[e0] + (int)ldu(tok + row * 8 + 4), r1 = sb[e1] + (int)ldu(tok + row * 8 + 5);
        const u32x4* s = (const u32x4*)(hb + (size_t)row * DM);
#pragma unroll
        for (int hh = 0; hh < 2; ++hh) {
            float f[16]; { float fa[8], fb[8]; unpack8(s[2 * lane + 128 * hh], fa); unpack8(s[2 * lane + 1 + 128 * hh], fb);
#pragma unroll
                for (int i = 0; i < 8; ++i) { f[i] = fa[i] * (float)(1 << X8_SH); f[8 + i] = fb[i] * (float)(1 << X8_SH); } }
            const u32x4 x = {pk4_fp8(f[0], f[1], f[2], f[3]), pk4_fp8(f[4], f[5], f[6], f[7]), pk4_fp8(f[8], f[9], f[10], f[11]), pk4_fp8(f[12], f[13], f[14], f[15])};
            *(u32x4*)(Xs + (size_t)r0 * DM + 16 * lane + 1024 * hh) = x; *(u32x4*)(Xs + (size_t)r1 * DM + 16 * lane + 1024 * hh) = x; }
        if (lane == 0) { tok[row * 8 + 6] = (unsigned)r0; tok[row * 8 + 7] = (unsigned)r1; }
    }
    __syncthreads();
}
constexpr int GL_V = 0, GL_K = 33792, GL_Q = 51200, GL_B = 68608, GL_GLW = 101376, GL_TOT = 105472, GL_AT = 107520, GL_RED = 116736, GL_W = 118784;
#ifndef GLA_PROBE
#define GLA_PROBE 0
#endif
#ifndef GLA_NOTR
#define GLA_NOTR 0
#endif
#ifndef ATT_QMAX_DEF
#define ATT_QMAX_DEF 512
#endif
constexpr int ATT_QMAX = ATT_QMAX_DEF;
constexpr int KSB = 272, VSB = 528, ASB = 144;
__device__ __forceinline__ int blx(int row, int col) { return row * 128 + ((((col >> 2) ^ (row & 7))) << 2) + (col & 3); }

__device__ __forceinline__ f32x4 gla_decay(unsigned char* lds) {
    const int tid = opq_tid();
    float* bl = (float*)(lds + GL_B); const float* glw = (const float*)(lds + GL_GLW); float* tot = (float*)(lds + GL_TOT); float* gt = (float*)(lds + GL_AT);
    const int dq = tid & 31, tg = tid >> 5;
    asm volatile("s_waitcnt vmcnt(0)" ::: "memory");
    __syncthreads();
    f32x4 all = (f32x4){0.f, 0.f, 0.f, 0.f};
#pragma unroll 1
    for (int pr_ = 0; pr_ < (GLA_PROBE == 1 ? 5 : 1); ++pr_) {
    const f32x4 bg = *(const f32x4*)((const float*)(lds + GL_W) + 2048 + 4 * dq);
    f32x4 x[4] = {bg, bg, bg, bg};
#pragma unroll
    for (int hf = 0; hf < 2; ++hf) {
        f32x4 w[8];
#pragma unroll
        for (int r = 0; r < 8; ++r) w[r] = *(const f32x4*)((const float*)(lds + GL_W) + (8 * hf + r) * 128 + 4 * dq);
#pragma unroll
        for (int tt = 0; tt < 4; ++tt) { const f32x4* gr = (const f32x4*)(glw + (tg * 4 + tt) * 16 + 8 * hf); const f32x4 g0 = gr[0], g1 = gr[1];
            x[tt] += g0[0] * w[0] + g0[1] * w[1] + g0[2] * w[2] + g0[3] * w[3] + g1[0] * w[4] + g1[1] * w[5] + g1[2] * w[6] + g1[3] * w[7]; }
        __builtin_amdgcn_sched_barrier(0);
    }
    f32x4 run = (f32x4){0.f, 0.f, 0.f, 0.f};
#pragma unroll
    for (int tt = 0; tt < 4; ++tt) {
        const int tk = tg * 4 + tt;
#pragma unroll
        for (int j = 0; j < 4; ++j) run[j] += (fminf(x[tt][j], 0.f) - __logf(1.0f + __expf(-fabsf(x[tt][j])))) * 0.0625f;
        *(f32x4*)(bl + tk * 128 + 4 * dq) = run;
    }
    *(f32x4*)(gt + tg * 128 + 4 * dq) = run;
    __syncthreads();
    f32x4 pre = (f32x4){0.f, 0.f, 0.f, 0.f}; all = pre;
#pragma unroll
    for (int g2 = 0; g2 < 16; ++g2) { const f32x4 tv = *(const f32x4*)(gt + g2 * 128 + 4 * dq); if (g2 < tg) pre += tv; all += tv; }
#pragma unroll
    for (int tt = 0; tt < 4; ++tt) { f32x4* bp = (f32x4*)(bl + (tg * 4 + tt) * 128 + 4 * dq); *bp = *bp + pre; }
    if (tg == 0) { *(f32x4*)(tot + 4 * dq) = all; *(f32x4*)(tot + 128 + 4 * dq) = (f32x4){__expf(all[0]), __expf(all[1]), __expf(all[2]), __expf(all[3])}; }
    __syncthreads();
    }
    return all;
}
__device__ __forceinline__ void gla_stage_v(const bf16_t* proj, int c, int h, unsigned char* lds) {
    const int tid = opq_tid(), tk = tid >> 3, dv0 = (tid & 7) * 32;
    const u32x4* s = (const u32x4*)(proj + ix_gv(h, c * 64 + tk) + dv0);
    u32x4* d = (u32x4*)(lds + GL_V + tk * VSB + dv0 * 2);
#pragma unroll
    for (int i = 0; i < 4; ++i) d[i] = s[i];
}

template <bool OUT>
static __device__ void gla_super_unit(const Params& p, int layer, int sc, int h, unsigned char* lds) {
    const int tid = opq_tid(), lane = tid & 63, wave = tid >> 6, g = lane >> 4, l15 = lane & 15;
    const bf16_t* proj = (const bf16_t*)(p.ws + WS_PROJ);
    const int tk0 = tid >> 3, dk0 = (tid & 7) * 16, dv0 = (tid & 7) * 32;
    const int lbase = (int)(uintptr_t)lds, trow = l15 >> 2, tcol = 4 * (lane & 3);
    const float* bl = (const float*)(lds + GL_B); float* tot = (float*)(lds + GL_TOT);
    f32x4 S[8][2];
    if (OUT && sc > 0) {
        const bf16_t* Sst = (const bf16_t*)(p.ws + WS_S) + ((size_t)sc * 4 + h) * 256 * 128;
#pragma unroll
        for (int m = 0; m < 8; ++m)
#pragma unroll
            for (int nn = 0; nn < 2; ++nn) { const u32x2 w = *(const u32x2*)(Sst + (size_t)(32 * wave + 16 * nn + l15) * 128 + 16 * m + 4 * g);
                S[m][nn] = (f32x4){bflo(w.x), bfhi(w.x), bflo(w.y), bfhi(w.y)}; }
    } else {
#pragma unroll
        for (int m = 0; m < 8; ++m) { S[m][0] = (f32x4){0.f, 0.f, 0.f, 0.f}; S[m][1] = (f32x4){0.f, 0.f, 0.f, 0.f}; }
    }
    f32x4 bsum = (f32x4){0.f, 0.f, 0.f, 0.f};
    if (!OUT) { float* wl = (float*)(lds + GL_W);
#pragma unroll
      for (int j = 0; j < 4; ++j) { const int idx = tid + 512 * j; wl[idx] = p.in[3][(size_t)layer * 16 * 512 + (idx >> 7) * 512 + h * 128 + (idx & 127)]; }
      if (tid < 128) wl[2048 + tid] = p.in[4][layer * 512 + h * 128 + tid]; }
    float* gB = (float*)(p.ws + WS_BDEC);
    u32x4 qreg[2], kreg[2], vreg[4];
    const int wu = __builtin_amdgcn_readfirstlane(wave);
#define GLA_REQ(cq) { const int c_ = (cq); \
        const u32x4* sk = (const u32x4*)(proj + ix_gk(h, c_ * 64 + tk0) + dk0); const u32x4* sv = (const u32x4*)(proj + ix_gv(h, c_ * 64 + tk0) + dv0); \
        kreg[0] = sk[0]; kreg[1] = sk[1]; \
        if (OUT) { const u32x4* sq = (const u32x4*)(proj + ix_gq(h, c_ * 64 + tk0) + dk0); qreg[0] = sq[0]; qreg[1] = sq[1]; } \
        _Pragma("unroll") for (int i = 0; i < 4; ++i) vreg[i] = sv[i]; \
        if (!OUT) { if (wu < 4) __builtin_amdgcn_global_load_lds((const unsigned*)((const float*)(p.ws + WS_GLOW) + (size_t)c_ * 64 * 16 + tid * 4), (PG8_LAS unsigned*)(size_t)(unsigned)(lbase + GL_GLW + wu * 1024), 16, 0, 0); } \
        else { _Pragma("unroll") for (int k_ = 0; k_ < 4; ++k_) __builtin_amdgcn_global_load_lds((const unsigned*)(gB + ((size_t)c_ * 4 + h) * 8192 + (k_ * 512 + tid) * 4), (PG8_LAS unsigned*)(size_t)(unsigned)(lbase + GL_B + k_ * 8192 + wu * 1024), 16, 0, 0); } }
    GLA_REQ(sc * 4);
#pragma unroll 1
    for (int cc = 0; cc < 4; ++cc) {
        const int c = sc * 4 + cc;
        if (!OUT) {
            bsum += gla_decay(lds);
            float* gt_ = gB + ((size_t)c * 4 + h) * 8192;
#pragma unroll
            for (int k_ = 0; k_ < 4; ++k_) *(f32x4*)(gt_ + (k_ * 512 + tid) * 4) = *(const f32x4*)(bl + (k_ * 512 + tid) * 4);
        } else {
            asm volatile("s_waitcnt vmcnt(0)" ::: "memory");
            __syncthreads();
            if (tid < 128) { const float bb = bl[63 * 128 + tid]; tot[tid] = bb; tot[128 + tid] = __expf(bb); }
        }
        if (OUT) {
#pragma unroll
            for (int hlf = 0; hlf < 2; ++hlf) { float fq[8], fk[8]; unpack8(qreg[hlf], fq); unpack8(kreg[hlf], fk);
#pragma unroll
                for (int j = 0; j < 8; ++j) { const float bb = bl[tk0 * 128 + dk0 + hlf * 8 + j]; fq[j] *= __expf(bb) * 0.08838834764831845f; fk[j] *= __expf(-bb); }
                *(u32x4*)(lds + GL_Q + tk0 * KSB + (dk0 + hlf * 8) * 2) = pack8(fq); *(u32x4*)(lds + GL_K + tk0 * KSB + (dk0 + hlf * 8) * 2) = pack8(fk); }
        }
#pragma unroll
        for (int i = 0; i < 4; ++i) *(u32x4*)(lds + GL_V + tk0 * VSB + dv0 * 2 + 16 * i) = vreg[i];
        __syncthreads();
        f32x4 acc[2][4]; u32x2 ggr[4][2]; f32x4 gn[2];
        if (OUT) {
#if GLA_PROBE == 2
#pragma unroll 1
            for (int pr_ = 0; pr_ < 5; ++pr_)
#endif
            { const int mj = wave >> 1;
              f32x4 at[2] = {(f32x4){0.f, 0.f, 0.f, 0.f}, (f32x4){0.f, 0.f, 0.f, 0.f}};
#pragma unroll
              for (int ks = 0; ks < 4; ++ks) {
                  const bf16x8 A = *(const bf16x8*)(lds + GL_K + (16 * mj + l15) * KSB + (32 * ks + 8 * g) * 2);
#pragma unroll
                  for (int t2 = 0; t2 < 2; ++t2) { const int ni = 2 * (wave & 1) + t2; const bf16x8 B = *(const bf16x8*)(lds + GL_Q + (16 * ni + l15) * KSB + (32 * ks + 8 * g) * 2); at[t2] = MFMA16(A, B, at[t2]); }
              }
#pragma unroll
              for (int t2 = 0; t2 < 2; ++t2) { const int ni = 2 * (wave & 1) + t2, i = 16 * ni + l15, j0 = 16 * mj + 4 * g;
                  float v[4];
#pragma unroll
                  for (int r = 0; r < 4; ++r) v[r] = (i >= j0 + r) ? at[t2][r] : 0.f;
                  u32x2 w; w.x = cvt_pk(v[0], v[1]); w.y = cvt_pk(v[2], v[3]); *(u32x2*)(lds + GL_AT + i * ASB + j0 * 2) = w; }
            }
            __syncthreads();
        }
#pragma unroll
        for (int hlf = 0; hlf < 2; ++hlf) { float f[8]; unpack8(kreg[hlf], f);
#pragma unroll
            for (int j = 0; j < 8; ++j) f[j] *= __expf(tot[dk0 + hlf * 8 + j] - bl[tk0 * 128 + dk0 + hlf * 8 + j]);
            *(u32x4*)(lds + GL_K + tk0 * KSB + (dk0 + hlf * 8) * 2) = pack8(f); }
        if (!OUT) GLA_REQ(sc * 4 + (cc < 3 ? cc + 1 : 3));
        if (OUT) {
#pragma unroll
            for (int mm = 0; mm < 2; ++mm)
#pragma unroll
                for (int n = 0; n < 4; ++n) acc[mm][n] = (f32x4){0.f, 0.f, 0.f, 0.f};
#if GLA_PROBE == 3
#pragma unroll 1
            for (int pr_ = 0; pr_ < 5; ++pr_) {
            if (pr_ > 0) {
#pragma unroll
                for (int mm = 0; mm < 2; ++mm)
#pragma unroll
                    for (int n = 0; n < 4; ++n) acc[mm][n] *= 1e-30f; }
#endif
#pragma unroll
            for (int ks = 0; ks < 2; ++ks) {
                const int kb = 32 * ks + 8 * g + trow;
                s16x4 vl[2], vh[2]; bf16x8 B[4];
#pragma unroll
                for (int mm = 0; mm < 2; ++mm) { const int a = lbase + GL_V + kb * VSB + (32 * wave + 16 * mm + tcol) * 2; vl[mm] = tr_rd(a); vh[mm] = tr_rd(a + 4 * VSB); }
#pragma unroll
                for (int n = 0; n < 4; ++n) B[n] = *(const bf16x8*)(lds + GL_AT + (16 * n + l15) * ASB + (32 * ks + 8 * g) * 2);
                LGKM0();
#pragma unroll
                for (int mm = 0; mm < 2; ++mm)
#pragma unroll
                    for (int n = 0; n < 4; ++n) acc[mm][n] = MFMA16(PK8(vl[mm], vh[mm]), B[n], acc[mm][n]);
            }
            if (sc > 0 || cc > 0) {
#pragma unroll
                for (int s = 0; s < 4; ++s) {
                    bf16x8 A[2], B[4];
#pragma unroll
                    for (int mm = 0; mm < 2; ++mm) { u32x4 w; w.x = cvt_pk(S[2 * s][mm][0], S[2 * s][mm][1]); w.y = cvt_pk(S[2 * s][mm][2], S[2 * s][mm][3]);
                        w.z = cvt_pk(S[2 * s + 1][mm][0], S[2 * s + 1][mm][1]); w.w = cvt_pk(S[2 * s + 1][mm][2], S[2 * s + 1][mm][3]); A[mm] = __builtin_bit_cast(bf16x8, w); }
#pragma unroll
                    for (int n = 0; n < 4; ++n) { const unsigned char* qr = lds + GL_Q + (16 * n + l15) * KSB + (32 * s + 4 * g) * 2;
                        const u32x2 lo = *(const u32x2*)qr, hi = *(const u32x2*)(qr + 32); u32x4 w; w.x = lo.x; w.y = lo.y; w.z = hi.x; w.w = hi.y; B[n] = __builtin_bit_cast(bf16x8, w); }
#pragma unroll
                    for (int mm = 0; mm < 2; ++mm)
#pragma unroll
                        for (int n = 0; n < 4; ++n) acc[mm][n] = MFMA16(A[mm], B[n], acc[mm][n]);
                    __builtin_amdgcn_sched_barrier(0);
                }
            }
#if GLA_PROBE == 3
            }
#endif
            GLA_REQ(sc * 4 + (cc < 3 ? cc + 1 : 3));
#pragma unroll
            for (int n = 0; n < 4; ++n)
#pragma unroll
                for (int mm = 0; mm < 2; ++mm) ggr[n][mm] = *(const u32x2*)(proj + ix_gg(h, c * 64 + 16 * n + l15) + 32 * wave + 16 * mm + 4 * g);
#pragma unroll
            for (int mm = 0; mm < 2; ++mm) gn[mm] = *(const f32x4*)(p.in[5] + layer * 256 + 32 * wave + 16 * mm + 4 * g);
            float* red = (float*)(lds + GL_RED);
            float ss[4];
#pragma unroll
            for (int n = 0; n < 4; ++n) { float s = 0.f;
#pragma unroll
                for (int mm = 0; mm < 2; ++mm)
#pragma unroll
                    for (int r = 0; r < 4; ++r) s += acc[mm][n][r] * acc[mm][n][r];
                s += __shfl_xor(s, 16); s += __shfl_xor(s, 32); ss[n] = s; }
            if (g == 0) {
#pragma unroll
                for (int n = 0; n < 4; ++n) red[(16 * n + l15) * 8 + wave] = ss[n]; }
        }
        __syncthreads();
        if (OUT) {
#if GLA_PROBE == 4
#pragma unroll 1
            for (int pr_ = 0; pr_ < 5; ++pr_) {
#endif
            const float* red = (const float*)(lds + GL_RED);
            bf16_t* mix = (bf16_t*)(p.ws + WS_MIX);
#pragma unroll
            for (int n = 0; n < 4; ++n) {
                const int tk = 16 * n + l15; const f32x4 r0 = *(const f32x4*)(red + tk * 8), r1 = *(const f32x4*)(red + tk * 8 + 4);
                const float rstd = rsqrtf(((r0[0] + r0[1]) + (r0[2] + r0[3]) + (r1[0] + r1[1]) + (r1[2] + r1[3])) * (1.0f / 256.0f) + 1e-6f);
                const size_t tg = (size_t)c * 64 + tk;
#pragma unroll
                for (int mm = 0; mm < 2; ++mm) { const int dv = 32 * wave + 16 * mm + 4 * g;
                    const u32x2 gg = ggr[n][mm]; const f32x4 nr = gn[mm];
                    const f32x4 o4 = acc[mm][n] * ((nr * rstd) * (f32x4){silu_f(bflo(gg.x)), silu_f(bfhi(gg.x)), silu_f(bflo(gg.y)), silu_f(bfhi(gg.y))});
                    const float o0 = o4[0], o1 = o4[1], o2 = o4[2], o3 = o4[3];
#if OUT8
                    *(unsigned*)((unsigned char*)mix + tg * DM + h * 256 + dv) = pk4_fp8(o0 * (float)(1 << MIX8_SH), o1 * (float)(1 << MIX8_SH), o2 * (float)(1 << MIX8_SH), o3 * (float)(1 << MIX8_SH)); }
#else
                    u32x2 w; w.x = cvt_pk(o0, o1); w.y = cvt_pk(o2, o3); *(u32x2*)(mix + tg * DM + h * 256 + dv) = w; }
#endif
            }
#if GLA_PROBE == 4
            }
#endif
        }
        if (!OUT || cc < 3) {
#pragma unroll
            for (int m = 0; m < 8; ++m) { const f32x4 av = *(const f32x4*)(tot + 128 + 16 * m + 4 * g);
#pragma unroll
                for (int nn = 0; nn < 2; ++nn) S[m][nn] *= av; }
#pragma unroll
            for (int ks = 0; ks < 2; ++ks) {
                const int kb = 32 * ks + 8 * g + trow;
                s16x4 al[4], ah[4], vl[2], vh[2];
#pragma unroll
                for (int nn = 0; nn < 2; ++nn) { const int a = lbase + GL_V + kb * VSB + (32 * wave + 16 * nn + tcol) * 2; vl[nn] = tr_rd(a); vh[nn] = tr_rd(a + 4 * VSB); }
#pragma unroll
                for (int mh = 0; mh < 2; ++mh) {
#pragma unroll
                    for (int m = 0; m < 4; ++m) { const int a = lbase + GL_K + kb * KSB + (16 * (4 * mh + m) + tcol) * 2; al[m] = tr_rd(a); ah[m] = tr_rd(a + 4 * KSB); }
                    LGKM0();
#pragma unroll
                    for (int m = 0; m < 4; ++m)
#pragma unroll
                        for (int nn = 0; nn < 2; ++nn) S[4 * mh + m][nn] = MFMA16(PK8(al[m], ah[m]), PK8(vl[nn], vh[nn]), S[4 * mh + m][nn]);
                    __builtin_amdgcn_sched_barrier(0);
                }
            }
        }
        __syncthreads();
    }
    if (!OUT) {
        bf16_t* E = (bf16_t*)(p.ws + WS_U);
#pragma unroll
        for (int m = 0; m < 8; ++m)
#pragma unroll
            for (int nn = 0; nn < 2; ++nn) { const int dv = 32 * wave + 16 * nn + l15, dk = 16 * m + 4 * g;
                u32x2 w; w.x = cvt_pk(S[m][nn][0], S[m][nn][1]); w.y = cvt_pk(S[m][nn][2], S[m][nn][3]);
                *(u32x2*)(E + (((size_t)sc * 4 + h) * 256 + dv) * 128 + dk) = w; }
        if (tid < 32) *(f32x4*)((float*)(p.ws + WS_GDEC) + ((size_t)sc * 4 + h) * 128 + 4 * tid) = (f32x4){__expf(bsum[0]), __expf(bsum[1]), __expf(bsum[2]), __expf(bsum[3])};
    }
}
#undef GLA_REQ
static __device__ void gla_scan(const Params& p, int bi, int nblk, unsigned char* lds) {
    const unsigned* U32 = (const unsigned*)(p.ws + WS_U); unsigned* S32 = (unsigned*)(p.ws + WS_S); const float* gdec = (const float*)(p.ws + WS_GDEC);
    const int tid = opq_tid();
    float* dl = (float*)lds;
    for (int i0 = bi * 256; i0 < 65536; i0 += nblk * 256) {
        const int idx = i0 + (tid & 255), h = i0 >> 14, dk = (2 * idx) & 127;
        unsigned u[64];
        if (tid < 256) {
#pragma unroll
            for (int i = 0; i < 64; ++i) u[i] = U32[(size_t)i * 65536 + idx]; }
#pragma unroll
        for (int k = 0; k < 4; ++k) { const int e = (tid + 512 * k) * 4, c = e >> 7, d = e & 127; *(f32x4*)(dl + e) = *(const f32x4*)(gdec + ((size_t)c * 4 + h) * 128 + d); }
        __syncthreads();
        if (tid < 256) {
            float s0 = 0.f, s1 = 0.f;
#pragma unroll
            for (int i = 0; i < 64; ++i) { S32[(size_t)i * 65536 + idx] = cvt_pk(s0, s1); const f32x2 a = *(const f32x2*)(dl + i * 128 + dk); s0 = a[0] * s0 + bflo(u[i]); s1 = a[1] * s1 + bfhi(u[i]); } }
        __syncthreads();
    }
}

static __device__ void moba_kmean_unit(const Params& p, int h, int j, unsigned char* lds) {
    const int tid = opq_tid(), d0 = (tid & 15) * 8, kg = tid >> 4;
    const bf16_t* proj = (const bf16_t*)(p.ws + WS_PROJ);
    float acc[8];
#pragma unroll
    for (int i = 0; i < 8; ++i) acc[i] = 0.f;
#pragma unroll
    for (int kk = 0; kk < 8; ++kk) { float f[8]; unpack8(*(const u32x4*)(proj + ix_mk(h, j * 256 + kg * 8 + kk) + d0), f);
#pragma unroll
        for (int i = 0; i < 8; ++i) acc[i] += f[i]; }
    float* red = (float*)lds;
#pragma unroll
    for (int i = 0; i < 8; ++i) red[kg * 128 + d0 + i] = acc[i];
    __syncthreads();
    if (tid < 128) { float s = 0.f;
#pragma unroll 8
        for (int q = 0; q < 32; ++q) s += red[q * 128 + tid];
        ((float*)(p.ws + WS_KMEAN))[((size_t)h * 64 + j) * 128 + tid] = s * (1.0f / 256.0f); }
    __syncthreads();
}

#define TOP3_INS_IF(ok, s, j) do { const float _s = (s); const int _j = (j); const bool _ok = (ok); \
    const bool _c0 = _ok & ((_s > v0) | ((_s == v0) & (_j < i0))), _c1 = _ok & ((_s > v1) | ((_s == v1) & (_j < i1))), _c2 = _ok & ((_s > v2) | ((_s == v2) & (_j < i2))); \
    v2 = _c1 ? v1 : (_c2 ? _s : v2); i2 = _c1 ? i1 : (_c2 ? _j : i2); \
    v1 = _c0 ? v0 : (_c1 ? _s : v1); i1 = _c0 ? i0 : (_c1 ? _j : i1); \
    v0 = _c0 ? _s : v0;              i0 = _c0 ? _j : i0; } while (0)
#define TOP3_INS(s, j) TOP3_INS_IF(true, s, j)

static __device__ void moba_gate_unit(const Params& p, int h, int qb, unsigned char* lds) {
    const int tid = opq_tid(), lane = tid & 63, wave = tid >> 6, g = lane >> 4, l15 = lane & 15;
    const bf16_t* proj = (const bf16_t*)(p.ws + WS_PROJ);
    unsigned* selp = (unsigned*)(p.ws + WS_SEL) + (size_t)h * T + qb * 256;
    if (qb == 0) { if (tid < 256) selp[tid] = 0xFFFFFFFFu; return; }
    constexpr int GSB = 272, GLO = 64 * GSB;
    bf16x8 B[2][4];
#pragma unroll
    for (int t2 = 0; t2 < 2; ++t2)
#pragma unroll
        for (int s2 = 0; s2 < 4; ++s2) B[t2][s2] = *(const bf16x8*)(proj + ix_mq(h, qb * 256 + 32 * wave + 16 * t2 + l15) + 32 * s2 + 8 * g);
    { const int j = tid >> 3, c0 = (tid & 7) * 16;
      {
          const f32x4* src = (const f32x4*)((const float*)(p.ws + WS_KMEAN) + ((size_t)h * 64 + j) * 128 + c0);
          u32x4 hi[2], lo[2];
#pragma unroll
          for (int k = 0; k < 2; ++k) { const f32x4 a = src[2 * k], b = src[2 * k + 1];
              hi[k].x = cvt_pk(a[0], a[1]); hi[k].y = cvt_pk(a[2], a[3]); hi[k].z = cvt_pk(b[0], b[1]); hi[k].w = cvt_pk(b[2], b[3]);
              lo[k].x = cvt_pk(a[0] - bflo(hi[k].x), a[1] - bfhi(hi[k].x)); lo[k].y = cvt_pk(a[2] - bflo(hi[k].y), a[3] - bfhi(hi[k].y));
              lo[k].z = cvt_pk(b[0] - bflo(hi[k].z), b[1] - bfhi(hi[k].z)); lo[k].w = cvt_pk(b[2] - bflo(hi[k].w), b[3] - bfhi(hi[k].w)); }
          *(u32x4*)(lds + j * GSB + c0 * 2) = hi[0]; *(u32x4*)(lds + j * GSB + c0 * 2 + 16) = hi[1];
          *(u32x4*)(lds + GLO + j * GSB + c0 * 2) = lo[0]; *(u32x4*)(lds + GLO + j * GSB + c0 * 2 + 16) = lo[1]; } }
    __syncthreads();
    f32x4 acc[2][4];
#pragma unroll
    for (int t2 = 0; t2 < 2; ++t2)
#pragma unroll
        for (int n = 0; n < 4; ++n) acc[t2][n] = (f32x4){0.f, 0.f, 0.f, 0.f};
#pragma unroll
    for (int n = 0; n < 4; ++n) {
        {
#pragma unroll
            for (int s2 = 0; s2 < 4; ++s2) {
                const bf16x8 Ah = *(const bf16x8*)(lds + (16 * n + l15) * GSB + (32 * s2 + 8 * g) * 2), Al = *(const bf16x8*)(lds + GLO + (16 * n + l15) * GSB + (32 * s2 + 8 * g) * 2);
#pragma unroll
                for (int t2 = 0; t2 < 2; ++t2) { acc[t2][n] = MFMA16(Ah, B[t2][s2], acc[t2][n]); acc[t2][n] = MFMA16(Al, B[t2][s2], acc[t2][n]); }
            }
        }
    }
#pragma unroll
    for (int t2 = 0; t2 < 2; ++t2) {
        float v0 = -3.0e38f, v1 = -3.0e38f, v2 = -3.0e38f; int i0 = 255, i1 = 255, i2 = 255;
#pragma unroll
        for (int n = 0; n < 4; ++n)
#pragma unroll
            for (int r = 0; r < 4; ++r) { const int j = 16 * n + 4 * g + r; TOP3_INS_IF(j < qb, acc[t2][n][r], j); }
#pragma unroll
        for (int o = 16; o <= 32; o <<= 1) {
            const float c0 = __shfl_xor(v0, o), c1 = __shfl_xor(v1, o), c2 = __shfl_xor(v2, o); const int j0 = __shfl_xor(i0, o), j1 = __shfl_xor(i1, o), j2 = __shfl_xor(i2, o);
            TOP3_INS_IF(j0 != 255, c0, j0);
            TOP3_INS_IF(j1 != 255, c1, j1);
            TOP3_INS_IF(j2 != 255, c2, j2);
        }
        if (g == 0) selp[32 * wave + 16 * t2 + l15] = (unsigned)i0 | ((unsigned)i1 << 8) | ((unsigned)i2 << 16) | 0xFF000000u;
    }
    __syncthreads();
}

__device__ __forceinline__ int list_off(int j) { return 256 * (63 * j - (j * (j - 1)) / 2); }

static __device__ void moba_list_unit(const Params& p, int layer, int h, int j, unsigned char* lds) {
    const int tid = opq_tid(), lane = tid & 63, wave = tid >> 6;
    const unsigned* sel = (const unsigned*)(p.ws + WS_SEL) + (size_t)h * T;
    unsigned* list = (unsigned*)(p.ws + WS_LIST) + (size_t)h * LISTH + list_off(j);
    int* wcnt = (int*)lds;
    int total = 0;
    const u32x4 none = {0xFFFFFFFFu, 0xFFFFFFFFu, 0xFFFFFFFFu, 0xFFFFFFFFu};
    const int qs = (j + 1) * 256 + 4 * tid;
    u32x4 wa = none, wb = none, wc = none;
    if (qs < T) wa = *(const u32x4*)(sel + qs);
    if (qs + 4 * NTHR < T) wb = *(const u32x4*)(sel + qs + 4 * NTHR);
    if (qs + 8 * NTHR < T) wc = *(const u32x4*)(sel + qs + 8 * NTHR);
#pragma unroll 1
    for (int q0 = (j + 1) * 256; q0 < T; q0 += 4 * NTHR) {
        const int q = q0 + 4 * tid;
        const u32x4 w4 = wa; wa = wb; wb = wc; wc = none;
        if (q + 12 * NTHR < T) wc = *(const u32x4*)(sel + q + 12 * NTHR);
        int slot[4], cntl = 0;
#pragma unroll
        for (int i = 0; i < 4; ++i) { const unsigned w = w4[i];
            slot[i] = ((w & 0xFF) == (unsigned)j) ? 0 : (((w >> 8) & 0xFF) == (unsigned)j) ? 1 : (((w >> 16) & 0xFF) == (unsigned)j) ? 2 : -1; cntl += slot[i] >= 0; }
        int incl = cntl;
#pragma unroll
        for (int o = 1; o < 64; o <<= 1) { const int t2 = __shfl_up(incl, o); if (lane >= o) incl += t2; }
        if (lane == 63) wcnt[wave] = incl;
        __syncthreads();
        int off = total + incl - cntl, tot = 0;
#pragma unroll
        for (int w2 = 0; w2 < 8; ++w2) { const int cw = wcnt[w2]; off += (w2 < wave) ? cw : 0; tot += cw; }
#pragma unroll
        for (int i = 0; i < 4; ++i) if (slot[i] >= 0) { list[off] = (unsigned)(q + i) | ((unsigned)slot[i] << 16); ++off; }
        total += tot;
        __syncthreads();
    }
    if (tid == 0) {
        unsigned* ctl = (unsigned*)(p.ws + WS_CTL);
        const int nit = total > 0 ? (total + ATT_QMAX - 1) / ATT_QMAX : 1;
        u32x4* items = (u32x4*)(p.ws + WS_ITEMS) + layer * 4096;
        if (nit > 1) { const unsigned bf = atomicAdd(&ctl[CW_NIT + layer * 64 + 1], (unsigned)(nit - 1));
            for (int c = 0; c < nit - 1; ++c) items[bf + c] = (u32x4){(unsigned)h, (unsigned)j, (unsigned)c, (unsigned)total}; }
        const unsigned bb = atomicAdd(&ctl[CW_NIT + layer * 64 + 2], 1u);
        items[4095 - bb] = (u32x4){(unsigned)h, (unsigned)j, (unsigned)(nit - 1), (unsigned)total};
        atomicAdd(&ctl[CW_NIT + layer * 64], (unsigned)nit);
    }
}
namespace att {
constexpr int D = 128, NW = 8, QBLK = 32, KVBLK = 64, LDK = 128;
constexpr float SCALE = 0.088388347648318440f, THR = 8.f;
constexpr float CEXP = SCALE * 1.4426950408889634f;
constexpr size_t SHM_V = KVBLK * D * 2, SHM_K = KVBLK * D * 2;
#define KSWZ(row, colB) ((row) * 256 + ((colB) ^ (((row) & 7) << 4)))
#define SBAR() __builtin_amdgcn_sched_barrier(0)
__device__ __forceinline__ int crow(int r, int hi) { return (r & 3) + 8 * (r >> 2) + 4 * hi; }
__device__ __forceinline__ unsigned cvtpk(float lo, float hi) { return cvt_pk(lo, hi); }

__device__ __forceinline__ void partialSM(f32x16& p0, f32x16& p1, float& m_reg, float& mn, float& alpha) {
  constexpr float C = CEXP;
  float pmax = p0[0];
#pragma unroll
  for (int r = 1; r < 16; ++r) pmax = fmaxf(pmax, p0[r]);
#pragma unroll
  for (int r = 0; r < 16; ++r) pmax = fmaxf(pmax, p1[r]);
  { auto rr = __builtin_amdgcn_permlane32_swap(__float_as_uint(pmax), __float_as_uint(pmax), false, false);
    pmax = fmaxf(__uint_as_float(rr[0]), __uint_as_float(rr[1])); }
  if (__builtin_expect(__all(pmax - m_reg <= THR / SCALE), 1)) { mn = m_reg; alpha = 1.f; }
  else { mn = fmaxf(m_reg, pmax); alpha = __builtin_amdgcn_exp2f((m_reg - mn) * C); m_reg = mn; }
  const float mnC = -mn * C;
  { f32x16 cv, mv;
#pragma unroll
    for (int r = 0; r < 16; ++r) { cv[r] = C; mv[r] = mnC; }
    p0 = p0 * cv + mv; p1 = p1 * cv + mv; }
#pragma unroll
  for (int r = 0; r < 16; ++r) p0[r] = __builtin_amdgcn_exp2f(p0[r]);
}
__device__ __forceinline__ void finishSM(f32x16& p0, f32x16& p1, float alpha, float& l_reg, bf16x8& pa0, bf16x8& pa1, bf16x8& pa2, bf16x8& pa3) {
#pragma unroll
  for (int r = 0; r < 16; ++r) p1[r] = __builtin_amdgcn_exp2f(p1[r]);
  float ps;
  { const f32x16 s16 = p0 + p1;
    float t8[8];
#pragma unroll
    for (int r = 0; r < 8; ++r) t8[r] = s16[2 * r] + s16[2 * r + 1];
    ps = ((t8[0] + t8[1]) + (t8[2] + t8[3])) + ((t8[4] + t8[5]) + (t8[6] + t8[7])); }
  { auto rr = __builtin_amdgcn_permlane32_swap(__float_as_uint(ps), __float_as_uint(ps), false, false);
    ps = __uint_as_float(rr[0]) + __uint_as_float(rr[1]); }
  l_reg = l_reg * alpha + ps;
#define PK4(P, BASE, OUT) do { unsigned a0 = cvtpk(P[BASE + 0], P[BASE + 1]), a1 = cvtpk(P[BASE + 2], P[BASE + 3]);   \
    unsigned b0 = cvtpk(P[BASE + 4], P[BASE + 5]), b1 = cvtpk(P[BASE + 6], P[BASE + 7]);                              \
    auto r0 = __builtin_amdgcn_permlane32_swap(a0, b0, false, false); auto r1 = __builtin_amdgcn_permlane32_swap(a1, b1, false, false); \
    u32x4 w = {r0[0], r1[0], r0[1], r1[1]}; OUT = *reinterpret_cast<bf16x8*>(&w); } while (0)
  PK4(p0, 0, pa0); PK4(p0, 8, pa1); PK4(p1, 0, pa2); PK4(p1, 8, pa3);
#undef PK4
}
__device__ __forceinline__ void qkt(f32x16& p0, f32x16& p1, const char* Ks, const bf16x8* qr, int r32, int hi) {
  p0 = f32x16{}; p1 = f32x16{};
#pragma unroll
  for (int d0 = 0; d0 < 8; ++d0) { const int cb = (d0 * 16 + hi * 8) * 2;
    const bf16x8 b0 = *reinterpret_cast<const bf16x8*>(Ks + KSWZ(r32, cb));
    const bf16x8 b1 = *reinterpret_cast<const bf16x8*>(Ks + KSWZ(32 + r32, cb));
    p0 = __builtin_amdgcn_mfma_f32_32x32x16_bf16(b0, qr[d0], p0, 0, 0, 0);
    p1 = __builtin_amdgcn_mfma_f32_32x32x16_bf16(b1, qr[d0], p1, 0, 0, 0); }
}
__device__ __forceinline__ void mask_tile(f32x16& p0, f32x16& p1, int tile, int qrow, int hi) {
  const int t_ = qrow - tile * 64 - 4 * hi;
#pragma unroll
  for (int r = 0; r < 16; ++r) { const int kc = (r & 3) + 8 * (r >> 2); if (kc > t_) p0[r] = -1.0e30f; if (kc + 32 > t_) p1[r] = -1.0e30f; }
}
__device__ __forceinline__ int v_st(int k, int c) { const int kk = (k & ~0xC) | ((k & 4) << 1) | ((k & 8) >> 1); return ((kk >> 3) * 4 + (c >> 5)) * 512 + ((kk & 7) * 32 + (c & 31)) * 2; }
__device__ __forceinline__ int v_rd_base(int lane) { return ((lane & 3) << 3) | (((lane >> 2) & 3) << 6) | (((lane >> 4) & 1) << 5) | (((lane >> 5) & 1) << 8); }
constexpr int v_rd_off(int d0, int ks, int half) { return d0 * 512 + ks * 4096 + half * 2048; }
template <int OFF> __device__ __forceinline__ s16x4 tr_read(int vb) {
  s16x4 r; asm volatile("ds_read_b64_tr_b16 %0, %1 offset:%2" : "=&v"(r) : "v"(vb), "i"(OFF) : "memory"); return r;
}
template <int D0> __device__ __forceinline__ void pv_one(f32x16& od, int vb, bf16x8 pa0, bf16x8 pa1, bf16x8 pa2, bf16x8 pa3) {
  const s16x4 l0 = tr_read<v_rd_off(D0, 0, 0)>(vb), h0 = tr_read<v_rd_off(D0, 0, 1)>(vb), l1 = tr_read<v_rd_off(D0, 1, 0)>(vb), h1 = tr_read<v_rd_off(D0, 1, 1)>(vb);
  const s16x4 l2 = tr_read<v_rd_off(D0, 2, 0)>(vb), h2 = tr_read<v_rd_off(D0, 2, 1)>(vb), l3 = tr_read<v_rd_off(D0, 3, 0)>(vb), h3 = tr_read<v_rd_off(D0, 3, 1)>(vb);
  asm volatile("s_waitcnt lgkmcnt(0)" ::: "memory"); SBAR();
  od = __builtin_amdgcn_mfma_f32_32x32x16_bf16(pa0, PK8(l0, h0), od, 0, 0, 0);
  od = __builtin_amdgcn_mfma_f32_32x32x16_bf16(pa1, PK8(l1, h1), od, 0, 0, 0);
  od = __builtin_amdgcn_mfma_f32_32x32x16_bf16(pa2, PK8(l2, h2), od, 0, 0, 0);
  od = __builtin_amdgcn_mfma_f32_32x32x16_bf16(pa3, PK8(l3, h3), od, 0, 0, 0);
}
__device__ __forceinline__ void pv_d0(f32x16* o, int vb, bf16x8 pa0, bf16x8 pa1, bf16x8 pa2, bf16x8 pa3) {
  pv_one<0>(o[0], vb, pa0, pa1, pa2, pa3); pv_one<1>(o[1], vb, pa0, pa1, pa2, pa3); pv_one<2>(o[2], vb, pa0, pa1, pa2, pa3); pv_one<3>(o[3], vb, pa0, pa1, pa2, pa3);
}

__device__ __forceinline__ void moba_item(const bf16_t* __restrict__ proj, int h, int jblk, const unsigned* list, int nvalid, bf16_t* PO, float* PML, char* lds) {
  const int tid = opq_tid(), wid = tid >> 6, lane = tid & 63, r32 = lane & 31, hi = lane >> 5;
  const bool own = (list == nullptr);
  char* V_lds = lds; char* K_lds = lds + 2 * SHM_V;
  float* ws = (float*)(lds + 2 * SHM_V + 2 * SHM_K) + wid * 64; float* al_l = ws + 32;
  float m_reg = -1e30f, l_reg = 0; f32x16 o[4] = {}; bf16x8 qr[8];
  const int myrow = wid * QBLK + r32;
  int q, slot; bool valid;
  if (own) { q = jblk * 256 + myrow; slot = 3; valid = true; }
  else { const int rr = myrow < nvalid ? myrow : nvalid - 1; const unsigned e = list[rr]; q = (int)(e & 0xFFFFu); slot = (int)(e >> 16); valid = myrow < nvalid; }
  const bf16_t* Qw = proj + ix_mq(h, q) + hi * 8;
#pragma unroll
  for (int d0 = 0; d0 < 8; ++d0) qr[d0] = *reinterpret_cast<const bf16x8*>(Qw + d0 * 16);
  const bf16_t* Kh = proj + ix_mk(h, jblk * 256);
  const bf16_t* Vh = proj + ix_mv(h, jblk * 256);
  const int sr = tid >> 4, sc = (tid & 15) * 8, vst0 = v_st(sr, sc), vst1 = v_st(32 + sr, sc);
  const int vb0 = (int)(uintptr_t)V_lds + v_rd_base(lane);
  struct { bf16x8 vs0, vs1, ks0, ks1; } sr_[2];
#define SLOAD(i, k0) do { sr_[i].vs0 = *(const bf16x8*)(&Vh[(size_t)((k0) + sr) * LDK + sc]); sr_[i].vs1 = *(const bf16x8*)(&Vh[(size_t)((k0) + 32 + sr) * LDK + sc]); \
    sr_[i].ks0 = *(const bf16x8*)(&Kh[(size_t)((k0) + sr) * LDK + sc]); sr_[i].ks1 = *(const bf16x8*)(&Kh[(size_t)((k0) + 32 + sr) * LDK + sc]); } while (0)
#define SWRITE(b, i) do { *(bf16x8*)(V_lds + (b) * SHM_V + vst0) = sr_[i].vs0;          \
    *(bf16x8*)(V_lds + (b) * SHM_V + vst1) = sr_[i].vs1; const int kc = sc * 2;               \
    *(bf16x8*)(K_lds + (b) * SHM_K + KSWZ(sr, kc)) = sr_[i].ks0;                       \
    *(bf16x8*)(K_lds + (b) * SHM_K + KSWZ(32 + sr, kc)) = sr_[i].ks1; } while (0)
#define SWAIT() asm volatile("s_waitcnt vmcnt(4)" ::: "memory")
#define RESC(a) do { if (__any((a) < 1.f)) { if (hi == 0) al_l[r32] = (a); asm volatile("s_waitcnt lgkmcnt(0)" ::: "memory"); \
    _Pragma("unroll") for (int d = 0; d < 4; ++d) _Pragma("unroll") for (int r = 0; r < 16; ++r) o[d][r] *= al_l[crow(r, hi)]; } } while (0)
  f32x16 pA0, pA1, pB0, pB1; float mnA, mnB, alA, alB; bf16x8 pa0, pa1, pa2, pa3;
  constexpr int NT = 4, SE = 0, SO = 1;
  SLOAD(SE, 0); asm volatile("s_waitcnt vmcnt(0)" ::: "memory"); SWRITE(0, SE); __syncthreads();
  qkt(pA0, pA1, K_lds, qr, r32, hi); if (own) mask_tile(pA0, pA1, 0, myrow, hi); partialSM(pA0, pA1, m_reg, mnA, alA);
  SLOAD(SO, KVBLK); SLOAD(SE, 2 * KVBLK);
  SWAIT(); SWRITE(1, SO); __syncthreads();
  {
    SBAR(); qkt(pB0, pB1, K_lds + SHM_K, qr, r32, hi); if (own) mask_tile(pB0, pB1, 1, myrow, hi);
    finishSM(pA0, pA1, alA, l_reg, pa0, pa1, pa2, pa3); SBAR();
    SLOAD(SO, 3 * KVBLK); SBAR();
    pv_d0(o, vb0, pa0, pa1, pa2, pa3); partialSM(pB0, pB1, m_reg, mnB, alB);
    __syncthreads(); SWAIT(); SWRITE(0, SE);
    RESC(alB); __syncthreads();
    SBAR(); qkt(pA0, pA1, K_lds, qr, r32, hi); if (own) mask_tile(pA0, pA1, 2, myrow, hi);
    finishSM(pB0, pB1, alB, l_reg, pa0, pa1, pa2, pa3); SBAR();
    pv_d0(o, vb0 + (int)SHM_V, pa0, pa1, pa2, pa3); partialSM(pA0, pA1, m_reg, mnA, alA);
    __syncthreads(); asm volatile("s_waitcnt vmcnt(0)" ::: "memory"); SWRITE(1, SO);
    RESC(alA); __syncthreads();
  }
  SBAR(); qkt(pB0, pB1, K_lds + SHM_K, qr, r32, hi); if (own) mask_tile(pB0, pB1, 3, myrow, hi);
  finishSM(pA0, pA1, alA, l_reg, pa0, pa1, pa2, pa3); SBAR();
  pv_d0(o, vb0, pa0, pa1, pa2, pa3); partialSM(pB0, pB1, m_reg, mnB, alB);
  __syncthreads(); RESC(alB);
  finishSM(pB0, pB1, alB, l_reg, pa0, pa1, pa2, pa3); SBAR();
  pv_d0(o, vb0 + (int)SHM_V, pa0, pa1, pa2, pa3);
  __syncthreads();
  unsigned short* st = (unsigned short*)(lds + wid * 8192);
#pragma unroll
  for (int d0 = 0; d0 < 4; ++d0)
#pragma unroll
    for (int r = 0; r < 16; ++r) st[crow(r, hi) * 128 + 32 * d0 + r32] = (unsigned short)(cvtpk(o[d0][r], o[d0][r]) & 0xFFFFu);
  const int porow = valid ? ((q * 8 + h) * 4 + slot) : -1;
  if (hi == 0 && valid) { PML[(size_t)porow * 2] = m_reg * CEXP; PML[(size_t)porow * 2 + 1] = l_reg; }
  asm volatile("s_waitcnt lgkmcnt(0)" ::: "memory");
#pragma unroll
  for (int it = 0; it < 8; ++it) {
    const int row = it * 4 + (lane >> 4), ch = lane & 15;
    const int pr = __shfl(porow, row);
    const u32x4 vv = *(const u32x4*)(st + row * 128 + ch * 8);
    if (pr >= 0) *(u32x4*)(PO + (size_t)pr * 128 + ch * 8) = vv;
  }
  __syncthreads();
#undef SLOAD
#undef SWRITE
#undef SWAIT
#undef RESC
}

#ifndef ATT_PROBE
#define ATT_PROBE 0
#endif
constexpr int ATT2_QMAX = 768;
__device__ __forceinline__ void moba_item2(const bf16_t* __restrict__ proj, int h, int jblk, const unsigned* list, int nrows, int nown, bf16_t* PO, float* PML, char* lds,
                                           const unsigned* items, int nit, int nfront, unsigned nxt, unsigned (&dsc)[4], bool ldr) {
  const int tid = opq_tid(), wid = tid >> 6, lane = tid & 63, r32 = lane & 31, hi = lane >> 5;
  char* V_lds = lds; char* K_lds = lds + 65536;
  float* al_l = (float*)(lds + LDS_SCR + 4096) + wid * 32;
  unsigned short* st = (unsigned short*)(lds + LDS_SCR + 4096 + 1024 + wid * 2048);
  const int vb0 = (int)(uintptr_t)V_lds + v_rd_base(lane);
  const int no = nown >> 5, ngroups = no + ((nrows + 31) >> 5);
#define ENTRY(gg) (((gg) < no) ? (unsigned)(jblk * 256 + (gg) * 32 + r32) | (3u << 16) : list[(((gg) - no) * 32 + r32) < nrows ? (((gg) - no) * 32 + r32) : nrows - 1])
  unsigned e_cur = 0u, e_nxt = 0u; bf16x8 qrn[8];
  if (wid < ngroups) { e_cur = ENTRY(wid); if (wid + NW < ngroups) e_nxt = ENTRY(wid + NW); }
#if ATT_PROBE == 1
#pragma unroll 1
  for (int pr_ = 0; pr_ < 3; ++pr_)
#endif
  { const bf16_t* Kh = proj + ix_mk(h, jblk * 256); const bf16_t* Vh = proj + ix_mv(h, jblk * 256);
    const int sc = (tid & 15) * 8;
    bf16x8 kv[8], vv[8];
#pragma unroll
    for (int it = 0; it < 8; ++it) { const int key = it * 32 + (tid >> 4); kv[it] = *(const bf16x8*)(Kh + (size_t)key * 128 + sc); vv[it] = *(const bf16x8*)(Vh + (size_t)key * 128 + sc); }
    if (wid < ngroups) {
      const bf16_t* Qw = proj + ix_mq(h, (int)(e_cur & 0xFFFFu)) + hi * 8;
#pragma unroll
      for (int d0 = 0; d0 < 8; ++d0) qrn[d0] = *reinterpret_cast<const bf16x8*>(Qw + d0 * 16); }
    if (ldr && (int)nxt < nit) { const unsigned sl = (int)nxt < nfront ? nxt : 4095u - (nxt - (unsigned)nfront);
      dsc[0] = ldu(items + sl * 4); dsc[1] = ldu(items + sl * 4 + 1); dsc[2] = ldu(items + sl * 4 + 2); dsc[3] = ldu(items + sl * 4 + 3); }
#pragma unroll
    for (int it = 0; it < 8; ++it) { const int key = it * 32 + (tid >> 4), tl = key >> 6, kr = key & 63;
      *(bf16x8*)(K_lds + tl * 16384 + KSWZ(kr, sc * 2)) = kv[it]; *(bf16x8*)(V_lds + tl * 16384 + v_st(kr, sc)) = vv[it]; }
#if ATT_PROBE == 1
    __syncthreads();
#endif
  }
  __syncthreads();
  for (int g = wid; g < ngroups; g += NW) {
    const bool own = g < no;
    const int myrow = (own ? g : g - no) * 32 + r32;
    const int q = (int)(e_cur & 0xFFFFu), slot = (int)(e_cur >> 16); const bool valid = own || myrow < nrows;
    bf16x8 qr[8];
#pragma unroll
    for (int d0 = 0; d0 < 8; ++d0) qr[d0] = qrn[d0];
    e_cur = e_nxt;
    if (g + NW < ngroups) {
      const bf16_t* Qw = proj + ix_mq(h, (int)(e_cur & 0xFFFFu)) + hi * 8;
#pragma unroll
      for (int d0 = 0; d0 < 8; ++d0) qrn[d0] = *reinterpret_cast<const bf16x8*>(Qw + d0 * 16);
      if (g + 2 * NW < ngroups) e_nxt = ENTRY(g + 2 * NW); }
    float m_reg = -1e30f, l_reg = 0.f; f32x16 o[4] = {};
    const int ntile = own ? ((g * 32 + 31) >> 6) + 1 : 4;
#if ATT_PROBE == 2
#pragma unroll 1
    for (int pr_ = 0; pr_ < 2; ++pr_) {
    if (pr_ == 1) { m_reg = -1e30f; l_reg = 0.f; o[0] = f32x16{}; o[1] = f32x16{}; o[2] = f32x16{}; o[3] = f32x16{}; }
#endif
#pragma unroll 1
    for (int tl = 0; tl < ntile; ++tl) {
      f32x16 p0, p1; float mn, alpha; bf16x8 pa0, pa1, pa2, pa3;
      qkt(p0, p1, K_lds + tl * 16384, qr, r32, hi);
      if (own) mask_tile(p0, p1, tl, myrow, hi);
      partialSM(p0, p1, m_reg, mn, alpha);
      if (__any(alpha < 1.f)) { if (hi == 0) al_l[r32] = alpha; asm volatile("s_waitcnt lgkmcnt(0)" ::: "memory");
#pragma unroll
        for (int d = 0; d < 4; ++d)
#pragma unroll
          for (int r = 0; r < 16; ++r) o[d][r] *= al_l[crow(r, hi)]; }
      finishSM(p0, p1, alpha, l_reg, pa0, pa1, pa2, pa3); SBAR();
      pv_d0(o, vb0 + tl * 16384, pa0, pa1, pa2, pa3);
    }
#if ATT_PROBE == 2
    }
#endif
    const int porow = valid ? ((q * 8 + h) * 4 + slot) : -1;
    if (hi == 0 && valid) { PML[(size_t)porow * 2] = m_reg * CEXP; PML[(size_t)porow * 2 + 1] = l_reg; }
    const int pr = __shfl(porow, lane >> 1);
#if PO8
    if (hi == 0) al_l[r32] = __builtin_amdgcn_rcpf(l_reg) * (float)(1 << PO8_SH);
    asm volatile("s_waitcnt lgkmcnt(0)" ::: "memory");
    float rl_[16];
#pragma unroll
    for (int r = 0; r < 16; ++r) rl_[r] = al_l[crow(r, hi)];
    unsigned char* st8 = (unsigned char*)st;
#pragma unroll
    for (int d0 = 0; d0 < 4; ++d0) {
#pragma unroll
      for (int r = 0; r < 16; r += 2) { const unsigned w = (unsigned)__builtin_amdgcn_cvt_pk_fp8_f32(o[d0][r] * rl_[r], o[d0][r + 1] * rl_[r + 1], 0, false);
        st8[crow(r, hi) * 32 + r32] = (unsigned char)w; st8[crow(r + 1, hi) * 32 + r32] = (unsigned char)(w >> 8); }
      asm volatile("s_waitcnt lgkmcnt(0)" ::: "memory");
      const u32x4 a = *(const u32x4*)(st8 + (lane >> 1) * 32 + (lane & 1) * 16);
      if (pr >= 0) *(u32x4*)((unsigned char*)PO + (size_t)pr * 128 + 32 * d0 + (lane & 1) * 16) = a;
      asm volatile("s_waitcnt lgkmcnt(0)" ::: "memory");
    }
#else
#pragma unroll
    for (int d0 = 0; d0 < 4; ++d0) {
#pragma unroll
      for (int r = 0; r < 16; ++r) st[crow(r, hi) * 32 + r32] = (unsigned short)(cvtpk(o[d0][r], o[d0][r]) & 0xFFFFu);
      asm volatile("s_waitcnt lgkmcnt(0)" ::: "memory");
      const u32x4 a = *(const u32x4*)(st + (lane >> 1) * 32 + (lane & 1) * 16), b = *(const u32x4*)(st + (lane >> 1) * 32 + (lane & 1) * 16 + 8);
      if (pr >= 0) { *(u32x4*)(PO + (size_t)pr * 128 + 32 * d0 + (lane & 1) * 16) = a; *(u32x4*)(PO + (size_t)pr * 128 + 32 * d0 + (lane & 1) * 16 + 8) = b; }
      asm volatile("s_waitcnt lgkmcnt(0)" ::: "memory");
    }
#endif
  }
  __syncthreads();
#undef ENTRY
}
#undef KSWZ
#undef SBAR
}

static __device__ void moba_combine(const Params& p) {
    const bf16_t* PO = (const bf16_t*)(p.ws + WS_PO); const float* PML = (const float*)(p.ws + WS_PML); bf16_t* mix = (bf16_t*)(p.ws + WS_MIX);
    const int stride = (int)gridDim.x * NTHR;
    for (int base = blockIdx.x * NTHR + opq_tid(); base < T * 8 * 16; base += 4 * stride) {
        u32x4 po[4][4]; f32x2 ml[4][4];
#pragma unroll
        for (int u = 0; u < 4; ++u) { const int idx = base + u * stride, ch = idx & 15, qh = idx >> 4, qb = qh >> 11, nv = qb < 3 ? qb : 3;
#pragma unroll
            for (int k = 0; k < 4; ++k) { const bool ok = (k == 3) || (k < nv);
                ml[u][k] = (f32x2){-3.0e38f, 0.f}; po[u][k] = (u32x4){0u, 0u, 0u, 0u};
#if PO8
                if (ok) { ml[u][k] = *(const f32x2*)(PML + ((size_t)qh * 4 + k) * 2); const u32x2 t8 = *(const u32x2*)((const unsigned char*)PO + ((size_t)qh * 4 + k) * 128 + ch * 8); po[u][k].x = t8.x; po[u][k].y = t8.y; } } }
#else
                if (ok) { ml[u][k] = *(const f32x2*)(PML + ((size_t)qh * 4 + k) * 2); po[u][k] = *(const u32x4*)(PO + ((size_t)qh * 4 + k) * 128 + ch * 8); } } }
#endif
#pragma unroll
        for (int u = 0; u < 4; ++u) { const int idx = base + u * stride, ch = idx & 15, qh = idx >> 4, q = qh >> 3, h = qh & 7;
            float M = -3.0e38f;
#pragma unroll
            for (int k = 0; k < 4; ++k) M = fmaxf(M, ml[u][k][0]);
            float o[8], L = 0.f;
#pragma unroll
            for (int i = 0; i < 8; ++i) o[i] = 0.f;
#pragma unroll
#if PO8
            for (int k = 0; k < 4; ++k) { const float wl = __builtin_amdgcn_exp2f(ml[u][k][0] - M) * ml[u][k][1]; L += wl; const float w = wl * (1.0f / (float)(1 << PO8_SH)); float f[8];
                const f32x2 f01 = __builtin_amdgcn_cvt_pk_f32_fp8((int)po[u][k].x, false), f23 = __builtin_amdgcn_cvt_pk_f32_fp8((int)po[u][k].x, true), f45 = __builtin_amdgcn_cvt_pk_f32_fp8((int)po[u][k].y, false), f67 = __builtin_amdgcn_cvt_pk_f32_fp8((int)po[u][k].y, true);
                f[0] = f01[0]; f[1] = f01[1]; f[2] = f23[0]; f[3] = f23[1]; f[4] = f45[0]; f[5] = f45[1]; f[6] = f67[0]; f[7] = f67[1];
#pragma unroll
                for (int i = 0; i < 8; ++i) o[i] += w * f[i]; }
#else
            for (int k = 0; k < 4; ++k) { const float w = __builtin_amdgcn_exp2f(ml[u][k][0] - M); L += w * ml[u][k][1]; float f[8]; unpack8(po[u][k], f);
#pragma unroll
                for (int i = 0; i < 8; ++i) o[i] += w * f[i]; }
#endif
            const float rl = 1.0f / L;
#pragma unroll
            for (int i = 0; i < 8; ++i) o[i] *= rl;
#if OUT8
            { u32x2 w8; w8.x = pk4_fp8(o[0] * (float)(1 << MIX8_SH), o[1] * (float)(1 << MIX8_SH), o[2] * (float)(1 << MIX8_SH), o[3] * (float)(1 << MIX8_SH));
              w8.y = pk4_fp8(o[4] * (float)(1 << MIX8_SH), o[5] * (float)(1 << MIX8_SH), o[6] * (float)(1 << MIX8_SH), o[7] * (float)(1 << MIX8_SH));
              *(u32x2*)((unsigned char*)mix + (size_t)q * DM + 1024 + h * 128 + ch * 8) = w8; } }
#else
            *(u32x4*)(mix + (size_t)q * DM + 1024 + h * 128 + ch * 8) = pack8(o); }
#endif
    }
}
#ifndef DBL_MASK
#define DBL_MASK 0
#endif
#define REP(k) for (int rep_ = 0; rep_ < (((DBL_MASK >> (k)) & 1) ? 2 : 1); ++rep_)
#ifndef NCV
#define NCV 0
#endif
#ifndef PROBE_MASK
#define PROBE_MASK 0
#endif
#ifndef PHMASK
#define PHMASK 0xFFFF
#endif
enum { PH_CVT = 0, PH_INPROJ, PH_MIXA, PH_MIXB, PH_MIXC, PH_ATT, PH_COMB, PH_OUTPROJ, PH_LN1, PH_PERM, PH_MOE1, PH_MOE2, PH_LN2, NPH };
constexpr int NSLOT = 2 * NPH;
#ifndef MK_DEBUG
#define MK_DEBUG 0
#endif
#if MK_DEBUG
#include "part_chk.inc"
#endif

__device__ __forceinline__ Params opq_params(const Params& p) {
#if !defined(__HIP_DEVICE_COMPILE__)
    return p;
#else
    const __attribute__((address_space(4))) Params* kp = (const __attribute__((address_space(4))) Params*)__builtin_amdgcn_kernarg_segment_ptr();
    asm volatile("" : "+s"(kp));
    return *kp;
#endif
}
#ifndef SUBREP_MASK
#define SUBREP_MASK 0
#endif
#define SUBREP(k) (((SUBREP_MASK >> (k)) & 1) ? 2 : 1)
#ifndef CVT_REPS
#define CVT_REPS 1
#endif
__global__ void __launch_bounds__(NTHR, 2) mk_fwd(Params p) {
    extern __shared__ __attribute__((aligned(16))) unsigned char lds[];
    const int tid = threadIdx.x;
    for (int u = tid; u < (LDS_BYTES - LDS_SCR) / 4; u += NTHR) ((unsigned*)(lds + LDS_SCR))[u] = 0u;
    __syncthreads();
    unsigned* ctl = (unsigned*)(p.ws + WS_CTL);
    XcdBarrier bar; bar.bar = ctl + CW_BAR; bar.x = 0; bar.st = (volatile LAS unsigned*)(lds + LDS_SCR + 32);
    constexpr int STEP = 2;
    if (p.g_hi - p.g_lo > STEP) bar = xcd_barrier_post(ctl + CW_BAR, (volatile LAS unsigned*)(lds + LDS_SCR + 32));
    if (p.g_hi - p.g_lo > STEP) xcd_barrier_census(bar);
    const int G = (int)gridDim.x, bx = (int)blockIdx.x;
    PG8_LAS unsigned char* lds3 = (PG8_LAS unsigned char*)lds;

#if PROBE_MASK
    unsigned long long tacc = 0ull, tprev = __builtin_amdgcn_s_memrealtime();
#endif
    for (int layer = -1; layer < NLAYER; ++layer) {
        const int s0 = (layer + 1) * NSLOT;
#define IN(k) (((PHMASK >> (k)) & 1) && (layer >= 0 || (k) <= PH_INPROJ) && p.g_lo <= s0 + 2 * (k) && s0 + 2 * (k) < p.g_hi)
#if PROBE_MASK
#define SEAM(k) do { xcd_barrier(bar); if (bx == 0 && tid == 0) { const unsigned long long now = __builtin_amdgcn_s_memrealtime(); if ((PROBE_MASK >> (k)) & 1) tacc += now - tprev; tprev = now; } } while (0)
#else
#ifndef BAR2
#define BAR2 0
#endif
#define SEAM(k) do { if (s0 + 2 * (k) + STEP < p.g_hi) { xcd_barrier(bar); if ((BAR2 >> (k)) & 1) xcd_barrier(bar); } } while (0)
#endif
        if (IN(PH_CVT)) { if (layer < 0) { const Params q = opq_params(p); phase_rope(q); phase_rows<0>(q, 0, lds); } }
        if (IN(PH_INPROJ)) REP(PH_INPROJ) { const Params q = opq_params(p);
#pragma unroll 1
            for (int stp = 0; stp < 2; ++stp) {
                const bool cv = (layer < 0) ? (stp == 0) : (((bx & 1) != 0) == (stp == 0));
                if (cv) { if (rep_ == 0) {
_Pragma("unroll 1")
                    for (int r2_ = 0; r2_ < CVT_REPS; ++r2_) phase_cvt<false, 7>(q, layer < 0 ? 0 : layer, layer < 0 ? 0 : 256, layer < 0 ? 256 : 1024, bx, G, lds); } }
                else if (layer >= 0) {
                    pg8::Gemm g{(const bf16_t*)(q.ws + WS_HBQ), (const bf16_t*)(q.ws + ((layer & 1) ? WS_WIN2 : WS_WIN)), T, NPROJ, DM / 2, 127 - WIN8_SH, 127 - X8_SH}; pg8::StaticOrder S; S.init(T, NPROJ, G, bx);
                    pg8::EpiProj E{(bf16_t*)(q.ws + WS_PROJ), (const float*)(q.ws + WS_ROPE), (const float*)(q.ws + WS_ROPE) + (size_t)T * 64};
                    pg8::gemm_phase<pg8::EpiProj, pg8::StaticOrder, true, true, true>(lds3, g, S, E);
                }
            }
            SEAM(PH_INPROJ); }
        if (IN(PH_MIXA)) REP(PH_MIXA) { const Params q = opq_params(p);
            for (int u = bx; u < 768; u += G) { if (u < 256) { _Pragma("unroll 1") for (int r_ = 0; r_ < SUBREP(0); ++r_) gla_super_unit<false>(q, layer, u >> 2, u & 3, lds); } else { _Pragma("unroll 1") for (int r_ = 0; r_ < SUBREP(1); ++r_) moba_kmean_unit(q, (u - 256) >> 6, (u - 256) & 63, lds); } }
            SEAM(PH_MIXA); }
        if (IN(PH_MIXB)) REP(PH_MIXB) { const Params q = opq_params(p);
            { _Pragma("unroll 1") for (int r_ = 0; r_ < SUBREP(2); ++r_) gla_scan(q, bx, G, lds); }
            { int kk = 0; for (int u = bx; u < 512; u += G, ++kk) { const int q0 = u & 63; _Pragma("unroll 1") for (int r_ = 0; r_ < SUBREP(3); ++r_) moba_gate_unit(q, u >> 6, (kk & 1) ? 63 - q0 : q0, lds); } }
            SEAM(PH_MIXB); }
        if (IN(PH_MIXC)) REP(PH_MIXC) { const Params q = opq_params(p);
            for (int u = bx; u < 768; u += G) { if (u < 256) { _Pragma("unroll 1") for (int r_ = 0; r_ < SUBREP(4); ++r_) gla_super_unit<true>(q, layer, u >> 2, u & 3, lds); } else if (rep_ == 0) { const int v = u - 256, j0 = v & 63; moba_list_unit(q, layer, v >> 6, ((v / G) & 1) ? 63 - j0 : j0, lds); } }
            SEAM(PH_MIXC); }
        if (IN(PH_ATT)) REP(PH_ATT) { const Params q = opq_params(p);
            const int nit = __builtin_amdgcn_readfirstlane((int)ldu(ctl + CW_NIT + layer * 64));
            const int nfront = __builtin_amdgcn_readfirstlane((int)ldu(ctl + CW_NIT + layer * 64 + 1));
            const unsigned* items = (const unsigned*)(q.ws + WS_ITEMS) + layer * 4096 * 4;
            unsigned* qhead = ctl + CW_NIT + layer * 64 + 16 + rep_;
            volatile LAS unsigned* qslot = (volatile LAS unsigned*)(lds + LDS_SCR + 64);
            const int qt = opq_tid();
            if (qt == 0) { const unsigned f = atomicAdd(qhead, 1u); qslot[0] = f;
                if ((int)f < nit) { const unsigned sl = (int)f < nfront ? f : 4095u - (f - (unsigned)nfront); qslot[1] = ldu(items + sl * 4); qslot[2] = ldu(items + sl * 4 + 1); qslot[3] = ldu(items + sl * 4 + 2); qslot[4] = ldu(items + sl * 4 + 3); } }
            __syncthreads();
            int it = __builtin_amdgcn_readfirstlane((int)qslot[0]);
            while (it < nit) {
                const int h = __builtin_amdgcn_readfirstlane((int)qslot[1]), j = __builtin_amdgcn_readfirstlane((int)qslot[2]), c = __builtin_amdgcn_readfirstlane((int)qslot[3]), n = __builtin_amdgcn_readfirstlane((int)qslot[4]);
                unsigned nxt = 0u, dsc[4] = {0u, 0u, 0u, 0u};
                if (qt == 0) nxt = atomicAdd(qhead, 1u);
                const unsigned* list = (const unsigned*)(q.ws + WS_LIST) + (size_t)h * LISTH + list_off(j) + c * ATT_QMAX;
                const int rem = n - c * ATT_QMAX, nrows = rem < 0 ? 0 : (rem < ATT_QMAX ? rem : ATT_QMAX);
                __syncthreads();
                att::moba_item2((bf16_t*)(q.ws + WS_PROJ), h, j, list, nrows, c == 0 ? 256 : 0, (bf16_t*)(q.ws + WS_PO), (float*)(q.ws + WS_PML), (char*)lds, items, nit, nfront, nxt, dsc, qt == 0);
                if (qt == 0) { qslot[0] = nxt; qslot[1] = dsc[0]; qslot[2] = dsc[1]; qslot[3] = dsc[2]; qslot[4] = dsc[3]; }
                __syncthreads();
                it = __builtin_amdgcn_readfirstlane((int)qslot[0]);
            }
            SEAM(PH_ATT); }
        if (IN(PH_COMB)) REP(PH_COMB) { const Params q = opq_params(p); moba_combine(q); SEAM(PH_COMB); }
        if (IN(PH_OUTPROJ)) REP(PH_OUTPROJ) { const Params q = opq_params(p);
#if OUT8
            pg8::Gemm g{(const bf16_t*)(q.ws + WS_MIX), (const bf16_t*)(q.ws + WS_WO), T, DM, DM / 2, 127 - WO8_SH, 127 - MIX8_SH}; pg8::StaticOrder S; S.init(T, DM, G, bx);
#else
            pg8::Gemm g{(const bf16_t*)(q.ws + WS_MIX), (const bf16_t*)(q.ws + WS_WO), T, DM, DM}; pg8::StaticOrder S; S.init(T, DM, G, bx);
#endif
            pg8::EpiOut E{layer == 0 ? q.in[0] : nullptr, (const bf16_t*)(q.ws + WS_HB), (bf16_t*)(q.ws + WS_PRE), DN_ALPHA};
            pg8::gemm_phase<pg8::EpiOut, pg8::StaticOrder, true, true, OUT8 != 0>(lds3, g, S, E);
            SEAM(PH_OUTPROJ); }
#ifndef LNPROBE
#define LNPROBE 0
#endif
        if (IN(PH_LN1)) { const Params q = opq_params(p); if (LNPROBE & 1) { phase_rows<1, true>(q, layer, lds); SEAM(PH_LN1); } phase_rows<1>(q, layer, lds); SEAM(PH_LN1); }
        if (IN(PH_MOE1)) REP(PH_MOE1) { const Params q = opq_params(p);
            int* sbm = (int*)(lds + LDS_SCR + 128);
            moe_bases(ctl + CW_CNT + layer * 64, sbm);
            const int np = __builtin_amdgcn_readfirstlane(sbm[16]) >> 8;
            pg8::Gemm g{(const bf16_t*)(q.ws + WS_HB8), (const bf16_t*)(q.ws + WS_WGU), np * 256, 2048, DM / 2, 127 - WGU8_SH, 127 - X8_SH}; pg8::MoeOrder S; S.init(np * 256, 2048, G, bx); S.sb = sbm; S.idx = (const unsigned*)(q.ws + WS_IDX); S.rowbytes = DM;
            pg8::EpiGU E{q.ws + WS_HS};
            pg8::gemm_phase<pg8::EpiGU, pg8::MoeOrder, true, true, true, true>(lds3, g, S, E);
            if (rep_ == 0) phase_cvt<true, 8>(q, layer, 1280, 512, 0, 1, lds, ctl + CW_CVQ + layer * 64);
            SEAM(PH_MOE1); }
        if (IN(PH_MOE2)) REP(PH_MOE2) { const Params q = opq_params(p);
            int* sbm = (int*)(lds + LDS_SCR + 128);
            moe_bases(ctl + CW_CNT + layer * 64, sbm);
            const int np = __builtin_amdgcn_readfirstlane(sbm[16]) >> 8;
            pg8::Gemm g{(const bf16_t*)(q.ws + WS_HS), (const bf16_t*)(q.ws + WS_WD), np * 256, 2048, DEXP / 2, 127 - WD8_SH, 127 - H8_SH}; pg8::MoeOrder S; S.init(np * 256, 2048, G, bx); S.sb = sbm; S.idx = (const unsigned*)(q.ws + WS_IDX); S.rowbytes = DEXP;
            pg8::EpiY E{(bf16_t*)(q.ws + WS_YS)};
            pg8::gemm_phase<pg8::EpiY, pg8::MoeOrder, true, true, true>(lds3, g, S, E);
            if (rep_ == 0 && layer + 1 < NLAYER) phase_cvt<true, 3>(q, layer + 1, 0, 256, 0, 1, lds, ctl + CW_CVQ + layer * 64 + 16);
            SEAM(PH_MOE2); }
        if (IN(PH_LN2)) { const Params q = opq_params(p); if (LNPROBE & 2) { phase_rows<2, true>(q, layer, lds); xcd_barrier(bar); } phase_rows<2>(q, layer, lds); SEAM(PH_LN2); }
#undef IN
#undef SEAM
    }
#if PROBE_MASK
    if (bx == 0 && tid == 0) __hip_atomic_store(ctl + CW_DBG, (unsigned)tacc, __ATOMIC_RELAXED, __HIP_MEMORY_SCOPE_AGENT);
    xcd_barrier(bar);
    { const float sc = 1.0f + (float)ldu(ctl + CW_DBG) * (1.0f / 40000.0f);
      for (size_t i = (size_t)bx * NTHR + tid; i < (size_t)T * DM / 4; i += (size_t)G * NTHR) { f32x4 v = ((f32x4*)p.out)[i]; ((f32x4*)p.out)[i] = v * sc; } }
#endif
}

#if MK_DEBUG
__global__ void __launch_bounds__(NTHR, 2) mk_chk(Params p, int layer, int k) { if (k >= 0) chk_phase(p, layer, k); else chk_final(p); }
#endif
#ifndef MK_ONE_LAUNCH
#define MK_ONE_LAUNCH 1
#endif
extern "C" void kernel_launch(void* const* d_in, const int* in_sizes, int n_in, void* d_out, int out_size, void* d_ws, size_t ws_size, hipStream_t stream) {
    static int grid = 0;
    if (grid == 0) {
        if (n_in != 16 || in_sizes[0] != T * DM || out_size != T * DM || ws_size < WS_END) {
            fprintf(stderr, "kernel_launch: unexpected problem: n_in %d in0 %d out %d ws %zu (need >= %zu); nothing launched\n", n_in, n_in > 0 ? in_sizes[0] : -1, out_size, ws_size, (size_t)WS_END); grid = -1; return; }
        int dev = 0, cus = 0, per_cu = 0;
        if (hipGetDevice(&dev) != hipSuccess || hipDeviceGetAttribute(&cus, hipDeviceAttributeMultiprocessorCount, dev) != hipSuccess) { grid = -1; return; }
        if (hipFuncSetAttribute((const void*)mk_fwd, hipFuncAttributeMaxDynamicSharedMemorySize, LDS_BYTES) != hipSuccess) { fprintf(stderr, "kernel_launch: hipFuncSetAttribute failed\n"); grid = -1; return; }
        if (hipOccupancyMaxActiveBlocksPerMultiprocessor(&per_cu, (const void*)mk_fwd, NTHR, LDS_BYTES) != hipSuccess || per_cu < 1)
            fprintf(stderr, "kernel_launch: note: occupancy query reports %d blocks per CU\n", per_cu);
        (void)hipGetLastError();
        grid = cus;
        if (grid != 256) fprintf(stderr, "kernel_launch: note: %d CUs (row phases assume the grid divides 2048 row groups)\n", grid);
        if (2048 % grid != 0) grid = 256;
    }
    if (grid < 0) return;
    if (hipMemsetAsync((char*)d_ws + WS_CTL, 0, CTL_BYTES, stream) != hipSuccess) return;
    Params p{};
    for (int i = 0; i < 16; ++i) p.in[i] = (const float*)d_in[i];
    p.out = (float*)d_out; p.ws = (unsigned char*)d_ws;
#if MK_ONE_LAUNCH
    p.g_lo = 0; p.g_hi = (NLAYER + 1) * NSLOT;
    hipLaunchKernelGGL(mk_fwd, dim3(grid), dim3(NTHR), LDS_BYTES, stream, p);
#else
    for (int s = 0; s < (NLAYER + 1) * NSLOT; s += 2) { p.g_lo = s; p.g_hi = s + 1; hipLaunchKernelGGL(mk_fwd, dim3(grid), dim3(NTHR), LDS_BYTES, stream, p);
#if MK_DEBUG
        if (s >= NSLOT) hipLaunchKernelGGL(mk_chk, dim3(8), dim3(NTHR), 0, stream, p, s / NSLOT - 1, (s % NSLOT) / 2);
#endif
    }
#if MK_DEBUG
    hipLaunchKernelGGL(mk_chk, dim3(grid), dim3(NTHR), 0, stream, p, 0, -1);
#endif
#endif
    const hipError_t le = hipPeekAtLastError();
    if (le != hipSuccess) fprintf(stderr, "kernel_launch: launch failed: %s\n", hipGetErrorName(le));
}
```

```cpp
#define MK_DEBUG 0
#define MK_ONE_LAUNCH 1
#define RECOMP 0
#include <hip/hip_runtime.h>
#include <cstdio>
#include <cstdint>
__device__ __forceinline__ int opq_tid() { int t = (int)threadIdx.x; asm volatile("" : "+v"(t)); return t; }
#ifndef EPI_PROBE
#define EPI_PROBE 0
#endif
namespace pg8 {
#define PG8_LAS __attribute__((address_space(3)))
typedef unsigned short bf16_t;
typedef short bf16x8 __attribute__((ext_vector_type(8)));
typedef float f32x4 __attribute__((ext_vector_type(4)));
typedef unsigned u32x4 __attribute__((ext_vector_type(4)));
constexpr int BM = 256, BK = 64, HALF = 128, HTB = HALF * BK * 2  , STAGE_BYTES = 8 * HTB, NXCD = 8, WGM = 4;

__host__ __device__ __forceinline__ int lds_byte(int r, int c) { const int st = (r >> 4) * 2 + (c >> 5), rr = r & 15, cc = c & 31, ob = rr * 64 + cc * 2; return st * 1024 + (ob ^ (((ob >> 9) & 1) << 5)); }
__host__ __device__ __forceinline__ void stage_rc(int b, int& R, int& C) { const int st = b / 1024, sb = b % 1024, swz = sb ^ (((sb >> 9) & 1) << 5); R = (st >> 1) * 16 + swz / 64; C = (st & 1) * 32 + (swz % 64) / 2; }
__host__ __device__ __forceinline__ int perm32(int rho) { const int n = rho >> 4, i = rho & 15; return 8 * (i >> 2) + 4 * n + (i & 3); }

struct Unit { int pm, pn; };
struct Gemm { const bf16_t* A; const bf16_t* Bt; int M, N, K; int sa, sb; };

struct StaticOrder {
    int nM, nN, nwg, G, c, wgm;
    __host__ __device__ void init(int M, int N, int G_, int c_, int wgm_ = WGM) { nM = M / BM; nN = N / BM; nwg = nM * nN; G = G_; c = c_; wgm = wgm_; }
    __host__ __device__ bool next(int i, Unit& u) const {
        const long L = (long)i * G + c; if (L >= nwg) return false;
        int wgid = (int)L; { const int q = nwg / NXCD, r = nwg % NXCD, xcd = wgid % NXCD, off = wgid / NXCD; wgid = (xcd < r ? xcd * (q + 1) : r * (q + 1) + (xcd - r) * q) + off; }
        const int nig = wgm * nN, gid = wgid / nig, fm = gid * wgm, gsz = (nM - fm) < wgm ? (nM - fm) : wgm;
        u.pm = fm + ((wgid % nig) % gsz); u.pn = (wgid % nig) / gsz; return true;
    }
    __device__ __forceinline__ void a_ready(const Unit&) const {}
    __device__ __forceinline__ void done(const Unit&) const {}
    __device__ __forceinline__ unsigned arow(const Unit&, int) const { return 0u; }
};
__device__ __forceinline__ unsigned cvt_pk_bf16(float lo, float hi) { unsigned r; asm volatile("v_cvt_pk_bf16_f32 %0, %1, %2" : "=v"(r) : "v"(lo), "v"(hi)); return r; }

typedef int v8i32 __attribute__((ext_vector_type(8)));
typedef int v4i32 __attribute__((ext_vector_type(4)));
__device__ __forceinline__ v8i32 cat8(bf16x8 lo, bf16x8 hi) { const v4i32 a = __builtin_bit_cast(v4i32, lo), b = __builtin_bit_cast(v4i32, hi); return __builtin_shufflevector(a, b, 0, 1, 2, 3, 4, 5, 6, 7); }
template <class Epi, class Sched, bool ALIGN_EPI = false, bool SP2 = false, bool FP8 = false, bool GATHER = false>
__device__ __forceinline__ void gemm_phase(PG8_LAS unsigned char* lds, const Gemm g, const Sched& S, const Epi& E) {
    const int tid = opq_tid(), wid = __builtin_amdgcn_readfirstlane(tid >> 6), lane = tid & 63, wr = wid >> 2, wc = wid & 3, fr = lane & 15, fq = lane >> 4;
    int Kq = g.K; asm volatile("" : "+s"(Kq));
    const int K = Kq, nt = K / BK;
    unsigned voffA[2], voffB[2];
#pragma unroll
    for (int i = 0; i < 2; ++i) { int R, C; stage_rc(tid * 16 + i * 8192, R, C); const int Rb = Epi::PERM ? ((R & ~31) + perm32(R & 31)) : R;
        voffA[i] = (unsigned)(R * K + C) * 2u; voffB[i] = (unsigned)(Rb * K + C) * 2u; }
    unsigned va[2][2] = {{0u, 0u}, {0u, 0u}};
    PG8_LAS unsigned* vnl = (PG8_LAS unsigned*)(lds + STAGE_BYTES + 8192) + tid * 4;
#define PG8_GCALC(v, u) do { _Pragma("unroll") for (int _h = 0; _h < 2; ++_h) _Pragma("unroll") for (int _i = 0; _i < 2; ++_i) { int _R, _C; stage_rc(tid * 16 + _i * 8192, _R, _C); (v)[_h][_i] = S.arow((u), _h * HALF + _R) + (unsigned)_C * 2u; } } while (0)
#define PG8_STAGE_A(bufoff, gbase, h, v) do { if constexpr (GATHER) { _Pragma("unroll") for (int _i = 0; _i < 2; ++_i) \
        __builtin_amdgcn_global_load_lds((const unsigned*)((const char*)(gbase) + (v)[h][_i]), (PG8_LAS unsigned*)(lds + (bufoff) + ldsw + _i * 8192), 16, 0, 0); } \
        else { PG8_STAGE(bufoff, (gbase) + (h) * hstep, voffA); } } while (0)
    const size_t kstep = (size_t)(BK * 2);
    const size_t hstep = (size_t)HALF * K * 2;
    const size_t tstep = 2 * hstep;
    const unsigned ldsw = (unsigned)wid * 1024u;
    const int aoff = lds_byte(wr * 64 + fr, fq * 8), boff = lds_byte(wc * 32 + fr, fq * 8);
#define PG8_SA(b, h) (((b) * 2 + (h)) * HTB)
#define PG8_SB(b, h) ((4 + (b) * 2 + (h)) * HTB)
#define PG8_STAGE(bufoff, gbase, voff) do { _Pragma("unroll") for (int _i = 0; _i < 2; ++_i) \
        __builtin_amdgcn_global_load_lds((const unsigned*)((const char*)(gbase) + (voff)[_i]), (PG8_LAS unsigned*)(lds + (bufoff) + ldsw + _i * 8192), 16, 0, 0); } while (0)
#define PG8_LDA(dst, b, h) do { _Pragma("unroll") for (int m = 0; m < 4; ++m) _Pragma("unroll") for (int k = 0; k < 2; ++k) dst[m][k] = *(const PG8_LAS bf16x8*)(lds + PG8_SA(b, h) + aoff + m * 2048 + k * 1024); } while (0)
#define PG8_LDB(dst, b, h) do { _Pragma("unroll") for (int n = 0; n < 2; ++n) _Pragma("unroll") for (int k = 0; k < 2; ++k) dst[n][k] = *(const PG8_LAS bf16x8*)(lds + PG8_SB(b, h) + boff + n * 2048 + k * 1024); } while (0)
#define PG8_MMA(ai, bj, At, Bt) do { __builtin_amdgcn_s_setprio(1); _Pragma("unroll") for (int m = 0; m < 4; ++m) _Pragma("unroll") for (int n = 0; n < 2; ++n) { \
        if constexpr (FP8) { const v8i32 wq = cat8(Bt[n][0], Bt[n][1]), aq = cat8(At[m][0], At[m][1]); \
            asm volatile("s_nop 1\n\tv_mfma_scale_f32_16x16x128_f8f6f4 %0, %1, %2, %0, %3, %4 op_sel_hi:[0,0,0]" : "+v"(acc[ai][bj][m][n]) : "v"(wq), "v"(aq), "v"(g.sa), "v"(g.sb)); } \
        else { _Pragma("unroll") for (int k = 0; k < 2; ++k) acc[ai][bj][m][n] = __builtin_amdgcn_mfma_f32_16x16x32_bf16(Bt[n][k], At[m][k], acc[ai][bj][m][n], 0, 0, 0); } } \
        __builtin_amdgcn_s_setprio(0); } while (0)
#define PG8_WAIT_V(n) asm volatile("s_waitcnt vmcnt(" #n ")" ::: "memory")
#define PG8_WAIT_L(n) asm volatile("s_waitcnt lgkmcnt(" #n ")" ::: "memory")
#define PG8_BAR __builtin_amdgcn_s_barrier()
#define PG8_SCHED __builtin_amdgcn_sched_barrier(0)
    Unit cur, nxt; int ui = 0;
    if (!S.next(0, cur)) return;
    f32x4 acc[2][2][4][2];
#pragma unroll
    for (int a = 0; a < 2; ++a)
#pragma unroll
        for (int b = 0; b < 2; ++b)
#pragma unroll
            for (int m = 0; m < 4; ++m)
#pragma unroll
                for (int n = 0; n < 2; ++n) acc[a][b][m][n] = (f32x4){0.f, 0.f, 0.f, 0.f};
    bf16x8 At[4][2], B0[2][2], B1[2][2];
    const char* cA = (const char*)g.A + (GATHER ? (size_t)0 : (size_t)cur.pm * tstep); const char* cB = (const char*)g.Bt + (size_t)cur.pn * tstep;
    if constexpr (GATHER) PG8_GCALC(va, cur);
    S.a_ready(cur);
    if constexpr (SP2) {
        PG8_STAGE(PG8_SB(0, 0), cB, voffB); PG8_STAGE(PG8_SB(0, 1), cB + hstep, voffB); PG8_STAGE_A(PG8_SA(0, 0), cA, 0, va); PG8_STAGE_A(PG8_SA(0, 1), cA, 1, va);
        if (wr == 1) PG8_BAR;
        PG8_WAIT_V(2); PG8_BAR;
        PG8_STAGE(PG8_SB(1, 0), cB + kstep, voffB); PG8_STAGE_A(PG8_SA(1, 0), cA + kstep, 0, va); PG8_STAGE(PG8_SB(1, 1), cB + hstep + kstep, voffB);
        PG8_WAIT_V(6); PG8_BAR;
    } else {
        PG8_STAGE(PG8_SB(0, 0), cB, voffB); PG8_STAGE(PG8_SA(0, 0), cA, voffA); PG8_STAGE(PG8_SB(0, 1), cB + hstep, voffB); PG8_STAGE(PG8_SA(0, 1), cA + hstep, voffA);
        if (wr == 1) PG8_BAR;
        PG8_WAIT_V(4); PG8_BAR;
        PG8_STAGE(PG8_SB(1, 0), cB + kstep, voffB); PG8_STAGE(PG8_SA(1, 0), cA + kstep, voffA); PG8_STAGE(PG8_SB(1, 1), cB + hstep + kstep, voffB);
        PG8_WAIT_V(6); PG8_BAR;
    }
    for (;;) {
        const bool has_next = S.next(ui + 1, nxt);
        const char* nA = (has_next && !GATHER) ? (const char*)g.A + (size_t)nxt.pm * tstep : cA; const char* nB = has_next ? (const char*)g.Bt + (size_t)nxt.pn * tstep : cB;
        if constexpr (GATHER) { unsigned vn[2][2]; if (has_next) PG8_GCALC(vn, nxt); else { _Pragma("unroll") for (int _h = 0; _h < 2; ++_h) _Pragma("unroll") for (int _i = 0; _i < 2; ++_i) vn[_h][_i] = va[_h][_i]; }
            vnl[0] = vn[0][0]; vnl[1] = vn[0][1]; vnl[2] = vn[1][0]; vnl[3] = vn[1][1]; }
        for (int t = 0; t < nt; t += 2) {
            const bool last = (t == nt - 2);
            const char* a1 = cA + (size_t)(t + 1) * kstep;
            const char* a2 = last ? nA : cA + (size_t)(t + 2) * kstep; const char* b2 = last ? nB : cB + (size_t)(t + 2) * kstep;
            const char* a3 = a2 + kstep; const char* b3 = b2 + kstep;
            if (last && has_next) S.a_ready(nxt);
            unsigned v2[2][2];
            if constexpr (GATHER) { _Pragma("unroll") for (int _h = 0; _h < 2; ++_h) _Pragma("unroll") for (int _i = 0; _i < 2; ++_i) v2[_h][_i] = va[_h][_i];
                if (last) { v2[0][0] = vnl[0]; v2[0][1] = vnl[1]; v2[1][0] = vnl[2]; v2[1][1] = vnl[3]; } }
            if constexpr (SP2) {
            PG8_LDB(B0, 0, 0); PG8_LDB(B1, 0, 1); PG8_SCHED; PG8_LDA(At, 0, 0); PG8_STAGE_A(PG8_SA(1, 1), a1, 1, va);
            PG8_WAIT_V(8); PG8_WAIT_L(0); PG8_BAR; PG8_MMA(0, 0, At, B0); PG8_MMA(0, 1, At, B1); PG8_BAR; PG8_SCHED;
            PG8_LDA(At, 0, 1); PG8_STAGE(PG8_SB(0, 0), b2, voffB); PG8_STAGE(PG8_SB(0, 1), b2 + hstep, voffB); PG8_STAGE_A(PG8_SA(0, 0), a2, 0, v2);
            PG8_WAIT_V(8); PG8_WAIT_L(0); PG8_BAR; PG8_MMA(1, 0, At, B0); PG8_MMA(1, 1, At, B1); PG8_BAR; PG8_SCHED;
            PG8_LDB(B0, 1, 0); PG8_LDB(B1, 1, 1); PG8_SCHED; PG8_LDA(At, 1, 0); PG8_STAGE_A(PG8_SA(0, 1), a2, 1, v2);
            PG8_WAIT_V(8); PG8_WAIT_L(0); PG8_BAR; PG8_MMA(0, 0, At, B0); PG8_MMA(0, 1, At, B1); PG8_BAR; PG8_SCHED;
            PG8_LDA(At, 1, 1); PG8_STAGE(PG8_SB(1, 0), b3, voffB); PG8_STAGE(PG8_SB(1, 1), b3 + hstep, voffB); PG8_STAGE_A(PG8_SA(1, 0), a3, 0, v2);
            PG8_WAIT_V(8); PG8_WAIT_L(0); PG8_BAR; PG8_MMA(1, 0, At, B0); PG8_MMA(1, 1, At, B1); PG8_BAR; PG8_SCHED;
            } else {
            PG8_LDB(B0, 0, 0); PG8_SCHED; PG8_LDA(At, 0, 0); PG8_STAGE(PG8_SA(1, 1), a1 + hstep, voffA);
            PG8_WAIT_L(8); PG8_BAR; PG8_WAIT_L(0); PG8_MMA(0, 0, At, B0); PG8_BAR; PG8_SCHED;
            PG8_LDB(B1, 0, 1); PG8_STAGE(PG8_SB(0, 0), b2, voffB);
            PG8_BAR; PG8_WAIT_L(0); PG8_MMA(0, 1, At, B1); PG8_BAR;
            PG8_LDA(At, 0, 1); PG8_STAGE(PG8_SA(0, 0), a2, voffA);
            PG8_BAR; PG8_WAIT_L(0); PG8_MMA(1, 0, At, B0); PG8_BAR; PG8_SCHED;
            PG8_STAGE(PG8_SB(0, 1), b2 + hstep, voffB);
            PG8_WAIT_V(6); PG8_BAR; PG8_MMA(1, 1, At, B1); PG8_BAR;
            PG8_LDB(B0, 1, 0); PG8_SCHED; PG8_LDA(At, 1, 0); PG8_STAGE(PG8_SA(0, 1), a2 + hstep, voffA);
            PG8_WAIT_L(8); PG8_BAR; PG8_WAIT_L(0); PG8_MMA(0, 0, At, B0); PG8_BAR; PG8_SCHED;
            PG8_LDB(B1, 1, 1); PG8_STAGE(PG8_SB(1, 0), b3, voffB);
            PG8_BAR; PG8_WAIT_L(0); PG8_MMA(0, 1, At, B1); PG8_BAR;
            PG8_LDA(At, 1, 1); PG8_STAGE(PG8_SA(1, 0), a3, voffA);
            PG8_BAR; PG8_WAIT_L(0); PG8_MMA(1, 0, At, B0); PG8_BAR; PG8_SCHED;
            PG8_STAGE(PG8_SB(1, 1), b3 + hstep, voffB);
            PG8_WAIT_V(6); PG8_BAR; PG8_MMA(1, 1, At, B1); PG8_BAR;
            }
        }
        if constexpr (FP8) { asm volatile("s_nop 15\n\ts_nop 15" ::: "memory"); }
        if constexpr (ALIGN_EPI) { if (wr == 0) PG8_BAR; }
        if constexpr (!Epi::AFTER_DRAIN) { E(acc, cur, wr, wc, fr, fq);
#if EPI_PROBE
            _Pragma("unroll 1") for (int pr_ = 0; pr_ < 2; ++pr_) { asm volatile("" ::: "memory"); E(acc, cur, wr, wc, fr, fq); }
#endif
            S.done(cur); }
        if (!has_next) break;
#pragma unroll
        for (int a = 0; a < 2; ++a)
#pragma unroll
            for (int b = 0; b < 2; ++b)
#pragma unroll
                for (int m = 0; m < 4; ++m)
#pragma unroll
                    for (int n = 0; n < 2; ++n) acc[a][b][m][n] = (f32x4){0.f, 0.f, 0.f, 0.f};
        cur = nxt; cA = nA; cB = nB; ++ui;
        if constexpr (GATHER) { va[0][0] = vnl[0]; va[0][1] = vnl[1]; va[1][0] = vnl[2]; va[1][1] = vnl[3]; }
        if constexpr (ALIGN_EPI) { if (wr == 1) PG8_BAR; }
    }
    PG8_WAIT_V(0);
    if constexpr (!ALIGN_EPI) { if (wr == 0) PG8_BAR; }
    PG8_BAR;
    if constexpr (Epi::AFTER_DRAIN) { E.fused(acc, cur, wr, wc, fr, fq, lds, wid, lane); S.done(cur); }
#undef PG8_SA
#undef PG8_SB
#undef PG8_STAGE
#undef PG8_STAGE_A
#undef PG8_GCALC
#undef PG8_LDA
#undef PG8_LDB
#undef PG8_MMA
#undef PG8_WAIT_V
#undef PG8_WAIT_L
#undef PG8_BAR
#undef PG8_SCHED
}
}
#define LAS __attribute__((address_space(3)))
#define XB_TMO      128
#define XB_XCNT(j)  (256  + 64 * (j))
#define XB_XSUB(j)  (1280 + 64 * (j))
#define XB_XGEN(j)  (2304 + 64 * (j))
#define XB_TOP      3328
#define XB_TOPGEN   3392
#define XCD_BAR_WORDS 3456
#define XB_SPIN_CAP (1u << 18)

__device__ __forceinline__ unsigned xb_ld(unsigned* p)              { return __hip_atomic_load(p, __ATOMIC_RELAXED, __HIP_MEMORY_SCOPE_AGENT); }
__device__ __forceinline__ unsigned xb_add(unsigned* p, unsigned v) { return __hip_atomic_fetch_add(p, v, __ATOMIC_RELAXED, __HIP_MEMORY_SCOPE_AGENT); }
__device__ __forceinline__ unsigned xb_xcc_id() { return (unsigned)__builtin_amdgcn_s_getreg((3 << 11) | 20) & 0xFu; }
#define XB_SPIN(cond, bar) do { unsigned _sp = 0; while (cond) { __builtin_amdgcn_s_sleep(1); \
    if ((++_sp & 255u) == 0u) { if (xb_ld(&(bar)[XB_TMO])) break; if (_sp > XB_SPIN_CAP) { atomicAdd(&(bar)[XB_TMO], 1u); break; } } } } while (0)

struct XcdBarrier {
    unsigned* bar; unsigned x;
    volatile LAS unsigned* st;
};

__device__ __forceinline__ XcdBarrier xcd_barrier_post(unsigned* bar, volatile LAS unsigned* st) {
    XcdBarrier b; b.bar = bar; b.x = xb_xcc_id(); b.st = st;
    if (threadIdx.x == 0) (void)xb_add(&bar[XB_XCNT(b.x)], 1u);
    return b;
}
__device__ __forceinline__ void xcd_barrier_complete(unsigned* bar, unsigned x, unsigned& nloc, unsigned& nx) {
    const unsigned G = gridDim.x * gridDim.y * gridDim.z;
    unsigned sum, cnt, mine, sp = 0u;
    for (;;) {
        sum = 0u; cnt = 0u; mine = 0u;
#pragma unroll 1
        for (unsigned j = 0; j < 16; ++j) { const unsigned c = xb_ld(&bar[XB_XCNT(j)]); sum += c; cnt += (c > 0u) ? 1u : 0u; mine = (j == x) ? c : mine; }
        if (sum == G) break;
        __builtin_amdgcn_s_sleep(1);
        if ((++sp & 255u) == 0u) { if (xb_ld(&bar[XB_TMO])) break; if (sp > XB_SPIN_CAP) { atomicAdd(&bar[XB_TMO], 1u); break; } }
    }
    nloc = mine > 0u ? mine : 1u; nx = cnt > 0u ? cnt : 1u;
}

__device__ __forceinline__ void xcd_barrier_census(const XcdBarrier& b) {
    if (threadIdx.x == 0) { unsigned nloc, nx; xcd_barrier_complete(b.bar, b.x, nloc, nx); b.st[0] = nloc; b.st[1] = nx; }
    __syncthreads();
}
__device__ __forceinline__ void xcd_barrier(const XcdBarrier& b) {
    asm volatile("s_waitcnt vmcnt(0)" ::: "memory");
    __syncthreads();
    if (threadIdx.x == 0) {
        unsigned* bar = b.bar;
        __builtin_amdgcn_s_waitcnt(0);
        unsigned nloc = b.st[0], nx = b.st[1];
        const unsigned old = xb_add(&bar[XB_XSUB(b.x)], 1u);
        const unsigned gen = old / nloc;
        if (old + 1u == (gen + 1u) * nloc) {
            __builtin_amdgcn_fence(__ATOMIC_RELEASE, "agent");
            asm volatile("s_waitcnt vmcnt(0)" ::: "memory");
            const unsigned og = xb_add(&bar[XB_TOP], 1u);
            const unsigned tg = og / nx;
            if (og + 1u == (tg + 1u) * nx) xb_add(&bar[XB_TOPGEN], 1u);
            else XB_SPIN(xb_ld(&bar[XB_TOPGEN]) == tg, bar);
            __builtin_amdgcn_fence(__ATOMIC_ACQUIRE, "agent");
            xb_add(&bar[XB_XGEN(b.x)], 1u);
            asm volatile("s_waitcnt vmcnt(0)" ::: "memory");
        } else {
            XB_SPIN(xb_ld(&bar[XB_XGEN(b.x)]) == gen, bar);
            __builtin_amdgcn_fence(__ATOMIC_ACQUIRE, "agent");
            asm volatile("s_waitcnt vmcnt(0)" ::: "memory");
        }
    }
    __syncthreads();
}

#define GAS __attribute__((address_space(1)))
typedef unsigned short bf16_t;
typedef short bf16x8 __attribute__((ext_vector_type(8)));
typedef short s16x4 __attribute__((ext_vector_type(4)));
typedef float f32x4 __attribute__((ext_vector_type(4)));
typedef float f32x2 __attribute__((ext_vector_type(2)));
typedef float f32x16 __attribute__((ext_vector_type(16)));
typedef unsigned u32x4 __attribute__((ext_vector_type(4)));
typedef unsigned u32x2 __attribute__((ext_vector_type(2)));

constexpr int T = 16384, DM = 2048, DIN = 6160, NPROJ = 6144, NLAYER = 2, NE = 16, DEXP = 1024;
constexpr int PQ = 0, PK = 512, PV = 1024, PG = 2048, PMQ = 3072, PMK = 4096, PMV = 5120;
__host__ __device__ __forceinline__ size_t ix_gq(int h, int t) { return ((size_t)(0 + h) * T + t) * 128; }
__host__ __device__ __forceinline__ size_t ix_gk(int h, int t) { return ((size_t)(4 + h) * T + t) * 128; }
__host__ __device__ __forceinline__ size_t ix_gv(int h, int t) { return (size_t)(8 + 2 * h) * T * 128 + (size_t)t * 256; }
__host__ __device__ __forceinline__ size_t ix_gg(int h, int t) { return (size_t)(16 + 2 * h) * T * 128 + (size_t)t * 256; }
__host__ __device__ __forceinline__ size_t ix_mq(int h, int t) { return ((size_t)(24 + h) * T + t) * 128; }
__host__ __device__ __forceinline__ size_t ix_mk(int h, int t) { return ((size_t)(32 + h) * T + t) * 128; }
__host__ __device__ __forceinline__ size_t ix_mv(int h, int t) { return ((size_t)(40 + h) * T + t) * 128; }
constexpr float DN_ALPHA = 1.4142135623730951f;
constexpr int MAXROWS = 36864;
constexpr int LISTH = 516096;
constexpr int NTHR = 512;

constexpr size_t MiB = 1u << 20;
constexpr size_t WS_CTL = 0, CTL_BYTES = 64 * 1024;
constexpr size_t WS_MISC = 1 * MiB;
constexpr size_t WS_ITEMS = 1 * MiB + 65536;
constexpr size_t WS_TOK = 2 * MiB, WS_SEL = 3 * MiB, WS_KMEAN = 4 * MiB, WS_GDEC = 5 * MiB, WS_GLOW = 6 * MiB, WS_PML = 8 * MiB;
constexpr size_t WS_HBQ = 228 * MiB;
constexpr int WIN8_SH = 5;
constexpr size_t WS_IDX = 7 * MiB;
constexpr size_t WS_HB8 = 456 * MiB;
constexpr size_t WS_ROPE = 12 * MiB, WS_LIST = 20 * MiB;
constexpr size_t WS_WIN = 36 * MiB, WS_WO = 60 * MiB, WS_WGU = 68 * MiB, WS_WIN2 = 132 * MiB, WS_WD = 196 * MiB;
constexpr size_t WS_HB = 260 * MiB, WS_MIX = 324 * MiB;
constexpr size_t WS_PROJ = 388 * MiB, WS_U = 580 * MiB, WS_S = 644 * MiB, WS_PO = 708 * MiB;
constexpr size_t WS_BDEC = 708 * MiB;
constexpr size_t WS_PRE = 388 * MiB;
constexpr size_t WS_XS = 388 * MiB, WS_HS = 532 * MiB, WS_YS = 604 * MiB;
constexpr size_t WS_END = 836 * MiB;
constexpr int CW_BAR = 4096, CW_CNT = 8192, CW_NIT = 8448, CW_DBG = 8704, CW_CVQ = 9216;
constexpr int LDS_SCR = 131072, LDS_BYTES = 155648;

struct Params { const float* in[16]; float* out; unsigned char* ws; int g_lo, g_hi; };

__device__ __forceinline__ unsigned cvt_pk(float lo, float hi) { return pg8::cvt_pk_bf16(lo, hi); }
__device__ __forceinline__ float bflo(unsigned u) { return __uint_as_float(u << 16); }
__device__ __forceinline__ float bfhi(unsigned u) { return __uint_as_float(u & 0xffff0000u); }
__device__ __forceinline__ float bf2f(bf16_t u) { return __uint_as_float(((unsigned)u) << 16); }
__device__ __forceinline__ unsigned ldu(const unsigned* p) { return __hip_atomic_load(p, __ATOMIC_RELAXED, __HIP_MEMORY_SCOPE_AGENT); }
__device__ __forceinline__ float ldf(const float* p) { return __uint_as_float(__hip_atomic_load((const unsigned*)p, __ATOMIC_RELAXED, __HIP_MEMORY_SCOPE_AGENT)); }
#ifndef OUT8
#define OUT8 1
#endif
constexpr int MIX8_SH = 3, WO8_SH = 5;
#ifndef YS8
#define YS8 1
#endif
constexpr int Y8_SH = 4;
#ifndef RECOMP
#define RECOMP 1
#endif
#ifndef PO8
#define PO8 1
#endif
constexpr int PO8_SH = 4;
constexpr int X8_SH = 2, H8_SH = 2, WGU8_SH = 5, WD8_SH = 6;
__device__ __forceinline__ unsigned pk4_fp8(float a, float b, float c, float d);
__device__ __forceinline__ unsigned pk4_fp8v(f32x4 x, float s) { const f32x4 y = x * s; return pk4_fp8(y[0], y[1], y[2], y[3]); }
__device__ __forceinline__ unsigned pk4_fp8(float a, float b, float c, float d) { int t = __builtin_amdgcn_cvt_pk_fp8_f32(a, b, 0, false); t = __builtin_amdgcn_cvt_pk_fp8_f32(c, d, t, true); return (unsigned)t; }
__device__ __forceinline__ float fp8_dec(unsigned b) { const unsigned s = b >> 7, e = (b >> 3) & 15u, m = b & 7u; const float v = e ? (1.0f + 0.125f * (float)m) * __builtin_ldexpf(1.0f, (int)e - 7) : 0.125f * (float)m * 0.015625f; return s ? -v : v; }
__device__ __forceinline__ void unpack8(const u32x4 x, float (&f)[8]) { f[0] = bflo(x.x); f[1] = bfhi(x.x); f[2] = bflo(x.y); f[3] = bfhi(x.y); f[4] = bflo(x.z); f[5] = bfhi(x.z); f[6] = bflo(x.w); f[7] = bfhi(x.w); }
__device__ __forceinline__ u32x4 pack8(const float (&f)[8]) { u32x4 w; w.x = cvt_pk(f[0], f[1]); w.y = cvt_pk(f[2], f[3]); w.z = cvt_pk(f[4], f[5]); w.w = cvt_pk(f[6], f[7]); return w; }

__device__ __forceinline__ void moe_bases(const unsigned* cnt, int* sb) {
    const int tid = opq_tid();
    if (tid < 64) { const int lane = tid;
        const int c = (lane < NE) ? (int)ldu(cnt + lane) : 0; const int nP = (c + 255) >> 8; int incl = nP;
#pragma unroll
        for (int o = 1; o < 16; o <<= 1) { const int t = __shfl_up(incl, o); if (lane >= o) incl += t; }
        if (lane < NE) { sb[lane] = (incl - nP) * 256; sb[32 + lane] = c; if (lane == NE - 1) sb[16] = incl * 256; } }
    __syncthreads();
}
__device__ __forceinline__ float wave_sum(float v) {
#define WS_DPP(ctrl) v += __int_as_float(__builtin_amdgcn_update_dpp(0, __float_as_int(v), (ctrl), 0xF, 0xF, true))
    WS_DPP(0xB1); WS_DPP(0x4E); WS_DPP(0x141); WS_DPP(0x140);
#undef WS_DPP
    const int vi = __float_as_int(v);
    return (__int_as_float(__builtin_amdgcn_readlane(vi, 0)) + __int_as_float(__builtin_amdgcn_readlane(vi, 16))) + (__int_as_float(__builtin_amdgcn_readlane(vi, 32)) + __int_as_float(__builtin_amdgcn_readlane(vi, 48)));
}
__device__ __forceinline__ float silu_f(float x) { return x * __builtin_amdgcn_rcpf(1.0f + __expf(-x)); }
__device__ __forceinline__ s16x4 tr_rd(int addr) { s16x4 r; asm volatile("ds_read_b64_tr_b16 %0, %1" : "=&v"(r) : "v"(addr) : "memory"); return r; }
#define LGKM0() do { asm volatile("s_waitcnt lgkmcnt(0)" ::: "memory"); __builtin_amdgcn_sched_barrier(0); } while (0)
#define PK8(L, H) ((bf16x8){L[0], L[1], L[2], L[3], H[0], H[1], H[2], H[3]})
#define MFMA16(a, b, c) __builtin_amdgcn_mfma_f32_16x16x32_bf16((a), (b), (c), 0, 0, 0)

namespace pg8 {
#ifndef NT_PROJ
#define NT_PROJ 0
#endif
struct EpiProj {
    static constexpr bool PERM = true, AFTER_DRAIN = false;
    bf16_t* O; const float* cs; const float* sn;
    __device__ __forceinline__ void operator()(const f32x4 (&acc)[2][2][4][2], const Unit& u, int wr, int wc, int fr, int fq) const {
        const int row0 = u.pm * BM + wr * 64 + fr, cin = wc * 32 + 8 * fq;
        const bool rope = (u.pn >= 12 && u.pn < 20);
        size_t hb0[2]; int rs;
        if (u.pn < 4) { rs = 128; for (int bj = 0; bj < 2; ++bj) hb0[bj] = (size_t)((u.pn < 2 ? 0 : 4) + 2 * (u.pn & 1) + bj) * T * 128; }
        else if (u.pn < 12) { rs = 256; for (int bj = 0; bj < 2; ++bj) hb0[bj] = (size_t)((u.pn < 8 ? 8 : 16) + 2 * ((u.pn - 4) & 3)) * T * 128 + bj * 128; }
        else { rs = 128; for (int bj = 0; bj < 2; ++bj) hb0[bj] = (size_t)(24 + 8 * ((u.pn - 12) >> 2) + 2 * ((u.pn - 12) & 3) + bj) * T * 128; }
#pragma unroll
        for (int ai = 0; ai < 2; ++ai) {
            f32x4 c[4], s[4];
#pragma unroll
            for (int m = 0; m < 4; ++m) { c[m] = (f32x4){1.f, 1.f, 1.f, 1.f}; s[m] = (f32x4){0.f, 0.f, 0.f, 0.f}; }
            if (rope) {
#pragma unroll
                for (int m = 0; m < 4; ++m) { const int row = row0 + ai * HALF + m * 16; c[m] = *(const f32x4*)(cs + (size_t)row * 64 + 16 * wc + 4 * fq); s[m] = *(const f32x4*)(sn + (size_t)row * 64 + 16 * wc + 4 * fq); } }
#pragma unroll
            for (int m = 0; m < 4; ++m) {
                const int row = row0 + ai * HALF + m * 16;
#pragma unroll
                for (int bj = 0; bj < 2; ++bj) {
                    const f32x4 a0 = acc[ai][bj][m][0], a1 = acc[ai][bj][m][1];
                    const f32x4 v0 = a0 * c[m] - a1 * s[m], v1 = a1 * c[m] + a0 * s[m];
                    u32x4 w; w.x = cvt_pk_bf16(v0[0], v0[1]); w.y = cvt_pk_bf16(v0[2], v0[3]); w.z = cvt_pk_bf16(v1[0], v1[1]); w.w = cvt_pk_bf16(v1[2], v1[3]);
                    if (NT_PROJ) __builtin_nontemporal_store(w, (u32x4*)(O + hb0[bj] + (size_t)row * rs + cin)); else *(u32x4*)(O + hb0[bj] + (size_t)row * rs + cin) = w; }
            }
        }
    }
};
struct EpiOut {
    static constexpr bool PERM = true, AFTER_DRAIN = false;
    const float* res32; const bf16_t* res16; bf16_t* out; float alpha;
    __device__ __forceinline__ void operator()(const f32x4 (&acc)[2][2][4][2], const Unit& u, int wr, int wc, int fr, int fq) const {
        const int row0 = u.pm * BM + wr * 64 + fr, col0 = u.pn * BM + wc * 32 + 8 * fq;
        if (res32) {
#pragma unroll
            for (int ai = 0; ai < 2; ++ai)
#pragma unroll
                for (int mh = 0; mh < 2; ++mh) { f32x4 r[2][2][2];
#pragma unroll
                    for (int m2 = 0; m2 < 2; ++m2)
#pragma unroll
                        for (int bj = 0; bj < 2; ++bj) { const size_t off = (size_t)(row0 + ai * HALF + (2 * mh + m2) * 16) * 2048 + col0 + bj * HALF; r[m2][bj][0] = *(const f32x4*)(res32 + off); r[m2][bj][1] = *(const f32x4*)(res32 + off + 4); }
#pragma unroll
                    for (int m2 = 0; m2 < 2; ++m2)
#pragma unroll
                        for (int bj = 0; bj < 2; ++bj) { const int m = 2 * mh + m2; const size_t off = (size_t)(row0 + ai * HALF + m * 16) * 2048 + col0 + bj * HALF;
                            const f32x4 v0 = r[m2][bj][0] * alpha + acc[ai][bj][m][0], v1 = r[m2][bj][1] * alpha + acc[ai][bj][m][1];
                            u32x4 w; w.x = cvt_pk_bf16(v0[0], v0[1]); w.y = cvt_pk_bf16(v0[2], v0[3]); w.z = cvt_pk_bf16(v1[0], v1[1]); w.w = cvt_pk_bf16(v1[2], v1[3]);
                            *(u32x4*)(out + off) = w; } }
        } else {
#pragma unroll
            for (int ai = 0; ai < 2; ++ai) { u32x4 b[4][2];
#pragma unroll
                for (int m = 0; m < 4; ++m)
#pragma unroll
                    for (int bj = 0; bj < 2; ++bj) b[m][bj] = *(const u32x4*)(res16 + (size_t)(row0 + ai * HALF + m * 16) * 2048 + col0 + bj * HALF);
#pragma unroll
                for (int m = 0; m < 4; ++m)
#pragma unroll
                    for (int bj = 0; bj < 2; ++bj) { const size_t off = (size_t)(row0 + ai * HALF + m * 16) * 2048 + col0 + bj * HALF; const u32x4 bb = b[m][bj];
                        const f32x4 r0 = (f32x4){bflo(bb.x), bfhi(bb.x), bflo(bb.y), bfhi(bb.y)}, r1 = (f32x4){bflo(bb.z), bfhi(bb.z), bflo(bb.w), bfhi(bb.w)};
                        const f32x4 v0 = r0 * alpha + acc[ai][bj][m][0], v1 = r1 * alpha + acc[ai][bj][m][1];
                        u32x4 w; w.x = cvt_pk_bf16(v0[0], v0[1]); w.y = cvt_pk_bf16(v0[2], v0[3]); w.z = cvt_pk_bf16(v1[0], v1[1]); w.w = cvt_pk_bf16(v1[2], v1[3]);
                        *(u32x4*)(out + off) = w; } }
        }
    }
};
struct EpiGU {
    static constexpr bool PERM = true, AFTER_DRAIN = false;
    unsigned char* H;
    __device__ __forceinline__ void operator()(const f32x4 (&acc)[2][2][4][2], const Unit& u, int wr, int wc, int fr, int fq) const {
        const int row0 = u.pm * BM + wr * 64 + fr, col0 = ((u.pn & 7) * BM + wc * 32 + 8 * fq) >> 1;
#pragma unroll
        for (int ai = 0; ai < 2; ++ai)
#pragma unroll
            for (int m = 0; m < 4; ++m) { unsigned char* rowp = H + (size_t)(row0 + ai * HALF + m * 16) * 1024 + col0;
#pragma unroll
                for (int bj = 0; bj < 2; ++bj) { const f32x4 g = acc[ai][bj][m][0], up = acc[ai][bj][m][1]; f32x4 h;
#pragma unroll
                    for (int j = 0; j < 4; ++j) h[j] = g[j] * __builtin_amdgcn_rcpf(1.0f + __expf(-g[j])) * up[j] * (float)(1 << H8_SH);
                    *(unsigned*)(rowp + bj * (HALF / 2)) = pk4_fp8(h[0], h[1], h[2], h[3]); } }
    }
};
struct EpiY {
    static constexpr bool PERM = true, AFTER_DRAIN = false;
    bf16_t* Y;
    __device__ __forceinline__ void operator()(const f32x4 (&acc)[2][2][4][2], const Unit& u, int wr, int wc, int fr, int fq) const {
        const int row0 = u.pm * BM + wr * 64 + fr, col0 = (u.pn & 7) * BM + wc * 32 + 8 * fq;
#pragma unroll
        for (int ai = 0; ai < 2; ++ai)
#pragma unroll
            for (int m = 0; m < 4; ++m) { bf16_t* rowp = Y + (size_t)(row0 + ai * HALF + m * 16) * 2048 + col0;
#pragma unroll
                for (int bj = 0; bj < 2; ++bj) { const f32x4 v0 = acc[ai][bj][m][0], v1 = acc[ai][bj][m][1];
#if YS8
                    u32x2 w; w.x = pk4_fp8(v0[0] * (float)(1 << Y8_SH), v0[1] * (float)(1 << Y8_SH), v0[2] * (float)(1 << Y8_SH), v0[3] * (float)(1 << Y8_SH));
                    w.y = pk4_fp8(v1[0] * (float)(1 << Y8_SH), v1[1] * (float)(1 << Y8_SH), v1[2] * (float)(1 << Y8_SH), v1[3] * (float)(1 << Y8_SH));
                    *(u32x2*)((unsigned char*)Y + (size_t)(row0 + ai * HALF + m * 16) * 2048 + col0 + bj * HALF) = w; } }
#else
                    u32x4 w; w.x = cvt_pk_bf16(v0[0], v0[1]); w.y = cvt_pk_bf16(v0[2], v0[3]); w.z = cvt_pk_bf16(v1[0], v1[1]); w.w = cvt_pk_bf16(v1[2], v1[3]);
                    *(u32x4*)(rowp + bj * HALF) = w; } }
#endif
    }
};
struct MoeOrder : StaticOrder {
    const int* sb; const unsigned* idx; int rowbytes;
    __device__ __forceinline__ int expert_of(int pm) const { const int r = pm * BM; int e = 0;
#pragma unroll
        for (int k = 1; k < 16; ++k) e += (sb[k] <= r) ? 1 : 0;
        return e; }
    __device__ __forceinline__ bool next(int i, Unit& u) const {
        if (!StaticOrder::next(i, u)) return false;
        u.pn += 8 * __builtin_amdgcn_readfirstlane(expert_of(u.pm));
        return true; }
    __device__ __forceinline__ unsigned arow(const Unit& u, int r) const {
        const int e = u.pn >> 3, slot = u.pm * BM - sb[e] + r;
        const unsigned t = (slot < sb[32 + e]) ? __hip_atomic_load(idx + (size_t)e * 16384 + slot, __ATOMIC_RELAXED, __HIP_MEMORY_SCOPE_AGENT) : 0u;
        return t * (unsigned)rowbytes; }
};
}
__device__ __forceinline__ int rope_src_col(int n) {
    const int seg = (n - PMQ) >> 7, pp = (n - PMQ) & 127, g = pp >> 3, e = pp & 7;
    return 3088 + seg * 128 + (e < 4 ? 4 * g + e : 64 + 4 * g + (e - 4));
}
constexpr int CVT_NT = 1792, CVT_NT_IN = 192;
template <bool DYN, int JOBS>
static __device__ void phase_cvt(const Params& p, int tl, int t0, int ntot, int w, int nwk, unsigned char* lds, unsigned* qw = nullptr) {
    const int tid = opq_tid(), lane = tid & 63, wave = __builtin_amdgcn_readfirstlane(tid >> 6);
    volatile unsigned* qs = (volatile unsigned*)(lds + LDS_SCR + 96);
    int tt = w;
    if (DYN) { if (tid == 0) *qs = atomicAdd(qw, 1u); __syncthreads(); tt = (int)*qs; }
    while (tt < ntot) {
        unsigned qn = 0u; if (DYN && tid == 0) qn = atomicAdd(qw, 1u);
        int t = t0 + tt;
        int job, e = 0, kt, nt;
        if ((JOBS & 1) && (t < 192 || JOBS == 1)) { job = 0; kt = t / 12; nt = t % 12; }
        else if ((JOBS & 2) && (t < 256 || !(JOBS & 12))) { t -= 192; job = 1; kt = t >> 2; nt = t & 3; }
        else if ((JOBS & 4) && (t < 1280 || !(JOBS & 8))) { t -= 256; job = 2; e = t >> 6; t &= 63; kt = t >> 2; nt = t & 3; }
        else { t -= 1280; job = 3; e = t >> 5; t &= 31; kt = t >> 2; nt = t & 3; }
        const int n0 = nt * 512, k0 = kt * 128;
        const float* s0; const float* s1; size_t ld; int nl0, nl1;
        if (job == 0) { const float* wi = p.in[2] + (size_t)tl * DM * DIN + (size_t)k0 * DIN; ld = DIN;
            const int na = n0 + 4 * lane, nb = n0 + 256 + 4 * lane;
            s0 = wi + ((na < PMQ) ? na : (na < PMV ? rope_src_col(na) : na + 16)); s1 = wi + ((nb < PMQ) ? nb : (nb < PMV ? rope_src_col(nb) : nb + 16)); nl0 = 4 * lane; nl1 = 256 + 4 * lane; }
        else if (job == 1) { const float* wo = p.in[6] + (size_t)tl * DM * DM + (size_t)k0 * DM + n0; ld = DM; s0 = wo + 4 * lane; s1 = wo + 256 + 4 * lane; nl0 = 4 * lane; nl1 = 256 + 4 * lane; }
        else if (job == 2) { const size_t off = ((size_t)(tl * NE + e) * DM + k0) * DEXP + (n0 >> 1) + 4 * lane; ld = DEXP; s0 = p.in[11] + off; s1 = p.in[12] + off; nl0 = 8 * lane; nl1 = 8 * lane + 4; }
        else { const float* wd = p.in[13] + ((size_t)(tl * NE + e) * DEXP + k0) * DM + n0; ld = DM; s0 = wd + 4 * lane; s1 = wd + 256 + 4 * lane; nl0 = 4 * lane; nl1 = 256 + 4 * lane; }
        const bool f8 = OUT8 ? true : (job != 1); const float sc = (job == 0) ? (float)(1 << WIN8_SH) : (job == 1) ? (float)(1 << WO8_SH) : (job == 2) ? (float)(1 << WGU8_SH) : (float)(1 << WD8_SH);
        f32x4 v[3][8];
#pragma unroll
        for (int pb = 0; pb < 2; ++pb)
#pragma unroll
            for (int i = 0; i < 4; ++i) { const size_t ro = (size_t)(wave + 8 * (4 * pb + i)) * ld; v[pb][2 * i] = *(const f32x4*)(s0 + ro); v[pb][2 * i + 1] = *(const f32x4*)(s1 + ro); }
#pragma unroll
        for (int bt = 0; bt < 4; ++bt) {
            if (bt < 2) {
#pragma unroll
                for (int i = 0; i < 4; ++i) { const size_t ro = (size_t)(wave + 8 * (4 * (bt + 2) + i)) * ld; v[(bt + 2) % 3][2 * i] = *(const f32x4*)(s0 + ro); v[(bt + 2) % 3][2 * i + 1] = *(const f32x4*)(s1 + ro); } }
#pragma unroll
            for (int i = 0; i < 4; ++i) { const int r = wave + 8 * (4 * bt + i); const f32x4 x0 = v[bt % 3][2 * i], x1 = v[bt % 3][2 * i + 1];
                if (f8) { *(unsigned*)(lds + r * 512 + nl0) = pk4_fp8(x0[0] * sc, x0[1] * sc, x0[2] * sc, x0[3] * sc); *(unsigned*)(lds + r * 512 + nl1) = pk4_fp8(x1[0] * sc, x1[1] * sc, x1[2] * sc, x1[3] * sc); }
                else { u32x2 a; a.x = cvt_pk(x0[0], x0[1]); a.y = cvt_pk(x0[2], x0[3]); u32x2 c2; c2.x = cvt_pk(x1[0], x1[1]); c2.y = cvt_pk(x1[2], x1[3]);
                       *(u32x2*)(lds + r * 1024 + 2 * nl0) = a; *(u32x2*)(lds + r * 1024 + 2 * nl1) = c2; } }
        }
        __syncthreads();
        if (f8) {
            unsigned char* d = (job == 0) ? p.ws + ((tl & 1) ? WS_WIN2 : WS_WIN) + (size_t)(n0 + tid) * DM + k0
                             : (job == 1) ? p.ws + WS_WO + (size_t)(n0 + tid) * DM + k0
                             : (job == 2) ? p.ws + WS_WGU + ((size_t)e * 2048 + n0 + tid) * DM + k0 : p.ws + WS_WD + ((size_t)e * 2048 + n0 + tid) * DEXP + k0;
#pragma unroll
            for (int c = 0; c < 8; ++c) { unsigned wq[4];
#pragma unroll
                for (int j = 0; j < 4; ++j) { const unsigned char* s8 = lds + (16 * c + 4 * j) * 512 + tid; wq[j] = (unsigned)s8[0] | ((unsigned)s8[512] << 8) | ((unsigned)s8[1024] << 16) | ((unsigned)s8[1536] << 24); }
                *(u32x4*)(d + 16 * c) = (u32x4){wq[0], wq[1], wq[2], wq[3]}; }
        } else {
            unsigned char* d = p.ws + WS_WO + ((size_t)(n0 + tid) * DM + k0) * 2;
#pragma unroll
            for (int c = 0; c < 16; ++c) { unsigned wq[4];
#pragma unroll
                for (int j = 0; j < 4; ++j) { const unsigned lo = *(const unsigned short*)(lds + (8 * c + 2 * j) * 1024 + 2 * tid), hi = *(const unsigned short*)(lds + (8 * c + 2 * j + 1) * 1024 + 2 * tid); wq[j] = lo | (hi << 16); }
                *(u32x4*)(d + 16 * c) = (u32x4){wq[0], wq[1], wq[2], wq[3]}; }
        }
        if (DYN) { if (tid == 0) *qs = qn; }
        __syncthreads();
        if (DYN) tt = (int)*qs; else tt += nwk;
    }
}

static __device__ void phase_rope(const Params& p) {
    float* cs = (float*)(p.ws + WS_ROPE); float* sn = cs + (size_t)T * 64;
    const int* pos = (const int*)p.in[1];
    const int tid0 = opq_tid();
    float inv;
    { const int i = tid0 & 63; double pw = 1.0; for (int k = 0; k < i; ++k) pw *= 1.1547819846894583;
      inv = 1.0f / (float)pw; }
    for (int idx = blockIdx.x * NTHR + tid0; idx < T * 64; idx += gridDim.x * NTHR) {
        const int t = idx >> 6;
        const float ang = (float)pos[t] * inv;
        const double rev = (double)ang * 0.15915494309189535; const float fr = (float)(rev - floor(rev));
        cs[idx] = __builtin_amdgcn_cosf(fr); sn[idx] = __builtin_amdgcn_sinf(fr);
    }
}

__device__ __forceinline__ float reduce16(const float (&a)[16], int lane) {
    float b[8], c[4], d[2];
    const bool x = lane & 1, y = lane & 2, z = lane & 4, w = lane & 8;
#pragma unroll
    for (int m = 0; m < 8; ++m) { const float keep = x ? a[2 * m + 1] : a[2 * m], give = x ? a[2 * m] : a[2 * m + 1]; b[m] = keep + __shfl_xor(give, 1); }
#pragma unroll
    for (int m = 0; m < 4; ++m) { const float keep = y ? b[2 * m + 1] : b[2 * m], give = y ? b[2 * m] : b[2 * m + 1]; c[m] = keep + __shfl_xor(give, 2); }
#pragma unroll
    for (int m = 0; m < 2; ++m) { const float keep = z ? c[2 * m + 1] : c[2 * m], give = z ? c[2 * m] : c[2 * m + 1]; d[m] = keep + __shfl_xor(give, 4); }
    float e = (w ? d[1] : d[0]) + __shfl_xor(w ? d[0] : d[1], 8);
    e += __shfl_xor(e, 16); e += __shfl_xor(e, 32);
    return e;
}
#ifndef SHARE_W
#define SHARE_W 1
#endif
#ifndef ROW_PROBE
#define ROW_PROBE 0
#endif
template <class Tp> __device__ __forceinline__ Tp* opq_uniform(Tp* ptr) { unsigned long long w = (unsigned long long)ptr; asm volatile("" : "+s"(w)); return (Tp*)w; }
template <int MODE, bool DUMMY = false> static __device__ void phase_rows(const Params& p, int layer, unsigned char* lds) {
    const int tid = opq_tid(), lane = tid & 63, wave = (MODE == 1) ? (tid >> 6) : __builtin_amdgcn_readfirstlane(tid >> 6);
    float* wT = (float*)lds;
    constexpr bool SK16 = false;
    float* rlog = (float*)(lds + LDS_SCR + 20480);
    int* lcnt = (int*)(lds + LDS_SCR + 512); int* gbase = lcnt + 16; float* rinfo = (float*)(lds + LDS_SCR + 1024);
    const bool last = (layer == NLAYER - 1);
    const bool do_skinny = !(MODE == 2 && last);
    const float* W; int ld, c0;
    if (MODE == 0) { W = p.in[2]; ld = DIN; c0 = 3072; }
    else if (MODE == 1) { W = p.in[9]; ld = 16; c0 = 0; }
    else { W = p.in[2] + (size_t)(last ? layer : layer + 1) * DM * DIN; ld = DIN; c0 = 3072; }
    bf16_t* hb = (bf16_t*)(p.ws + (DUMMY ? (MODE == 1 ? WS_U : WS_MIX) : WS_HB));
    float* glow = (float*)(p.ws + (DUMMY ? WS_PML + 2 * MiB : WS_GLOW));
    unsigned* tok = (unsigned*)(p.ws + (DUMMY && MODE == 1 ? WS_PML : WS_TOK));
    float* outw = DUMMY ? (float*)(p.ws + (MODE == 1 ? WS_PROJ : WS_WGU)) : p.out;
    const bf16_t* Ys = (const bf16_t*)(p.ws + WS_YS);
    int* sbm = (int*)(lds + LDS_SCR + 128);
#ifndef NR2_DEF
#define NR2_DEF 1
#endif
    constexpr int NR = (MODE == 2) ? NR2_DEF : 2;
    const int nit = T / (8 * (int)gridDim.x);
    constexpr bool PF = true;
#if YS8
    u32x2 nx[NR][8]; unsigned ny0[8], ny1[8]; f32x4 nf[NR][8];
#else
    u32x2 nx[NR][8], ny0[8], ny1[8]; f32x4 nf[NR][8];
#endif
    float nw0 = 0.f, nw1 = 0.f; unsigned nt[6];
    const bf16_t* srcb0 = (const bf16_t*)(p.ws + ((MODE == 2 && !RECOMP) ? WS_HB : WS_PRE));
    if (PF) {
#pragma unroll
        for (int rr = 0; rr < NR; ++rr) { const int r = (rr * (int)gridDim.x + (int)blockIdx.x) * 8 + wave;
#pragma unroll
            for (int i = 0; i < 8; ++i) { if (MODE == 1) nx[rr][i] = *(const u32x2*)(srcb0 + (size_t)r * DM + 256 * i + 4 * lane); else if (MODE == 2) nx[rr][i] = *(const u32x2*)(opq_uniform(srcb0 + (size_t)r * DM) + 256 * i + 4 * lane); else nf[rr][i] = *(const f32x4*)(opq_uniform(p.in[0] + (size_t)r * DM) + 256 * i + 4 * lane); } }
        if (MODE == 2) {
            const int r = (int)blockIdx.x * 8 + wave;
#pragma unroll
            for (int j = 0; j < 6; ++j) nt[j] = ldu(tok + r * 8 + j);
        }
    }
    if (MODE == 2) moe_bases((const unsigned*)(p.ws + WS_CTL) + CW_CNT + layer * 64, sbm);
    if (PF && MODE == 2) {
        nw0 = __uint_as_float(nt[2]); nw1 = __uint_as_float(nt[3]);
#if YS8
        const unsigned char* y0 = opq_uniform((const unsigned char*)Ys + (size_t)__builtin_amdgcn_readfirstlane((int)((unsigned)sbm[nt[0]] + nt[4])) * DM); const unsigned char* y1 = opq_uniform((const unsigned char*)Ys + (size_t)__builtin_amdgcn_readfirstlane((int)((unsigned)sbm[nt[1]] + nt[5])) * DM);
#pragma unroll
        for (int i = 0; i < 8; ++i) { ny0[i] = *(const unsigned*)(y0 + 256 * i + 4 * lane); ny1[i] = *(const unsigned*)(y1 + 256 * i + 4 * lane); }
#else
        const bf16_t* y0 = Ys + (size_t)((unsigned)sbm[nt[0]] + nt[4]) * DM; const bf16_t* y1 = Ys + (size_t)((unsigned)sbm[nt[1]] + nt[5]) * DM;
#pragma unroll
        for (int i = 0; i < 8; ++i) { ny0[i] = *(const u32x2*)(y0 + 256 * i + 4 * lane); ny1[i] = *(const u32x2*)(y1 + 256 * i + 4 * lane); }
#endif
        const int r2 = ((nit > 1 ? 1 : 0) * (int)gridDim.x + (int)blockIdx.x) * 8 + wave;
#pragma unroll
        for (int j = 0; j < 6; ++j) nt[j] = ldu(tok + r2 * 8 + j);
    }
    if (do_skinny) {
#pragma unroll
        for (int hb2 = 0; hb2 < 2; ++hb2) { f32x4 wv[8];
#pragma unroll
            for (int i = 0; i < 8; ++i) { const int i4 = tid + NTHR * (8 * hb2 + i), k = i4 >> 2, e4 = (i4 & 3) * 4; wv[i] = *(const f32x4*)(W + (size_t)k * ld + c0 + e4); }
#pragma unroll
            for (int i = 0; i < 8; ++i) { const int i4 = tid + NTHR * (8 * hb2 + i), k = i4 >> 2, e4 = (i4 & 3) * 4;
#pragma unroll
                for (int j = 0; j < 4; j += 2) *(f32x2*)(wT + (((e4 + j) >> 1) * DM + k) * 2) = (f32x2){wv[i][j], wv[i][j + 1]}; } }
    }
    if (MODE == 1 && tid < 16) lcnt[tid] = 0;
    float* gl = (float*)(lds + LDS_SCR + 4096); float* bl2 = gl + DM;
    unsigned short* tb2 = (unsigned short*)(lds + LDS_SCR + 12288); unsigned short* tg1 = tb2 + DM; unsigned short* tb1 = tg1 + DM;
    if (MODE != 0) {
        const float* gp = p.in[MODE == 1 ? 7 : 14] + (size_t)layer * DM; const float* bp = p.in[MODE == 1 ? 8 : 15] + (size_t)layer * DM;
        if (MODE == 2 && RECOMP) {
            const float* g1p = p.in[7] + (size_t)layer * DM; const float* b1p = p.in[8] + (size_t)layer * DM;
#pragma unroll
            for (int k = 0; k < DM / NTHR; ++k) { const int idx = tid + NTHR * k; gl[idx] = gp[idx];
                tb2[idx] = (unsigned short)(cvt_pk(bp[idx], 0.f) & 0xFFFFu); tg1[idx] = (unsigned short)(cvt_pk(g1p[idx], 0.f) & 0xFFFFu); tb1[idx] = (unsigned short)(cvt_pk(b1p[idx], 0.f) & 0xFFFFu); }
        } else {
#pragma unroll
            for (int k = 0; k < DM / NTHR; ++k) { const int idx = tid + NTHR * k; gl[idx] = gp[idx]; bl2[idx] = bp[idx]; }
        }
    }
    __syncthreads();
    for (int it = 0; it < nit; it += NR) {
        int row[NR]; float v[NR][32];
#pragma unroll
        for (int rr = 0; rr < NR; ++rr) { row[rr] = ((it + rr) * (int)gridDim.x + (int)blockIdx.x) * 8 + wave;
            if (MODE != 0) {
#pragma unroll
                for (int i = 0; i < 8; ++i) { const u32x2 x = nx[rr][i]; v[rr][4 * i] = bflo(x.x); v[rr][4 * i + 1] = bfhi(x.x); v[rr][4 * i + 2] = bflo(x.y); v[rr][4 * i + 3] = bfhi(x.y); }
            } else {
#pragma unroll
                for (int i = 0; i < 8; ++i) { const f32x4 x = nf[rr][i];
#pragma unroll
                    for (int j = 0; j < 4; ++j) v[rr][4 * i + j] = x[j]; } } }
        if (MODE == 2 && RECOMP) {
            __builtin_amdgcn_sched_barrier(0);
            float s = 0.f;
#pragma unroll
            for (int i = 0; i < 32; ++i) s += v[0][i];
            const float mean = wave_sum(s) * (1.0f / DM);
            float qq = 0.f;
#pragma unroll
            for (int i = 0; i < 32; ++i) { const float d = v[0][i] - mean; qq += d * d; }
            const float rstd = rsqrtf(wave_sum(qq) * (1.0f / DM) + 1e-5f);
#pragma unroll
            for (int i = 0; i < 8; ++i) { const u32x2 g4 = *(const u32x2*)(tg1 + 256 * i + 4 * lane), b4 = *(const u32x2*)(tb1 + 256 * i + 4 * lane);
                v[0][4 * i + 0] = (v[0][4 * i + 0] - mean) * rstd * bflo(g4.x) + bflo(b4.x); v[0][4 * i + 1] = (v[0][4 * i + 1] - mean) * rstd * bfhi(g4.x) + bfhi(b4.x);
                v[0][4 * i + 2] = (v[0][4 * i + 2] - mean) * rstd * bflo(g4.y) + bflo(b4.y); v[0][4 * i + 3] = (v[0][4 * i + 3] - mean) * rstd * bfhi(g4.y) + bfhi(b4.y);
                asm volatile("" ::: "memory"); }
            __builtin_amdgcn_sched_barrier(0);
        }
        if (MODE == 2) {
#if YS8
            const float w0 = nw0 * (1.0f / (float)(1 << Y8_SH)), w1 = nw1 * (1.0f / (float)(1 << Y8_SH));
#pragma unroll
            for (int i = 0; i < 8; ++i) { const unsigned a = ny0[i], c = ny1[i];
                const f32x2 a01 = __builtin_amdgcn_cvt_pk_f32_fp8((int)a, false), a23 = __builtin_amdgcn_cvt_pk_f32_fp8((int)a, true), c01 = __builtin_amdgcn_cvt_pk_f32_fp8((int)c, false), c23 = __builtin_amdgcn_cvt_pk_f32_fp8((int)c, true);
                v[0][4 * i + 0] = DN_ALPHA * v[0][4 * i + 0] + w0 * a01[0] + w1 * c01[0]; v[0][4 * i + 1] = DN_ALPHA * v[0][4 * i + 1] + w0 * a01[1] + w1 * c01[1];
                v[0][4 * i + 2] = DN_ALPHA * v[0][4 * i + 2] + w0 * a23[0] + w1 * c23[0]; v[0][4 * i + 3] = DN_ALPHA * v[0][4 * i + 3] + w0 * a23[1] + w1 * c23[1]; }
#else
            const float w0 = nw0, w1 = nw1;
#pragma unroll
            for (int i = 0; i < 8; ++i) { const u32x2 a = ny0[i], c = ny1[i];
                v[0][4 * i + 0] = DN_ALPHA * v[0][4 * i + 0] + w0 * bflo(a.x) + w1 * bflo(c.x); v[0][4 * i + 1] = DN_ALPHA * v[0][4 * i + 1] + w0 * bfhi(a.x) + w1 * bfhi(c.x);
                v[0][4 * i + 2] = DN_ALPHA * v[0][4 * i + 2] + w0 * bflo(a.y) + w1 * bflo(c.y); v[0][4 * i + 3] = DN_ALPHA * v[0][4 * i + 3] + w0 * bfhi(a.y) + w1 * bfhi(c.y); }
#endif
        }
        if (PF) {
            const int itn = (it + NR < nit) ? it + NR : it;
#pragma unroll
            for (int rr = 0; rr < NR; ++rr) { const int r = ((itn + rr) * (int)gridDim.x + (int)blockIdx.x) * 8 + wave;
#pragma unroll
                for (int i = 0; i < 8; ++i) { if (MODE == 1) nx[rr][i] = *(const u32x2*)(srcb0 + (size_t)r * DM + 256 * i + 4 * lane); else if (MODE == 2) nx[rr][i] = *(const u32x2*)(opq_uniform(srcb0 + (size_t)r * DM) + 256 * i + 4 * lane); else nf[rr][i] = *(const f32x4*)(opq_uniform(p.in[0] + (size_t)r * DM) + 256 * i + 4 * lane); } }
            if (MODE == 2) {
                nw0 = __uint_as_float(nt[2]); nw1 = __uint_as_float(nt[3]);
#if YS8
                        const unsigned char* y0 = opq_uniform((const unsigned char*)Ys + (size_t)__builtin_amdgcn_readfirstlane((int)((unsigned)sbm[nt[0]] + nt[4])) * DM); const unsigned char* y1 = opq_uniform((const unsigned char*)Ys + (size_t)__builtin_amdgcn_readfirstlane((int)((unsigned)sbm[nt[1]] + nt[5])) * DM);
#pragma unroll
                for (int i = 0; i < 8; ++i) { ny0[i] = *(const unsigned*)(y0 + 256 * i + 4 * lane); ny1[i] = *(const unsigned*)(y1 + 256 * i + 4 * lane); }
#else
                const bf16_t* y0 = Ys + (size_t)((unsigned)sbm[nt[0]] + nt[4]) * DM; const bf16_t* y1 = Ys + (size_t)((unsigned)sbm[nt[1]] + nt[5]) * DM;
#pragma unroll
                for (int i = 0; i < 8; ++i) { ny0[i] = *(const u32x2*)(y0 + 256 * i + 4 * lane); ny1[i] = *(const u32x2*)(y1 + 256 * i + 4 * lane); }
#endif
                const int it2 = (it + 2 < nit) ? it + 2 : nit - 1;
                const int r2 = (it2 * (int)gridDim.x + (int)blockIdx.x) * 8 + wave;
#pragma unroll
                for (int j = 0; j < 6; ++j) nt[j] = ldu(tok + r2 * 8 + j);
            }
        }
#pragma unroll
        for (int rr = 0; rr < NR; ++rr) {
            __builtin_amdgcn_sched_barrier(0);
            if (MODE != 0) {
                f32x2 s2 = (f32x2){0.f, 0.f};
#pragma unroll
                for (int i = 0; i < 16; ++i) s2 += (f32x2){v[rr][2 * i], v[rr][2 * i + 1]};
                const float mean = wave_sum(s2[0] + s2[1]) * (1.0f / DM);
                const f32x2 m2 = (f32x2){mean, mean};
                f32x2 q2 = (f32x2){0.f, 0.f};
#pragma unroll
                for (int i = 0; i < 16; ++i) { const f32x2 d2 = (f32x2){v[rr][2 * i], v[rr][2 * i + 1]} - m2; q2 += d2 * d2; }
                const float rstd = rsqrtf(wave_sum(q2[0] + q2[1]) * (1.0f / DM) + 1e-5f);
                const f32x4 m4 = (f32x4){mean, mean, mean, mean}, r4 = (f32x4){rstd, rstd, rstd, rstd};
#pragma unroll
                for (int i = 0; i < 8; ++i) { const f32x4 gv = *(const f32x4*)(gl + 256 * i + 4 * lane); f32x4 bv;
                    if (MODE == 2 && RECOMP) { const u32x2 b4 = *(const u32x2*)(tb2 + 256 * i + 4 * lane); bv = (f32x4){bflo(b4.x), bfhi(b4.x), bflo(b4.y), bfhi(b4.y)}; }
                    else bv = *(const f32x4*)(bl2 + 256 * i + 4 * lane);
                    const f32x4 x4 = ((f32x4){v[rr][4 * i], v[rr][4 * i + 1], v[rr][4 * i + 2], v[rr][4 * i + 3]} - m4) * (r4 * gv) + bv;
#pragma unroll
                    for (int j = 0; j < 4; ++j) v[rr][4 * i + j] = x4[j]; }
                if (MODE == 2 && last) {
                    float* dst = (MODE == 1) ? outw + (size_t)row[rr] * DM : opq_uniform(outw + (size_t)row[rr] * DM);
#pragma unroll
                    for (int i = 0; i < 8; ++i) *(f32x4*)(dst + 256 * i + 4 * lane) = (f32x4){v[rr][4 * i], v[rr][4 * i + 1], v[rr][4 * i + 2], v[rr][4 * i + 3]}; }
            }
            if (MODE != 0 && !(MODE == 2 && last) && !(MODE == 1 && RECOMP)) {
#pragma unroll
                for (int i = 0; i < 8; ++i) { u32x2 w; w.x = cvt_pk(v[rr][4 * i], v[rr][4 * i + 1]); w.y = cvt_pk(v[rr][4 * i + 2], v[rr][4 * i + 3]); *(u32x2*)(((MODE == 1) ? hb + (size_t)row[rr] * DM : opq_uniform(hb + (size_t)row[rr] * DM)) + 256 * i + 4 * lane) = w; }
            }
            if (MODE == 1 || !(MODE == 2 && last)) {
                unsigned char* hb8 = p.ws + (DUMMY ? WS_S : (MODE == 1 ? WS_HB8 : WS_HBQ));
#pragma unroll
                for (int i = 0; i < 8; ++i) *(unsigned*)(((MODE == 1) ? hb8 + (size_t)row[rr] * DM : opq_uniform(hb8 + (size_t)row[rr] * DM)) + 256 * i + 4 * lane) = pk4_fp8(v[rr][4 * i] * (float)(1 << X8_SH), v[rr][4 * i + 1] * (float)(1 << X8_SH), v[rr][4 * i + 2] * (float)(1 << X8_SH), v[rr][4 * i + 3] * (float)(1 << X8_SH));
            }
            asm volatile("" ::: "memory"); __builtin_amdgcn_sched_barrier(0);
        }
        if (do_skinny) {
            float tots[NR];
            if (MODE != 2 && SHARE_W) {
                asm volatile("" ::: "memory"); __builtin_amdgcn_sched_barrier(0);
                f32x2 accA[8], accB[8];
#pragma unroll
                for (int ep = 0; ep < 8; ++ep) { accA[ep] = (f32x2){0.f, 0.f}; accB[ep] = (f32x2){0.f, 0.f}; }
#pragma unroll
                for (int i = 0; i < 8; ++i) {
#pragma unroll
                    for (int eq = 0; eq < 4; ++eq) {
#pragma unroll
                        for (int ep = 2 * eq; ep < 2 * eq + 2; ++ep) { const f32x4 wa = *(const f32x4*)(wT + (ep * DM + 256 * i + 4 * lane) * 2), wb = *(const f32x4*)(wT + (ep * DM + 256 * i + 4 * lane) * 2 + 4);
                            accA[ep] += (f32x2){v[0][4 * i], v[0][4 * i]} * (f32x2){wa[0], wa[1]}; accA[ep] += (f32x2){v[0][4 * i + 1], v[0][4 * i + 1]} * (f32x2){wa[2], wa[3]};
                            accA[ep] += (f32x2){v[0][4 * i + 2], v[0][4 * i + 2]} * (f32x2){wb[0], wb[1]}; accA[ep] += (f32x2){v[0][4 * i + 3], v[0][4 * i + 3]} * (f32x2){wb[2], wb[3]};
                            accB[ep] += (f32x2){v[NR - 1][4 * i], v[NR - 1][4 * i]} * (f32x2){wa[0], wa[1]}; accB[ep] += (f32x2){v[NR - 1][4 * i + 1], v[NR - 1][4 * i + 1]} * (f32x2){wa[2], wa[3]};
                            accB[ep] += (f32x2){v[NR - 1][4 * i + 2], v[NR - 1][4 * i + 2]} * (f32x2){wb[0], wb[1]}; accB[ep] += (f32x2){v[NR - 1][4 * i + 3], v[NR - 1][4 * i + 3]} * (f32x2){wb[2], wb[3]}; }
                        asm volatile("" ::: "memory"); } }
                { float acc1[16];
#pragma unroll
                  for (int ep = 0; ep < 8; ++ep) { acc1[2 * ep] = accA[ep][0]; acc1[2 * ep + 1] = accA[ep][1]; }
                  tots[0] = reduce16(acc1, lane); }
                asm volatile("" ::: "memory"); __builtin_amdgcn_sched_barrier(0);
                { float acc1[16];
#pragma unroll
                  for (int ep = 0; ep < 8; ++ep) { acc1[2 * ep] = accB[ep][0]; acc1[2 * ep + 1] = accB[ep][1]; }
                  tots[NR - 1] = reduce16(acc1, lane); }
                if (MODE != 1) { if (lane < 16) { glow[(size_t)row[0] * 16 + lane] = tots[0]; glow[(size_t)row[NR - 1] * 16 + lane] = tots[NR - 1]; } }
            } else
#pragma unroll
            for (int rr = 0; rr < NR; ++rr) {
                asm volatile("" ::: "memory"); __builtin_amdgcn_sched_barrier(0);
                float acc1[16];
                {
                    f32x2 acc2[8];
#pragma unroll
                    for (int ep = 0; ep < 8; ++ep) acc2[ep] = (f32x2){0.f, 0.f};
#pragma unroll
                    for (int i = 0; i < 8; ++i) {
                        const f32x2 s0 = (f32x2){v[rr][4 * i], v[rr][4 * i]}, s1 = (f32x2){v[rr][4 * i + 1], v[rr][4 * i + 1]}, s2 = (f32x2){v[rr][4 * i + 2], v[rr][4 * i + 2]}, s3 = (f32x2){v[rr][4 * i + 3], v[rr][4 * i + 3]};
#pragma unroll
                        for (int eh = 0; eh < 2; ++eh) {
#pragma unroll
                            for (int ep = 4 * eh; ep < 4 * eh + 4; ++ep) { const f32x4 wa = *(const f32x4*)(wT + (ep * DM + 256 * i + 4 * lane) * 2), wb = *(const f32x4*)(wT + (ep * DM + 256 * i + 4 * lane) * 2 + 4);
                                acc2[ep] += s0 * (f32x2){wa[0], wa[1]}; acc2[ep] += s1 * (f32x2){wa[2], wa[3]}; acc2[ep] += s2 * (f32x2){wb[0], wb[1]}; acc2[ep] += s3 * (f32x2){wb[2], wb[3]}; }
                            asm volatile("" ::: "memory"); } }
#pragma unroll
                    for (int ep = 0; ep < 8; ++ep) { acc1[2 * ep] = acc2[ep][0]; acc1[2 * ep + 1] = acc2[ep][1]; }
                }
                tots[rr] = reduce16(acc1, lane);
                if (MODE != 1) { if (lane < 16) glow[(size_t)row[rr] * 16 + lane] = tots[rr]; }
            }
            if (MODE == 1) {
#pragma unroll
              for (int rr = 0; rr < NR; ++rr) { if (lane < 16) rlog[((it + rr) * 8 + wave) * 16 + lane] = tots[rr]; }
            }
        }
    }
    if (MODE == 1) {
        unsigned* cnt = (unsigned*)(p.ws + WS_CTL) + (DUMMY ? CW_DBG + 64 : CW_CNT + layer * 64);
        __syncthreads();
        int e0 = 0, e1 = 0, ls0 = 0, ls1 = 0; float rw0 = 0.f, rw1 = 0.f;
        if (tid < 8 * nit) {
                    float lg[16];
#pragma unroll
                    for (int e = 0; e < 16; ++e) lg[e] = rlog[tid * 16 + e];
                    float mx = lg[0];
#pragma unroll
                    for (int e = 1; e < 16; ++e) mx = fmaxf(mx, lg[e]);
                    float aff[16], bi[16], sum = 0.f;
#pragma unroll
                    for (int e = 0; e < 16; ++e) { aff[e] = __expf(lg[e] - mx); sum += aff[e]; }
                    const float rs = 1.0f / sum;
#pragma unroll
                    for (int e = 0; e < 16; ++e) { aff[e] *= rs; bi[e] = aff[e] + p.in[10][e]; }
                    float gs[4];
#pragma unroll
                    for (int gi = 0; gi < 4; ++gi) { const float a0 = bi[4 * gi], a1 = bi[4 * gi + 1], a2 = bi[4 * gi + 2], a3 = bi[4 * gi + 3];
                        gs[gi] = fmaxf(fmaxf(fmaxf(a0 + a1, a0 + a2), fmaxf(a0 + a3, a1 + a2)), fmaxf(a1 + a3, a2 + a3)); }
                    int best = 0; float bv = gs[0];
#pragma unroll
                    for (int gi = 1; gi < 4; ++gi) if (gs[gi] > bv) { bv = gs[gi]; best = gi; }
                    float ab[4], aa[4];
#pragma unroll
                    for (int k = 0; k < 4; ++k) { ab[k] = best == 0 ? bi[k] : best == 1 ? bi[4 + k] : best == 2 ? bi[8 + k] : bi[12 + k];
                                                  aa[k] = best == 0 ? aff[k] : best == 1 ? aff[4 + k] : best == 2 ? aff[8 + k] : aff[12 + k]; }
                    int i1 = 0; float v1 = ab[0];
#pragma unroll
                    for (int k = 1; k < 4; ++k) if (ab[k] > v1) { v1 = ab[k]; i1 = k; }
                    int i2 = -1; float v2 = -3.0e38f;
#pragma unroll
                    for (int k = 0; k < 4; ++k) if (k != i1 && ab[k] > v2) { v2 = ab[k]; i2 = k; }
                    const float a1 = i1 == 0 ? aa[0] : i1 == 1 ? aa[1] : i1 == 2 ? aa[2] : aa[3];
                    const float a2 = i2 == 0 ? aa[0] : i2 == 1 ? aa[1] : i2 == 2 ? aa[2] : aa[3];
                    const float ws = 1.0f / (a1 + a2);
                    e0 = 4 * best + i1; e1 = 4 * best + i2; rw0 = a1 * ws; rw1 = a2 * ws;
                    ls0 = atomicAdd(&lcnt[e0], 1); ls1 = atomicAdd(&lcnt[e1], 1);
        }
        __syncthreads();
        if (tid < 16) gbase[tid] = (int)atomicAdd(&cnt[tid], (unsigned)lcnt[tid]);
        __syncthreads();
        if (tid < 8 * nit) {
            const int it = tid >> 3, wv = tid & 7, row = (it * (int)gridDim.x + (int)blockIdx.x) * 8 + wv;
            u32x4 a; a.x = (unsigned)e0; a.y = (unsigned)e1; a.z = __float_as_uint(rw0); a.w = __float_as_uint(rw1);
            u32x4 c; c.x = (unsigned)(gbase[e0] + ls0); c.y = (unsigned)(gbase[e1] + ls1); c.z = 0u; c.w = 0u;
            *(u32x4*)(tok + row * 8) = a; *(u32x4*)(tok + row * 8 + 4) = c;
            if (!DUMMY) { unsigned* idx = (unsigned*)(p.ws + WS_IDX); idx[(size_t)e0 * 16384 + c.x] = (unsigned)row; idx[(size_t)e1 * 16384 + c.y] = (unsigned)row; }
        }
        __syncthreads();
    }
    __syncthreads();
}

__device__ void phase_perm(const Params& p, int layer, unsigned char* lds) {
    const int tid = opq_tid(), lane = tid & 63, wave = __builtin_amdgcn_readfirstlane(tid >> 6);
    int* sb = (int*)lds;
    const unsigned* cnt = (const unsigned*)(p.ws + WS_CTL) + CW_CNT + layer * 64;
    unsigned* misc = (unsigned*)(p.ws + WS_MISC) + layer * 256;
    if (tid < 64) {
        const int c = (lane < NE) ? (int)ldu(cnt + lane) : 0;
        const int nP = (c + 255) >> 8;
        int incl = nP;
#pragma unroll
        for (int o = 1; o < 16; o <<= 1) { const int t = __shfl_up(incl, o); if (lane >= o) incl += t; }
        const int excl = incl - nP;
        if (lane < NE) {
            sb[lane] = excl * 256;
            if (blockIdx.x == 0) { misc[16 + lane] = (unsigned)(excl * 256); for (int q = 0; q < nP; ++q) misc[64 + excl + q] = (unsigned)lane; if (lane == NE - 1) misc[0] = (unsigned)incl; }
        }
    }
    __syncthreads();
    unsigned* tok = (unsigned*)(p.ws + WS_TOK);
    const bf16_t* hb = (const bf16_t*)(p.ws + WS_HB); unsigned char* Xs = p.ws + WS_XS;
    const int nit = T / (8 * (int)gridDim.x);
    for (int it = 0; it < nit; ++it) {
        const int row = (it * (int)gridDim.x + (int)blockIdx.x) * 8 + wave;
        const int e0 = (int)ldu(tok + row * 8), e1 = (int)ldu(tok + row * 8 + 1);
        const int r0 = sb[e0] + (int)ldu(tok + row * 8 + 4), r1 = sb[e1] + (int)ldu(tok + row * 8 + 5);
        const u32x4* s = (const u32x4*)(hb + (size_t)row * DM);
#pragma unroll
        for (int hh = 0; hh < 2; ++hh) {
            float f[16]; { float fa[8], fb[8]; unpack8(s[2 * lane + 128 * hh], fa); unpack8(s[2 * lane + 1 + 128 * hh], fb);
#pragma unroll
                for (int i = 0; i < 8; ++i) { f[i] = fa[i] * (float)(1 << X8_SH); f[8 + i] = fb[i] * (float)(1 << X8_SH); } }
            const u32x4 x = {pk4_fp8(f[0], f[1], f[2], f[3]), pk4_fp8(f[4], f[5], f[6], f[7]), pk4_fp8(f[8], f[9], f[10], f[11]), pk4_fp8(f[12], f[13], f[14], f[15])};
            *(u32x4*)(Xs + (size_t)r0 * DM + 16 * lane + 1024 * hh) = x; *(u32x4*)(Xs + (size_t)r1 * DM + 16 * lane + 1024 * hh) = x; }
        if (lane == 0) { tok[row * 8 + 6] = (unsigned)r0; tok[row * 8 + 7] = (unsigned)r1; }
    }
    __syncthreads();
}
constexpr int GL_V = 0, GL_K = 33792, GL_Q = 51200, GL_B = 68608, GL_GLW = 101376, GL_TOT = 105472, GL_AT = 107520, GL_RED = 116736, GL_W = 118784;
#ifndef ATT_LPT
#define ATT_LPT 1
#endif
#ifndef GLA_PROBE
#define GLA_PROBE 0
#endif
#ifndef GLA_NOTR
#define GLA_NOTR 0
#endif
#ifndef ATT_QMAX_DEF
#define ATT_QMAX_DEF 512
#endif
constexpr int ATT_QMAX = ATT_QMAX_DEF;
constexpr int KSB = 272, VSB = 528, ASB = 144;
__device__ __forceinline__ int blx(int row, int col) { return row * 128 + ((((col >> 2) ^ (row & 7))) << 2) + (col & 3); }

__device__ __forceinline__ f32x4 gla_decay(unsigned char* lds) {
    const int tid = opq_tid();
    float* bl = (float*)(lds + GL_B); const float* glw = (const float*)(lds + GL_GLW); float* tot = (float*)(lds + GL_TOT); float* gt = (float*)(lds + GL_AT);
    const int dq = tid & 31, tg = tid >> 5;
    asm volatile("s_waitcnt vmcnt(0)" ::: "memory");
    __syncthreads();
    f32x4 all = (f32x4){0.f, 0.f, 0.f, 0.f};
#pragma unroll 1
    for (int pr_ = 0; pr_ < (GLA_PROBE == 1 ? 5 : 1); ++pr_) {
    const f32x4 bg = *(const f32x4*)((const float*)(lds + GL_W) + 2048 + 4 * dq);
    f32x4 x[4] = {bg, bg, bg, bg};
#pragma unroll
    for (int hf = 0; hf < 2; ++hf) {
        f32x4 w[8];
#pragma unroll
        for (int r = 0; r < 8; ++r) w[r] = *(const f32x4*)((const float*)(lds + GL_W) + (8 * hf + r) * 128 + 4 * dq);
#pragma unroll
        for (int tt = 0; tt < 4; ++tt) { const f32x4* gr = (const f32x4*)(glw + (tg * 4 + tt) * 16 + 8 * hf); const f32x4 g0 = gr[0], g1 = gr[1];
            x[tt] += g0[0] * w[0] + g0[1] * w[1] + g0[2] * w[2] + g0[3] * w[3] + g1[0] * w[4] + g1[1] * w[5] + g1[2] * w[6] + g1[3] * w[7]; }
        __builtin_amdgcn_sched_barrier(0);
    }
    f32x4 run = (f32x4){0.f, 0.f, 0.f, 0.f};
#pragma unroll
    for (int tt = 0; tt < 4; ++tt) {
        const int tk = tg * 4 + tt;
#pragma unroll
        for (int j = 0; j < 4; ++j) run[j] += (fminf(x[tt][j], 0.f) - __logf(1.0f + __expf(-fabsf(x[tt][j])))) * 0.0625f;
        *(f32x4*)(bl + tk * 128 + 4 * dq) = run;
    }
    *(f32x4*)(gt + tg * 128 + 4 * dq) = run;
    __syncthreads();
    f32x4 pre = (f32x4){0.f, 0.f, 0.f, 0.f}; all = pre;
#pragma unroll
    for (int g2 = 0; g2 < 16; ++g2) { const f32x4 tv = *(const f32x4*)(gt + g2 * 128 + 4 * dq); if (g2 < tg) pre += tv; all += tv; }
#pragma unroll
    for (int tt = 0; tt < 4; ++tt) { f32x4* bp = (f32x4*)(bl + (tg * 4 + tt) * 128 + 4 * dq); *bp = *bp + pre; }
    if (tg == 0) { *(f32x4*)(tot + 4 * dq) = all; *(f32x4*)(tot + 128 + 4 * dq) = (f32x4){__expf(all[0]), __expf(all[1]), __expf(all[2]), __expf(all[3])}; }
    __syncthreads();
    }
    return all;
}
__device__ __forceinline__ void gla_stage_v(const bf16_t* proj, int c, int h, unsigned char* lds) {
    const int tid = opq_tid(), tk = tid >> 3, dv0 = (tid & 7) * 32;
    const u32x4* s = (const u32x4*)(proj + ix_gv(h, c * 64 + tk) + dv0);
    u32x4* d = (u32x4*)(lds + GL_V + tk * VSB + dv0 * 2);
#pragma unroll
    for (int i = 0; i < 4; ++i) d[i] = s[i];
}

template <bool OUT>
static __device__ void gla_super_unit(const Params& p, int layer, int sc, int h, unsigned char* lds) {
    const int tid = opq_tid(), lane = tid & 63, wave = tid >> 6, g = lane >> 4, l15 = lane & 15;
    const bf16_t* proj = (const bf16_t*)(p.ws + WS_PROJ);
    const int tk0 = tid >> 3, dk0 = (tid & 7) * 16, dv0 = (tid & 7) * 32;
    const int lbase = (int)(uintptr_t)lds, trow = l15 >> 2, tcol = 4 * (lane & 3);
    const float* bl = (const float*)(lds + GL_B); float* tot = (float*)(lds + GL_TOT);
    f32x4 S[8][2];
    if (OUT && sc > 0) {
        const bf16_t* Sst = (const bf16_t*)(p.ws + WS_S) + ((size_t)sc * 4 + h) * 256 * 128;
#pragma unroll
        for (int m = 0; m < 8; ++m)
#pragma unroll
            for (int nn = 0; nn < 2; ++nn) { const u32x2 w = *(const u32x2*)(Sst + (size_t)(32 * wave + 16 * nn + l15) * 128 + 16 * m + 4 * g);
                S[m][nn] = (f32x4){bflo(w.x), bfhi(w.x), bflo(w.y), bfhi(w.y)}; }
    } else {
#pragma unroll
        for (int m = 0; m < 8; ++m) { S[m][0] = (f32x4){0.f, 0.f, 0.f, 0.f}; S[m][1] = (f32x4){0.f, 0.f, 0.f, 0.f}; }
    }
    f32x4 bsum = (f32x4){0.f, 0.f, 0.f, 0.f};
    if (!OUT) { float* wl = (float*)(lds + GL_W);
#pragma unroll
      for (int j = 0; j < 4; ++j) { const int idx = tid + 512 * j; wl[idx] = p.in[3][(size_t)layer * 16 * 512 + (idx >> 7) * 512 + h * 128 + (idx & 127)]; }
      if (tid < 128) wl[2048 + tid] = p.in[4][layer * 512 + h * 128 + tid]; }
    float* gB = (float*)(p.ws + WS_BDEC);
    u32x4 qreg[2], kreg[2], vreg[4];
    const int wu = __builtin_amdgcn_readfirstlane(wave);
#define GLA_REQ(cq) { const int c_ = (cq); \
        const u32x4* sk = (const u32x4*)(proj + ix_gk(h, c_ * 64 + tk0) + dk0); const u32x4* sv = (const u32x4*)(proj + ix_gv(h, c_ * 64 + tk0) + dv0); \
        kreg[0] = sk[0]; kreg[1] = sk[1]; \
        if (OUT) { const u32x4* sq = (const u32x4*)(proj + ix_gq(h, c_ * 64 + tk0) + dk0); qreg[0] = sq[0]; qreg[1] = sq[1]; } \
        _Pragma("unroll") for (int i = 0; i < 4; ++i) vreg[i] = sv[i]; \
        if (!OUT) { if (wu < 4) __builtin_amdgcn_global_load_lds((const unsigned*)((const float*)(p.ws + WS_GLOW) + (size_t)c_ * 64 * 16 + tid * 4), (PG8_LAS unsigned*)(size_t)(unsigned)(lbase + GL_GLW + wu * 1024), 16, 0, 0); } \
        else { _Pragma("unroll") for (int k_ = 0; k_ < 4; ++k_) __builtin_amdgcn_global_load_lds((const unsigned*)(gB + ((size_t)c_ * 4 + h) * 8192 + (k_ * 512 + tid) * 4), (PG8_LAS unsigned*)(size_t)(unsigned)(lbase + GL_B + k_ * 8192 + wu * 1024), 16, 0, 0); } }
    GLA_REQ(sc * 4);
#pragma unroll 1
    for (int cc = 0; cc < 4; ++cc) {
        const int c = sc * 4 + cc;
        if (!OUT) {
            bsum += gla_decay(lds);
            float* gt_ = gB + ((size_t)c * 4 + h) * 8192;
#pragma unroll
            for (int k_ = 0; k_ < 4; ++k_) *(f32x4*)(gt_ + (k_ * 512 + tid) * 4) = *(const f32x4*)(bl + (k_ * 512 + tid) * 4);
        } else {
            asm volatile("s_waitcnt vmcnt(0)" ::: "memory");
            __syncthreads();
            if (tid < 128) { const float bb = bl[63 * 128 + tid]; tot[tid] = bb; tot[128 + tid] = __expf(bb); }
        }
        if (OUT) {
#pragma unroll
            for (int hlf = 0; hlf < 2; ++hlf) { float fq[8], fk[8]; unpack8(qreg[hlf], fq); unpack8(kreg[hlf], fk);
#pragma unroll
                for (int j = 0; j < 8; ++j) { const float bb = bl[tk0 * 128 + dk0 + hlf * 8 + j]; fq[j] *= __expf(bb) * 0.08838834764831845f; fk[j] *= __expf(-bb); }
                *(u32x4*)(lds + GL_Q + tk0 * KSB + (dk0 + hlf * 8) * 2) = pack8(fq); *(u32x4*)(lds + GL_K + tk0 * KSB + (dk0 + hlf * 8) * 2) = pack8(fk); }
        }
#pragma unroll
        for (int i = 0; i < 4; ++i) *(u32x4*)(lds + GL_V + tk0 * VSB + dv0 * 2 + 16 * i) = vreg[i];
        __syncthreads();
        f32x4 acc[2][4]; u32x2 ggr[4][2]; f32x4 gn[2];
        if (OUT) {
#if GLA_PROBE == 2
#pragma unroll 1
            for (int pr_ = 0; pr_ < 5; ++pr_)
#endif
            { const int mj = wave >> 1;
              f32x4 at[2] = {(f32x4){0.f, 0.f, 0.f, 0.f}, (f32x4){0.f, 0.f, 0.f, 0.f}};
#pragma unroll
              for (int ks = 0; ks < 4; ++ks) {
                  const bf16x8 A = *(const bf16x8*)(lds + GL_K + (16 * mj + l15) * KSB + (32 * ks + 8 * g) * 2);
#pragma unroll
                  for (int t2 = 0; t2 < 2; ++t2) { const int ni = 2 * (wave & 1) + t2; const bf16x8 B = *(const bf16x8*)(lds + GL_Q + (16 * ni + l15) * KSB + (32 * ks + 8 * g) * 2); at[t2] = MFMA16(A, B, at[t2]); }
              }
#pragma unroll
              for (int t2 = 0; t2 < 2; ++t2) { const int ni = 2 * (wave & 1) + t2, i = 16 * ni + l15, j0 = 16 * mj + 4 * g;
                  float v[4];
#pragma unroll
                  for (int r = 0; r < 4; ++r) v[r] = (i >= j0 + r) ? at[t2][r] : 0.f;
                  u32x2 w; w.x = cvt_pk(v[0], v[1]); w.y = cvt_pk(v[2], v[3]); *(u32x2*)(lds + GL_AT + i * ASB + j0 * 2) = w; }
            }
            __syncthreads();
        }
#pragma unroll
        for (int hlf = 0; hlf < 2; ++hlf) { float f[8]; unpack8(kreg[hlf], f);
#pragma unroll
            for (int j = 0; j < 8; ++j) f[j] *= __expf(tot[dk0 + hlf * 8 + j] - bl[tk0 * 128 + dk0 + hlf * 8 + j]);
            *(u32x4*)(lds + GL_K + tk0 * KSB + (dk0 + hlf * 8) * 2) = pack8(f); }
        if (!OUT) GLA_REQ(sc * 4 + (cc < 3 ? cc + 1 : 3));
        if (OUT) {
#pragma unroll
            for (int mm = 0; mm < 2; ++mm)
#pragma unroll
                for (int n = 0; n < 4; ++n) acc[mm][n] = (f32x4){0.f, 0.f, 0.f, 0.f};
#if GLA_PROBE == 3
#pragma unroll 1
            for (int pr_ = 0; pr_ < 5; ++pr_) {
            if (pr_ > 0) {
#pragma unroll
                for (int mm = 0; mm < 2; ++mm)
#pragma unroll
                    for (int n = 0; n < 4; ++n) acc[mm][n] *= 1e-30f; }
#endif
#pragma unroll
            for (int ks = 0; ks < 2; ++ks) {
                const int kb = 32 * ks + 8 * g + trow;
                s16x4 vl[2], vh[2]; bf16x8 B[4];
#pragma unroll
                for (int mm = 0; mm < 2; ++mm) { const int a = lbase + GL_V + kb * VSB + (32 * wave + 16 * mm + tcol) * 2; vl[mm] = tr_rd(a); vh[mm] = tr_rd(a + 4 * VSB); }
#pragma unroll
                for (int n = 0; n < 4; ++n) B[n] = *(const bf16x8*)(lds + GL_AT + (16 * n + l15) * ASB + (32 * ks + 8 * g) * 2);
                LGKM0();
#pragma unroll
                for (int mm = 0; mm < 2; ++mm)
#pragma unroll
                    for (int n = 0; n < 4; ++n) acc[mm][n] = MFMA16(PK8(vl[mm], vh[mm]), B[n], acc[mm][n]);
            }
            if (sc > 0 || cc > 0) {
#pragma unroll
                for (int s = 0; s < 4; ++s) {
                    bf16x8 A[2], B[4];
#pragma unroll
                    for (int mm = 0; mm < 2; ++mm) { u32x4 w; w.x = cvt_pk(S[2 * s][mm][0], S[2 * s][mm][1]); w.y = cvt_pk(S[2 * s][mm][2], S[2 * s][mm][3]);
                        w.z = cvt_pk(S[2 * s + 1][mm][0], S[2 * s + 1][mm][1]); w.w = cvt_pk(S[2 * s + 1][mm][2], S[2 * s + 1][mm][3]); A[mm] = __builtin_bit_cast(bf16x8, w); }
#pragma unroll
                    for (int n = 0; n < 4; ++n) { const unsigned char* qr = lds + GL_Q + (16 * n + l15) * KSB + (32 * s + 4 * g) * 2;
                        const u32x2 lo = *(const u32x2*)qr, hi = *(const u32x2*)(qr + 32); u32x4 w; w.x = lo.x; w.y = lo.y; w.z = hi.x; w.w = hi.y; B[n] = __builtin_bit_cast(bf16x8, w); }
#pragma unroll
                    for (int mm = 0; mm < 2; ++mm)
#pragma unroll
                        for (int n = 0; n < 4; ++n) acc[mm][n] = MFMA16(A[mm], B[n], acc[mm][n]);
                    __builtin_amdgcn_sched_barrier(0);
                }
            }
#if GLA_PROBE == 3
            }
#endif
            GLA_REQ(sc * 4 + (cc < 3 ? cc + 1 : 3));
#pragma unroll
            for (int n = 0; n < 4; ++n)
#pragma unroll
                for (int mm = 0; mm < 2; ++mm) ggr[n][mm] = *(const u32x2*)(proj + ix_gg(h, c * 64 + 16 * n + l15) + 32 * wave + 16 * mm + 4 * g);
#pragma unroll
            for (int mm = 0; mm < 2; ++mm) gn[mm] = *(const f32x4*)(p.in[5] + layer * 256 + 32 * wave + 16 * mm + 4 * g);
            float* red = (float*)(lds + GL_RED);
            float ss[4];
#pragma unroll
            for (int n = 0; n < 4; ++n) { float s = 0.f;
#pragma unroll
                for (int mm = 0; mm < 2; ++mm)
#pragma unroll
                    for (int r = 0; r < 4; ++r) s += acc[mm][n][r] * acc[mm][n][r];
                s += __shfl_xor(s, 16); s += __shfl_xor(s, 32); ss[n] = s; }
            if (g == 0) {
#pragma unroll
                for (int n = 0; n < 4; ++n) red[(16 * n + l15) * 8 + wave] = ss[n]; }
        }
        __syncthreads();
        if (OUT) {
#if GLA_PROBE == 4
#pragma unroll 1
            for (int pr_ = 0; pr_ < 5; ++pr_) {
#endif
            const float* red = (const float*)(lds + GL_RED);
            bf16_t* mix = (bf16_t*)(p.ws + WS_MIX);
#pragma unroll
            for (int n = 0; n < 4; ++n) {
                const int tk = 16 * n + l15; const f32x4 r0 = *(const f32x4*)(red + tk * 8), r1 = *(const f32x4*)(red + tk * 8 + 4);
                const float rstd = rsqrtf(((r0[0] + r0[1]) + (r0[2] + r0[3]) + (r1[0] + r1[1]) + (r1[2] + r1[3])) * (1.0f / 256.0f) + 1e-6f);
                const size_t tg = (size_t)c * 64 + tk;
#pragma unroll
                for (int mm = 0; mm < 2; ++mm) { const int dv = 32 * wave + 16 * mm + 4 * g;
                    const u32x2 gg = ggr[n][mm]; const f32x4 nr = gn[mm];
                    const f32x4 o4 = acc[mm][n] * ((nr * rstd) * (f32x4){silu_f(bflo(gg.x)), silu_f(bfhi(gg.x)), silu_f(bflo(gg.y)), silu_f(bfhi(gg.y))});
                    const float o0 = o4[0], o1 = o4[1], o2 = o4[2], o3 = o4[3];
#if OUT8
                    *(unsigned*)((unsigned char*)mix + tg * DM + h * 256 + dv) = pk4_fp8(o0 * (float)(1 << MIX8_SH), o1 * (float)(1 << MIX8_SH), o2 * (float)(1 << MIX8_SH), o3 * (float)(1 << MIX8_SH)); }
#else
                    u32x2 w; w.x = cvt_pk(o0, o1); w.y = cvt_pk(o2, o3); *(u32x2*)(mix + tg * DM + h * 256 + dv) = w; }
#endif
            }
#if GLA_PROBE == 4
            }
#endif
        }
        if (!OUT || cc < 3) {
#pragma unroll
            for (int m = 0; m < 8; ++m) { const f32x4 av = *(const f32x4*)(tot + 128 + 16 * m + 4 * g);
#pragma unroll
                for (int nn = 0; nn < 2; ++nn) S[m][nn] *= av; }
#pragma unroll
            for (int ks = 0; ks < 2; ++ks) {
                const int kb = 32 * ks + 8 * g + trow;
                s16x4 al[4], ah[4], vl[2], vh[2];
#pragma unroll
                for (int nn = 0; nn < 2; ++nn) { const int a = lbase + GL_V + kb * VSB + (32 * wave + 16 * nn + tcol) * 2; vl[nn] = tr_rd(a); vh[nn] = tr_rd(a + 4 * VSB); }
#pragma unroll
                for (int mh = 0; mh < 2; ++mh) {
#pragma unroll
                    for (int m = 0; m < 4; ++m) { const int a = lbase + GL_K + kb * KSB + (16 * (4 * mh + m) + tcol) * 2; al[m] = tr_rd(a); ah[m] = tr_rd(a + 4 * KSB); }
                    LGKM0();
#pragma unroll
                    for (int m = 0; m < 4; ++m)
#pragma unroll
                        for (int nn = 0; nn < 2; ++nn) S[4 * mh + m][nn] = MFMA16(PK8(al[m], ah[m]), PK8(vl[nn], vh[nn]), S[4 * mh + m][nn]);
                    __builtin_amdgcn_sched_barrier(0);
                }
            }
        }
        __syncthreads();
    }
    if (!OUT) {
        bf16_t* E = (bf16_t*)(p.ws + WS_U);
#pragma unroll
        for (int m = 0; m < 8; ++m)
#pragma unroll
            for (int nn = 0; nn < 2; ++nn) { const int dv = 32 * wave + 16 * nn + l15, dk = 16 * m + 4 * g;
                u32x2 w; w.x = cvt_pk(S[m][nn][0], S[m][nn][1]); w.y = cvt_pk(S[m][nn][2], S[m][nn][3]);
                *(u32x2*)(E + (((size_t)sc * 4 + h) * 256 + dv) * 128 + dk) = w; }
        if (tid < 32) *(f32x4*)((float*)(p.ws + WS_GDEC) + ((size_t)sc * 4 + h) * 128 + 4 * tid) = (f32x4){__expf(bsum[0]), __expf(bsum[1]), __expf(bsum[2]), __expf(bsum[3])};
    }
}
#undef GLA_REQ
static __device__ void gla_scan(const Params& p, int bi, int nblk, unsigned char* lds) {
    const unsigned* U32 = (const unsigned*)(p.ws + WS_U); unsigned* S32 = (unsigned*)(p.ws + WS_S); const float* gdec = (const float*)(p.ws + WS_GDEC);
    const int tid = opq_tid();
    float* dl = (float*)lds;
    for (int i0 = bi * 256; i0 < 65536; i0 += nblk * 256) {
        const int idx = i0 + (tid & 255), h = i0 >> 14, dk = (2 * idx) & 127;
        unsigned u[64];
        if (tid < 256) {
#pragma unroll
            for (int i = 0; i < 64; ++i) u[i] = U32[(size_t)i * 65536 + idx]; }
#pragma unroll
        for (int k = 0; k < 4; ++k) { const int e = (tid + 512 * k) * 4, c = e >> 7, d = e & 127; *(f32x4*)(dl + e) = *(const f32x4*)(gdec + ((size_t)c * 4 + h) * 128 + d); }
        __syncthreads();
        if (tid < 256) {
            float s0 = 0.f, s1 = 0.f;
#pragma unroll
            for (int i = 0; i < 64; ++i) { S32[(size_t)i * 65536 + idx] = cvt_pk(s0, s1); const f32x2 a = *(const f32x2*)(dl + i * 128 + dk); s0 = a[0] * s0 + bflo(u[i]); s1 = a[1] * s1 + bfhi(u[i]); } }
        __syncthreads();
    }
}

static __device__ void moba_kmean_unit2(const Params& p, int ha, int ja, int hb, int jb, unsigned char* lds) {
    const int tid = opq_tid(), d0 = (tid & 15) * 8, kg = tid >> 4;
    const bf16_t* proj = (const bf16_t*)(p.ws + WS_PROJ);
    u32x4 ra[8], rb[8];
#pragma unroll
    for (int kk = 0; kk < 8; ++kk) { ra[kk] = *(const u32x4*)(proj + ix_mk(ha, ja * 256 + kg * 8 + kk) + d0); rb[kk] = *(const u32x4*)(proj + ix_mk(hb, jb * 256 + kg * 8 + kk) + d0); }
    float acc[8], acd[8];
#pragma unroll
    for (int i = 0; i < 8; ++i) { acc[i] = 0.f; acd[i] = 0.f; }
#pragma unroll
    for (int kk = 0; kk < 8; ++kk) { float f[8], f2[8]; unpack8(ra[kk], f); unpack8(rb[kk], f2);
#pragma unroll
        for (int i = 0; i < 8; ++i) { acc[i] += f[i]; acd[i] += f2[i]; } }
    float* red = (float*)lds;
#pragma unroll
    for (int i = 0; i < 8; ++i) { red[kg * 128 + d0 + i] = acc[i]; red[4096 + kg * 128 + d0 + i] = acd[i]; }
    __syncthreads();
    if (tid < 256) { const int t = tid & 127, ub = tid >> 7; float s = 0.f;
#pragma unroll 8
        for (int q = 0; q < 32; ++q) s += red[ub * 4096 + q * 128 + t];
        ((float*)(p.ws + WS_KMEAN))[((size_t)(ub ? hb : ha) * 64 + (ub ? jb : ja)) * 128 + t] = s * (1.0f / 256.0f); }
    __syncthreads();
}
static __device__ void moba_kmean_unit(const Params& p, int h, int j, unsigned char* lds) {
    const int tid = opq_tid(), d0 = (tid & 15) * 8, kg = tid >> 4;
    const bf16_t* proj = (const bf16_t*)(p.ws + WS_PROJ);
    float acc[8];
#pragma unroll
    for (int i = 0; i < 8; ++i) acc[i] = 0.f;
#pragma unroll
    for (int kk = 0; kk < 8; ++kk) { float f[8]; unpack8(*(const u32x4*)(proj + ix_mk(h, j * 256 + kg * 8 + kk) + d0), f);
#pragma unroll
        for (int i = 0; i < 8; ++i) acc[i] += f[i]; }
    float* red = (float*)lds;
#pragma unroll
    for (int i = 0; i < 8; ++i) red[kg * 128 + d0 + i] = acc[i];
    __syncthreads();
    if (tid < 128) { float s = 0.f;
#pragma unroll 8
        for (int q = 0; q < 32; ++q) s += red[q * 128 + tid];
        ((float*)(p.ws + WS_KMEAN))[((size_t)h * 64 + j) * 128 + tid] = s * (1.0f / 256.0f); }
    __syncthreads();
}

#define TOP3_INS_IF(ok, s, j) do { const float _s = (s); const int _j = (j); const bool _ok = (ok); \
    const bool _c0 = _ok & ((_s > v0) | ((_s == v0) & (_j < i0))), _c1 = _ok & ((_s > v1) | ((_s == v1) & (_j < i1))), _c2 = _ok & ((_s > v2) | ((_s == v2) & (_j < i2))); \
    v2 = _c1 ? v1 : (_c2 ? _s : v2); i2 = _c1 ? i1 : (_c2 ? _j : i2); \
    v1 = _c0 ? v0 : (_c1 ? _s : v1); i1 = _c0 ? i0 : (_c1 ? _j : i1); \
    v0 = _c0 ? _s : v0;              i0 = _c0 ? _j : i0; } while (0)
#define TOP3_INS(s, j) TOP3_INS_IF(true, s, j)

static __device__ void moba_gate_unit(const Params& p, int h, int qb, unsigned char* lds) {
    const int tid = opq_tid(), lane = tid & 63, wave = tid >> 6, g = lane >> 4, l15 = lane & 15;
    const bf16_t* proj = (const bf16_t*)(p.ws + WS_PROJ);
    unsigned* selp = (unsigned*)(p.ws + WS_SEL) + (size_t)h * T + qb * 256;
    if (qb == 0) { if (tid < 256) selp[tid] = 0xFFFFFFFFu; return; }
    constexpr int GSB = 272, GLO = 64 * GSB;
    bf16x8 B[2][4];
#pragma unroll
    for (int t2 = 0; t2 < 2; ++t2)
#pragma unroll
        for (int s2 = 0; s2 < 4; ++s2) B[t2][s2] = *(const bf16x8*)(proj + ix_mq(h, qb * 256 + 32 * wave + 16 * t2 + l15) + 32 * s2 + 8 * g);
    { const int j = tid >> 3, c0 = (tid & 7) * 16;
      {
          const f32x4* src = (const f32x4*)((const float*)(p.ws + WS_KMEAN) + ((size_t)h * 64 + j) * 128 + c0);
          u32x4 hi[2], lo[2];
#pragma unroll
          for (int k = 0; k < 2; ++k) { const f32x4 a = src[2 * k], b = src[2 * k + 1];
              hi[k].x = cvt_pk(a[0], a[1]); hi[k].y = cvt_pk(a[2], a[3]); hi[k].z = cvt_pk(b[0], b[1]); hi[k].w = cvt_pk(b[2], b[3]);
              lo[k].x = cvt_pk(a[0] - bflo(hi[k].x), a[1] - bfhi(hi[k].x)); lo[k].y = cvt_pk(a[2] - bflo(hi[k].y), a[3] - bfhi(hi[k].y));
              lo[k].z = cvt_pk(b[0] - bflo(hi[k].z), b[1] - bfhi(hi[k].z)); lo[k].w = cvt_pk(b[2] - bflo(hi[k].w), b[3] - bfhi(hi[k].w)); }
          *(u32x4*)(lds + j * GSB + c0 * 2) = hi[0]; *(u32x4*)(lds + j * GSB + c0 * 2 + 16) = hi[1];
          *(u32x4*)(lds + GLO + j * GSB + c0 * 2) = lo[0]; *(u32x4*)(lds + GLO + j * GSB + c0 * 2 + 16) = lo[1]; } }
    __syncthreads();
    f32x4 acc[2][4];
#pragma unroll
    for (int t2 = 0; t2 < 2; ++t2)
#pragma unroll
        for (int n = 0; n < 4; ++n) acc[t2][n] = (f32x4){0.f, 0.f, 0.f, 0.f};
#pragma unroll
    for (int n = 0; n < 4; ++n) {
        {
#pragma unroll
            for (int s2 = 0; s2 < 4; ++s2) {
                const bf16x8 Ah = *(const bf16x8*)(lds + (16 * n + l15) * GSB + (32 * s2 + 8 * g) * 2), Al = *(const bf16x8*)(lds + GLO + (16 * n + l15) * GSB + (32 * s2 + 8 * g) * 2);
#pragma unroll
                for (int t2 = 0; t2 < 2; ++t2) { acc[t2][n] = MFMA16(Ah, B[t2][s2], acc[t2][n]); acc[t2][n] = MFMA16(Al, B[t2][s2], acc[t2][n]); }
            }
        }
    }
#pragma unroll
    for (int t2 = 0; t2 < 2; ++t2) {
        float v0 = -3.0e38f, v1 = -3.0e38f, v2 = -3.0e38f; int i0 = 255, i1 = 255, i2 = 255;
#pragma unroll
        for (int n = 0; n < 4; ++n)
#pragma unroll
            for (int r = 0; r < 4; ++r) { const int j = 16 * n + 4 * g + r; TOP3_INS_IF(j < qb, acc[t2][n][r], j); }
#pragma unroll
        for (int o = 16; o <= 32; o <<= 1) {
            const float c0 = __shfl_xor(v0, o), c1 = __shfl_xor(v1, o), c2 = __shfl_xor(v2, o); const int j0 = __shfl_xor(i0, o), j1 = __shfl_xor(i1, o), j2 = __shfl_xor(i2, o);
            TOP3_INS_IF(j0 != 255, c0, j0);
            TOP3_INS_IF(j1 != 255, c1, j1);
            TOP3_INS_IF(j2 != 255, c2, j2);
        }
        if (g == 0) selp[32 * wave + 16 * t2 + l15] = (unsigned)i0 | ((unsigned)i1 << 8) | ((unsigned)i2 << 16) | 0xFF000000u;
    }
    __syncthreads();
}

__device__ __forceinline__ int list_off(int j) { return 256 * (63 * j - (j * (j - 1)) / 2); }

static __device__ void moba_list_unit(const Params& p, int layer, int h, int j, unsigned char* lds) {
    const int tid = opq_tid(), lane = tid & 63, wave = tid >> 6;
    const unsigned* sel = (const unsigned*)(p.ws + WS_SEL) + (size_t)h * T;
    unsigned* list = (unsigned*)(p.ws + WS_LIST) + (size_t)h * LISTH + list_off(j);
    int* wcnt = (int*)lds;
    int total = 0;
    const u32x4 none = {0xFFFFFFFFu, 0xFFFFFFFFu, 0xFFFFFFFFu, 0xFFFFFFFFu};
    const int qs = (j + 1) * 256 + 4 * tid;
    u32x4 wa = none, wb = none, wc = none;
    if (qs < T) wa = *(const u32x4*)(sel + qs);
    if (qs + 4 * NTHR < T) wb = *(const u32x4*)(sel + qs + 4 * NTHR);
    if (qs + 8 * NTHR < T) wc = *(const u32x4*)(sel + qs + 8 * NTHR);
#pragma unroll 1
    for (int q0 = (j + 1) * 256; q0 < T; q0 += 4 * NTHR) {
        const int q = q0 + 4 * tid;
        const u32x4 w4 = wa; wa = wb; wb = wc; wc = none;
        if (q + 12 * NTHR < T) wc = *(const u32x4*)(sel + q + 12 * NTHR);
        int slot[4], cntl = 0;
#pragma unroll
        for (int i = 0; i < 4; ++i) { const unsigned w = w4[i];
            slot[i] = ((w & 0xFF) == (unsigned)j) ? 0 : (((w >> 8) & 0xFF) == (unsigned)j) ? 1 : (((w >> 16) & 0xFF) == (unsigned)j) ? 2 : -1; cntl += slot[i] >= 0; }
        int incl = cntl;
#pragma unroll
        for (int o = 1; o < 64; o <<= 1) { const int t2 = __shfl_up(incl, o); if (lane >= o) incl += t2; }
        if (lane == 63) wcnt[wave] = incl;
        __syncthreads();
        int off = total + incl - cntl, tot = 0;
#pragma unroll
        for (int w2 = 0; w2 < 8; ++w2) { const int cw = wcnt[w2]; off += (w2 < wave) ? cw : 0; tot += cw; }
#pragma unroll
        for (int i = 0; i < 4; ++i) if (slot[i] >= 0) { list[off] = (unsigned)(q + i) | ((unsigned)slot[i] << 16); ++off; }
        total += tot;
        __syncthreads();
    }
    if (tid == 0) {
        unsigned* ctl = (unsigned*)(p.ws + WS_CTL);
        const int nit = total > 0 ? (total + ATT_QMAX - 1) / ATT_QMAX : 1;
        u32x4* items = (u32x4*)(p.ws + WS_ITEMS) + layer * 4096;
#if ATT_LPT
        if (nit > 1) { const unsigned bf = atomicAdd(&ctl[CW_NIT + layer * 64 + 1], (unsigned)(nit - 1));
            for (int c = 0; c < nit - 1; ++c) items[bf + c] = (u32x4){(unsigned)h, (unsigned)j, (unsigned)c, (unsigned)total}; }
        const unsigned bb = atomicAdd(&ctl[CW_NIT + layer * 64 + 2], 1u);
        items[4095 - bb] = (u32x4){(unsigned)h, (unsigned)j, (unsigned)(nit - 1), (unsigned)total};
#else
        { const unsigned bf = atomicAdd(&ctl[CW_NIT + layer * 64 + 1], (unsigned)nit);
            for (int c = 0; c < nit; ++c) items[bf + c] = (u32x4){(unsigned)h, (unsigned)j, (unsigned)c, (unsigned)total}; }
#endif
        atomicAdd(&ctl[CW_NIT + layer * 64], (unsigned)nit);
    }
}
namespace att {
constexpr int D = 128, NW = 8, QBLK = 32, KVBLK = 64, LDK = 128;
constexpr float SCALE = 0.088388347648318440f, THR = 8.f;
constexpr float CEXP = SCALE * 1.4426950408889634f;
constexpr size_t SHM_V = KVBLK * D * 2, SHM_K = KVBLK * D * 2;
#define KSWZ(row, colB) ((row) * 256 + ((colB) ^ (((row) & 7) << 4)))
#define SBAR() __builtin_amdgcn_sched_barrier(0)
__device__ __forceinline__ int crow(int r, int hi) { return (r & 3) + 8 * (r >> 2) + 4 * hi; }
__device__ __forceinline__ unsigned cvtpk(float lo, float hi) { return cvt_pk(lo, hi); }

__device__ __forceinline__ void partialSM(f32x16& p0, f32x16& p1, float& m_reg, float& mn, float& alpha) {
  constexpr float C = CEXP;
  float pmax = p0[0];
#pragma unroll
  for (int r = 1; r < 16; ++r) pmax = fmaxf(pmax, p0[r]);
#pragma unroll
  for (int r = 0; r < 16; ++r) pmax = fmaxf(pmax, p1[r]);
  { auto rr = __builtin_amdgcn_permlane32_swap(__float_as_uint(pmax), __float_as_uint(pmax), false, false);
    pmax = fmaxf(__uint_as_float(rr[0]), __uint_as_float(rr[1])); }
  if (__builtin_expect(__all(pmax - m_reg <= THR / SCALE), 1)) { mn = m_reg; alpha = 1.f; }
  else { mn = fmaxf(m_reg, pmax); alpha = __builtin_amdgcn_exp2f((m_reg - mn) * C); m_reg = mn; }
  const float mnC = -mn * C;
  { f32x16 cv, mv;
#pragma unroll
    for (int r = 0; r < 16; ++r) { cv[r] = C; mv[r] = mnC; }
    p0 = p0 * cv + mv; p1 = p1 * cv + mv; }
#pragma unroll
  for (int r = 0; r < 16; ++r) p0[r] = __builtin_amdgcn_exp2f(p0[r]);
}
__device__ __forceinline__ void finishSM(f32x16& p0, f32x16& p1, float alpha, float& l_reg, bf16x8& pa0, bf16x8& pa1, bf16x8& pa2, bf16x8& pa3) {
#pragma unroll
  for (int r = 0; r < 16; ++r) p1[r] = __builtin_amdgcn_exp2f(p1[r]);
  float ps;
  { const f32x16 s16 = p0 + p1;
    float t8[8];
#pragma unroll
    for (int r = 0; r < 8; ++r) t8[r] = s16[2 * r] + s16[2 * r + 1];
    ps = ((t8[0] + t8[1]) + (t8[2] + t8[3])) + ((t8[4] + t8[5]) + (t8[6] + t8[7])); }
  { auto rr = __builtin_amdgcn_permlane32_swap(__float_as_uint(ps), __float_as_uint(ps), false, false);
    ps = __uint_as_float(rr[0]) + __uint_as_float(rr[1]); }
  l_reg = l_reg * alpha + ps;
#define PK4(P, BASE, OUT) do { unsigned a0 = cvtpk(P[BASE + 0], P[BASE + 1]), a1 = cvtpk(P[BASE + 2], P[BASE + 3]);   \
    unsigned b0 = cvtpk(P[BASE + 4], P[BASE + 5]), b1 = cvtpk(P[BASE + 6], P[BASE + 7]);                              \
    auto r0 = __builtin_amdgcn_permlane32_swap(a0, b0, false, false); auto r1 = __builtin_amdgcn_permlane32_swap(a1, b1, false, false); \
    u32x4 w = {r0[0], r1[0], r0[1], r1[1]}; OUT = *reinterpret_cast<bf16x8*>(&w); } while (0)
  PK4(p0, 0, pa0); PK4(p0, 8, pa1); PK4(p1, 0, pa2); PK4(p1, 8, pa3);
#undef PK4
}
__device__ __forceinline__ void qkt(f32x16& p0, f32x16& p1, const char* Ks, const bf16x8* qr, int r32, int hi) {
  p0 = f32x16{}; p1 = f32x16{};
#pragma unroll
  for (int d0 = 0; d0 < 8; ++d0) { const int cb = (d0 * 16 + hi * 8) * 2;
    const bf16x8 b0 = *reinterpret_cast<const bf16x8*>(Ks + KSWZ(r32, cb));
    const bf16x8 b1 = *reinterpret_cast<const bf16x8*>(Ks + KSWZ(32 + r32, cb));
    p0 = __builtin_amdgcn_mfma_f32_32x32x16_bf16(b0, qr[d0], p0, 0, 0, 0);
    p1 = __builtin_amdgcn_mfma_f32_32x32x16_bf16(b1, qr[d0], p1, 0, 0, 0); }
}
__device__ __forceinline__ void mask_tile(f32x16& p0, f32x16& p1, int tile, int qrow, int hi) {
  const int t_ = qrow - tile * 64 - 4 * hi;
#pragma unroll
  for (int r = 0; r < 16; ++r) { const int kc = (r & 3) + 8 * (r >> 2); if (kc > t_) p0[r] = -1.0e30f; if (kc + 32 > t_) p1[r] = -1.0e30f; }
}
__device__ __forceinline__ int v_st(int k, int c) { const int kk = (k & ~0xC) | ((k & 4) << 1) | ((k & 8) >> 1); return ((kk >> 3) * 4 + (c >> 5)) * 512 + ((kk & 7) * 32 + (c & 31)) * 2; }
__device__ __forceinline__ int v_rd_base(int lane) { return ((lane & 3) << 3) | (((lane >> 2) & 3) << 6) | (((lane >> 4) & 1) << 5) | (((lane >> 5) & 1) << 8); }
constexpr int v_rd_off(int d0, int ks, int half) { return d0 * 512 + ks * 4096 + half * 2048; }
template <int OFF> __device__ __forceinline__ s16x4 tr_read(int vb) {
  s16x4 r; asm volatile("ds_read_b64_tr_b16 %0, %1 offset:%2" : "=&v"(r) : "v"(vb), "i"(OFF) : "memory"); return r;
}
template <int D0> __device__ __forceinline__ void pv_one(f32x16& od, int vb, bf16x8 pa0, bf16x8 pa1, bf16x8 pa2, bf16x8 pa3) {
  const s16x4 l0 = tr_read<v_rd_off(D0, 0, 0)>(vb), h0 = tr_read<v_rd_off(D0, 0, 1)>(vb), l1 = tr_read<v_rd_off(D0, 1, 0)>(vb), h1 = tr_read<v_rd_off(D0, 1, 1)>(vb);
  const s16x4 l2 = tr_read<v_rd_off(D0, 2, 0)>(vb), h2 = tr_read<v_rd_off(D0, 2, 1)>(vb), l3 = tr_read<v_rd_off(D0, 3, 0)>(vb), h3 = tr_read<v_rd_off(D0, 3, 1)>(vb);
  asm volatile("s_waitcnt lgkmcnt(0)" ::: "memory"); SBAR();
  od = __builtin_amdgcn_mfma_f32_32x32x16_bf16(pa0, PK8(l0, h0), od, 0, 0, 0);
  od = __builtin_amdgcn_mfma_f32_32x32x16_bf16(pa1, PK8(l1, h1), od, 0, 0, 0);
  od = __builtin_amdgcn_mfma_f32_32x32x16_bf16(pa2, PK8(l2, h2), od, 0, 0, 0);
  od = __builtin_amdgcn_mfma_f32_32x32x16_bf16(pa3, PK8(l3, h3), od, 0, 0, 0);
}
__device__ __forceinline__ void pv_d0(f32x16* o, int vb, bf16x8 pa0, bf16x8 pa1, bf16x8 pa2, bf16x8 pa3) {
  pv_one<0>(o[0], vb, pa0, pa1, pa2, pa3); pv_one<1>(o[1], vb, pa0, pa1, pa2, pa3); pv_one<2>(o[2], vb, pa0, pa1, pa2, pa3); pv_one<3>(o[3], vb, pa0, pa1, pa2, pa3);
}

__device__ __forceinline__ void moba_item(const bf16_t* __restrict__ proj, int h, int jblk, const unsigned* list, int nvalid, bf16_t* PO, float* PML, char* lds) {
  const int tid = opq_tid(), wid = tid >> 6, lane = tid & 63, r32 = lane & 31, hi = lane >> 5;
  const bool own = (list == nullptr);
  char* V_lds = lds; char* K_lds = lds + 2 * SHM_V;
  float* ws = (float*)(lds + 2 * SHM_V + 2 * SHM_K) + wid * 64; float* al_l = ws + 32;
  float m_reg = -1e30f, l_reg = 0; f32x16 o[4] = {}; bf16x8 qr[8];
  const int myrow = wid * QBLK + r32;
  int q, slot; bool valid;
  if (own) { q = jblk * 256 + myrow; slot = 3; valid = true; }
  else { const int rr = myrow < nvalid ? myrow : nvalid - 1; const unsigned e = list[rr]; q = (int)(e & 0xFFFFu); slot = (int)(e >> 16); valid = myrow < nvalid; }
  const bf16_t* Qw = proj + ix_mq(h, q) + hi * 8;
#pragma unroll
  for (int d0 = 0; d0 < 8; ++d0) qr[d0] = *reinterpret_cast<const bf16x8*>(Qw + d0 * 16);
  const bf16_t* Kh = proj + ix_mk(h, jblk * 256);
  const bf16_t* Vh = proj + ix_mv(h, jblk * 256);
  const int sr = tid >> 4, sc = (tid & 15) * 8, vst0 = v_st(sr, sc), vst1 = v_st(32 + sr, sc);
  const int vb0 = (int)(uintptr_t)V_lds + v_rd_base(lane);
  struct { bf16x8 vs0, vs1, ks0, ks1; } sr_[2];
#define SLOAD(i, k0) do { sr_[i].vs0 = *(const bf16x8*)(&Vh[(size_t)((k0) + sr) * LDK + sc]); sr_[i].vs1 = *(const bf16x8*)(&Vh[(size_t)((k0) + 32 + sr) * LDK + sc]); \
    sr_[i].ks0 = *(const bf16x8*)(&Kh[(size_t)((k0) + sr) * LDK + sc]); sr_[i].ks1 = *(const bf16x8*)(&Kh[(size_t)((k0) + 32 + sr) * LDK + sc]); } while (0)
#define SWRITE(b, i) do { *(bf16x8*)(V_lds + (b) * SHM_V + vst0) = sr_[i].vs0;          \
    *(bf16x8*)(V_lds + (b) * SHM_V + vst1) = sr_[i].vs1; const int kc = sc * 2;               \
    *(bf16x8*)(K_lds + (b) * SHM_K + KSWZ(sr, kc)) = sr_[i].ks0;                       \
    *(bf16x8*)(K_lds + (b) * SHM_K + KSWZ(32 + sr, kc)) = sr_[i].ks1; } while (0)
#define SWAIT() asm volatile("s_waitcnt vmcnt(4)" ::: "memory")
#define RESC(a) do { if (__any((a) < 1.f)) { if (hi == 0) al_l[r32] = (a); asm volatile("s_waitcnt lgkmcnt(0)" ::: "memory"); \
    _Pragma("unroll") for (int d = 0; d < 4; ++d) _Pragma("unroll") for (int r = 0; r < 16; ++r) o[d][r] *= al_l[crow(r, hi)]; } } while (0)
  f32x16 pA0, pA1, pB0, pB1; float mnA, mnB, alA, alB; bf16x8 pa0, pa1, pa2, pa3;
  constexpr int NT = 4, SE = 0, SO = 1;
  SLOAD(SE, 0); asm volatile("s_waitcnt vmcnt(0)" ::: "memory"); SWRITE(0, SE); __syncthreads();
  qkt(pA0, pA1, K_lds, qr, r32, hi); if (own) mask_tile(pA0, pA1, 0, myrow, hi); partialSM(pA0, pA1, m_reg, mnA, alA);
  SLOAD(SO, KVBLK); SLOAD(SE, 2 * KVBLK);
  SWAIT(); SWRITE(1, SO); __syncthreads();
  {
    SBAR(); qkt(pB0, pB1, K_lds + SHM_K, qr, r32, hi); if (own) mask_tile(pB0, pB1, 1, myrow, hi);
    finishSM(pA0, pA1, alA, l_reg, pa0, pa1, pa2, pa3); SBAR();
    SLOAD(SO, 3 * KVBLK); SBAR();
    pv_d0(o, vb0, pa0, pa1, pa2, pa3); partialSM(pB0, pB1, m_reg, mnB, alB);
    __syncthreads(); SWAIT(); SWRITE(0, SE);
    RESC(alB); __syncthreads();
    SBAR(); qkt(pA0, pA1, K_lds, qr, r32, hi); if (own) mask_tile(pA0, pA1, 2, myrow, hi);
    finishSM(pB0, pB1, alB, l_reg, pa0, pa1, pa2, pa3); SBAR();
    pv_d0(o, vb0 + (int)SHM_V, pa0, pa1, pa2, pa3); partialSM(pA0, pA1, m_reg, mnA, alA);
    __syncthreads(); asm volatile("s_waitcnt vmcnt(0)" ::: "memory"); SWRITE(1, SO);
    RESC(alA); __syncthreads();
  }
  SBAR(); qkt(pB0, pB1, K_lds + SHM_K, qr, r32, hi); if (own) mask_tile(pB0, pB1, 3, myrow, hi);
  finishSM(pA0, pA1, alA, l_reg, pa0, pa1, pa2, pa3); SBAR();
  pv_d0(o, vb0, pa0, pa1, pa2, pa3); partialSM(pB0, pB1, m_reg, mnB, alB);
  __syncthreads(); RESC(alB);
  finishSM(pB0, pB1, alB, l_reg, pa0, pa1, pa2, pa3); SBAR();
  pv_d0(o, vb0 + (int)SHM_V, pa0, pa1, pa2, pa3);
  __syncthreads();
  unsigned short* st = (unsigned short*)(lds + wid * 8192);
#pragma unroll
  for (int d0 = 0; d0 < 4; ++d0)
#pragma unroll
    for (int r = 0; r < 16; ++r) st[crow(r, hi) * 128 + 32 * d0 + r32] = (unsigned short)(cvtpk(o[d0][r], o[d0][r]) & 0xFFFFu);
  const int porow = valid ? ((q * 8 + h) * 4 + slot) : -1;
  if (hi == 0 && valid) { PML[(size_t)porow * 2] = m_reg * CEXP; PML[(size_t)porow * 2 + 1] = l_reg; }
  asm volatile("s_waitcnt lgkmcnt(0)" ::: "memory");
#pragma unroll
  for (int it = 0; it < 8; ++it) {
    const int row = it * 4 + (lane >> 4), ch = lane & 15;
    const int pr = __shfl(porow, row);
    const u32x4 vv = *(const u32x4*)(st + row * 128 + ch * 8);
    if (pr >= 0) *(u32x4*)(PO + (size_t)pr * 128 + ch * 8) = vv;
  }
  __syncthreads();
#undef SLOAD
#undef SWRITE
#undef SWAIT
#undef RESC
}

#ifndef ATT_PROBE
#define ATT_PROBE 0
#endif
constexpr int ATT2_QMAX = 768;
__device__ __forceinline__ void moba_item2(const bf16_t* __restrict__ proj, int h, int jblk, const unsigned* list, int nrows, int nown, bf16_t* PO, float* PML, char* lds,
                                           const unsigned* items, int nit, int nfront, unsigned nxt, unsigned (&dsc)[4], bool ldr) {
  const int tid = opq_tid(), wid = tid >> 6, lane = tid & 63, r32 = lane & 31, hi = lane >> 5;
  char* V_lds = lds; char* K_lds = lds + 65536;
  float* al_l = (float*)(lds + LDS_SCR + 4096) + wid * 32;
  unsigned short* st = (unsigned short*)(lds + LDS_SCR + 4096 + 1024 + wid * 2048);
  const int vb0 = (int)(uintptr_t)V_lds + v_rd_base(lane);
  const int no = nown >> 5, ngroups = no + ((nrows + 31) >> 5);
#define ENTRY(gg) (((gg) < no) ? (unsigned)(jblk * 256 + (gg) * 32 + r32) | (3u << 16) : list[(((gg) - no) * 32 + r32) < nrows ? (((gg) - no) * 32 + r32) : nrows - 1])
  unsigned e_cur = 0u, e_nxt = 0u; bf16x8 qrn[8];
  if (wid < ngroups) { e_cur = ENTRY(wid); if (wid + NW < ngroups) e_nxt = ENTRY(wid + NW); }
#if ATT_PROBE == 1
#pragma unroll 1
  for (int pr_ = 0; pr_ < 3; ++pr_)
#endif
  { const bf16_t* Kh = proj + ix_mk(h, jblk * 256); const bf16_t* Vh = proj + ix_mv(h, jblk * 256);
    const int sc = (tid & 15) * 8;
    bf16x8 kv[8], vv[8];
#pragma unroll
    for (int it = 0; it < 8; ++it) { const int key = it * 32 + (tid >> 4); kv[it] = *(const bf16x8*)(Kh + (size_t)key * 128 + sc); vv[it] = *(const bf16x8*)(Vh + (size_t)key * 128 + sc); }
    if (wid < ngroups) {
      const bf16_t* Qw = proj + ix_mq(h, (int)(e_cur & 0xFFFFu)) + hi * 8;
#pragma unroll
      for (int d0 = 0; d0 < 8; ++d0) qrn[d0] = *reinterpret_cast<const bf16x8*>(Qw + d0 * 16); }
    if (ldr && (int)nxt < nit) { const unsigned sl = (int)nxt < nfront ? nxt : 4095u - (nxt - (unsigned)nfront);
      dsc[0] = ldu(items + sl * 4); dsc[1] = ldu(items + sl * 4 + 1); dsc[2] = ldu(items + sl * 4 + 2); dsc[3] = ldu(items + sl * 4 + 3); }
#pragma unroll
    for (int it = 0; it < 8; ++it) { const int key = it * 32 + (tid >> 4), tl = key >> 6, kr = key & 63;
      *(bf16x8*)(K_lds + tl * 16384 + KSWZ(kr, sc * 2)) = kv[it]; *(bf16x8*)(V_lds + tl * 16384 + v_st(kr, sc)) = vv[it]; }
#if ATT_PROBE == 1
    __syncthreads();
#endif
  }
  __syncthreads();
  for (int g = wid; g < ngroups; g += NW) {
    const bool own = g < no;
    const int myrow = (own ? g : g - no) * 32 + r32;
    const int q = (int)(e_cur & 0xFFFFu), slot = (int)(e_cur >> 16); const bool valid = own || myrow < nrows;
    bf16x8 qr[8];
#pragma unroll
    for (int d0 = 0; d0 < 8; ++d0) qr[d0] = qrn[d0];
    e_cur = e_nxt;
    if (g + NW < ngroups) {
      const bf16_t* Qw = proj + ix_mq(h, (int)(e_cur & 0xFFFFu)) + hi * 8;
#pragma unroll
      for (int d0 = 0; d0 < 8; ++d0) qrn[d0] = *reinterpret_cast<const bf16x8*>(Qw + d0 * 16);
      if (g + 2 * NW < ngroups) e_nxt = ENTRY(g + 2 * NW); }
    float m_reg = -1e30f, l_reg = 0.f; f32x16 o[4] = {};
    const int ntile = own ? ((g * 32 + 31) >> 6) + 1 : 4;
#if ATT_PROBE == 2
#pragma unroll 1
    for (int pr_ = 0; pr_ < 2; ++pr_) {
    if (pr_ == 1) { m_reg = -1e30f; l_reg = 0.f; o[0] = f32x16{}; o[1] = f32x16{}; o[2] = f32x16{}; o[3] = f32x16{}; }
#endif
#pragma unroll 1
    for (int tl = 0; tl < ntile; ++tl) {
      f32x16 p0, p1; float mn, alpha; bf16x8 pa0, pa1, pa2, pa3;
      qkt(p0, p1, K_lds + tl * 16384, qr, r32, hi);
      if (own) mask_tile(p0, p1, tl, myrow, hi);
      partialSM(p0, p1, m_reg, mn, alpha);
      if (__any(alpha < 1.f)) { if (hi == 0) al_l[r32] = alpha; asm volatile("s_waitcnt lgkmcnt(0)" ::: "memory");
#pragma unroll
        for (int d = 0; d < 4; ++d)
#pragma unroll
          for (int r = 0; r < 16; ++r) o[d][r] *= al_l[crow(r, hi)]; }
      finishSM(p0, p1, alpha, l_reg, pa0, pa1, pa2, pa3); SBAR();
      pv_d0(o, vb0 + tl * 16384, pa0, pa1, pa2, pa3);
    }
#if ATT_PROBE == 2
    }
#endif
    const int porow = valid ? ((q * 8 + h) * 4 + slot) : -1;
    if (hi == 0 && valid) { PML[(size_t)porow * 2] = m_reg * CEXP; PML[(size_t)porow * 2 + 1] = l_reg; }
    const int pr = __shfl(porow, lane >> 1);
#if PO8
    if (hi == 0) al_l[r32] = __builtin_amdgcn_rcpf(l_reg) * (float)(1 << PO8_SH);
    asm volatile("s_waitcnt lgkmcnt(0)" ::: "memory");
    float rl_[16];
#pragma unroll
    for (int r = 0; r < 16; ++r) rl_[r] = al_l[crow(r, hi)];
    unsigned char* st8 = (unsigned char*)st;
#pragma unroll
    for (int d0 = 0; d0 < 4; ++d0) {
#pragma unroll
      for (int r = 0; r < 16; r += 2) { const unsigned w = (unsigned)__builtin_amdgcn_cvt_pk_fp8_f32(o[d0][r] * rl_[r], o[d0][r + 1] * rl_[r + 1], 0, false);
        st8[crow(r, hi) * 32 + r32] = (unsigned char)w; st8[crow(r + 1, hi) * 32 + r32] = (unsigned char)(w >> 8); }
      asm volatile("s_waitcnt lgkmcnt(0)" ::: "memory");
      const u32x4 a = *(const u32x4*)(st8 + (lane >> 1) * 32 + (lane & 1) * 16);
      if (pr >= 0) *(u32x4*)((unsigned char*)PO + (size_t)pr * 128 + 32 * d0 + (lane & 1) * 16) = a;
      asm volatile("s_waitcnt lgkmcnt(0)" ::: "memory");
    }
#else
#pragma unroll
    for (int d0 = 0; d0 < 4; ++d0) {
#pragma unroll
      for (int r = 0; r < 16; ++r) st[crow(r, hi) * 32 + r32] = (unsigned short)(cvtpk(o[d0][r], o[d0][r]) & 0xFFFFu);
      asm volatile("s_waitcnt lgkmcnt(0)" ::: "memory");
      const u32x4 a = *(const u32x4*)(st + (lane >> 1) * 32 + (lane & 1) * 16), b = *(const u32x4*)(st + (lane >> 1) * 32 + (lane & 1) * 16 + 8);
      if (pr >= 0) { *(u32x4*)(PO + (size_t)pr * 128 + 32 * d0 + (lane & 1) * 16) = a; *(u32x4*)(PO + (size_t)pr * 128 + 32 * d0 + (lane & 1) * 16 + 8) = b; }
      asm volatile("s_waitcnt lgkmcnt(0)" ::: "memory");
    }
#endif
  }
  __syncthreads();
#undef ENTRY
}
#undef KSWZ
#undef SBAR
}

static __device__ void moba_combine(const Params& p) {
    const bf16_t* PO = (const bf16_t*)(p.ws + WS_PO); const float* PML = (const float*)(p.ws + WS_PML); bf16_t* mix = (bf16_t*)(p.ws + WS_MIX);
    const int stride = (int)gridDim.x * NTHR;
    for (int base = blockIdx.x * NTHR + opq_tid(); base < T * 8 * 16; base += 4 * stride) {
        u32x4 po[4][4]; f32x2 ml[4][4];
#pragma unroll
        for (int u = 0; u < 4; ++u) { const int idx = base + u * stride, ch = idx & 15, qh = idx >> 4, qb = qh >> 11, nv = qb < 3 ? qb : 3;
#pragma unroll
            for (int k = 0; k < 4; ++k) { const bool ok = (k == 3) || (k < nv);
                ml[u][k] = (f32x2){-3.0e38f, 0.f}; po[u][k] = (u32x4){0u, 0u, 0u, 0u};
#if PO8
                if (ok) { ml[u][k] = *(const f32x2*)(PML + ((size_t)qh * 4 + k) * 2); const u32x2 t8 = *(const u32x2*)((const unsigned char*)PO + ((size_t)qh * 4 + k) * 128 + ch * 8); po[u][k].x = t8.x; po[u][k].y = t8.y; } } }
#else
                if (ok) { ml[u][k] = *(const f32x2*)(PML + ((size_t)qh * 4 + k) * 2); po[u][k] = *(const u32x4*)(PO + ((size_t)qh * 4 + k) * 128 + ch * 8); } } }
#endif
#pragma unroll
        for (int u = 0; u < 4; ++u) { const int idx = base + u * stride, ch = idx & 15, qh = idx >> 4, q = qh >> 3, h = qh & 7;
            float M = -3.0e38f;
#pragma unroll
            for (int k = 0; k < 4; ++k) M = fmaxf(M, ml[u][k][0]);
            float o[8], L = 0.f;
#pragma unroll
            for (int i = 0; i < 8; ++i) o[i] = 0.f;
#pragma unroll
#if PO8
            for (int k = 0; k < 4; ++k) { const float wl = __builtin_amdgcn_exp2f(ml[u][k][0] - M) * ml[u][k][1]; L += wl; const float w = wl * (1.0f / (float)(1 << PO8_SH)); float f[8];
                const f32x2 f01 = __builtin_amdgcn_cvt_pk_f32_fp8((int)po[u][k].x, false), f23 = __builtin_amdgcn_cvt_pk_f32_fp8((int)po[u][k].x, true), f45 = __builtin_amdgcn_cvt_pk_f32_fp8((int)po[u][k].y, false), f67 = __builtin_amdgcn_cvt_pk_f32_fp8((int)po[u][k].y, true);
                f[0] = f01[0]; f[1] = f01[1]; f[2] = f23[0]; f[3] = f23[1]; f[4] = f45[0]; f[5] = f45[1]; f[6] = f67[0]; f[7] = f67[1];
#pragma unroll
                for (int i = 0; i < 8; ++i) o[i] += w * f[i]; }
#else
            for (int k = 0; k < 4; ++k) { const float w = __builtin_amdgcn_exp2f(ml[u][k][0] - M); L += w * ml[u][k][1]; float f[8]; unpack8(po[u][k], f);
#pragma unroll
                for (int i = 0; i < 8; ++i) o[i] += w * f[i]; }
#endif
            const float rl = 1.0f / L;
#pragma unroll
            for (int i = 0; i < 8; ++i) o[i] *= rl;
#if OUT8
            { u32x2 w8; w8.x = pk4_fp8(o[0] * (float)(1 << MIX8_SH), o[1] * (float)(1 << MIX8_SH), o[2] * (float)(1 << MIX8_SH), o[3] * (float)(1 << MIX8_SH));
              w8.y = pk4_fp8(o[4] * (float)(1 << MIX8_SH), o[5] * (float)(1 << MIX8_SH), o[6] * (float)(1 << MIX8_SH), o[7] * (float)(1 << MIX8_SH));
              *(u32x2*)((unsigned char*)mix + (size_t)q * DM + 1024 + h * 128 + ch * 8) = w8; } }
#else
            *(u32x4*)(mix + (size_t)q * DM + 1024 + h * 128 + ch * 8) = pack8(o); }
#endif
    }
}
#ifndef DBL_MASK
#define DBL_MASK 0
#endif
#define REP(k) for (int rep_ = 0; rep_ < (((DBL_MASK >> (k)) & 1) ? 2 : 1); ++rep_)
#ifndef NCV
#define NCV 0
#endif
#ifndef PROBE_MASK
#define PROBE_MASK 0
#endif
#ifndef PHMASK
#define PHMASK 0xFFFF
#endif
enum { PH_CVT = 0, PH_INPROJ, PH_MIXA, PH_MIXB, PH_MIXC, PH_ATT, PH_COMB, PH_OUTPROJ, PH_LN1, PH_PERM, PH_MOE1, PH_MOE2, PH_LN2, NPH };
constexpr int NSLOT = 2 * NPH;
#ifndef MK_DEBUG
#define MK_DEBUG 0
#endif
#if MK_DEBUG
#include "part_chk.inc"
#endif

__device__ __forceinline__ Params opq_params(const Params& p) {
#if !defined(__HIP_DEVICE_COMPILE__)
    return p;
#else
    const __attribute__((address_space(4))) Params* kp = (const __attribute__((address_space(4))) Params*)__builtin_amdgcn_kernarg_segment_ptr();
    asm volatile("" : "+s"(kp));
    return *kp;
#endif
}
#ifndef SUBREP_MASK
#define SUBREP_MASK 0
#endif
#define SUBREP(k) (((SUBREP_MASK >> (k)) & 1) ? 2 : 1)
#ifndef WGM_IN
#define WGM_IN 4
#endif
#ifndef WGM_OUT
#define WGM_OUT 4
#endif
#ifndef WGM_MOE
#define WGM_MOE 4
#endif
#ifndef CVT_REPS
#define CVT_REPS 1
#endif
__global__ void __launch_bounds__(NTHR, 2) mk_fwd(Params p) {
    extern __shared__ __attribute__((aligned(16))) unsigned char lds[];
    const int tid = threadIdx.x;
    for (int u = tid; u < (LDS_BYTES - LDS_SCR) / 4; u += NTHR) ((unsigned*)(lds + LDS_SCR))[u] = 0u;
    __syncthreads();
    unsigned* ctl = (unsigned*)(p.ws + WS_CTL);
    XcdBarrier bar; bar.bar = ctl + CW_BAR; bar.x = 0; bar.st = (volatile LAS unsigned*)(lds + LDS_SCR + 32);
    constexpr int STEP = 2;
    if (p.g_hi - p.g_lo > STEP) bar = xcd_barrier_post(ctl + CW_BAR, (volatile LAS unsigned*)(lds + LDS_SCR + 32));
    if (p.g_hi - p.g_lo > STEP) xcd_barrier_census(bar);
    const int G = (int)gridDim.x, bx = (int)blockIdx.x;
    PG8_LAS unsigned char* lds3 = (PG8_LAS unsigned char*)lds;

#if PROBE_MASK
    unsigned long long tacc = 0ull, tprev = __builtin_amdgcn_s_memrealtime();
#endif
    for (int layer = -1; layer < NLAYER; ++layer) {
        const int s0 = (layer + 1) * NSLOT;
#define IN(k) (((PHMASK >> (k)) & 1) && (layer >= 0 || (k) <= PH_INPROJ) && p.g_lo <= s0 + 2 * (k) && s0 + 2 * (k) < p.g_hi)
#if PROBE_MASK
#define SEAM(k) do { xcd_barrier(bar); if (bx == 0 && tid == 0) { const unsigned long long now = __builtin_amdgcn_s_memrealtime(); if ((PROBE_MASK >> (k)) & 1) tacc += now - tprev; tprev = now; } } while (0)
#else
#ifndef BAR2
#define BAR2 0
#endif
#define SEAM(k) do { if (s0 + 2 * (k) + STEP < p.g_hi) { xcd_barrier(bar); if ((BAR2 >> (k)) & 1) xcd_barrier(bar); } } while (0)
#endif
        if (IN(PH_CVT)) { if (layer < 0) { const Params q = opq_params(p); phase_rope(q); phase_rows<0>(q, 0, lds); } }
        if (IN(PH_INPROJ)) REP(PH_INPROJ) { const Params q = opq_params(p);
#pragma unroll 1
            for (int stp = 0; stp < 2; ++stp) {
                const bool cv = (layer < 0) ? (stp == 0) : (((bx & 1) != 0) == (stp == 0));
                if (cv) { if (rep_ == 0) {
_Pragma("unroll 1")
                    for (int r2_ = 0; r2_ < CVT_REPS; ++r2_) phase_cvt<false, 7>(q, layer < 0 ? 0 : layer, layer < 0 ? 0 : 256, layer < 0 ? 256 : 1024, bx, G, lds); } }
                else if (layer >= 0) {
                    pg8::Gemm g{(const bf16_t*)(q.ws + WS_HBQ), (const bf16_t*)(q.ws + ((layer & 1) ? WS_WIN2 : WS_WIN)), T, NPROJ, DM / 2, 127 - WIN8_SH, 127 - X8_SH}; pg8::StaticOrder S; S.init(T, NPROJ, G, bx, WGM_IN);
                    pg8::EpiProj E{(bf16_t*)(q.ws + WS_PROJ), (const float*)(q.ws + WS_ROPE), (const float*)(q.ws + WS_ROPE) + (size_t)T * 64};
                    pg8::gemm_phase<pg8::EpiProj, pg8::StaticOrder, true, true, true>(lds3, g, S, E);
                }
            }
            SEAM(PH_INPROJ); }
        if (IN(PH_MIXA)) REP(PH_MIXA) { const Params q = opq_params(p);
            if (G == 256) { gla_super_unit<false>(q, layer, bx >> 2, bx & 3, lds); moba_kmean_unit2(q, bx >> 6, bx & 63, (bx + 256) >> 6, bx & 63, lds); }
            else for (int u = bx; u < 768; u += G) { if (u < 256) { _Pragma("unroll 1") for (int r_ = 0; r_ < SUBREP(0); ++r_) gla_super_unit<false>(q, layer, u >> 2, u & 3, lds); } else { _Pragma("unroll 1") for (int r_ = 0; r_ < SUBREP(1); ++r_) moba_kmean_unit(q, (u - 256) >> 6, (u - 256) & 63, lds); } }
            SEAM(PH_MIXA); }
        if (IN(PH_MIXB)) REP(PH_MIXB) { const Params q = opq_params(p);
            { _Pragma("unroll 1") for (int r_ = 0; r_ < SUBREP(2); ++r_) gla_scan(q, bx, G, lds); }
            { int kk = 0; for (int u = bx; u < 512; u += G, ++kk) { const int q0 = u & 63; _Pragma("unroll 1") for (int r_ = 0; r_ < SUBREP(3); ++r_) moba_gate_unit(q, u >> 6, (kk & 1) ? 63 - q0 : q0, lds); } }
            SEAM(PH_MIXB); }
        if (IN(PH_MIXC)) REP(PH_MIXC) { const Params q = opq_params(p);
            for (int u = bx; u < 768; u += G) { if (u < 256) { _Pragma("unroll 1") for (int r_ = 0; r_ < SUBREP(4); ++r_) gla_super_unit<true>(q, layer, u >> 2, u & 3, lds); } else if (rep_ == 0) { const int v = u - 256, j0 = v & 63; moba_list_unit(q, layer, v >> 6, ((v / G) & 1) ? 63 - j0 : j0, lds); } }
            SEAM(PH_MIXC); }
        if (IN(PH_ATT)) REP(PH_ATT) { const Params q = opq_params(p);
            const int nit = __builtin_amdgcn_readfirstlane((int)ldu(ctl + CW_NIT + layer * 64));
            const int nfront = __builtin_amdgcn_readfirstlane((int)ldu(ctl + CW_NIT + layer * 64 + 1));
            const unsigned* items = (const unsigned*)(q.ws + WS_ITEMS) + layer * 4096 * 4;
            unsigned* qhead = ctl + CW_NIT + layer * 64 + 16 + rep_;
            volatile LAS unsigned* qslot = (volatile LAS unsigned*)(lds + LDS_SCR + 64);
            const int qt = opq_tid();
            if (qt == 0) { const unsigned f = atomicAdd(qhead, 1u); qslot[0] = f;
                if ((int)f < nit) { const unsigned sl = (int)f < nfront ? f : 4095u - (f - (unsigned)nfront); qslot[1] = ldu(items + sl * 4); qslot[2] = ldu(items + sl * 4 + 1); qslot[3] = ldu(items + sl * 4 + 2); qslot[4] = ldu(items + sl * 4 + 3); } }
            __syncthreads();
            int it = __builtin_amdgcn_readfirstlane((int)qslot[0]);
            while (it < nit) {
                const int h = __builtin_amdgcn_readfirstlane((int)qslot[1]), j = __builtin_amdgcn_readfirstlane((int)qslot[2]), c = __builtin_amdgcn_readfirstlane((int)qslot[3]), n = __builtin_amdgcn_readfirstlane((int)qslot[4]);
                unsigned nxt = 0u, dsc[4] = {0u, 0u, 0u, 0u};
                if (qt == 0) nxt = atomicAdd(qhead, 1u);
                const unsigned* list = (const unsigned*)(q.ws + WS_LIST) + (size_t)h * LISTH + list_off(j) + c * ATT_QMAX;
                const int rem = n - c * ATT_QMAX, nrows = rem < 0 ? 0 : (rem < ATT_QMAX ? rem : ATT_QMAX);
                __syncthreads();
                att::moba_item2((bf16_t*)(q.ws + WS_PROJ), h, j, list, nrows, c == 0 ? 256 : 0, (bf16_t*)(q.ws + WS_PO), (float*)(q.ws + WS_PML), (char*)lds, items, nit, nfront, nxt, dsc, qt == 0);
                if (qt == 0) { qslot[0] = nxt; qslot[1] = dsc[0]; qslot[2] = dsc[1]; qslot[3] = dsc[2]; qslot[4] = dsc[3]; }
                __syncthreads();
                it = __builtin_amdgcn_readfirstlane((int)qslot[0]);
            }
            SEAM(PH_ATT); }
        if (IN(PH_COMB)) REP(PH_COMB) { const Params q = opq_params(p); moba_combine(q); SEAM(PH_COMB); }
        if (IN(PH_OUTPROJ)) REP(PH_OUTPROJ) { const Params q = opq_params(p);
#if OUT8
            pg8::Gemm g{(const bf16_t*)(q.ws + WS_MIX), (const bf16_t*)(q.ws + WS_WO), T, DM, DM / 2, 127 - WO8_SH, 127 - MIX8_SH}; pg8::StaticOrder S; S.init(T, DM, G, bx, WGM_OUT);
#else
            pg8::Gemm g{(const bf16_t*)(q.ws + WS_MIX), (const bf16_t*)(q.ws + WS_WO), T, DM, DM}; pg8::StaticOrder S; S.init(T, DM, G, bx, WGM_OUT);
#endif
            pg8::EpiOut E{layer == 0 ? q.in[0] : nullptr, (const bf16_t*)(q.ws + WS_HB), (bf16_t*)(q.ws + WS_PRE), DN_ALPHA};
            pg8::gemm_phase<pg8::EpiOut, pg8::StaticOrder, true, true, OUT8 != 0>(lds3, g, S, E);
            SEAM(PH_OUTPROJ); }
#ifndef LNPROBE
#define LNPROBE 0
#endif
        if (IN(PH_LN1)) { const Params q = opq_params(p); if (LNPROBE & 1) { phase_rows<1, true>(q, layer, lds); SEAM(PH_LN1); } phase_rows<1>(q, layer, lds); SEAM(PH_LN1); }
        if (IN(PH_MOE1)) REP(PH_MOE1) { const Params q = opq_params(p);
            int* sbm = (int*)(lds + LDS_SCR + 128);
            moe_bases(ctl + CW_CNT + layer * 64, sbm);
            const int np = __builtin_amdgcn_readfirstlane(sbm[16]) >> 8;
            pg8::Gemm g{(const bf16_t*)(q.ws + WS_HB8), (const bf16_t*)(q.ws + WS_WGU), np * 256, 2048, DM / 2, 127 - WGU8_SH, 127 - X8_SH}; pg8::MoeOrder S; S.init(np * 256, 2048, G, bx, WGM_MOE); S.sb = sbm; S.idx = (const unsigned*)(q.ws + WS_IDX); S.rowbytes = DM;
            pg8::EpiGU E{q.ws + WS_HS};
            pg8::gemm_phase<pg8::EpiGU, pg8::MoeOrder, true, true, true, true>(lds3, g, S, E);
            if (rep_ == 0) phase_cvt<true, 8>(q, layer, 1280, 512, 0, 1, lds, ctl + CW_CVQ + layer * 64);
            SEAM(PH_MOE1); }
        if (IN(PH_MOE2)) REP(PH_MOE2) { const Params q = opq_params(p);
            int* sbm = (int*)(lds + LDS_SCR + 128);
            moe_bases(ctl + CW_CNT + layer * 64, sbm);
            const int np = __builtin_amdgcn_readfirstlane(sbm[16]) >> 8;
            pg8::Gemm g{(const bf16_t*)(q.ws + WS_HS), (const bf16_t*)(q.ws + WS_WD), np * 256, 2048, DEXP / 2, 127 - WD8_SH, 127 - H8_SH}; pg8::MoeOrder S; S.init(np * 256, 2048, G, bx, WGM_MOE); S.sb = sbm; S.idx = (const unsigned*)(q.ws + WS_IDX); S.rowbytes = DEXP;
            pg8::EpiY E{(bf16_t*)(q.ws + WS_YS)};
            pg8::gemm_phase<pg8::EpiY, pg8::MoeOrder, true, true, true>(lds3, g, S, E);
            if (rep_ == 0 && layer + 1 < NLAYER) phase_cvt<true, 3>(q, layer + 1, 0, 256, 0, 1, lds, ctl + CW_CVQ + layer * 64 + 16);
            SEAM(PH_MOE2); }
        if (IN(PH_LN2)) { const Params q = opq_params(p); if (LNPROBE & 2) { phase_rows<2, true>(q, layer, lds); xcd_barrier(bar); } phase_rows<2>(q, layer, lds); SEAM(PH_LN2); }
#undef IN
#undef SEAM
    }
#if PROBE_MASK
    if (bx == 0 && tid == 0) __hip_atomic_store(ctl + CW_DBG, (unsigned)tacc, __ATOMIC_RELAXED, __HIP_MEMORY_SCOPE_AGENT);
    xcd_barrier(bar);
    { const float sc = 1.0f + (float)ldu(ctl + CW_DBG) * (1.0f / 40000.0f);
      for (size_t i = (size_t)bx * NTHR + tid; i < (size_t)T * DM / 4; i += (size_t)G * NTHR) { f32x4 v = ((f32x4*)p.out)[i]; ((f32x4*)p.out)[i] = v * sc; } }
#endif
}

#if MK_DEBUG
__global__ void __launch_bounds__(NTHR, 2) mk_chk(Params p, int layer, int k) { if (k >= 0) chk_phase(p, layer, k); else chk_final(p); }
#endif
#ifndef MK_ONE_LAUNCH
#define MK_ONE_LAUNCH 1
#endif
extern "C" void kernel_launch(void* const* d_in, const int* in_sizes, int n_in, void* d_out, int out_size, void* d_ws, size_t ws_size, hipStream_t stream) {
    static int grid = 0;
    if (grid == 0) {
        if (n_in != 16 || in_sizes[0] != T * DM || out_size != T * DM || ws_size < WS_END) {
            fprintf(stderr, "kernel_launch: unexpected problem: n_in %d in0 %d out %d ws %zu (need >= %zu); nothing launched\n", n_in, n_in > 0 ? in_sizes[0] : -1, out_size, ws_size, (size_t)WS_END); grid = -1; return; }
        int dev = 0, cus = 0, per_cu = 0;
        if (hipGetDevice(&dev) != hipSuccess || hipDeviceGetAttribute(&cus, hipDeviceAttributeMultiprocessorCount, dev) != hipSuccess) { grid = -1; return; }
        if (hipFuncSetAttribute((const void*)mk_fwd, hipFuncAttributeMaxDynamicSharedMemorySize, LDS_BYTES) != hipSuccess) { fprintf(stderr, "kernel_launch: hipFuncSetAttribute failed\n"); grid = -1; return; }
        if (hipOccupancyMaxActiveBlocksPerMultiprocessor(&per_cu, (const void*)mk_fwd, NTHR, LDS_BYTES) != hipSuccess || per_cu < 1)
            fprintf(stderr, "kernel_launch: note: occupancy query reports %d blocks per CU\n", per_cu);
        (void)hipGetLastError();
        grid = cus;
        if (grid != 256) fprintf(stderr, "kernel_launch: note: %d CUs (row phases assume the grid divides 2048 row groups)\n", grid);
        if (2048 % grid != 0) grid = 256;
    }
    if (grid < 0) return;
    if (hipMemsetAsync((char*)d_ws + WS_CTL, 0, CTL_BYTES, stream) != hipSuccess) return;
    Params p{};
    for (int i = 0; i < 16; ++i) p.in[i] = (const float*)d_in[i];
    p.out = (float*)d_out; p.ws = (unsigned char*)d_ws;
#if MK_ONE_LAUNCH
    p.g_lo = 0; p.g_hi = (NLAYER + 1) * NSLOT;
    hipLaunchKernelGGL(mk_fwd, dim3(grid), dim3(NTHR), LDS_BYTES, stream, p);
#else
    for (int s = 0; s < (NLAYER + 1) * NSLOT; s += 2) { p.g_lo = s; p.g_hi = s + 1; hipLaunchKernelGGL(mk_fwd, dim3(grid), dim3(NTHR), LDS_BYTES, stream, p);
#if MK_DEBUG
        if (s >= NSLOT) hipLaunchKernelGGL(mk_chk, dim3(8), dim3(NTHR), 0, stream, p, s / NSLOT - 1, (s % NSLOT) / 2);
#endif
    }
#if MK_DEBUG
    hipLaunchKernelGGL(mk_chk, dim3(grid), dim3(NTHR), 0, stream, p, 0, -1);
#endif
#endif
    const hipError_t le = hipPeekAtLastError();
    if (le != hipSuccess) fprintf(stderr, "kernel_launch: launch failed: %s\n", hipGetErrorName(le));
}
```
